# Optimizing an MI355X kernel written in HIP

```python
import jax
import jax.numpy as jnp
from jax import lax
import numpy as np

D_MODEL = 1024
BATCH = 32
SEQ = 2048
DEPTH = 4

GRID_W = 64
N_MIXERS = 3
HEAD_DIM = 64
D_FF = 4 * D_MODEL
D_PLE = 256
NA_HEADS = D_MODEL // HEAD_DIM
NA_KH_MAX = 8
NA_KW = 16
GQA_HEADS = D_MODEL // HEAD_DIM
GQA_KV_HEADS = GQA_HEADS // 4
GQA_GROUP = GQA_HEADS // GQA_KV_HEADS
Q_BLOCK = 128
ROPE_THETA = 10000.0
ML_HEADS = 8
ML_DV = D_MODEL // ML_HEADS
ML_DQK = ML_DV // 2
ML_CHUNK = 64
N_A = (DEPTH + N_MIXERS - 1) // N_MIXERS
N_B = (DEPTH + N_MIXERS - 2) // N_MIXERS
N_C = DEPTH // N_MIXERS
DN_ALPHA = (2 * DEPTH) ** 0.25
DN_BETA = (8 * DEPTH) ** -0.25
EPS = 1e-6

kernel_name = 'hybrid_natten_gqa_mlstm_encoder'


def layer_norm(x, g, b):
    xf = x.astype(jnp.float32)
    mu = jnp.mean(xf, -1, keepdims=True)
    var = jnp.mean(jnp.square(xf - mu), -1, keepdims=True)
    return ((xf - mu) * lax.rsqrt(var + EPS) * g.astype(jnp.float32) + b.astype(jnp.float32)).astype(x.dtype)


def rms_norm(x, g):
    xf = x.astype(jnp.float32)
    return xf * lax.rsqrt(jnp.mean(jnp.square(xf), -1, keepdims=True) + EPS) * g.astype(jnp.float32)


def neighborhood_attention(x, w_qkv, rpb, w_o):
    bsz, seq, _ = x.shape
    rows = seq // GRID_W
    kh = min(NA_KH_MAX, rows)
    qkv = (x @ w_qkv).reshape(bsz, rows, GRID_W, 3, NA_HEADS, HEAD_DIM)
    q = qkv[:, :, :, 0] * HEAD_DIM ** -0.5
    k = qkv[:, :, :, 1]
    v = qkv[:, :, :, 2]
    col = np.arange(GRID_W)
    c0 = np.clip(col - NA_KW // 2, 0, GRID_W - NA_KW)
    col_in = (col[None, :] >= c0[:, None]) & (col[None, :] < c0[:, None] + NA_KW)
    dc = np.clip(col[None, :] - col[:, None], 1 - NA_KW, NA_KW - 1) + NA_KW - 1

    def row_block(r):
        r0 = jnp.clip(r - kh // 2, 0, rows - kh)
        q_r = lax.dynamic_index_in_dim(q, r, axis=1, keepdims=False)
        k_b = lax.dynamic_slice_in_dim(k, r0, kh, axis=1)
        v_b = lax.dynamic_slice_in_dim(v, r0, kh, axis=1)
        s = jnp.einsum('bqhd,bakhd->bhqak', q_r, k_b, preferred_element_type=jnp.float32)
        dr = r0 + jnp.arange(kh) - r + NA_KH_MAX - 1
        bias = rpb[:, dr[None, :, None], dc[:, None, :]].astype(jnp.float32)
        s = jnp.where(col_in[:, None, :], s + bias, -jnp.inf)
        pr = jax.nn.softmax(s, axis=(-2, -1))
        return jnp.einsum('bhqak,bakhd->bqhd', pr.astype(v.dtype), v_b)

    out = lax.map(row_block, jnp.arange(rows))
    return jnp.moveaxis(out, 0, 1).reshape(bsz, seq, D_MODEL) @ w_o


def axial_rope_tables(seq):
    t = jnp.arange(seq)
    row = (t // GRID_W).astype(jnp.float32)
    col = (t % GRID_W).astype(jnp.float32)
    n_pairs = HEAD_DIM // 4
    inv = ROPE_THETA ** (-jnp.arange(n_pairs, dtype=jnp.float32) / n_pairs)
    ang = jnp.concatenate([row[:, None] * inv, col[:, None] * inv], -1)
    return jnp.cos(ang), jnp.sin(ang)


def apply_rope(x, cos, sin):
    shape = (x.shape[1],) + (1,) * (x.ndim - 3) + (cos.shape[-1],)
    c = cos.reshape(shape)
    s = sin.reshape(shape)
    x0, x1 = x[..., 0::2], x[..., 1::2]
    return jnp.stack([x0 * c - x1 * s, x0 * s + x1 * c], -1).reshape(x.shape)


def gqa_axial(x, w_qkv, q_norm, k_norm, w_o):
    bsz, seq, _ = x.shape
    kvd = GQA_KV_HEADS * HEAD_DIM
    qkv = x @ w_qkv
    q = qkv[..., :D_MODEL].reshape(bsz, seq, GQA_KV_HEADS, GQA_GROUP, HEAD_DIM)
    k = qkv[..., D_MODEL:D_MODEL + kvd].reshape(bsz, seq, GQA_KV_HEADS, HEAD_DIM)
    v = qkv[..., D_MODEL + kvd:].reshape(bsz, seq, GQA_KV_HEADS, HEAD_DIM)
    cos, sin = axial_rope_tables(seq)
    q = (apply_rope(rms_norm(q, q_norm), cos, sin) * HEAD_DIM ** -0.5).astype(x.dtype)
    k = apply_rope(rms_norm(k, k_norm), cos, sin).astype(x.dtype)
    n_blk = seq // Q_BLOCK
    qb = jnp.moveaxis(q.reshape(bsz, n_blk, Q_BLOCK, GQA_KV_HEADS, GQA_GROUP, HEAD_DIM), 1, 0)

    def block(q_blk):
        s = jnp.einsum('bqkgd,bskd->bkgqs', q_blk, k, preferred_element_type=jnp.float32)
        pr = jax.nn.softmax(s, axis=-1)
        return jnp.einsum('bkgqs,bskd->bqkgd', pr.astype(v.dtype), v)

    out = lax.map(block, qb)
    return jnp.moveaxis(out, 0, 1).reshape(bsz, seq, D_MODEL) @ w_o


def mlstm_scan(q, k, v, log_i, log_f):
    bsz, nh, seq, dqk = q.shape
    dv = v.shape[-1]
    nc, L = seq // ML_CHUNK, ML_CHUNK
    qc, kc, vc = [jnp.moveaxis(a.reshape(bsz, nh, nc, L, a.shape[-1]), 2, 0) for a in (q, k, v)]
    ic, fc = [jnp.moveaxis(a.reshape(bsz, nh, nc, L), 2, 0) for a in (log_i, log_f)]
    tri = jnp.tril(jnp.ones((L, L), bool))

    def step(carry, xs):
        C, n, m = carry
        q_, k_, v_, li, lf = xs
        b = jnp.cumsum(lf, axis=-1)
        d = jnp.where(tri, b[..., :, None] - b[..., None, :] + li[..., None, :], -jnp.inf)
        inter = b + m[..., None]
        m_t = jnp.maximum(jnp.max(d, -1), inter)
        w = jnp.exp(d - m_t[..., None])
        s_inter = jnp.exp(inter - m_t)
        qk = jnp.einsum('bhtd,bhsd->bhts', q_, k_) * w
        num = s_inter[..., None] * jnp.einsum('bhtd,bhdv->bhtv', q_, C) + jnp.einsum('bhts,bhsv->bhtv', qk, v_)
        den = s_inter * jnp.einsum('bhtd,bhd->bht', q_, n) + jnp.sum(qk, -1)
        h = num / jnp.maximum(jnp.abs(den), jnp.exp(-m_t))[..., None]
        b_last = b[..., -1]
        g = b_last[..., None] - b + li
        m_new = jnp.maximum(b_last + m, jnp.max(g, -1))
        decay = jnp.exp(b_last + m - m_new)
        wk = jnp.exp(g - m_new[..., None])[..., None] * k_
        C_new = decay[..., None, None] * C + jnp.einsum('bhsd,bhsv->bhdv', wk, v_)
        n_new = decay[..., None] * n + jnp.sum(wk, -2)
        return (C_new, n_new, m_new), h

    init = (jnp.zeros((bsz, nh, dqk, dv), jnp.float32), jnp.zeros((bsz, nh, dqk), jnp.float32),
            jnp.zeros((bsz, nh), jnp.float32))
    _, h = lax.scan(step, init, (qc, kc, vc, ic, fc))
    return jnp.moveaxis(h, 0, 2).reshape(bsz, nh, seq, dv)


def mlstm_mixer(x, w_in, b_gates, norm_g, w_o):
    bsz, seq, _ = x.shape
    qk_w = ML_HEADS * ML_DQK
    z = x @ w_in

    def heads(a, dh):
        return a.reshape(bsz, seq, ML_HEADS, dh).transpose(0, 2, 1, 3).astype(jnp.float32)

    q = heads(z[..., :qk_w], ML_DQK) * ML_DQK ** -0.5
    k = heads(z[..., qk_w:2 * qk_w], ML_DQK)
    v = heads(z[..., 2 * qk_w:2 * qk_w + D_MODEL], ML_DV)
    o = jax.nn.sigmoid(z[..., 2 * qk_w + D_MODEL:2 * qk_w + 2 * D_MODEL].astype(jnp.float32))
    gates = (z[..., 2 * qk_w + 2 * D_MODEL:].astype(jnp.float32) + b_gates.astype(jnp.float32))
    gates = gates.reshape(bsz, seq, 4, ML_HEADS).transpose(2, 0, 3, 1)
    i_fw, f_fw, i_bw, f_bw = gates[0], gates[1], gates[2], gates[3]
    h_fw = mlstm_scan(q, k, v, i_fw, jax.nn.log_sigmoid(f_fw))
    flip = lambda a: jnp.flip(a, axis=2)
    h_bw = flip(mlstm_scan(flip(q), flip(k), flip(v), flip(i_bw), flip(jax.nn.log_sigmoid(f_bw))))
    h = (h_fw + h_bw).transpose(0, 2, 1, 3)
    h = rms_norm(h, norm_g.reshape(ML_HEADS, ML_DV)).reshape(bsz, seq, D_MODEL)
    return (o * h).astype(x.dtype) @ w_o


def setup_inputs(seed: int = 0) -> dict:
    key = jax.random.key(seed)
    ks = jax.random.split(key, 24)
    f32 = jnp.float32

    def dense(k, shape, scale=1.0):
        return jax.random.normal(k, shape, f32) * (shape[-2] ** -0.5) * scale

    def gain(k, shape):
        return 1.0 + 0.02 * jax.random.normal(k, shape, f32)

    def small(k, shape):
        return 0.02 * jax.random.normal(k, shape, f32)

    x = jax.random.normal(ks[0], (BATCH, SEQ, D_MODEL), f32)
    p = jax.random.normal(ks[1], (DEPTH, BATCH, SEQ, D_PLE), f32)
    na_scale = jnp.concatenate([jnp.ones((2 * D_MODEL,), f32), jnp.full((D_MODEL,), DN_BETA, f32)])
    na_w_qkv = dense(ks[2], (N_A, D_MODEL, 3 * D_MODEL)) * na_scale
    na_rpb = small(ks[3], (N_A, NA_HEADS, 2 * NA_KH_MAX - 1, 2 * NA_KW - 1))
    na_w_o = dense(ks[4], (N_A, D_MODEL, D_MODEL), DN_BETA)
    kvd = GQA_KV_HEADS * HEAD_DIM
    gq_scale = jnp.concatenate([jnp.ones((D_MODEL + kvd,), f32), jnp.full((kvd,), DN_BETA, f32)])
    gq_w_qkv = dense(ks[5], (N_B, D_MODEL, D_MODEL + 2 * kvd)) * gq_scale
    gq_q_norm = gain(ks[6], (N_B, HEAD_DIM))
    gq_k_norm = gain(ks[7], (N_B, HEAD_DIM))
    gq_w_o = dense(ks[8], (N_B, D_MODEL, D_MODEL), DN_BETA)
    ml_cols = 2 * ML_HEADS * ML_DQK + 2 * D_MODEL + 4 * ML_HEADS
    ml_w_in = dense(ks[9], (N_C, D_MODEL, ml_cols))
    f_bias = jnp.linspace(3.0, 6.0, ML_HEADS, dtype=f32)
    zero_b = jnp.zeros((ML_HEADS,), f32)
    ml_b_gates = (0.1 * jax.random.normal(ks[10], (N_C, 4, ML_HEADS), f32)
                  + jnp.stack([zero_b, f_bias, zero_b, f_bias])).reshape(N_C, 4 * ML_HEADS)
    ml_norm_g = gain(ks[11], (N_C, D_MODEL))
    ml_w_o = dense(ks[12], (N_C, D_MODEL, D_MODEL), DN_BETA)
    ln1_g = gain(ks[13], (DEPTH, D_MODEL))
    ln1_b = small(ks[14], (DEPTH, D_MODEL))
    w_ff1 = dense(ks[15], (DEPTH, D_MODEL, D_FF))
    w_ff2 = dense(ks[16], (DEPTH, D_FF, D_MODEL), DN_BETA)
    ln2_g = gain(ks[17], (DEPTH, D_MODEL))
    ln2_b = small(ks[18], (DEPTH, D_MODEL))
    w_ple_gate = dense(ks[19], (DEPTH, D_MODEL, D_MODEL))
    w_ple_proj = dense(ks[20], (DEPTH, D_PLE, D_MODEL), DN_BETA)
    return {'x': x, 'p': p, 'na_w_qkv': na_w_qkv, 'na_rpb': na_rpb, 'na_w_o': na_w_o,
            'gq_w_qkv': gq_w_qkv, 'gq_q_norm': gq_q_norm, 'gq_k_norm': gq_k_norm, 'gq_w_o': gq_w_o,
            'ml_w_in': ml_w_in, 'ml_b_gates': ml_b_gates, 'ml_norm_g': ml_norm_g, 'ml_w_o': ml_w_o,
            'ln1_g': ln1_g, 'ln1_b': ln1_b, 'w_ff1': w_ff1, 'w_ff2': w_ff2, 'ln2_g': ln2_g, 'ln2_b': ln2_b,
            'w_ple_gate': w_ple_gate, 'w_ple_proj': w_ple_proj}


def reference(x, p, na_w_qkv, na_rpb, na_w_o, gq_w_qkv, gq_q_norm, gq_k_norm, gq_w_o,
              ml_w_in, ml_b_gates, ml_norm_g, ml_w_o, ln1_g, ln1_b, w_ff1, w_ff2, ln2_g, ln2_b,
              w_ple_gate, w_ple_proj):
    for i in range(DEPTH):
        kind, j = i % N_MIXERS, i // N_MIXERS
        if kind == 0:
            mix = neighborhood_attention(x, na_w_qkv[j], na_rpb[j], na_w_o[j])
        elif kind == 1:
            mix = gqa_axial(x, gq_w_qkv[j], gq_q_norm[j], gq_k_norm[j], gq_w_o[j])
        else:
            mix = mlstm_mixer(x, ml_w_in[j], ml_b_gates[j], ml_norm_g[j], ml_w_o[j])
        x = layer_norm(DN_ALPHA * x + mix, ln1_g[i], ln1_b[i])
        hid = jnp.square(jax.nn.relu(x @ w_ff1[i]))
        ple = jax.nn.sigmoid(x @ w_ple_gate[i]) * (p[i] @ w_ple_proj[i])
        x = layer_norm(DN_ALPHA * x + hid @ w_ff2[i] + ple, ln2_g[i], ln2_b[i])
    return x
```

```cpp
#include <hip/hip_runtime.h>
#include <hip/hip_cooperative_groups.h>
#include <cstdio>
#include <cstdint>
namespace cg = cooperative_groups;
namespace pg8 {
#define PG8_LAS __attribute__((address_space(3)))
typedef unsigned short bf16_t;
typedef short bf16x8 __attribute__((ext_vector_type(8)));
typedef float f32x4 __attribute__((ext_vector_type(4)));
typedef unsigned u32x4 __attribute__((ext_vector_type(4)));
constexpr int BM = 256, BK = 64, HALF = 128, HTB = HALF * BK * 2  , STAGE_BYTES = 8 * HTB, NXCD = 8, WGM = 8;

__host__ __device__ __forceinline__ int lds_byte(int r, int c) { const int st = (r >> 4) * 2 + (c >> 5), rr = r & 15, cc = c & 31, ob = rr * 64 + cc * 2; return st * 1024 + (ob ^ (((ob >> 9) & 1) << 5)); }
__host__ __device__ __forceinline__ void stage_rc(int b, int& R, int& C) { const int st = b / 1024, sb = b % 1024, swz = sb ^ (((sb >> 9) & 1) << 5); R = (st >> 1) * 16 + swz / 64; C = (st & 1) * 32 + (swz % 64) / 2; }
__host__ __device__ __forceinline__ int perm32(int rho) { const int n = rho >> 4, i = rho & 15; return 8 * (i >> 2) + 4 * n + (i & 3); }

struct Unit { int pm, pn; };
struct Gemm { const bf16_t* A; const bf16_t* Bt; int M, N, K; };

struct StaticOrder {
    int nM, nN, nwg, G, c;
    __host__ __device__ void init(int M, int N, int G_, int c_) { nM = M / BM; nN = N / BM; nwg = nM * nN; G = G_; c = c_; }
    __host__ __device__ bool next(int i, Unit& u) const {
        const long L = (long)i * G + c; if (L >= nwg) return false;
        int wgid = (int)L; { const int q = nwg / NXCD, r = nwg % NXCD, xcd = wgid % NXCD, off = wgid / NXCD; wgid = (xcd < r ? xcd * (q + 1) : r * (q + 1) + (xcd - r) * q) + off; }
        const int nig = WGM * nN, gid = wgid / nig, fm = gid * WGM, gsz = (nM - fm) < WGM ? (nM - fm) : WGM;
        u.pm = fm + ((wgid % nig) % gsz); u.pn = (wgid % nig) / gsz; return true;
    }
    __device__ __forceinline__ void a_ready(const Unit&) const {}
    __device__ __forceinline__ void done(const Unit&) const {}
};

__device__ __forceinline__ unsigned cvt_pk_bf16(float lo, float hi) { unsigned r; asm volatile("v_cvt_pk_bf16_f32 %0, %1, %2" : "=v"(r) : "v"(lo), "v"(hi)); return r; }
typedef float f32x2 __attribute__((ext_vector_type(2)));
__device__ __forceinline__ float bf2f(unsigned short h) { return __uint_as_float(((unsigned)h) << 16); }
__device__ __forceinline__ float sigmoidf_(float x) { return 1.0f / (1.0f + __expf(-x)); }
struct EpiPlain {
    static constexpr bool PERM = true, AFTER_DRAIN = false;
    bf16_t* O; int ldc; int scale_cols; float scale;
    __device__ __forceinline__ void operator()(const f32x4 (&acc)[2][2][4][2], const Unit& u, int wr, int wc, int fr, int fq) const {
        const int row0 = u.pm * BM + wr * 64 + fr, col0 = u.pn * BM + wc * 32 + 8 * fq;
        const float sc = (u.pn * BM < scale_cols) ? scale : 1.f;
#pragma unroll
        for (int ai = 0; ai < 2; ++ai)
#pragma unroll
            for (int m = 0; m < 4; ++m) { bf16_t* rowp = O + (size_t)(row0 + ai * HALF + m * 16) * ldc + col0;
#pragma unroll
                for (int bj = 0; bj < 2; ++bj) { f32x4 v0 = acc[ai][bj][m][0] * sc, v1 = acc[ai][bj][m][1] * sc;
                    u32x4 w; w.x = cvt_pk_bf16(v0[0], v0[1]); w.y = cvt_pk_bf16(v0[2], v0[3]); w.z = cvt_pk_bf16(v1[0], v1[1]); w.w = cvt_pk_bf16(v1[2], v1[3]);
                    *(u32x4*)(rowp + bj * HALF) = w; } }
    }
};
struct EpiMl {
    static constexpr bool PERM = true, AFTER_DRAIN = false;
    bf16_t* O; float* gates; const float* bias;
    __device__ __forceinline__ void operator()(const f32x4 (&acc)[2][2][4][2], const Unit& u, int wr, int wc, int fr, int fq) const {
        const int row0 = u.pm * BM + wr * 64 + fr;
        if (u.pn < 12) {
            const int col0 = u.pn * BM + wc * 32 + 8 * fq; const float sc = (u.pn < 2) ? 0.125f : 1.f;
#pragma unroll
            for (int ai = 0; ai < 2; ++ai)
#pragma unroll
                for (int m = 0; m < 4; ++m) { bf16_t* rowp = O + (size_t)(row0 + ai * HALF + m * 16) * 3072 + col0;
#pragma unroll
                    for (int bj = 0; bj < 2; ++bj) { f32x4 v0 = acc[ai][bj][m][0] * sc, v1 = acc[ai][bj][m][1] * sc;
                        u32x4 w; w.x = cvt_pk_bf16(v0[0], v0[1]); w.y = cvt_pk_bf16(v0[2], v0[3]); w.z = cvt_pk_bf16(v1[0], v1[1]); w.w = cvt_pk_bf16(v1[2], v1[3]);
                        *(u32x4*)(rowp + bj * HALF) = w; } }
        } else if (wc == 0) {
            const f32x4 b0 = *(const f32x4*)(bias + 8 * fq), b1 = *(const f32x4*)(bias + 8 * fq + 4);
#pragma unroll
            for (int ai = 0; ai < 2; ++ai)
#pragma unroll
                for (int m = 0; m < 4; ++m) { float* gp = gates + (size_t)(row0 + ai * HALF + m * 16) * 32 + 8 * fq;
                    *(f32x4*)gp = acc[ai][0][m][0] + b0; *(f32x4*)(gp + 4) = acc[ai][0][m][1] + b1; }
        }
    }
};
struct EpiFf1 {
    static constexpr bool PERM = true, AFTER_DRAIN = false;
    bf16_t* H; bf16_t* PP;
    __device__ __forceinline__ void operator()(const f32x4 (&acc)[2][2][4][2], const Unit& u, int wr, int wc, int fr, int fq) const {
        const int row0 = u.pm * BM + wr * 64 + fr;
        if (u.pn < 16) {
            const int col0 = u.pn * BM + wc * 32 + 8 * fq;
#pragma unroll
            for (int ai = 0; ai < 2; ++ai)
#pragma unroll
                for (int m = 0; m < 4; ++m) { bf16_t* rowp = H + (size_t)(row0 + ai * HALF + m * 16) * 4096 + col0;
#pragma unroll
                    for (int bj = 0; bj < 2; ++bj) { f32x4 v0 = acc[ai][bj][m][0], v1 = acc[ai][bj][m][1];
#pragma unroll
                        for (int e = 0; e < 4; ++e) { const float a = fmaxf(v0[e], 0.f), b = fmaxf(v1[e], 0.f); v0[e] = a * a; v1[e] = b * b; }
                        u32x4 w; w.x = cvt_pk_bf16(v0[0], v0[1]); w.y = cvt_pk_bf16(v0[2], v0[3]); w.z = cvt_pk_bf16(v1[0], v1[1]); w.w = cvt_pk_bf16(v1[2], v1[3]);
                        *(u32x4*)(rowp + bj * HALF) = w; } }
        } else {
            const int col0 = (u.pn - 16) * BM + wc * 32 + 8 * fq;
#pragma unroll
            for (int ai = 0; ai < 2; ++ai)
#pragma unroll
                for (int m = 0; m < 4; ++m) { bf16_t* rowp = PP + (size_t)(row0 + ai * HALF + m * 16) * 1024 + col0;
#pragma unroll
                    for (int bj = 0; bj < 2; ++bj) { f32x4 v0 = acc[ai][bj][m][0], v1 = acc[ai][bj][m][1];
                        const u32x4 pp = *(const u32x4*)(rowp + bj * HALF);
                        const unsigned pw[4] = {pp.x, pp.y, pp.z, pp.w};
#pragma unroll
                        for (int e = 0; e < 2; ++e) {
                            v0[2 * e]     = sigmoidf_(v0[2 * e])     * __uint_as_float(pw[e] << 16);
                            v0[2 * e + 1] = sigmoidf_(v0[2 * e + 1]) * __uint_as_float(pw[e] & 0xffff0000u);
                            v1[2 * e]     = sigmoidf_(v1[2 * e])     * __uint_as_float(pw[2 + e] << 16);
                            v1[2 * e + 1] = sigmoidf_(v1[2 * e + 1]) * __uint_as_float(pw[2 + e] & 0xffff0000u); }
                        u32x4 w; w.x = cvt_pk_bf16(v0[0], v0[1]); w.y = cvt_pk_bf16(v0[2], v0[3]); w.z = cvt_pk_bf16(v1[0], v1[1]); w.w = cvt_pk_bf16(v1[2], v1[3]);
                        *(u32x4*)(rowp + bj * HALF) = w; } }
        }
    }
};
struct EpiResid {
    static constexpr bool PERM = false, AFTER_DRAIN = false;
    const float* res; float* out; const bf16_t* ple; float alpha;
    __device__ __forceinline__ void operator()(const f32x4 (&acc)[2][2][4][2], const Unit& u, int wr, int wc, int fr, int fq) const {
        const int row0 = u.pm * BM + wr * 64 + fr, col0 = u.pn * BM + wc * 32 + 4 * fq;
#pragma unroll
        for (int ai = 0; ai < 2; ++ai)
#pragma unroll
            for (int m = 0; m < 4; ++m) { const size_t off = (size_t)(row0 + ai * HALF + m * 16) * 1024 + col0;
#pragma unroll
                for (int bj = 0; bj < 2; ++bj)
#pragma unroll
                    for (int n = 0; n < 2; ++n) { const size_t o2 = off + bj * HALF + n * 16;
                        const f32x4 r = *(const f32x4*)(res + o2); f32x4 v = acc[ai][bj][m][n] + r * alpha;
                        if (ple) { const unsigned long long pw = *(const unsigned long long*)(ple + o2); const unsigned lo = (unsigned)pw, hi = (unsigned)(pw >> 32);
                            v[0] += __uint_as_float(lo << 16); v[1] += __uint_as_float(lo & 0xffff0000u); v[2] += __uint_as_float(hi << 16); v[3] += __uint_as_float(hi & 0xffff0000u); }
                        *(f32x4*)(out + o2) = v; } }
    }
};
template <class Epi, class Sched, bool ALIGN_EPI = false, bool SP2 = false>
__device__ __forceinline__ void gemm_phase(PG8_LAS unsigned char* lds, const Gemm g, const Sched& S, const Epi& E) {
    const int tid = threadIdx.x, wid = __builtin_amdgcn_readfirstlane(tid >> 6), lane = tid & 63, wr = wid >> 2, wc = wid & 3, fr = lane & 15, fq = lane >> 4;
    const int K = g.K, nt = K / BK;
    unsigned voffA[2], voffB[2];
#pragma unroll
    for (int i = 0; i < 2; ++i) { int R, C; stage_rc(tid * 16 + i * 8192, R, C); const int Rb = Epi::PERM ? ((R & ~31) + perm32(R & 31)) : R;
        voffA[i] = (unsigned)(R * K + C) * 2u; voffB[i] = (unsigned)(Rb * K + C) * 2u; }
    const size_t kstep = (size_t)(BK * 2);
    const size_t hstep = (size_t)HALF * K * 2;
    const size_t tstep = 2 * hstep;
    const unsigned ldsw = (unsigned)wid * 1024u;
    const int aoff = lds_byte(wr * 64 + fr, fq * 8), boff = lds_byte(wc * 32 + fr, fq * 8);
#define PG8_SA(b, h) (((b) * 2 + (h)) * HTB)
#define PG8_SB(b, h) ((4 + (b) * 2 + (h)) * HTB)
#define PG8_STAGE(bufoff, gbase, voff) do { _Pragma("unroll") for (int _i = 0; _i < 2; ++_i) \
        __builtin_amdgcn_global_load_lds((const unsigned*)((const char*)(gbase) + (voff)[_i]), (PG8_LAS unsigned*)(lds + (bufoff) + ldsw + _i * 8192), 16, 0, 0); } while (0)
#define PG8_LDA(dst, b, h) do { _Pragma("unroll") for (int m = 0; m < 4; ++m) _Pragma("unroll") for (int k = 0; k < 2; ++k) dst[m][k] = *(const PG8_LAS bf16x8*)(lds + PG8_SA(b, h) + aoff + m * 2048 + k * 1024); } while (0)
#define PG8_LDB(dst, b, h) do { _Pragma("unroll") for (int n = 0; n < 2; ++n) _Pragma("unroll") for (int k = 0; k < 2; ++k) dst[n][k] = *(const PG8_LAS bf16x8*)(lds + PG8_SB(b, h) + boff + n * 2048 + k * 1024); } while (0)
#define PG8_MMA(ai, bj, At, Bt) do { __builtin_amdgcn_s_setprio(1); _Pragma("unroll") for (int m = 0; m < 4; ++m) _Pragma("unroll") for (int n = 0; n < 2; ++n) _Pragma("unroll") for (int k = 0; k < 2; ++k) \
        acc[ai][bj][m][n] = __builtin_amdgcn_mfma_f32_16x16x32_bf16(Bt[n][k], At[m][k], acc[ai][bj][m][n], 0, 0, 0); __builtin_amdgcn_s_setprio(0); } while (0)
#define PG8_WAIT_V(n) asm volatile("s_waitcnt vmcnt(" #n ")" ::: "memory")
#define PG8_WAIT_L(n) asm volatile("s_waitcnt lgkmcnt(" #n ")" ::: "memory")
#define PG8_BAR __builtin_amdgcn_s_barrier()
#define PG8_SCHED __builtin_amdgcn_sched_barrier(0)
    Unit cur, nxt; int ui = 0;
    if (!S.next(0, cur)) return;
    f32x4 acc[2][2][4][2];
#pragma unroll
    for (int a = 0; a < 2; ++a)
#pragma unroll
        for (int b = 0; b < 2; ++b)
#pragma unroll
            for (int m = 0; m < 4; ++m)
#pragma unroll
                for (int n = 0; n < 2; ++n) acc[a][b][m][n] = (f32x4){0.f, 0.f, 0.f, 0.f};
    bf16x8 At[4][2], B0[2][2], B1[2][2];
    const char* cA = (const char*)g.A + (size_t)cur.pm * tstep; const char* cB = (const char*)g.Bt + (size_t)cur.pn * tstep;
    S.a_ready(cur);
    if constexpr (SP2) {
        PG8_STAGE(PG8_SB(0, 0), cB, voffB); PG8_STAGE(PG8_SB(0, 1), cB + hstep, voffB); PG8_STAGE(PG8_SA(0, 0), cA, voffA); PG8_STAGE(PG8_SA(0, 1), cA + hstep, voffA);
        if (wr == 1) PG8_BAR;
        PG8_WAIT_V(2); PG8_BAR;
        PG8_STAGE(PG8_SB(1, 0), cB + kstep, voffB); PG8_STAGE(PG8_SA(1, 0), cA + kstep, voffA); PG8_STAGE(PG8_SB(1, 1), cB + hstep + kstep, voffB);
        PG8_WAIT_V(6); PG8_BAR;
    } else {
        PG8_STAGE(PG8_SB(0, 0), cB, voffB); PG8_STAGE(PG8_SA(0, 0), cA, voffA); PG8_STAGE(PG8_SB(0, 1), cB + hstep, voffB); PG8_STAGE(PG8_SA(0, 1), cA + hstep, voffA);
        if (wr == 1) PG8_BAR;
        PG8_WAIT_V(4); PG8_BAR;
        PG8_STAGE(PG8_SB(1, 0), cB + kstep, voffB); PG8_STAGE(PG8_SA(1, 0), cA + kstep, voffA); PG8_STAGE(PG8_SB(1, 1), cB + hstep + kstep, voffB);
        PG8_WAIT_V(6); PG8_BAR;
    }
    for (;;) {
        const bool has_next = S.next(ui + 1, nxt);
        const char* nA = has_next ? (const char*)g.A + (size_t)nxt.pm * tstep : cA; const char* nB = has_next ? (const char*)g.Bt + (size_t)nxt.pn * tstep : cB;
        for (int t = 0; t < nt; t += 2) {
            const bool last = (t == nt - 2);
            const char* a1 = cA + (size_t)(t + 1) * kstep;
            const char* a2 = last ? nA : cA + (size_t)(t + 2) * kstep; const char* b2 = last ? nB : cB + (size_t)(t + 2) * kstep;
            const char* a3 = a2 + kstep; const char* b3 = b2 + kstep;
            if (last && has_next) S.a_ready(nxt);
            if constexpr (SP2) {
            PG8_LDB(B0, 0, 0); PG8_LDB(B1, 0, 1); PG8_SCHED; PG8_LDA(At, 0, 0); PG8_STAGE(PG8_SA(1, 1), a1 + hstep, voffA);
            PG8_WAIT_V(8); PG8_WAIT_L(0); PG8_BAR; PG8_MMA(0, 0, At, B0); PG8_MMA(0, 1, At, B1); PG8_BAR; PG8_SCHED;
            PG8_LDA(At, 0, 1); PG8_STAGE(PG8_SB(0, 0), b2, voffB); PG8_STAGE(PG8_SB(0, 1), b2 + hstep, voffB); PG8_STAGE(PG8_SA(0, 0), a2, voffA);
            PG8_WAIT_V(8); PG8_WAIT_L(0); PG8_BAR; PG8_MMA(1, 0, At, B0); PG8_MMA(1, 1, At, B1); PG8_BAR; PG8_SCHED;
            PG8_LDB(B0, 1, 0); PG8_LDB(B1, 1, 1); PG8_SCHED; PG8_LDA(At, 1, 0); PG8_STAGE(PG8_SA(0, 1), a2 + hstep, voffA);
            PG8_WAIT_V(8); PG8_WAIT_L(0); PG8_BAR; PG8_MMA(0, 0, At, B0); PG8_MMA(0, 1, At, B1); PG8_BAR; PG8_SCHED;
            PG8_LDA(At, 1, 1); PG8_STAGE(PG8_SB(1, 0), b3, voffB); PG8_STAGE(PG8_SB(1, 1), b3 + hstep, voffB); PG8_STAGE(PG8_SA(1, 0), a3, voffA);
            PG8_WAIT_V(8); PG8_WAIT_L(0); PG8_BAR; PG8_MMA(1, 0, At, B0); PG8_MMA(1, 1, At, B1); PG8_BAR; PG8_SCHED;
            } else {
            PG8_LDB(B0, 0, 0); PG8_SCHED; PG8_LDA(At, 0, 0); PG8_STAGE(PG8_SA(1, 1), a1 + hstep, voffA);
            PG8_WAIT_L(8); PG8_BAR; PG8_WAIT_L(0); PG8_MMA(0, 0, At, B0); PG8_BAR; PG8_SCHED;
            PG8_LDB(B1, 0, 1); PG8_STAGE(PG8_SB(0, 0), b2, voffB);
            PG8_BAR; PG8_WAIT_L(0); PG8_MMA(0, 1, At, B1); PG8_BAR;
            PG8_LDA(At, 0, 1); PG8_STAGE(PG8_SA(0, 0), a2, voffA);
            PG8_BAR; PG8_WAIT_L(0); PG8_MMA(1, 0, At, B0); PG8_BAR; PG8_SCHED;
            PG8_STAGE(PG8_SB(0, 1), b2 + hstep, voffB);
            PG8_WAIT_V(6); PG8_BAR; PG8_MMA(1, 1, At, B1); PG8_BAR;
            PG8_LDB(B0, 1, 0); PG8_SCHED; PG8_LDA(At, 1, 0); PG8_STAGE(PG8_SA(0, 1), a2 + hstep, voffA);
            PG8_WAIT_L(8); PG8_BAR; PG8_WAIT_L(0); PG8_MMA(0, 0, At, B0); PG8_BAR; PG8_SCHED;
            PG8_LDB(B1, 1, 1); PG8_STAGE(PG8_SB(1, 0), b3, voffB);
            PG8_BAR; PG8_WAIT_L(0); PG8_MMA(0, 1, At, B1); PG8_BAR;
            PG8_LDA(At, 1, 1); PG8_STAGE(PG8_SA(1, 0), a3, voffA);
            PG8_BAR; PG8_WAIT_L(0); PG8_MMA(1, 0, At, B0); PG8_BAR; PG8_SCHED;
            PG8_STAGE(PG8_SB(1, 1), b3 + hstep, voffB);
            PG8_WAIT_V(6); PG8_BAR; PG8_MMA(1, 1, At, B1); PG8_BAR;
            }
        }
        if constexpr (ALIGN_EPI) { if (wr == 0) PG8_BAR; }
        if constexpr (!Epi::AFTER_DRAIN) { E(acc, cur, wr, wc, fr, fq); S.done(cur); }
        if (!has_next) break;
#pragma unroll
        for (int a = 0; a < 2; ++a)
#pragma unroll
            for (int b = 0; b < 2; ++b)
#pragma unroll
                for (int m = 0; m < 4; ++m)
#pragma unroll
                    for (int n = 0; n < 2; ++n) acc[a][b][m][n] = (f32x4){0.f, 0.f, 0.f, 0.f};
        cur = nxt; cA = nA; cB = nB; ++ui;
        if constexpr (ALIGN_EPI) { if (wr == 1) PG8_BAR; }
    }
    PG8_WAIT_V(0);
    if constexpr (!ALIGN_EPI) { if (wr == 0) PG8_BAR; }
    PG8_BAR;
    if constexpr (Epi::AFTER_DRAIN) { E.fused(acc, cur, wr, wc, fr, fq, lds, wid, lane); S.done(cur); }
#undef PG8_SA
#undef PG8_SB
#undef PG8_STAGE
#undef PG8_LDA
#undef PG8_LDB
#undef PG8_MMA
#undef PG8_WAIT_V
#undef PG8_WAIT_L
#undef PG8_BAR
#undef PG8_SCHED
}
}
#include <hip/hip_bf16.h>
#include <cmath>
namespace attn_body {
using bf16=__hip_bfloat16;
using bf16x8=__attribute__((ext_vector_type(8)))short;
using s16x4=__attribute__((ext_vector_type(4)))short;
using f32x16=__attribute__((ext_vector_type(16)))float;
using u32x4=__attribute__((ext_vector_type(4)))unsigned;
constexpr int BATCH=32,NHEAD=16,SEQ=2048,D=64,DM=1536,OP=1024;
constexpr int NW=8,QBLK=32,QB=QBLK*NW,KVBLK=64,NQB=SEQ/QB;
constexpr int ATTN_PITCH=DM, ATTN_UNIT_ROWS=QB;
__device__ __forceinline__ int crow(int r,int hi){return (r&3)+8*(r>>2)+4*hi;}
#define SBAR() __builtin_amdgcn_sched_barrier(0)
__device__ __forceinline__ void cmask(f32x16&p0,f32x16&p1,int jb,int qrel,int hi){
  const float NEG=-INFINITY; int kb=64*jb+4*hi;
  #pragma unroll
  for(int r=0;r<16;++r){int kv=kb+(r&3)+8*(r>>2); if(kv>qrel)p0[r]=NEG; if(kv+32>qrel)p1[r]=NEG;}
}

constexpr int NSLOT=3, SLOTB=8192;
constexpr int LDS_K=0, LDS_V=NSLOT*SLOTB, LDS_WS=2*NSLOT*SLOTB, LDS_OST=LDS_WS+NW*64*4, LDS_BYTES=LDS_OST+NW*4096;
constexpr float C2=0.125f*1.4426950408889634f;
__device__ __forceinline__ void glds16(const void*gsrc,unsigned lds_dst){unsigned keep;
  asm volatile("s_mov_b32 %0, m0\n\ts_mov_b32 m0, %2\n\ts_nop 0\n\tglobal_load_lds_dwordx4 %1, off\n\ts_mov_b32 m0, %0":"=&s"(keep):"v"(gsrc),"s"(lds_dst):"memory");}
__device__ __forceinline__ float max3f(float a,float b,float c){float r;asm("v_max3_f32 %0, %1, %2, %3":"=v"(r):"v"(a),"v"(b),"v"(c));return r;}
__device__ __forceinline__ float max2f(float a,float b){float r;asm("v_max_f32_e32 %0, %1, %2":"=v"(r):"v"(a),"v"(b));return r;}
__device__ __forceinline__ float fadd_s(float a,float b){float r;asm("v_add_f32_e32 %0, %1, %2":"=v"(r):"v"(a),"v"(b));return r;}
__device__ __forceinline__ float fsub_s(float a,float b){float r;asm("v_sub_f32_e32 %0, %1, %2":"=v"(r):"v"(a),"v"(b));return r;}
typedef float f32x2_t __attribute__((ext_vector_type(2))); typedef __bf16 bf16x2_t __attribute__((ext_vector_type(2)));
__device__ __forceinline__ unsigned cvtpk_s(float lo,float hi){f32x2_t v={lo,hi};bf16x2_t b=__builtin_convertvector(v,bf16x2_t);return __builtin_bit_cast(unsigned,b);}
#define WAIT_BAR(N) asm volatile("s_waitcnt vmcnt(" #N ") lgkmcnt(0)\n\ts_barrier":::"memory")

__device__ __forceinline__ void qkt(f32x16&p0,f32x16&p1,const char*Kslot,const bf16x8*qr,const f32x16&negm,int r32,int hi){
  const char*kb=Kslot+hi*1024+r32*16;
  #pragma unroll
  for(int d0=0;d0<4;++d0){
    const bf16x8 b0=*reinterpret_cast<const bf16x8*>(kb+d0*2048);
    const bf16x8 b1=*reinterpret_cast<const bf16x8*>(kb+d0*2048+512);
    if(d0==0){p0=__builtin_amdgcn_mfma_f32_32x32x16_bf16(b0,qr[0],negm,0,0,0);p1=__builtin_amdgcn_mfma_f32_32x32x16_bf16(b1,qr[0],negm,0,0,0);}
    else{p0=__builtin_amdgcn_mfma_f32_32x32x16_bf16(b0,qr[d0],p0,0,0,0);p1=__builtin_amdgcn_mfma_f32_32x32x16_bf16(b1,qr[d0],p1,0,0,0);}}
}
typedef __attribute__((address_space(3))) const char* lds_cptr;
typedef short v4i16_t __attribute__((ext_vector_type(4)));
__device__ __forceinline__ void kload8(bf16x8*kf,lds_cptr kp){
  kf[0]=*(const __attribute__((address_space(3))) bf16x8*)(kp);      kf[1]=*(const __attribute__((address_space(3))) bf16x8*)(kp+512);
  kf[2]=*(const __attribute__((address_space(3))) bf16x8*)(kp+2048); kf[3]=*(const __attribute__((address_space(3))) bf16x8*)(kp+2560);
  kf[4]=*(const __attribute__((address_space(3))) bf16x8*)(kp+4096); kf[5]=*(const __attribute__((address_space(3))) bf16x8*)(kp+4608);
  kf[6]=*(const __attribute__((address_space(3))) bf16x8*)(kp+6144); kf[7]=*(const __attribute__((address_space(3))) bf16x8*)(kp+6656);
}
__device__ __forceinline__ void kload2(bf16x8*kf,lds_cptr kp,int j){ kf[2*j]=*(const __attribute__((address_space(3))) bf16x8*)(kp+j*2048); kf[2*j+1]=*(const __attribute__((address_space(3))) bf16x8*)(kp+j*2048+512); }
__device__ __forceinline__ s16x4 vtr(lds_cptr p){ return __builtin_bit_cast(s16x4,__builtin_amdgcn_ds_read_tr16_b64_v4i16((__attribute__((address_space(3))) v4i16_t*)p)); }
__device__ __forceinline__ float rowmax(const f32x16&p0,const f32x16&p1){
  float a=max3f(p0[0],p0[1],p1[0]),b=max3f(p0[2],p0[3],p1[1]);a=max3f(a,p1[2],p1[3]);
  #pragma unroll
  for(int r=4;r<16;r+=4){a=max3f(a,p0[r],p0[r+1]);b=max3f(b,p0[r+2],p0[r+3]);a=max3f(a,p1[r],p1[r+1]);b=max3f(b,p1[r+2],p1[r+3]);}
  const float m=max2f(a,b);
  auto rr=__builtin_amdgcn_permlane32_swap(__float_as_uint(m),__float_as_uint(m),false,false);
  return max2f(__uint_as_float(rr[0]),__uint_as_float(rr[1]));
}
__device__ __forceinline__ void pv(f32x16*o,int vb,bf16x8 pa0,bf16x8 pa1,bf16x8 pa2,bf16x8 pa3){
  #pragma unroll
  for(int d0=0;d0<2;++d0){s16x4 lo[4],hi[4];
    #pragma unroll
    for(int ks=0;ks<4;++ks){
      asm volatile("ds_read_b64_tr_b16 %0,%1 offset:%c2":"=&v"(lo[ks]):"v"(vb),"i"(d0*4096+ks*1024):"memory");
      asm volatile("ds_read_b64_tr_b16 %0,%1 offset:%c2":"=&v"(hi[ks]):"v"(vb),"i"(d0*4096+ks*1024+512):"memory");}
    asm volatile("s_waitcnt lgkmcnt(0)":::"memory");SBAR();
    #define PK(k) (bf16x8){lo[k][0],lo[k][1],lo[k][2],lo[k][3],hi[k][0],hi[k][1],hi[k][2],hi[k][3]}
    o[d0]=__builtin_amdgcn_mfma_f32_32x32x16_bf16(pa0,PK(0),o[d0],0,0,0);
    o[d0]=__builtin_amdgcn_mfma_f32_32x32x16_bf16(pa1,PK(1),o[d0],0,0,0);
    o[d0]=__builtin_amdgcn_mfma_f32_32x32x16_bf16(pa2,PK(2),o[d0],0,0,0);
    o[d0]=__builtin_amdgcn_mfma_f32_32x32x16_bf16(pa3,PK(3),o[d0],0,0,0);
    #undef PK
  }
}

#ifndef ATTN_STORE16
#define ATTN_STORE16(p,v) (*(u32x4*)(p)=(v))
#endif
template<int THRL> __device__ __forceinline__ void attn_unit(int b,int h,int qb,const bf16*Q,const bf16*__restrict__ K,const bf16*__restrict__ V,bf16*O,char*shm){
  const int tid=threadIdx.x,lane=tid&63,r32=lane&31,hi=lane>>5; const int wid=__builtin_amdgcn_readfirstlane(tid>>6);
  const long rowbase=(long)b*SEQ; const int q0=qb*QB;
  const bf16*Qw=Q+(rowbase+q0+wid*QBLK)*DM+h*D;
  const bf16*Kh=K+rowbase*DM+(h>>2)*D,*Vh=V+rowbase*DM+(h>>2)*D;
  const unsigned lds0=(unsigned)(uintptr_t)shm;
  float*wsf=(float*)(shm+LDS_WS)+wid*64;
  const bf16*ksrc=Kh+(long)lane*DM+wid*8;
  const bf16*vsrc=Vh+(long)(16*(wid&3)+(lane>>2))*DM+(wid>>2)*32+(lane&3)*8;
  const unsigned kdst=lds0+LDS_K+wid*1024, vdst=lds0+LDS_V+wid*1024;
  #define DMA_K(t,slot) glds16(ksrc+(long)(t)*KVBLK*DM,(unsigned)__builtin_amdgcn_readfirstlane(kdst+(slot)))
  #define DMA_V(t,slot) glds16(vsrc+(long)(t)*KVBLK*DM,(unsigned)__builtin_amdgcn_readfirstlane(vdst+(slot)))
  const int vb0=(int)(lds0+LDS_V)+((lane>>4)&1)*32+(lane&3)*8+(4*hi+((lane&15)>>2))*64;
  const char*Kbase=shm+LDS_K; bf16x8 kf[8];
  const lds_cptr shm3=(lds_cptr)shm; const lds_cptr kp0=shm3+LDS_K+hi*1024+r32*16; const lds_cptr vp0=shm3+LDS_V+((lane>>4)&1)*32+(lane&3)*8+(4*hi+((lane&15)>>2))*64;
  const int NT=SEQ/KVBLK;
  DMA_K(0,0);DMA_V(0,0);DMA_K(1,SLOTB);
  bf16x8 qr[4];
  #pragma unroll
  for(int d0=0;d0<4;++d0)qr[d0]=*reinterpret_cast<const bf16x8*>(&Qw[(long)r32*DM+d0*16+hi*8]);
  float mhat=0.f,l_reg=0.f;f32x16 o[2];o[0]=f32x16{};o[1]=f32x16{};f32x16 negm=f32x16{};asm volatile("":"+v"(negm));

  #define CMASK(P0,P1,t) do{}while(0)
  bool resc=false;
  #define START(P0,P1) do{ const float rm=rowmax(P0,P1); resc=false; \
    { const float dl=rm; mhat=fadd_s(mhat,dl); \
      _Pragma("unroll") for(int r=0;r<16;++r){P0[r]=fsub_s(P0[r],dl);P1[r]=fsub_s(P1[r],dl);} \
      _Pragma("unroll") for(int r=0;r<16;++r)negm[r]=-mhat; asm volatile("":"+v"(negm)); } \
    _Pragma("unroll") for(int r=0;r<16;++r)P0[r]=__builtin_amdgcn_exp2f(P0[r]); }while(0)
  #define RESC() do{ if(resc){ asm volatile("s_waitcnt lgkmcnt(0)":::"memory"); \
      _Pragma("unroll") for(int d_=0;d_<2;++d_) _Pragma("unroll") for(int r=0;r<16;++r)o[d_][r]*=wsf[crow(r,hi)]; } }while(0)
  f32x16 pA0,pA1,pB0,pB1;
  int sl_prev=0,sl_cur=0,sl_next=SLOTB;
  #define ROT() do{sl_prev=sl_cur;sl_cur=sl_next;sl_next=(sl_next==(NSLOT-1)*SLOTB)?0:sl_next+SLOTB;}while(0)
  DMA_K(2,2*SLOTB);
  WAIT_BAR(3);
  qkt(pA0,pA1,Kbase,qr,negm,r32,hi);asm volatile("s_nop 15\n\ts_nop 7":"+v"(pA0),"+v"(pA1));CMASK(pA0,pA1,0);
  START(pA0,pA1);
  _Pragma("unroll") for(int r=0;r<16;++r)pA1[r]=__builtin_amdgcn_exp2f(pA1[r]);
  WAIT_BAR(0);
  DMA_K(3,0);DMA_V(1,SLOTB);
  ROT();
  kload8(kf,kp0+sl_cur);
  WAIT_BAR(2);
  s16x4 vlo[8],vhi[8]; u32x4 pw0,pw1,pw2,pw3;
  #define PKW(P,B) cvtpk_s(P[B],P[B+1])
  #define PAF(k) __builtin_bit_cast(bf16x8,pw##k)
  #define VFR(i) (bf16x8){vlo[i][0],vlo[i][1],vlo[i][2],vlo[i][3],vhi[i][0],vhi[i][1],vhi[i][2],vhi[i][3]}
  #define PIN(x) asm volatile("":"+v"(x))
  #define MX3(a,b,c) __builtin_fmaxf(__builtin_fmaxf((a),(b)),(c))
  #define GAPA(MF,A0,A1,A2,A3,W0,W1,PW) do{ MF; sacc+=A0; sacc+=A1; sacc+=A2; sacc+=A3; PIN(sacc); W0; W1; PIN(PW); SBAR(); }while(0)
  #define EX(v) __builtin_amdgcn_exp2f(v)
  #define GAPB(MF,X,B) do{ MF; X[B]=EX(X[B]); X[B+1]=EX(X[B+1]); X[B+2]=EX(X[B+2]); X[B+3]=EX(X[B+3]); PIN(X); SBAR(); }while(0)
  #define VRD(i) do{ vlo[i]=vtr(vp_+(((i)>>2)*4096+((i)&3)*1024)); vhi[i]=vtr(vp_+(((i)>>2)*4096+((i)&3)*1024+512)); }while(0)
  #define KRD(G,j) do{ if(G){ kload2(kf,kp0+sl_next,j); SBAR(); } }while(0)
  #define STEP(C0,C1,P0,P1,t,GK,GV,GL) do{ SBAR(); \
    const lds_cptr vp_=vp0+sl_prev; \
    VRD(0); SBAR(); float sacc=(P0[0]+P0[1]); \
    GAPA(C0=__builtin_amdgcn_mfma_f32_32x32x16_bf16(kf[0],qr[0],negm,0,0,0), P0[2],P0[3],P0[4],P0[5],     pw0[0]=PKW(P0,0), pw0[1]=PKW(P0,2), pw0); \
    VRD(4); SBAR(); GAPA(C1=__builtin_amdgcn_mfma_f32_32x32x16_bf16(kf[1],qr[0],negm,0,0,0), P0[6],P0[7],P0[8],P0[9],     pw0[2]=PKW(P0,4), pw0[3]=PKW(P0,6), pw0); \
    VRD(1); SBAR(); GAPA(C0=__builtin_amdgcn_mfma_f32_32x32x16_bf16(kf[2],qr[1],C0,0,0,0),   P0[10],P0[11],P0[12],P0[13], pw1[0]=PKW(P0,8), pw1[1]=PKW(P0,10), pw1); \
    VRD(5); SBAR(); GAPA(C1=__builtin_amdgcn_mfma_f32_32x32x16_bf16(kf[3],qr[1],C1,0,0,0),   P0[14],P0[15],P1[0],P1[1],   pw1[2]=PKW(P0,12),pw1[3]=PKW(P0,14), pw1); \
    VRD(2); SBAR(); GAPA(C0=__builtin_amdgcn_mfma_f32_32x32x16_bf16(kf[4],qr[2],C0,0,0,0),   P1[2],P1[3],P1[4],P1[5],     pw2[0]=PKW(P1,0), pw2[1]=PKW(P1,2), pw2); \
    VRD(6); SBAR(); GAPA(C1=__builtin_amdgcn_mfma_f32_32x32x16_bf16(kf[5],qr[2],C1,0,0,0),   P1[6],P1[7],P1[8],P1[9],     pw2[2]=PKW(P1,4), pw2[3]=PKW(P1,6), pw2); \
    VRD(3); SBAR(); GAPA(C0=__builtin_amdgcn_mfma_f32_32x32x16_bf16(kf[6],qr[3],C0,0,0,0),   P1[10],P1[11],P1[12],P1[13], pw3[0]=PKW(P1,8), pw3[1]=PKW(P1,10), pw3); \
    VRD(7); SBAR(); GAPA(C1=__builtin_amdgcn_mfma_f32_32x32x16_bf16(kf[7],qr[3],C1,0,0,0),   P1[14],P1[15],0.f,0.f,       pw3[2]=PKW(P1,12),pw3[3]=PKW(P1,14), pw3); \
    l_reg+=sacc; \
    if(GK){DMA_K((t)+3,sl_cur);} if(GV){DMA_V((t)+1,sl_next);} \
    CMASK(C0,C1,t); \
    { float a=MX3(C0[0],C0[1],C1[0]),b=MX3(C0[2],C0[3],C1[1]); a=MX3(a,C1[2],C1[3]); \
      _Pragma("unroll") for(int r=4;r<16;r+=4){a=MX3(a,C0[r],C0[r+1]);b=MX3(b,C0[r+2],C0[r+3]);a=MX3(a,C1[r],C1[r+1]);b=MX3(b,C1[r+2],C1[r+3]);} \
      float rm=__builtin_fmaxf(a,b); { auto rr=__builtin_amdgcn_permlane32_swap(__float_as_uint(rm),__float_as_uint(rm),false,false); rm=__builtin_fmaxf(__uint_as_float(rr[0]),__uint_as_float(rr[1])); } \
      resc=false; \
      if(__builtin_expect(__any(rm>(float)THRL),0)){ const float dl=__builtin_fmaxf(rm,0.f); mhat+=dl; \
        _Pragma("unroll") for(int r=0;r<16;++r){C0[r]-=dl;C1[r]-=dl;} \
        _Pragma("unroll") for(int r=0;r<16;++r)negm[r]=-mhat; asm volatile("":"+v"(negm)); \
        const float f=__builtin_amdgcn_exp2f(-dl); l_reg*=f; if(hi==0)wsf[r32]=f; resc=true; } } \
    SBAR(); \
    GAPB(o[0]=__builtin_amdgcn_mfma_f32_32x32x16_bf16(PAF(0),VFR(0),o[0],0,0,0), C0,0); \
    GAPB(o[1]=__builtin_amdgcn_mfma_f32_32x32x16_bf16(PAF(0),VFR(4),o[1],0,0,0), C0,4); \
    KRD(GL,0); GAPB(o[0]=__builtin_amdgcn_mfma_f32_32x32x16_bf16(PAF(1),VFR(1),o[0],0,0,0), C0,8); \
    KRD(GL,1); GAPB(o[1]=__builtin_amdgcn_mfma_f32_32x32x16_bf16(PAF(1),VFR(5),o[1],0,0,0), C0,12); \
    KRD(GL,2); GAPB(o[0]=__builtin_amdgcn_mfma_f32_32x32x16_bf16(PAF(2),VFR(2),o[0],0,0,0), C1,0); \
    KRD(GL,3); GAPB(o[1]=__builtin_amdgcn_mfma_f32_32x32x16_bf16(PAF(2),VFR(6),o[1],0,0,0), C1,4); \
    GAPB(o[0]=__builtin_amdgcn_mfma_f32_32x32x16_bf16(PAF(3),VFR(3),o[0],0,0,0), C1,8); \
    GAPB(o[1]=__builtin_amdgcn_mfma_f32_32x32x16_bf16(PAF(3),VFR(7),o[1],0,0,0), C1,12); \
    }while(0)
  int t=1;
  #undef CMASK
  #define CMASK(P0,P1,t) do{}while(0)
  for(;t+5<NT;t+=2){
    STEP(pB0,pB1,pA0,pA1,t,true,true,true);     WAIT_BAR(2); RESC(); ROT();
    STEP(pA0,pA1,pB0,pB1,t+1,true,true,true);   WAIT_BAR(2); RESC(); ROT();
  }
  #undef CMASK
  #define CMASK(P0,P1,t) do{}while(0)
  #define ENDW(tt) do{ if((tt)+3<NT){WAIT_BAR(2);} else if((tt)+2<NT){WAIT_BAR(1);} else {WAIT_BAR(0);} }while(0)
  for(;t+1<NT;t+=2){
    STEP(pB0,pB1,pA0,pA1,t,(t+3<NT),(t+1<NT),(t+1<NT));       ENDW(t);   RESC(); ROT();
    STEP(pA0,pA1,pB0,pB1,t+1,(t+4<NT),(t+2<NT),(t+2<NT));     ENDW(t+1); RESC(); ROT();
  }
  STEP(pB0,pB1,pA0,pA1,NT-1,false,false,false); RESC();
  { float sacc=pB0[0]+pB0[1]; _Pragma("unroll") for(int r=2;r<16;++r)sacc+=pB0[r]; _Pragma("unroll") for(int r=0;r<16;++r)sacc+=pB1[r]; l_reg+=sacc;
    pw0=(u32x4){PKW(pB0,0),PKW(pB0,2),PKW(pB0,4),PKW(pB0,6)};pw1=(u32x4){PKW(pB0,8),PKW(pB0,10),PKW(pB0,12),PKW(pB0,14)};pw2=(u32x4){PKW(pB1,0),PKW(pB1,2),PKW(pB1,4),PKW(pB1,6)};pw3=(u32x4){PKW(pB1,8),PKW(pB1,10),PKW(pB1,12),PKW(pB1,14)};
    SBAR(); pv(o,vb0+sl_cur,PAF(0),PAF(1),PAF(2),PAF(3)); }
  #undef PKW
  #undef PAF
  #undef VFR
  #undef PIN
  #undef MX3
  #undef GAPA
  #undef GAPB
  #undef EX
  #undef VRD
  #undef KRD
  #undef STEP
  #undef ENDW
  {auto rr=__builtin_amdgcn_permlane32_swap(__float_as_uint(l_reg),__float_as_uint(l_reg),false,false);l_reg=__uint_as_float(rr[0])+__uint_as_float(rr[1]);}
  if(hi==0)wsf[32+r32]=l_reg;asm volatile("s_waitcnt lgkmcnt(0)":::"memory");
  float rli[16];
  #pragma unroll
  for(int r=0;r<16;++r)rli[r]=__builtin_amdgcn_rcpf(wsf[32+crow(r,hi)]);
  bf16*Ow=O+(rowbase+q0+wid*QBLK)*OP+h*D;
  { bf16*stg=(bf16*)(shm+LDS_OST)+wid*2048;
    #pragma unroll
    for(int r=0;r<16;++r){const int orow=crow(r,hi);
      #pragma unroll
      for(int d0=0;d0<2;++d0)stg[orow*64+d0*32+r32]=__float2bfloat16(o[d0][r]*rli[r]);}
    asm volatile("s_waitcnt lgkmcnt(0)":::"memory");
    #pragma unroll
    for(int i=0;i<4;++i){const int row=i*8+(lane>>3),ch=lane&7; const u32x4 v=*(const u32x4*)(stg+row*64+ch*8); ATTN_STORE16(Ow+(long)row*OP+ch*8,v);} }
  asm volatile("s_waitcnt lgkmcnt(0)\n\ts_barrier":::"memory");
  #undef DMA_K
  #undef DMA_V
  #undef CMASK
  #undef START
  #undef RESC
  #undef ROT
}
constexpr int ATTN_LDS_BYTES=LDS_BYTES;
struct AttnTensors { const bf16* Q; const bf16* K; const bf16* V; bf16* O; };
struct AttnUnit { int bh; int qb; };
struct StaticOrder {
  int vcu,G;
  __device__ __forceinline__ explicit StaticOrder(int grid,int block):vcu((grid%8==0)?(block%8)*(grid/8)+block/8:block),G(grid){}
  __device__ __forceinline__ bool next(int i,AttnUnit&u)const{ const int x=i*G+vcu; if(x>=BATCH*NHEAD*NQB)return false; u.bh=x>>3; u.qb=x&7; return true; }
  __device__ __forceinline__ void a_ready(const AttnUnit&)const{}
  __device__ __forceinline__ void done(const AttnUnit&)const{}
};
template<class Sched,int THRL=8> __device__ __forceinline__ void attn_phase(char*lds,const AttnTensors&T,const Sched&S){
  AttnUnit u;
  for(int i=0;S.next(i,u);++i){ S.a_ready(u); attn_unit<THRL>(u.bh/NHEAD,u.bh%NHEAD,u.qb,T.Q,T.K,T.V,T.O,lds); S.done(u); }
}
#undef SBAR
#undef WAIT_BAR
}
constexpr int NWAVES = 8;
#ifndef DEPTH_
#define DEPTH_ 4
#endif
constexpr int M = 65536, D = 1024, SEQ = 2048, NBATCH = 32, FF = 4096, DPLE = 256, DEPTH = DEPTH_;
constexpr float DN_ALPHA = 1.6817928305074290f;
constexpr float LN_EPS = 1e-6f;
constexpr size_t MiB = 1u << 20;
constexpr size_t WS_W = 2 * MiB;
constexpr size_t WS_WIN = WS_W, WS_WO = WS_W + 28 * MiB, WS_W1G = WS_W + 36 * MiB, WS_W2 = WS_W + 76 * MiB, WS_WP = WS_W + 108 * MiB;
constexpr size_t WS_XN = 114 * MiB;
constexpr size_t WS_PB = 242 * MiB;
constexpr size_t WS_GATES = 274 * MiB;
constexpr size_t WS_QKV = 282 * MiB;
constexpr size_t WS_O = 698 * MiB;
constexpr size_t WS_PP = 826 * MiB;
constexpr size_t WS_H = 282 * MiB;
constexpr size_t WS_END = 954 * MiB;
constexpr int LDS_BYTES = 147456;

#define GAS __attribute__((address_space(1)))
#define LAS __attribute__((address_space(3)))
typedef unsigned short bf16;
typedef unsigned v4u __attribute__((ext_vector_type(4)));
typedef float f32x4 __attribute__((ext_vector_type(4)));
typedef short bf16x8 __attribute__((ext_vector_type(8)));
#define LDS_WAIT() asm volatile("s_waitcnt lgkmcnt(0)" ::: "memory")
__device__ __forceinline__ unsigned f2bf(float f) { unsigned u = __builtin_bit_cast(unsigned, f); return (u + 0x7fffu + ((u >> 16) & 1u)) >> 16; }
__device__ __forceinline__ unsigned pk2(float lo, float hi) { return f2bf(lo) | (f2bf(hi) << 16); }
__device__ __forceinline__ float bf2f(unsigned short h) { return __uint_as_float(((unsigned)h) << 16); }
__device__ __forceinline__ f32x4 mfma16(bf16x8 a, bf16x8 b, f32x4 c) { return __builtin_amdgcn_mfma_f32_16x16x32_bf16(a, b, c, 0, 0, 0); }
__device__ __forceinline__ float wave_sum(float v) {
#pragma unroll
    for (int o = 1; o < 64; o <<= 1) v += __shfl_xor(v, o);
    return v;
}

struct Args { const float* in[21]; float* out; unsigned char* ws; int skip, pad; };

__device__ __forceinline__ void p0_transpose_item(const float* W, int K, int N, bf16* WT, int row_off, LAS float* scr, int item, int lane) {
    const int nblk = N / 32, kb = item / nblk, nb = item % nblk, k0 = 64 * kb, n0 = 32 * nb;
#pragma unroll 8
    for (int i = 0; i < 32; ++i) { const int kk = 2 * i + (lane >> 5); scr[kk * 33 + (lane & 31)] = W[(size_t)(k0 + kk) * N + n0 + (lane & 31)]; }
    LDS_WAIT(); asm volatile("" ::: "memory");
    const int c = lane & 7;
#pragma unroll
    for (int j = 0; j < 4; ++j) { const int n = (lane >> 3) + 8 * j; const LAS float* s = scr + (8 * c) * 33 + n;
        v4u o; o.x = pk2(s[0 * 33], s[1 * 33]); o.y = pk2(s[2 * 33], s[3 * 33]); o.z = pk2(s[4 * 33], s[5 * 33]); o.w = pk2(s[6 * 33], s[7 * 33]);
        *(v4u*)(WT + (size_t)(row_off + n0 + n) * K + k0 + 8 * c) = o; }
    LDS_WAIT(); asm volatile("" ::: "memory");
}
struct WDesc { const float* src; int K, N; bf16* dst; int row_off; };
__device__ __forceinline__ WDesc wdesc(const Args& a, int idx) {
    const int l = idx / 6, kind = idx % 6; WDesc w; unsigned char* ws = a.ws;
    if (kind == 0) { w.K = 1024; w.row_off = 0; w.dst = (bf16*)(ws + WS_WIN + (size_t)l * 7 * MiB);
        if (l == 0) { w.src = a.in[2]; w.N = 3072; } else if (l == 1) { w.src = a.in[5]; w.N = 1536; } else if (l == 2) { w.src = a.in[9]; w.N = 3104; } else { w.src = a.in[2] + (size_t)1024 * 3072; w.N = 3072; } }
    else if (kind == 1) { w.K = 1024; w.N = 1024; w.row_off = 0; w.dst = (bf16*)(ws + WS_WO + (size_t)l * 2 * MiB);
        w.src = (l == 0) ? a.in[4] : (l == 1) ? a.in[8] : (l == 2) ? a.in[12] : a.in[4] + (size_t)1024 * 1024; }
    else if (kind == 2) { w.K = 1024; w.N = 4096; w.row_off = 0; w.dst = (bf16*)(ws + WS_W1G + (size_t)l * 10 * MiB); w.src = a.in[15] + (size_t)l * 1024 * 4096; }
    else if (kind == 3) { w.K = 1024; w.N = 1024; w.row_off = 4096; w.dst = (bf16*)(ws + WS_W1G + (size_t)l * 10 * MiB); w.src = a.in[19] + (size_t)l * 1024 * 1024; }
    else if (kind == 4) { w.K = 4096; w.N = 1024; w.row_off = 0; w.dst = (bf16*)(ws + WS_W2 + (size_t)l * 8 * MiB); w.src = a.in[16] + (size_t)l * 4096 * 1024; }
    else { w.K = 256; w.N = 1024; w.row_off = 0; w.dst = (bf16*)(ws + WS_WP + (size_t)l * (MiB / 2)); w.src = a.in[20] + (size_t)l * 256 * 1024; }
    return w;
}
__device__ __forceinline__ void cvt_rows(const float* src, bf16* dst, size_t n, int G) {
    const size_t nth = (size_t)G * 512, n8 = n / 8;
    for (size_t i = (size_t)blockIdx.x * 512 + threadIdx.x; i < n8; i += nth) {
        const f32x4 a = *(const f32x4*)(src + i * 8), b = *(const f32x4*)(src + i * 8 + 4);
        v4u o; o.x = pk2(a[0], a[1]); o.y = pk2(a[2], a[3]); o.z = pk2(b[0], b[1]); o.w = pk2(b[2], b[3]);
        *(v4u*)(dst + i * 8) = o; }
}
__device__ __forceinline__ void prologue_phase(const Args& a, LAS unsigned char* lds, int G) {
    const int tid = threadIdx.x, lane = tid & 63, wave = tid >> 6;
    LAS float* scr = (LAS float*)(lds + wave * 16384);
    const int gw = blockIdx.x * NWAVES + wave, NGW = G * NWAVES;
    for (int idx = 0; idx < 24; ++idx) { const WDesc w = wdesc(a, idx); const int nitems = (w.K / 64) * (w.N / 32);
        for (int it = gw; it < nitems; it += NGW) p0_transpose_item(w.src, w.K, w.N, w.dst, w.row_off, scr, it, lane); }
    {
        v4u* z = (v4u*)((bf16*)(a.ws + WS_WIN + (size_t)2 * 7 * MiB) + (size_t)3104 * 1024); const size_t n16 = (size_t)224 * 1024 * 2 / 16;
        for (size_t i = (size_t)blockIdx.x * 512 + tid; i < n16; i += (size_t)G * 512) z[i] = (v4u){0u, 0u, 0u, 0u}; }
    cvt_rows(a.in[0], (bf16*)(a.ws + WS_XN), (size_t)M * D, G);
    cvt_rows(a.in[1], (bf16*)(a.ws + WS_PB), (size_t)M * DPLE, G);
}
__device__ __forceinline__ void ln_phase(float* zx, const float* g, const float* bta, bf16* XN, int G) {
    const int lane = threadIdx.x & 63, wave = threadIdx.x >> 6; const int gw = blockIdx.x * NWAVES + wave, NGW = G * NWAVES;
    f32x4 gv[4], bv[4];
#pragma unroll
    for (int j = 0; j < 4; ++j) { gv[j] = *(const f32x4*)(g + 4 * lane + 256 * j); bv[j] = *(const f32x4*)(bta + 4 * lane + 256 * j); }
    for (int m = gw; m < M; m += NGW) {
        f32x4* xr = (f32x4*)(zx + (size_t)m * D) + lane; f32x4 v[4]; float s = 0.f;
#pragma unroll
        for (int j = 0; j < 4; ++j) { v[j] = xr[64 * j]; s += (v[j][0] + v[j][1]) + (v[j][2] + v[j][3]); }
        const float mean = wave_sum(s) * (1.f / D); float s2 = 0.f;
#pragma unroll
        for (int j = 0; j < 4; ++j) { v[j] = v[j] - mean; s2 += (v[j][0] * v[j][0] + v[j][1] * v[j][1]) + (v[j][2] * v[j][2] + v[j][3] * v[j][3]); }
        const float rstd = 1.f / sqrtf(wave_sum(s2) * (1.f / D) + LN_EPS);
        unsigned long long* o8 = (unsigned long long*)(XN + (size_t)m * D) + lane;
#pragma unroll
        for (int j = 0; j < 4; ++j) { const f32x4 y = v[j] * rstd * gv[j] + bv[j]; xr[64 * j] = y;
            o8[64 * j] = (unsigned long long)pk2(y[0], y[1]) | ((unsigned long long)pk2(y[2], y[3]) << 32); }
    }
}
__device__ __forceinline__ void na_phase(const bf16* QKV, const float* rpb, bf16* O, LAS unsigned char* lds, int G) {
    const int tid = threadIdx.x, lane = tid & 63, wave = tid >> 6, l15 = lane & 15, quad = lane >> 4;
    LAS bf16* vt = (LAS bf16*)(lds + wave * 5120);
    const int gw = blockIdx.x * NWAVES + wave, NGW = G * NWAVES;
    for (int uid = gw; uid < 65536; uid += NGW) {
        const int jq = uid & 3, h = (uid >> 2) & 15, r = (uid >> 6) & 31, b = uid >> 11;
        const int r0 = min(max(r - 4, 0), 24);
        const int kc0 = (jq == 0) ? 0 : (jq == 1) ? 8 : (jq == 2) ? 24 : 32;
        const size_t tokb = (size_t)b * 2048;
        const int c = jq * 16 + l15, c0 = min(max(c - 8, 0), 48);
        const bf16* qp = QKV + (tokb + r * 64 + c) * 3072 + h * 64 + quad * 8;
        const bf16x8 qf0 = *(const bf16x8*)qp, qf1 = *(const bf16x8*)(qp + 32);
        const float* rp = rpb + h * (15 * 31);
        f32x4 sc[8][2];
        float mx = -INFINITY;
#pragma unroll
        for (int a = 0; a < 8; ++a) {
            const int dr = r0 + a - r + 7;
#pragma unroll
            for (int cb = 0; cb < 2; ++cb) {
                const bf16* kp = QKV + (tokb + (r0 + a) * 64 + kc0 + cb * 16 + l15) * 3072 + 1024 + h * 64 + quad * 8;
                const bf16x8 k0 = *(const bf16x8*)kp, k1 = *(const bf16x8*)(kp + 32);
                f32x4 acc = {0.f, 0.f, 0.f, 0.f};
                acc = mfma16(k0, qf0, acc); acc = mfma16(k1, qf1, acc);
#pragma unroll
                for (int j = 0; j < 4; ++j) { const int kc = kc0 + cb * 16 + quad * 4 + j; const bool valid = (kc >= c0) && (kc < c0 + 16);
                    const int dc = min(max(kc - c + 15, 0), 30);
                    const float bias = rp[dr * 31 + dc];
                    acc[j] = valid ? acc[j] + bias : -INFINITY; mx = fmaxf(mx, acc[j]); }
                sc[a][cb] = acc;
            }
        }
        mx = fmaxf(mx, __shfl_xor(mx, 16)); mx = fmaxf(mx, __shfl_xor(mx, 32));
        float sum = 0.f;
#pragma unroll
        for (int a = 0; a < 8; ++a)
#pragma unroll
            for (int cb = 0; cb < 2; ++cb)
#pragma unroll
                for (int j = 0; j < 4; ++j) { const float p = __expf(sc[a][cb][j] - mx); sc[a][cb][j] = p; sum += p; }
        sum += __shfl_xor(sum, 16); sum += __shfl_xor(sum, 32);
        f32x4 o[4];
#pragma unroll
        for (int db = 0; db < 4; ++db) o[db] = (f32x4){0.f, 0.f, 0.f, 0.f};
        const int key = lane >> 1, half = lane & 1;
        const int kperm = (key < 16) ? ((key >> 2) * 8 + (key & 3)) : (((key - 16) >> 2) * 8 + 4 + (key & 3));
#pragma unroll
        for (int a = 0; a < 8; ++a) {
            const bf16* vp = QKV + (tokb + (r0 + a) * 64 + kc0 + key) * 3072 + 2048 + h * 64 + half * 32;
            bf16x8 vv[4];
#pragma unroll
            for (int i = 0; i < 4; ++i) vv[i] = *(const bf16x8*)(vp + 8 * i);
#pragma unroll
            for (int i = 0; i < 4; ++i)
#pragma unroll
                for (int e = 0; e < 8; ++e) vt[(half * 32 + i * 8 + e) * 40 + kperm] = (bf16)vv[i][e];
            LDS_WAIT();
            bf16x8 pb;
            { const unsigned w0 = pk2(sc[a][0][0], sc[a][0][1]), w1 = pk2(sc[a][0][2], sc[a][0][3]), w2 = pk2(sc[a][1][0], sc[a][1][1]), w3 = pk2(sc[a][1][2], sc[a][1][3]);
              const v4u w = {w0, w1, w2, w3}; pb = __builtin_bit_cast(bf16x8, w); }
#pragma unroll
            for (int db = 0; db < 4; ++db) { const bf16x8 vf = *(const LAS bf16x8*)(vt + (db * 16 + l15) * 40 + quad * 8); o[db] = mfma16(vf, pb, o[db]); }
            LDS_WAIT();
        }
        const float inv = 1.0f / sum;
        bf16* op = O + (tokb + r * 64 + c) * 1024 + h * 64 + quad * 4;
#pragma unroll
        for (int db = 0; db < 4; ++db) { const unsigned long long w = (unsigned long long)pk2(o[db][0] * inv, o[db][1] * inv) | ((unsigned long long)pk2(o[db][2] * inv, o[db][3] * inv) << 32);
            *(unsigned long long*)(op + db * 16) = w; }
    }
}
__device__ __forceinline__ void gq_normrope_phase(bf16* QKV, const float* qn, const float* kn, int G) {
    const size_t total = (size_t)M * 20 * 8, nth = (size_t)G * 512;
    for (size_t g = (size_t)blockIdx.x * 512 + threadIdx.x; g < total; g += nth) {
        const size_t item = g >> 3; const int l8 = (int)(g & 7); const size_t tok = item / 20; const int hv = (int)(item % 20);
        bf16* p = QKV + tok * 1536 + hv * 64 + l8 * 8;
        const v4u raw = *(const v4u*)p; const unsigned rw[4] = {raw.x, raw.y, raw.z, raw.w};
        float x[8]; float ss = 0.f;
#pragma unroll
        for (int e = 0; e < 4; ++e) { x[2 * e] = __uint_as_float(rw[e] << 16); x[2 * e + 1] = __uint_as_float(rw[e] & 0xffff0000u); ss += x[2 * e] * x[2 * e] + x[2 * e + 1] * x[2 * e + 1]; }
        ss += __shfl_xor(ss, 1); ss += __shfl_xor(ss, 2); ss += __shfl_xor(ss, 4);
        const float rinv = 1.0f / sqrtf(ss * (1.f / 64.f) + 1e-6f);
        const float* gvec = ((hv < 16) ? qn : kn) + l8 * 8;
        const int s = (int)(tok & 2047), row = s >> 6, col = s & 63;
        const float scale = (hv < 16) ? (0.125f * 1.4426950408889634f) : 1.0f;
        unsigned ow[4];
#pragma unroll
        for (int pr = 0; pr < 4; ++pr) { const int i = l8 * 4 + pr; const float pos = (float)((i < 16) ? row : col); const int fi = i & 15;
            const float inv = exp2f(-(float)fi * (13.287712379549449f / 16.f)); const float ang = pos * inv;
            float rev = ang * 0.15915494309189535f; rev -= rintf(rev);
            const float sn = __builtin_amdgcn_sinf(rev), cs = __builtin_amdgcn_cosf(rev);
            const float x0 = x[2 * pr] * rinv * gvec[2 * pr], x1 = x[2 * pr + 1] * rinv * gvec[2 * pr + 1];
            ow[pr] = pk2((x0 * cs - x1 * sn) * scale, (x0 * sn + x1 * cs) * scale); }
        *(v4u*)p = (v4u){ow[0], ow[1], ow[2], ow[3]};
    }
}
__device__ __forceinline__ f32x4 tile_mma64(const LAS bf16* A, int arow0, const LAS bf16* Bt, int brow0, f32x4 acc, int l15, int quad) {
    const LAS bf16* ap = A + (arow0 + l15) * 72 + quad * 8; const LAS bf16* bp = Bt + (brow0 + l15) * 72 + quad * 8;
    acc = mfma16(*(const LAS bf16x8*)ap, *(const LAS bf16x8*)bp, acc);
    acc = mfma16(*(const LAS bf16x8*)(ap + 32), *(const LAS bf16x8*)(bp + 32), acc);
    return acc;
}
__device__ __forceinline__ void ml_phase(const bf16* Z, const float* gates, const float* norm_g, bf16* HFW, bf16* O, LAS unsigned char* lds, int G) {
    const int tid = threadIdx.x, lane = tid & 63, wave = tid >> 6, l15 = lane & 15, quad = lane >> 4;
    LAS bf16* Qs = (LAS bf16*)(lds);
    LAS bf16* Ks = (LAS bf16*)(lds + 9216);
    LAS bf16* Vt = (LAS bf16*)(lds + 18432);
    LAS bf16* Kt = (LAS bf16*)(lds + 39168);
    LAS bf16* Ct = (LAS bf16*)(lds + 48384);
    LAS bf16* As = (LAS bf16*)(lds + 69120);
    LAS float* Hs = (LAS float*)(lds + 78336);
    LAS float* vec = (LAS float*)(lds + 112128);
    for (int unit = blockIdx.x; unit < 256; unit += G) {
        const int b = unit >> 3, h = unit & 7; const size_t tokb = (size_t)b * 2048;
        for (int dir = 0; dir < 2; ++dir) {
            for (int i = tid; i < 144 * 72; i += 512) Ct[i] = 0;
            for (int i = tid; i < 16 * 72; i += 512) Vt[128 * 72 + i] = (i < 72) ? (bf16)0x3F80 : (bf16)0;
            f32x4 cst[4], cst8 = {0.f, 0.f, 0.f, 0.f};
#pragma unroll
            for (int i = 0; i < 4; ++i) cst[i] = (f32x4){0.f, 0.f, 0.f, 0.f};
            float m_run = 0.f;
            __syncthreads();
            for (int cs = 0; cs < 32; ++cs) {
                const int t8 = tid >> 3, ch = tid & 7;
                const size_t tok8 = tokb + (size_t)(dir == 0 ? cs * 64 + t8 : 2047 - (cs * 64 + t8));
                {
                    const bf16* zr = Z + tok8 * 3072;
                    *(LAS v4u*)(Qs + t8 * 72 + ch * 8) = *(const v4u*)(zr + h * 64 + ch * 8);
                    *(LAS v4u*)(Ks + t8 * 72 + ch * 8) = *(const v4u*)(zr + 512 + h * 64 + ch * 8);
#pragma unroll
                    for (int i = 0; i < 2; ++i) { const int c16 = ch + 8 * i; const bf16x8 vv = *(const bf16x8*)(zr + 1024 + h * 128 + c16 * 8);
#pragma unroll
                        for (int e = 0; e < 8; ++e) Vt[(c16 * 8 + e) * 72 + t8] = (bf16)vv[e]; }
                }
                if (wave == 0) {
                    const size_t tok = tokb + (size_t)(dir == 0 ? cs * 64 + lane : 2047 - (cs * 64 + lane));
                    const float li = gates[tok * 32 + dir * 16 + h], f = gates[tok * 32 + dir * 16 + 8 + h];
                    const float lf = fminf(f, 0.f) - log1pf(__expf(-fabsf(f)));
                    float bs = lf;
#pragma unroll
                    for (int o = 1; o < 64; o <<= 1) { const float y = __shfl_up(bs, o); if (lane >= o) bs += y; }
                    const float u = li - bs; float pm = u;
#pragma unroll
                    for (int o = 1; o < 64; o <<= 1) { const float y = __shfl_up(pm, o); if (lane >= o) pm = fmaxf(pm, y); }
                    const float Mt = fmaxf(pm, m_run), sint = __expf(m_run - Mt), mt = bs + Mt;
                    vec[lane] = u; vec[64 + lane] = Mt; vec[128 + lane] = sint; vec[192 + lane] = __expf(-mt);
                    m_run = __shfl(mt, 63);
                }
                __syncthreads();
                {
                    const int tb = wave >> 1;
#pragma unroll
                    for (int i = 0; i < 2; ++i) { const int sb = 2 * (wave & 1) + i;
                        f32x4 acc = {0.f, 0.f, 0.f, 0.f}; if (sb <= tb) acc = tile_mma64(Qs, tb * 16, Ks, sb * 16, acc, l15, quad);
                        const int s = sb * 16 + l15; const float us = vec[s];
#pragma unroll
                        for (int j = 0; j < 4; ++j) { const int t = tb * 16 + 4 * quad + j; const float w = (s <= t) ? __expf(us - vec[64 + t]) : 0.f; As[t * 72 + s] = (bf16)f2bf(acc[j] * w); } }
                    const float w63 = __expf(vec[t8] - vec[64 + 63]);
                    const bf16x8 kk = *(const LAS bf16x8*)(Ks + t8 * 72 + ch * 8);
#pragma unroll
                    for (int e = 0; e < 8; ++e) Kt[(ch * 8 + e) * 72 + t8] = (bf16)f2bf(bf2f((bf16)kk[e]) * w63);
                }
                __syncthreads();
                {
#pragma unroll
                    for (int tb = 0; tb < 4; ++tb) { const f32x4 z4 = {0.f, 0.f, 0.f, 0.f};
                        const f32x4 ah = tile_mma64(As, tb * 16, Vt, wave * 16, z4, l15, quad), ag = tile_mma64(Qs, tb * 16, Ct, wave * 16, z4, l15, quad);
#pragma unroll
                        for (int j = 0; j < 4; ++j) { const int t = tb * 16 + 4 * quad + j; Hs[t * 132 + wave * 16 + l15] = vec[128 + t] * ag[j] + ah[j]; } }
                    if (wave < 4) { const int tb = wave; const f32x4 z4 = {0.f, 0.f, 0.f, 0.f};
                        const f32x4 ah = tile_mma64(As, tb * 16, Vt, 128, z4, l15, quad), ag = tile_mma64(Qs, tb * 16, Ct, 128, z4, l15, quad);
                        if (l15 == 0) {
#pragma unroll
                            for (int j = 0; j < 4; ++j) { const int t = tb * 16 + 4 * quad + j; vec[256 + t] = vec[128 + t] * ag[j] + ah[j]; } } }
                }
                __syncthreads();
                {
                    const float decay = vec[128 + 63];
#pragma unroll
                    for (int db = 0; db < 4; ++db) { cst[db] = tile_mma64(Vt, wave * 16, Kt, db * 16, cst[db] * decay, l15, quad);
#pragma unroll
                        for (int j = 0; j < 4; ++j) Ct[(wave * 16 + 4 * quad + j) * 72 + db * 16 + l15] = (bf16)f2bf(cst[db][j]); }
                    if (wave < 4) { cst8 = tile_mma64(Vt, 128, Kt, wave * 16, cst8 * decay, l15, quad);
#pragma unroll
                        for (int j = 0; j < 4; ++j) Ct[(128 + 4 * quad + j) * 72 + wave * 16 + l15] = (bf16)f2bf(cst8[j]); }
                    const float dn = fmaxf(fabsf(vec[256 + t8]), vec[192 + t8]); const float rd = 1.0f / dn;
                    float hv[16];
#pragma unroll
                    for (int e = 0; e < 16; ++e) hv[e] = Hs[t8 * 132 + ch * 16 + e] * rd;
                    const size_t ho = tok8 * 1024 + h * 128 + ch * 16;
                    if (dir == 0) {
                        v4u w0, w1; w0.x = pk2(hv[0], hv[1]); w0.y = pk2(hv[2], hv[3]); w0.z = pk2(hv[4], hv[5]); w0.w = pk2(hv[6], hv[7]);
                        w1.x = pk2(hv[8], hv[9]); w1.y = pk2(hv[10], hv[11]); w1.z = pk2(hv[12], hv[13]); w1.w = pk2(hv[14], hv[15]);
                        *(v4u*)(HFW + ho) = w0; *(v4u*)(HFW + ho + 8) = w1;
                    } else {
                        const v4u f0 = *(const v4u*)(HFW + ho), f1 = *(const v4u*)(HFW + ho + 8);
                        const unsigned fw[8] = {f0.x, f0.y, f0.z, f0.w, f1.x, f1.y, f1.z, f1.w};
                        float ss = 0.f;
#pragma unroll
                        for (int e = 0; e < 8; ++e) { hv[2 * e] += __uint_as_float(fw[e] << 16); hv[2 * e + 1] += __uint_as_float(fw[e] & 0xffff0000u); ss += hv[2 * e] * hv[2 * e] + hv[2 * e + 1] * hv[2 * e + 1]; }
                        ss += __shfl_xor(ss, 1); ss += __shfl_xor(ss, 2); ss += __shfl_xor(ss, 4);
                        const float rinv = 1.0f / sqrtf(ss * (1.f / 128.f) + 1e-6f);
                        const bf16* og = Z + tok8 * 3072 + 2048 + h * 128 + ch * 16;
                        const v4u g0 = *(const v4u*)og, g1 = *(const v4u*)(og + 8);
                        const unsigned gw_[8] = {g0.x, g0.y, g0.z, g0.w, g1.x, g1.y, g1.z, g1.w};
                        const float* ng = norm_g + h * 128 + ch * 16;
                        unsigned ow[8];
#pragma unroll
                        for (int e = 0; e < 8; ++e) { const float o0 = 1.0f / (1.0f + __expf(-__uint_as_float(gw_[e] << 16))), o1 = 1.0f / (1.0f + __expf(-__uint_as_float(gw_[e] & 0xffff0000u)));
                            ow[e] = pk2(hv[2 * e] * rinv * ng[2 * e] * o0, hv[2 * e + 1] * rinv * ng[2 * e + 1] * o1); }
                        *(v4u*)(O + ho) = (v4u){ow[0], ow[1], ow[2], ow[3]}; *(v4u*)(O + ho + 8) = (v4u){ow[4], ow[5], ow[6], ow[7]};
                    }
                }
                __syncthreads();
            }
        }
    }
}
#define SKIP(bit) ((a.skip >> (bit)) & 1)
template <int L> __device__ __forceinline__ void layer_program(const Args& a, LAS unsigned char* lds, unsigned char* lds_raw, const int G, cg::grid_group& grid) {
    constexpr int kind = L % 3;
    unsigned char* ws = a.ws;
    bf16* XN = (bf16*)(ws + WS_XN); bf16* QKV = (bf16*)(ws + WS_QKV); bf16* OB = (bf16*)(ws + WS_O); bf16* PP = (bf16*)(ws + WS_PP); bf16* HB = (bf16*)(ws + WS_H);
    if (!SKIP(1)) { const bf16* Win = (const bf16*)(ws + WS_WIN + (size_t)L * 7 * MiB);
        if constexpr (kind == 2) { pg8::Gemm g{XN, Win, M, 3328, D}; pg8::StaticOrder S; S.init(M, 3328, G, (int)blockIdx.x);
            pg8::EpiMl E{QKV, (float*)(ws + WS_GATES), a.in[10]};
            pg8::gemm_phase<pg8::EpiMl, pg8::StaticOrder, true, true>(lds, g, S, E); }
        else { constexpr int N = (kind == 0) ? 3072 : 1536; pg8::Gemm g{XN, Win, M, N, D}; pg8::StaticOrder S; S.init(M, N, G, (int)blockIdx.x);
            pg8::EpiPlain E{QKV, N, (kind == 0) ? 1024 : 0, 0.125f};
            pg8::gemm_phase<pg8::EpiPlain, pg8::StaticOrder, true, true>(lds, g, S, E); } }
    if (!SKIP(2)) { pg8::Gemm g{(const bf16*)(ws + WS_PB), (const bf16*)(ws + WS_WP + (size_t)L * (MiB / 2)), M, D, DPLE}; pg8::StaticOrder S; S.init(M, D, G, (int)blockIdx.x);
        pg8::EpiPlain E{PP, D, 0, 1.f};
        pg8::gemm_phase<pg8::EpiPlain, pg8::StaticOrder, true, true>(lds, g, S, E); }
    grid.sync();
    if constexpr (kind == 1) { if (!SKIP(3)) gq_normrope_phase(QKV, a.in[6], a.in[7], G); grid.sync(); }
    if (!SKIP(4)) {
        if constexpr (kind == 0) na_phase(QKV, a.in[3] + (size_t)(L / 3) * 16 * 15 * 31, OB, lds, G);
        else if constexpr (kind == 1) { const attn_body::AttnTensors AT{(const attn_body::bf16*)QKV, (const attn_body::bf16*)(QKV + 1024), (const attn_body::bf16*)(QKV + 1280), (attn_body::bf16*)OB};
            const attn_body::StaticOrder S(G, (int)blockIdx.x); attn_body::attn_phase<attn_body::StaticOrder>((char*)lds_raw, AT, S); }
        else ml_phase(QKV, (const float*)(ws + WS_GATES), a.in[11], XN, OB, lds, G);
    }
    grid.sync();
    if (!SKIP(5)) { pg8::Gemm g{OB, (const bf16*)(ws + WS_WO + (size_t)L * 2 * MiB), M, D, D}; pg8::StaticOrder S; S.init(M, D, G, (int)blockIdx.x);
        pg8::EpiResid E{(L == 0) ? a.in[0] : (const float*)a.out, a.out, nullptr, DN_ALPHA};
        pg8::gemm_phase<pg8::EpiResid, pg8::StaticOrder, true, true>(lds, g, S, E); }
    grid.sync();
    if (!SKIP(6)) ln_phase(a.out, a.in[13] + (size_t)L * D, a.in[14] + (size_t)L * D, XN, G);
    grid.sync();
    if (!SKIP(7)) { pg8::Gemm g{XN, (const bf16*)(ws + WS_W1G + (size_t)L * 10 * MiB), M, FF + D, D}; pg8::StaticOrder S; S.init(M, FF + D, G, (int)blockIdx.x);
        pg8::EpiFf1 E{HB, PP};
        pg8::gemm_phase<pg8::EpiFf1, pg8::StaticOrder, true, true>(lds, g, S, E); }
    grid.sync();
    if (!SKIP(8)) { pg8::Gemm g{HB, (const bf16*)(ws + WS_W2 + (size_t)L * 8 * MiB), M, D, FF}; pg8::StaticOrder S; S.init(M, D, G, (int)blockIdx.x);
        pg8::EpiResid E{(const float*)a.out, a.out, PP, DN_ALPHA};
        pg8::gemm_phase<pg8::EpiResid, pg8::StaticOrder, true, true>(lds, g, S, E); }
    grid.sync();
    if (!SKIP(9)) { ln_phase(a.out, a.in[17] + (size_t)L * D, a.in[18] + (size_t)L * D, XN, G);
        if constexpr (L + 1 < DEPTH) cvt_rows(a.in[1] + (size_t)(L + 1) * M * DPLE, (bf16*)(ws + WS_PB), (size_t)M * DPLE, G); }
    if constexpr (L + 1 < DEPTH) grid.sync();
}
__global__ void __launch_bounds__(NWAVES * 64, 2) fwd_megakernel(Args a) {
    extern __shared__ __attribute__((aligned(16))) unsigned char lds_raw[];
    LAS unsigned char* lds = (LAS unsigned char*)lds_raw;
    cg::grid_group grid = cg::this_grid();
    const int G = gridDim.x;
    if (!SKIP(0)) prologue_phase(a, lds, G);
    grid.sync();
    layer_program<0>(a, lds, lds_raw, G, grid);
#if DEPTH_ > 1
    layer_program<1>(a, lds, lds_raw, G, grid);
    layer_program<2>(a, lds, lds_raw, G, grid);
    layer_program<3>(a, lds, lds_raw, G, grid);
#endif
}
#undef SKIP

extern "C" void kernel_launch(void* const* d_in, const int* in_sizes, int n_in, void* d_out, int out_size, void* d_ws, size_t ws_size, hipStream_t stream) {
    static int grid = 0;
    if (grid == 0) {
        if (n_in != 21 || out_size != M * D || ws_size < WS_END) { fprintf(stderr, "kernel_launch: unexpected shapes (n_in %d, out %d, ws %zu)\n", n_in, out_size, ws_size); grid = -1; return; }
        int dev = 0, cus = 0, per_cu = 0;
        hipGetDevice(&dev); hipDeviceGetAttribute(&cus, hipDeviceAttributeMultiprocessorCount, dev);
        if (hipFuncSetAttribute((const void*)fwd_megakernel, hipFuncAttributeMaxDynamicSharedMemorySize, LDS_BYTES) != hipSuccess) { fprintf(stderr, "kernel_launch: hipFuncSetAttribute failed\n"); grid = -1; return; }
        if (hipOccupancyMaxActiveBlocksPerMultiprocessor(&per_cu, (const void*)fwd_megakernel, NWAVES * 64, LDS_BYTES) != hipSuccess || per_cu < 1) per_cu = 1;
        (void)hipGetLastError();
        grid = cus * per_cu;
        fprintf(stderr, "kernel_launch: grid %d (cus %d x %d)\n", grid, cus, per_cu);
    }
    if (grid < 0) return;
    Args a{};
    for (int i = 0; i < 21; ++i) a.in[i] = (const float*)d_in[i];
    a.out = (float*)d_out; a.ws = (unsigned char*)d_ws; a.skip = 0; a.pad = 0;
    void* args[] = {&a};
    const hipError_t e = hipLaunchCooperativeKernel((const void*)fwd_megakernel, dim3(grid), dim3(NWAVES * 64), args, LDS_BYTES, stream);
    if (e != hipSuccess) fprintf(stderr, "kernel_launch: cooperative launch failed: %s (grid %d)\n", hipGetErrorString(e), grid);
}
```

```cpp
#include <hip/hip_runtime.h>
#include <hip/hip_cooperative_groups.h>
#include <cstdio>
#include <cstdint>
namespace cg = cooperative_groups;
namespace pg8 {
#define PG8_LAS __attribute__((address_space(3)))
typedef unsigned short bf16_t;
typedef short bf16x8 __attribute__((ext_vector_type(8)));
typedef float f32x4 __attribute__((ext_vector_type(4)));
typedef unsigned u32x4 __attribute__((ext_vector_type(4)));
constexpr int BM = 256, BK = 64, HALF = 128, HTB = HALF * BK * 2  , STAGE_BYTES = 8 * HTB, NXCD = 8, WGM = 8;

__host__ __device__ __forceinline__ int lds_byte(int r, int c) { const int st = (r >> 4) * 2 + (c >> 5), rr = r & 15, cc = c & 31, ob = rr * 64 + cc * 2; return st * 1024 + (ob ^ (((ob >> 9) & 1) << 5)); }
__host__ __device__ __forceinline__ void stage_rc(int b, int& R, int& C) { const int st = b / 1024, sb = b % 1024, swz = sb ^ (((sb >> 9) & 1) << 5); R = (st >> 1) * 16 + swz / 64; C = (st & 1) * 32 + (swz % 64) / 2; }
__host__ __device__ __forceinline__ int perm32(int rho) { const int n = rho >> 4, i = rho & 15; return 8 * (i >> 2) + 4 * n + (i & 3); }

struct Unit { int pm, pn; };
struct Gemm { const bf16_t* A; const bf16_t* Bt; int M, N, K; };

struct StaticOrder {
    int nM, nN, nwg, G, c;
    __host__ __device__ void init(int M, int N, int G_, int c_) { nM = M / BM; nN = N / BM; nwg = nM * nN; G = G_; c = c_; }
    __host__ __device__ bool next(int i, Unit& u) const {
        const long L = (long)i * G + c; if (L >= nwg) return false;
        int wgid = (int)L; { const int q = nwg / NXCD, r = nwg % NXCD, xcd = wgid % NXCD, off = wgid / NXCD; wgid = (xcd < r ? xcd * (q + 1) : r * (q + 1) + (xcd - r) * q) + off; }
        const int nig = WGM * nN, gid = wgid / nig, fm = gid * WGM, gsz = (nM - fm) < WGM ? (nM - fm) : WGM;
        u.pm = fm + ((wgid % nig) % gsz); u.pn = (wgid % nig) / gsz; return true;
    }
    __device__ __forceinline__ void a_ready(const Unit&) const {}
    __device__ __forceinline__ void done(const Unit&) const {}
};

__device__ __forceinline__ unsigned cvt_pk_bf16(float lo, float hi) { unsigned r; asm volatile("v_cvt_pk_bf16_f32 %0, %1, %2" : "=v"(r) : "v"(lo), "v"(hi)); return r; }
typedef float f32x2 __attribute__((ext_vector_type(2)));
__device__ __forceinline__ float bf2f(unsigned short h) { return __uint_as_float(((unsigned)h) << 16); }
__device__ __forceinline__ float sigmoidf_(float x) { return 1.0f / (1.0f + __expf(-x)); }
struct EpiPlain {
    static constexpr bool PERM = true, AFTER_DRAIN = false;
    bf16_t* O; int ldc; int scale_cols; float scale;
    __device__ __forceinline__ void operator()(const f32x4 (&acc)[2][2][4][2], const Unit& u, int wr, int wc, int fr, int fq) const {
        const int row0 = u.pm * BM + wr * 64 + fr, col0 = u.pn * BM + wc * 32 + 8 * fq;
        const float sc = (u.pn * BM < scale_cols) ? scale : 1.f;
#pragma unroll
        for (int ai = 0; ai < 2; ++ai)
#pragma unroll
            for (int m = 0; m < 4; ++m) { bf16_t* rowp = O + (size_t)(row0 + ai * HALF + m * 16) * ldc + col0;
#pragma unroll
                for (int bj = 0; bj < 2; ++bj) { f32x4 v0 = acc[ai][bj][m][0] * sc, v1 = acc[ai][bj][m][1] * sc;
                    u32x4 w; w.x = cvt_pk_bf16(v0[0], v0[1]); w.y = cvt_pk_bf16(v0[2], v0[3]); w.z = cvt_pk_bf16(v1[0], v1[1]); w.w = cvt_pk_bf16(v1[2], v1[3]);
                    *(u32x4*)(rowp + bj * HALF) = w; } }
    }
};
struct EpiMl {
    static constexpr bool PERM = true, AFTER_DRAIN = false;
    bf16_t* O; float* gates; const float* bias;
    __device__ __forceinline__ void operator()(const f32x4 (&acc)[2][2][4][2], const Unit& u, int wr, int wc, int fr, int fq) const {
        const int row0 = u.pm * BM + wr * 64 + fr;
        if (u.pn < 12) {
            const int col0 = u.pn * BM + wc * 32 + 8 * fq; const float sc = (u.pn < 2) ? 0.125f : 1.f;
#pragma unroll
            for (int ai = 0; ai < 2; ++ai)
#pragma unroll
                for (int m = 0; m < 4; ++m) { bf16_t* rowp = O + (size_t)(row0 + ai * HALF + m * 16) * 3072 + col0;
#pragma unroll
                    for (int bj = 0; bj < 2; ++bj) { f32x4 v0 = acc[ai][bj][m][0] * sc, v1 = acc[ai][bj][m][1] * sc;
                        u32x4 w; w.x = cvt_pk_bf16(v0[0], v0[1]); w.y = cvt_pk_bf16(v0[2], v0[3]); w.z = cvt_pk_bf16(v1[0], v1[1]); w.w = cvt_pk_bf16(v1[2], v1[3]);
                        *(u32x4*)(rowp + bj * HALF) = w; } }
        } else if (wc == 0) {
            const f32x4 b0 = *(const f32x4*)(bias + 8 * fq), b1 = *(const f32x4*)(bias + 8 * fq + 4);
#pragma unroll
            for (int ai = 0; ai < 2; ++ai)
#pragma unroll
                for (int m = 0; m < 4; ++m) { float* gp = gates + (size_t)(row0 + ai * HALF + m * 16) * 32 + 8 * fq;
                    *(f32x4*)gp = acc[ai][0][m][0] + b0; *(f32x4*)(gp + 4) = acc[ai][0][m][1] + b1; }
        }
    }
};
struct EpiFf1 {
    static constexpr bool PERM = true, AFTER_DRAIN = false;
    bf16_t* H; bf16_t* PP;
    __device__ __forceinline__ void operator()(const f32x4 (&acc)[2][2][4][2], const Unit& u, int wr, int wc, int fr, int fq) const {
        const int row0 = u.pm * BM + wr * 64 + fr;
        if (u.pn < 16) {
            const int col0 = u.pn * BM + wc * 32 + 8 * fq;
#pragma unroll
            for (int ai = 0; ai < 2; ++ai)
#pragma unroll
                for (int m = 0; m < 4; ++m) { bf16_t* rowp = H + (size_t)(row0 + ai * HALF + m * 16) * 4096 + col0;
#pragma unroll
                    for (int bj = 0; bj < 2; ++bj) { f32x4 v0 = acc[ai][bj][m][0], v1 = acc[ai][bj][m][1];
#pragma unroll
                        for (int e = 0; e < 4; ++e) { const float a = fmaxf(v0[e], 0.f), b = fmaxf(v1[e], 0.f); v0[e] = a * a; v1[e] = b * b; }
                        u32x4 w; w.x = cvt_pk_bf16(v0[0], v0[1]); w.y = cvt_pk_bf16(v0[2], v0[3]); w.z = cvt_pk_bf16(v1[0], v1[1]); w.w = cvt_pk_bf16(v1[2], v1[3]);
                        *(u32x4*)(rowp + bj * HALF) = w; } }
        } else {
            const int col0 = (u.pn - 16) * BM + wc * 32 + 8 * fq;
#pragma unroll
            for (int ai = 0; ai < 2; ++ai)
#pragma unroll
                for (int m = 0; m < 4; ++m) { bf16_t* rowp = PP + (size_t)(row0 + ai * HALF + m * 16) * 1024 + col0;
#pragma unroll
                    for (int bj = 0; bj < 2; ++bj) { f32x4 v0 = acc[ai][bj][m][0], v1 = acc[ai][bj][m][1];
                        const u32x4 pp = *(const u32x4*)(rowp + bj * HALF);
                        const unsigned pw[4] = {pp.x, pp.y, pp.z, pp.w};
#pragma unroll
                        for (int e = 0; e < 2; ++e) {
                            v0[2 * e]     = sigmoidf_(v0[2 * e])     * __uint_as_float(pw[e] << 16);
                            v0[2 * e + 1] = sigmoidf_(v0[2 * e + 1]) * __uint_as_float(pw[e] & 0xffff0000u);
                            v1[2 * e]     = sigmoidf_(v1[2 * e])     * __uint_as_float(pw[2 + e] << 16);
                            v1[2 * e + 1] = sigmoidf_(v1[2 * e + 1]) * __uint_as_float(pw[2 + e] & 0xffff0000u); }
                        u32x4 w; w.x = cvt_pk_bf16(v0[0], v0[1]); w.y = cvt_pk_bf16(v0[2], v0[3]); w.z = cvt_pk_bf16(v1[0], v1[1]); w.w = cvt_pk_bf16(v1[2], v1[3]);
                        *(u32x4*)(rowp + bj * HALF) = w; } }
        }
    }
};
struct EpiResid {
    static constexpr bool PERM = false, AFTER_DRAIN = false;
    const float* res; float* out; const bf16_t* ple; float alpha;
    __device__ __forceinline__ void operator()(const f32x4 (&acc)[2][2][4][2], const Unit& u, int wr, int wc, int fr, int fq) const {
        const int row0 = u.pm * BM + wr * 64 + fr, col0 = u.pn * BM + wc * 32 + 4 * fq;
#pragma unroll
        for (int ai = 0; ai < 2; ++ai)
#pragma unroll
            for (int m = 0; m < 4; ++m) { const size_t off = (size_t)(row0 + ai * HALF + m * 16) * 1024 + col0;
#pragma unroll
                for (int bj = 0; bj < 2; ++bj)
#pragma unroll
                    for (int n = 0; n < 2; ++n) { const size_t o2 = off + bj * HALF + n * 16;
                        const f32x4 r = *(const f32x4*)(res + o2); f32x4 v = acc[ai][bj][m][n] + r * alpha;
                        if (ple) { const unsigned long long pw = *(const unsigned long long*)(ple + o2); const unsigned lo = (unsigned)pw, hi = (unsigned)(pw >> 32);
                            v[0] += __uint_as_float(lo << 16); v[1] += __uint_as_float(lo & 0xffff0000u); v[2] += __uint_as_float(hi << 16); v[3] += __uint_as_float(hi & 0xffff0000u); }
                        *(f32x4*)(out + o2) = v; } }
    }
};
template <class Epi, class Sched, bool ALIGN_EPI = false, bool SP2 = false>
__device__ __forceinline__ void gemm_phase(PG8_LAS unsigned char* lds, const Gemm g, const Sched& S, const Epi& E) {
    const int tid = threadIdx.x, wid = __builtin_amdgcn_readfirstlane(tid >> 6), lane = tid & 63, wr = wid >> 2, wc = wid & 3, fr = lane & 15, fq = lane >> 4;
    const int K = g.K, nt = K / BK;
    unsigned voffA[2], voffB[2];
#pragma unroll
    for (int i = 0; i < 2; ++i) { int R, C; stage_rc(tid * 16 + i * 8192, R, C); const int Rb = Epi::PERM ? ((R & ~31) + perm32(R & 31)) : R;
        voffA[i] = (unsigned)(R * K + C) * 2u; voffB[i] = (unsigned)(Rb * K + C) * 2u; }
    const size_t kstep = (size_t)(BK * 2);
    const size_t hstep = (size_t)HALF * K * 2;
    const size_t tstep = 2 * hstep;
    const unsigned ldsw = (unsigned)wid * 1024u;
    const int aoff = lds_byte(wr * 64 + fr, fq * 8), boff = lds_byte(wc * 32 + fr, fq * 8);
#define PG8_SA(b, h) (((b) * 2 + (h)) * HTB)
#define PG8_SB(b, h) ((4 + (b) * 2 + (h)) * HTB)
#define PG8_STAGE(bufoff, gbase, voff) do { _Pragma("unroll") for (int _i = 0; _i < 2; ++_i) \
        __builtin_amdgcn_global_load_lds((const unsigned*)((const char*)(gbase) + (voff)[_i]), (PG8_LAS unsigned*)(lds + (bufoff) + ldsw + _i * 8192), 16, 0, 0); } while (0)
#define PG8_LDA(dst, b, h) do { _Pragma("unroll") for (int m = 0; m < 4; ++m) _Pragma("unroll") for (int k = 0; k < 2; ++k) dst[m][k] = *(const PG8_LAS bf16x8*)(lds + PG8_SA(b, h) + aoff + m * 2048 + k * 1024); } while (0)
#define PG8_LDB(dst, b, h) do { _Pragma("unroll") for (int n = 0; n < 2; ++n) _Pragma("unroll") for (int k = 0; k < 2; ++k) dst[n][k] = *(const PG8_LAS bf16x8*)(lds + PG8_SB(b, h) + boff + n * 2048 + k * 1024); } while (0)
#define PG8_MMA(ai, bj, At, Bt) do { __builtin_amdgcn_s_setprio(1); _Pragma("unroll") for (int m = 0; m < 4; ++m) _Pragma("unroll") for (int n = 0; n < 2; ++n) _Pragma("unroll") for (int k = 0; k < 2; ++k) \
        acc[ai][bj][m][n] = __builtin_amdgcn_mfma_f32_16x16x32_bf16(Bt[n][k], At[m][k], acc[ai][bj][m][n], 0, 0, 0); __builtin_amdgcn_s_setprio(0); } while (0)
#define PG8_WAIT_V(n) asm volatile("s_waitcnt vmcnt(" #n ")" ::: "memory")
#define PG8_WAIT_L(n) asm volatile("s_waitcnt lgkmcnt(" #n ")" ::: "memory")
#define PG8_BAR __builtin_amdgcn_s_barrier()
#define PG8_SCHED __builtin_amdgcn_sched_barrier(0)
    Unit cur, nxt; int ui = 0;
    if (!S.next(0, cur)) return;
    f32x4 acc[2][2][4][2];
#pragma unroll
    for (int a = 0; a < 2; ++a)
#pragma unroll
        for (int b = 0; b < 2; ++b)
#pragma unroll
            for (int m = 0; m < 4; ++m)
#pragma unroll
                for (int n = 0; n < 2; ++n) acc[a][b][m][n] = (f32x4){0.f, 0.f, 0.f, 0.f};
    bf16x8 At[4][2], B0[2][2], B1[2][2];
    const char* cA = (const char*)g.A + (size_t)cur.pm * tstep; const char* cB = (const char*)g.Bt + (size_t)cur.pn * tstep;
    S.a_ready(cur);
    if constexpr (SP2) {
        PG8_STAGE(PG8_SB(0, 0), cB, voffB); PG8_STAGE(PG8_SB(0, 1), cB + hstep, voffB); PG8_STAGE(PG8_SA(0, 0), cA, voffA); PG8_STAGE(PG8_SA(0, 1), cA + hstep, voffA);
        if (wr == 1) PG8_BAR;
        PG8_WAIT_V(2); PG8_BAR;
        PG8_STAGE(PG8_SB(1, 0), cB + kstep, voffB); PG8_STAGE(PG8_SA(1, 0), cA + kstep, voffA); PG8_STAGE(PG8_SB(1, 1), cB + hstep + kstep, voffB);
        PG8_WAIT_V(6); PG8_BAR;
    } else {
        PG8_STAGE(PG8_SB(0, 0), cB, voffB); PG8_STAGE(PG8_SA(0, 0), cA, voffA); PG8_STAGE(PG8_SB(0, 1), cB + hstep, voffB); PG8_STAGE(PG8_SA(0, 1), cA + hstep, voffA);
        if (wr == 1) PG8_BAR;
        PG8_WAIT_V(4); PG8_BAR;
        PG8_STAGE(PG8_SB(1, 0), cB + kstep, voffB); PG8_STAGE(PG8_SA(1, 0), cA + kstep, voffA); PG8_STAGE(PG8_SB(1, 1), cB + hstep + kstep, voffB);
        PG8_WAIT_V(6); PG8_BAR;
    }
    for (;;) {
        const bool has_next = S.next(ui + 1, nxt);
        const char* nA = has_next ? (const char*)g.A + (size_t)nxt.pm * tstep : cA; const char* nB = has_next ? (const char*)g.Bt + (size_t)nxt.pn * tstep : cB;
        for (int t = 0; t < nt; t += 2) {
            const bool last = (t == nt - 2);
            const char* a1 = cA + (size_t)(t + 1) * kstep;
            const char* a2 = last ? nA : cA + (size_t)(t + 2) * kstep; const char* b2 = last ? nB : cB + (size_t)(t + 2) * kstep;
            const char* a3 = a2 + kstep; const char* b3 = b2 + kstep;
            if (last && has_next) S.a_ready(nxt);
            if constexpr (SP2) {
            PG8_LDB(B0, 0, 0); PG8_LDB(B1, 0, 1); PG8_SCHED; PG8_LDA(At, 0, 0); PG8_STAGE(PG8_SA(1, 1), a1 + hstep, voffA);
            PG8_WAIT_V(8); PG8_WAIT_L(0); PG8_BAR; PG8_MMA(0, 0, At, B0); PG8_MMA(0, 1, At, B1); PG8_BAR; PG8_SCHED;
            PG8_LDA(At, 0, 1); PG8_STAGE(PG8_SB(0, 0), b2, voffB); PG8_STAGE(PG8_SB(0, 1), b2 + hstep, voffB); PG8_STAGE(PG8_SA(0, 0), a2, voffA);
            PG8_WAIT_V(8); PG8_WAIT_L(0); PG8_BAR; PG8_MMA(1, 0, At, B0); PG8_MMA(1, 1, At, B1); PG8_BAR; PG8_SCHED;
            PG8_LDB(B0, 1, 0); PG8_LDB(B1, 1, 1); PG8_SCHED; PG8_LDA(At, 1, 0); PG8_STAGE(PG8_SA(0, 1), a2 + hstep, voffA);
            PG8_WAIT_V(8); PG8_WAIT_L(0); PG8_BAR; PG8_MMA(0, 0, At, B0); PG8_MMA(0, 1, At, B1); PG8_BAR; PG8_SCHED;
            PG8_LDA(At, 1, 1); PG8_STAGE(PG8_SB(1, 0), b3, voffB); PG8_STAGE(PG8_SB(1, 1), b3 + hstep, voffB); PG8_STAGE(PG8_SA(1, 0), a3, voffA);
            PG8_WAIT_V(8); PG8_WAIT_L(0); PG8_BAR; PG8_MMA(1, 0, At, B0); PG8_MMA(1, 1, At, B1); PG8_BAR; PG8_SCHED;
            } else {
            PG8_LDB(B0, 0, 0); PG8_SCHED; PG8_LDA(At, 0, 0); PG8_STAGE(PG8_SA(1, 1), a1 + hstep, voffA);
            PG8_WAIT_L(8); PG8_BAR; PG8_WAIT_L(0); PG8_MMA(0, 0, At, B0); PG8_BAR; PG8_SCHED;
            PG8_LDB(B1, 0, 1); PG8_STAGE(PG8_SB(0, 0), b2, voffB);
            PG8_BAR; PG8_WAIT_L(0); PG8_MMA(0, 1, At, B1); PG8_BAR;
            PG8_LDA(At, 0, 1); PG8_STAGE(PG8_SA(0, 0), a2, voffA);
            PG8_BAR; PG8_WAIT_L(0); PG8_MMA(1, 0, At, B0); PG8_BAR; PG8_SCHED;
            PG8_STAGE(PG8_SB(0, 1), b2 + hstep, voffB);
            PG8_WAIT_V(6); PG8_BAR; PG8_MMA(1, 1, At, B1); PG8_BAR;
            PG8_LDB(B0, 1, 0); PG8_SCHED; PG8_LDA(At, 1, 0); PG8_STAGE(PG8_SA(0, 1), a2 + hstep, voffA);
            PG8_WAIT_L(8); PG8_BAR; PG8_WAIT_L(0); PG8_MMA(0, 0, At, B0); PG8_BAR; PG8_SCHED;
            PG8_LDB(B1, 1, 1); PG8_STAGE(PG8_SB(1, 0), b3, voffB);
            PG8_BAR; PG8_WAIT_L(0); PG8_MMA(0, 1, At, B1); PG8_BAR;
            PG8_LDA(At, 1, 1); PG8_STAGE(PG8_SA(1, 0), a3, voffA);
            PG8_BAR; PG8_WAIT_L(0); PG8_MMA(1, 0, At, B0); PG8_BAR; PG8_SCHED;
            PG8_STAGE(PG8_SB(1, 1), b3 + hstep, voffB);
            PG8_WAIT_V(6); PG8_BAR; PG8_MMA(1, 1, At, B1); PG8_BAR;
            }
        }
        if constexpr (ALIGN_EPI) { if (wr == 0) PG8_BAR; }
        if constexpr (!Epi::AFTER_DRAIN) { E(acc, cur, wr, wc, fr, fq); S.done(cur); }
        if (!has_next) break;
#pragma unroll
        for (int a = 0; a < 2; ++a)
#pragma unroll
            for (int b = 0; b < 2; ++b)
#pragma unroll
                for (int m = 0; m < 4; ++m)
#pragma unroll
                    for (int n = 0; n < 2; ++n) acc[a][b][m][n] = (f32x4){0.f, 0.f, 0.f, 0.f};
        cur = nxt; cA = nA; cB = nB; ++ui;
        if constexpr (ALIGN_EPI) { if (wr == 1) PG8_BAR; }
    }
    PG8_WAIT_V(0);
    if constexpr (!ALIGN_EPI) { if (wr == 0) PG8_BAR; }
    PG8_BAR;
    if constexpr (Epi::AFTER_DRAIN) { E.fused(acc, cur, wr, wc, fr, fq, lds, wid, lane); S.done(cur); }
#undef PG8_SA
#undef PG8_SB
#undef PG8_STAGE
#undef PG8_LDA
#undef PG8_LDB
#undef PG8_MMA
#undef PG8_WAIT_V
#undef PG8_WAIT_L
#undef PG8_BAR
#undef PG8_SCHED
}
}
#include <hip/hip_bf16.h>
#include <cmath>
namespace attn_body {
using bf16=__hip_bfloat16;
using bf16x8=__attribute__((ext_vector_type(8)))short;
using s16x4=__attribute__((ext_vector_type(4)))short;
using f32x16=__attribute__((ext_vector_type(16)))float;
using u32x4=__attribute__((ext_vector_type(4)))unsigned;
constexpr int BATCH=32,NHEAD=16,SEQ=2048,D=64,DM=1536,OP=1024;
constexpr int NW=8,QBLK=32,QB=QBLK*NW,KVBLK=64,NQB=SEQ/QB;
constexpr int ATTN_PITCH=DM, ATTN_UNIT_ROWS=QB;
__device__ __forceinline__ int crow(int r,int hi){return (r&3)+8*(r>>2)+4*hi;}
#define SBAR() __builtin_amdgcn_sched_barrier(0)
__device__ __forceinline__ void cmask(f32x16&p0,f32x16&p1,int jb,int qrel,int hi){
  const float NEG=-INFINITY; int kb=64*jb+4*hi;
  #pragma unroll
  for(int r=0;r<16;++r){int kv=kb+(r&3)+8*(r>>2); if(kv>qrel)p0[r]=NEG; if(kv+32>qrel)p1[r]=NEG;}
}

constexpr int NSLOT=3, SLOTB=8192;
constexpr int LDS_K=0, LDS_V=NSLOT*SLOTB, LDS_WS=2*NSLOT*SLOTB, LDS_OST=LDS_WS+NW*64*4, LDS_BYTES=LDS_OST+NW*4096;
constexpr float C2=0.125f*1.4426950408889634f;
__device__ __forceinline__ void glds16(const void*gsrc,unsigned lds_dst){unsigned keep;
  asm volatile("s_mov_b32 %0, m0\n\ts_mov_b32 m0, %2\n\ts_nop 0\n\tglobal_load_lds_dwordx4 %1, off\n\ts_mov_b32 m0, %0":"=&s"(keep):"v"(gsrc),"s"(lds_dst):"memory");}
__device__ __forceinline__ float max3f(float a,float b,float c){float r;asm("v_max3_f32 %0, %1, %2, %3":"=v"(r):"v"(a),"v"(b),"v"(c));return r;}
__device__ __forceinline__ float max2f(float a,float b){float r;asm("v_max_f32_e32 %0, %1, %2":"=v"(r):"v"(a),"v"(b));return r;}
__device__ __forceinline__ float fadd_s(float a,float b){float r;asm("v_add_f32_e32 %0, %1, %2":"=v"(r):"v"(a),"v"(b));return r;}
__device__ __forceinline__ float fsub_s(float a,float b){float r;asm("v_sub_f32_e32 %0, %1, %2":"=v"(r):"v"(a),"v"(b));return r;}
typedef float f32x2_t __attribute__((ext_vector_type(2))); typedef __bf16 bf16x2_t __attribute__((ext_vector_type(2)));
__device__ __forceinline__ unsigned cvtpk_s(float lo,float hi){f32x2_t v={lo,hi};bf16x2_t b=__builtin_convertvector(v,bf16x2_t);return __builtin_bit_cast(unsigned,b);}
#define WAIT_BAR(N) asm volatile("s_waitcnt vmcnt(" #N ") lgkmcnt(0)\n\ts_barrier":::"memory")

__device__ __forceinline__ void qkt(f32x16&p0,f32x16&p1,const char*Kslot,const bf16x8*qr,const f32x16&negm,int r32,int hi){
  const char*kb=Kslot+hi*1024+r32*16;
  #pragma unroll
  for(int d0=0;d0<4;++d0){
    const bf16x8 b0=*reinterpret_cast<const bf16x8*>(kb+d0*2048);
    const bf16x8 b1=*reinterpret_cast<const bf16x8*>(kb+d0*2048+512);
    if(d0==0){p0=__builtin_amdgcn_mfma_f32_32x32x16_bf16(b0,qr[0],negm,0,0,0);p1=__builtin_amdgcn_mfma_f32_32x32x16_bf16(b1,qr[0],negm,0,0,0);}
    else{p0=__builtin_amdgcn_mfma_f32_32x32x16_bf16(b0,qr[d0],p0,0,0,0);p1=__builtin_amdgcn_mfma_f32_32x32x16_bf16(b1,qr[d0],p1,0,0,0);}}
}
typedef __attribute__((address_space(3))) const char* lds_cptr;
typedef short v4i16_t __attribute__((ext_vector_type(4)));
__device__ __forceinline__ void kload8(bf16x8*kf,lds_cptr kp){
  kf[0]=*(const __attribute__((address_space(3))) bf16x8*)(kp);      kf[1]=*(const __attribute__((address_space(3))) bf16x8*)(kp+512);
  kf[2]=*(const __attribute__((address_space(3))) bf16x8*)(kp+2048); kf[3]=*(const __attribute__((address_space(3))) bf16x8*)(kp+2560);
  kf[4]=*(const __attribute__((address_space(3))) bf16x8*)(kp+4096); kf[5]=*(const __attribute__((address_space(3))) bf16x8*)(kp+4608);
  kf[6]=*(const __attribute__((address_space(3))) bf16x8*)(kp+6144); kf[7]=*(const __attribute__((address_space(3))) bf16x8*)(kp+6656);
}
__device__ __forceinline__ void kload2(bf16x8*kf,lds_cptr kp,int j){ kf[2*j]=*(const __attribute__((address_space(3))) bf16x8*)(kp+j*2048); kf[2*j+1]=*(const __attribute__((address_space(3))) bf16x8*)(kp+j*2048+512); }
__device__ __forceinline__ s16x4 vtr(lds_cptr p){ return __builtin_bit_cast(s16x4,__builtin_amdgcn_ds_read_tr16_b64_v4i16((__attribute__((address_space(3))) v4i16_t*)p)); }
__device__ __forceinline__ float rowmax(const f32x16&p0,const f32x16&p1){
  float a=max3f(p0[0],p0[1],p1[0]),b=max3f(p0[2],p0[3],p1[1]);a=max3f(a,p1[2],p1[3]);
  #pragma unroll
  for(int r=4;r<16;r+=4){a=max3f(a,p0[r],p0[r+1]);b=max3f(b,p0[r+2],p0[r+3]);a=max3f(a,p1[r],p1[r+1]);b=max3f(b,p1[r+2],p1[r+3]);}
  const float m=max2f(a,b);
  auto rr=__builtin_amdgcn_permlane32_swap(__float_as_uint(m),__float_as_uint(m),false,false);
  return max2f(__uint_as_float(rr[0]),__uint_as_float(rr[1]));
}
__device__ __forceinline__ void pv(f32x16*o,int vb,bf16x8 pa0,bf16x8 pa1,bf16x8 pa2,bf16x8 pa3){
  #pragma unroll
  for(int d0=0;d0<2;++d0){s16x4 lo[4],hi[4];
    #pragma unroll
    for(int ks=0;ks<4;++ks){
      asm volatile("ds_read_b64_tr_b16 %0,%1 offset:%c2":"=&v"(lo[ks]):"v"(vb),"i"(d0*4096+ks*1024):"memory");
      asm volatile("ds_read_b64_tr_b16 %0,%1 offset:%c2":"=&v"(hi[ks]):"v"(vb),"i"(d0*4096+ks*1024+512):"memory");}
    asm volatile("s_waitcnt lgkmcnt(0)":::"memory");SBAR();
    #define PK(k) (bf16x8){lo[k][0],lo[k][1],lo[k][2],lo[k][3],hi[k][0],hi[k][1],hi[k][2],hi[k][3]}
    o[d0]=__builtin_amdgcn_mfma_f32_32x32x16_bf16(pa0,PK(0),o[d0],0,0,0);
    o[d0]=__builtin_amdgcn_mfma_f32_32x32x16_bf16(pa1,PK(1),o[d0],0,0,0);
    o[d0]=__builtin_amdgcn_mfma_f32_32x32x16_bf16(pa2,PK(2),o[d0],0,0,0);
    o[d0]=__builtin_amdgcn_mfma_f32_32x32x16_bf16(pa3,PK(3),o[d0],0,0,0);
    #undef PK
  }
}

#ifndef ATTN_STORE16
#define ATTN_STORE16(p,v) (*(u32x4*)(p)=(v))
#endif
template<int THRL> __device__ __forceinline__ void attn_unit(int b,int h,int qb,const bf16*Q,const bf16*__restrict__ K,const bf16*__restrict__ V,bf16*O,char*shm){
  const int tid=threadIdx.x,lane=tid&63,r32=lane&31,hi=lane>>5; const int wid=__builtin_amdgcn_readfirstlane(tid>>6);
  const long rowbase=(long)b*SEQ; const int q0=qb*QB;
  const bf16*Qw=Q+(rowbase+q0+wid*QBLK)*DM+h*D;
  const bf16*Kh=K+rowbase*DM+(h>>2)*D,*Vh=V+rowbase*DM+(h>>2)*D;
  const unsigned lds0=(unsigned)(uintptr_t)shm;
  float*wsf=(float*)(shm+LDS_WS)+wid*64;
  const bf16*ksrc=Kh+(long)lane*DM+wid*8;
  const bf16*vsrc=Vh+(long)(16*(wid&3)+(lane>>2))*DM+(wid>>2)*32+(lane&3)*8;
  const unsigned kdst=lds0+LDS_K+wid*1024, vdst=lds0+LDS_V+wid*1024;
  #define DMA_K(t,slot) glds16(ksrc+(long)(t)*KVBLK*DM,(unsigned)__builtin_amdgcn_readfirstlane(kdst+(slot)))
  #define DMA_V(t,slot) glds16(vsrc+(long)(t)*KVBLK*DM,(unsigned)__builtin_amdgcn_readfirstlane(vdst+(slot)))
  const int vb0=(int)(lds0+LDS_V)+((lane>>4)&1)*32+(lane&3)*8+(4*hi+((lane&15)>>2))*64;
  const char*Kbase=shm+LDS_K; bf16x8 kf[8];
  const lds_cptr shm3=(lds_cptr)shm; const lds_cptr kp0=shm3+LDS_K+hi*1024+r32*16; const lds_cptr vp0=shm3+LDS_V+((lane>>4)&1)*32+(lane&3)*8+(4*hi+((lane&15)>>2))*64;
  const int NT=SEQ/KVBLK;
  DMA_K(0,0);DMA_V(0,0);DMA_K(1,SLOTB);
  bf16x8 qr[4];
  #pragma unroll
  for(int d0=0;d0<4;++d0)qr[d0]=*reinterpret_cast<const bf16x8*>(&Qw[(long)r32*DM+d0*16+hi*8]);
  float mhat=0.f,l_reg=0.f;f32x16 o[2];o[0]=f32x16{};o[1]=f32x16{};f32x16 negm=f32x16{};asm volatile("":"+v"(negm));

  #define CMASK(P0,P1,t) do{}while(0)
  bool resc=false;
  #define START(P0,P1) do{ const float rm=rowmax(P0,P1); resc=false; \
    { const float dl=rm; mhat=fadd_s(mhat,dl); \
      _Pragma("unroll") for(int r=0;r<16;++r){P0[r]=fsub_s(P0[r],dl);P1[r]=fsub_s(P1[r],dl);} \
      _Pragma("unroll") for(int r=0;r<16;++r)negm[r]=-mhat; asm volatile("":"+v"(negm)); } \
    _Pragma("unroll") for(int r=0;r<16;++r)P0[r]=__builtin_amdgcn_exp2f(P0[r]); }while(0)
  #define RESC() do{ if(resc){ asm volatile("s_waitcnt lgkmcnt(0)":::"memory"); \
      _Pragma("unroll") for(int d_=0;d_<2;++d_) _Pragma("unroll") for(int r=0;r<16;++r)o[d_][r]*=wsf[crow(r,hi)]; } }while(0)
  f32x16 pA0,pA1,pB0,pB1;
  int sl_prev=0,sl_cur=0,sl_next=SLOTB;
  #define ROT() do{sl_prev=sl_cur;sl_cur=sl_next;sl_next=(sl_next==(NSLOT-1)*SLOTB)?0:sl_next+SLOTB;}while(0)
  DMA_K(2,2*SLOTB);
  WAIT_BAR(3);
  qkt(pA0,pA1,Kbase,qr,negm,r32,hi);asm volatile("s_nop 15\n\ts_nop 7":"+v"(pA0),"+v"(pA1));CMASK(pA0,pA1,0);
  START(pA0,pA1);
  _Pragma("unroll") for(int r=0;r<16;++r)pA1[r]=__builtin_amdgcn_exp2f(pA1[r]);
  WAIT_BAR(0);
  DMA_K(3,0);DMA_V(1,SLOTB);
  ROT();
  kload8(kf,kp0+sl_cur);
  WAIT_BAR(2);
  s16x4 vlo[8],vhi[8]; u32x4 pw0,pw1,pw2,pw3;
  #define PKW(P,B) cvtpk_s(P[B],P[B+1])
  #define PAF(k) __builtin_bit_cast(bf16x8,pw##k)
  #define VFR(i) (bf16x8){vlo[i][0],vlo[i][1],vlo[i][2],vlo[i][3],vhi[i][0],vhi[i][1],vhi[i][2],vhi[i][3]}
  #define PIN(x) asm volatile("":"+v"(x))
  #define MX3(a,b,c) __builtin_fmaxf(__builtin_fmaxf((a),(b)),(c))
  #define GAPA(MF,A0,A1,A2,A3,W0,W1,PW) do{ MF; sacc+=A0; sacc+=A1; sacc+=A2; sacc+=A3; PIN(sacc); W0; W1; PIN(PW); SBAR(); }while(0)
  #define EX(v) __builtin_amdgcn_exp2f(v)
  #define GAPB(MF,X,B) do{ MF; X[B]=EX(X[B]); X[B+1]=EX(X[B+1]); X[B+2]=EX(X[B+2]); X[B+3]=EX(X[B+3]); PIN(X); SBAR(); }while(0)
  #define VRD(i) do{ vlo[i]=vtr(vp_+(((i)>>2)*4096+((i)&3)*1024)); vhi[i]=vtr(vp_+(((i)>>2)*4096+((i)&3)*1024+512)); }while(0)
  #define KRD(G,j) do{ if(G){ kload2(kf,kp0+sl_next,j); SBAR(); } }while(0)
  #define STEP(C0,C1,P0,P1,t,GK,GV,GL) do{ SBAR(); \
    const lds_cptr vp_=vp0+sl_prev; \
    VRD(0); SBAR(); float sacc=(P0[0]+P0[1]); \
    GAPA(C0=__builtin_amdgcn_mfma_f32_32x32x16_bf16(kf[0],qr[0],negm,0,0,0), P0[2],P0[3],P0[4],P0[5],     pw0[0]=PKW(P0,0), pw0[1]=PKW(P0,2), pw0); \
    VRD(4); SBAR(); GAPA(C1=__builtin_amdgcn_mfma_f32_32x32x16_bf16(kf[1],qr[0],negm,0,0,0), P0[6],P0[7],P0[8],P0[9],     pw0[2]=PKW(P0,4), pw0[3]=PKW(P0,6), pw0); \
    VRD(1); SBAR(); GAPA(C0=__builtin_amdgcn_mfma_f32_32x32x16_bf16(kf[2],qr[1],C0,0,0,0),   P0[10],P0[11],P0[12],P0[13], pw1[0]=PKW(P0,8), pw1[1]=PKW(P0,10), pw1); \
    VRD(5); SBAR(); GAPA(C1=__builtin_amdgcn_mfma_f32_32x32x16_bf16(kf[3],qr[1],C1,0,0,0),   P0[14],P0[15],P1[0],P1[1],   pw1[2]=PKW(P0,12),pw1[3]=PKW(P0,14), pw1); \
    VRD(2); SBAR(); GAPA(C0=__builtin_amdgcn_mfma_f32_32x32x16_bf16(kf[4],qr[2],C0,0,0,0),   P1[2],P1[3],P1[4],P1[5],     pw2[0]=PKW(P1,0), pw2[1]=PKW(P1,2), pw2); \
    VRD(6); SBAR(); GAPA(C1=__builtin_amdgcn_mfma_f32_32x32x16_bf16(kf[5],qr[2],C1,0,0,0),   P1[6],P1[7],P1[8],P1[9],     pw2[2]=PKW(P1,4), pw2[3]=PKW(P1,6), pw2); \
    VRD(3); SBAR(); GAPA(C0=__builtin_amdgcn_mfma_f32_32x32x16_bf16(kf[6],qr[3],C0,0,0,0),   P1[10],P1[11],P1[12],P1[13], pw3[0]=PKW(P1,8), pw3[1]=PKW(P1,10), pw3); \
    VRD(7); SBAR(); GAPA(C1=__builtin_amdgcn_mfma_f32_32x32x16_bf16(kf[7],qr[3],C1,0,0,0),   P1[14],P1[15],0.f,0.f,       pw3[2]=PKW(P1,12),pw3[3]=PKW(P1,14), pw3); \
    l_reg+=sacc; \
    if(GK){DMA_K((t)+3,sl_cur);} if(GV){DMA_V((t)+1,sl_next);} \
    CMASK(C0,C1,t); \
    { float a=MX3(C0[0],C0[1],C1[0]),b=MX3(C0[2],C0[3],C1[1]); a=MX3(a,C1[2],C1[3]); \
      _Pragma("unroll") for(int r=4;r<16;r+=4){a=MX3(a,C0[r],C0[r+1]);b=MX3(b,C0[r+2],C0[r+3]);a=MX3(a,C1[r],C1[r+1]);b=MX3(b,C1[r+2],C1[r+3]);} \
      float rm=__builtin_fmaxf(a,b); { auto rr=__builtin_amdgcn_permlane32_swap(__float_as_uint(rm),__float_as_uint(rm),false,false); rm=__builtin_fmaxf(__uint_as_float(rr[0]),__uint_as_float(rr[1])); } \
      resc=false; \
      if(__builtin_expect(__any(rm>(float)THRL),0)){ const float dl=__builtin_fmaxf(rm,0.f); mhat+=dl; \
        _Pragma("unroll") for(int r=0;r<16;++r){C0[r]-=dl;C1[r]-=dl;} \
        _Pragma("unroll") for(int r=0;r<16;++r)negm[r]=-mhat; asm volatile("":"+v"(negm)); \
        const float f=__builtin_amdgcn_exp2f(-dl); l_reg*=f; if(hi==0)wsf[r32]=f; resc=true; } } \
    SBAR(); \
    GAPB(o[0]=__builtin_amdgcn_mfma_f32_32x32x16_bf16(PAF(0),VFR(0),o[0],0,0,0), C0,0); \
    GAPB(o[1]=__builtin_amdgcn_mfma_f32_32x32x16_bf16(PAF(0),VFR(4),o[1],0,0,0), C0,4); \
    KRD(GL,0); GAPB(o[0]=__builtin_amdgcn_mfma_f32_32x32x16_bf16(PAF(1),VFR(1),o[0],0,0,0), C0,8); \
    KRD(GL,1); GAPB(o[1]=__builtin_amdgcn_mfma_f32_32x32x16_bf16(PAF(1),VFR(5),o[1],0,0,0), C0,12); \
    KRD(GL,2); GAPB(o[0]=__builtin_amdgcn_mfma_f32_32x32x16_bf16(PAF(2),VFR(2),o[0],0,0,0), C1,0); \
    KRD(GL,3); GAPB(o[1]=__builtin_amdgcn_mfma_f32_32x32x16_bf16(PAF(2),VFR(6),o[1],0,0,0), C1,4); \
    GAPB(o[0]=__builtin_amdgcn_mfma_f32_32x32x16_bf16(PAF(3),VFR(3),o[0],0,0,0), C1,8); \
    GAPB(o[1]=__builtin_amdgcn_mfma_f32_32x32x16_bf16(PAF(3),VFR(7),o[1],0,0,0), C1,12); \
    }while(0)
  int t=1;
  #undef CMASK
  #define CMASK(P0,P1,t) do{}while(0)
  for(;t+5<NT;t+=2){
    STEP(pB0,pB1,pA0,pA1,t,true,true,true);     WAIT_BAR(2); RESC(); ROT();
    STEP(pA0,pA1,pB0,pB1,t+1,true,true,true);   WAIT_BAR(2); RESC(); ROT();
  }
  #undef CMASK
  #define CMASK(P0,P1,t) do{}while(0)
  #define ENDW(tt) do{ if((tt)+3<NT){WAIT_BAR(2);} else if((tt)+2<NT){WAIT_BAR(1);} else {WAIT_BAR(0);} }while(0)
  for(;t+1<NT;t+=2){
    STEP(pB0,pB1,pA0,pA1,t,(t+3<NT),(t+1<NT),(t+1<NT));       ENDW(t);   RESC(); ROT();
    STEP(pA0,pA1,pB0,pB1,t+1,(t+4<NT),(t+2<NT),(t+2<NT));     ENDW(t+1); RESC(); ROT();
  }
  STEP(pB0,pB1,pA0,pA1,NT-1,false,false,false); RESC();
  { float sacc=pB0[0]+pB0[1]; _Pragma("unroll") for(int r=2;r<16;++r)sacc+=pB0[r]; _Pragma("unroll") for(int r=0;r<16;++r)sacc+=pB1[r]; l_reg+=sacc;
    pw0=(u32x4){PKW(pB0,0),PKW(pB0,2),PKW(pB0,4),PKW(pB0,6)};pw1=(u32x4){PKW(pB0,8),PKW(pB0,10),PKW(pB0,12),PKW(pB0,14)};pw2=(u32x4){PKW(pB1,0),PKW(pB1,2),PKW(pB1,4),PKW(pB1,6)};pw3=(u32x4){PKW(pB1,8),PKW(pB1,10),PKW(pB1,12),PKW(pB1,14)};
    SBAR(); pv(o,vb0+sl_cur,PAF(0),PAF(1),PAF(2),PAF(3)); }
  #undef PKW
  #undef PAF
  #undef VFR
  #undef PIN
  #undef MX3
  #undef GAPA
  #undef GAPB
  #undef EX
  #undef VRD
  #undef KRD
  #undef STEP
  #undef ENDW
  {auto rr=__builtin_amdgcn_permlane32_swap(__float_as_uint(l_reg),__float_as_uint(l_reg),false,false);l_reg=__uint_as_float(rr[0])+__uint_as_float(rr[1]);}
  if(hi==0)wsf[32+r32]=l_reg;asm volatile("s_waitcnt lgkmcnt(0)":::"memory");
  float rli[16];
  #pragma unroll
  for(int r=0;r<16;++r)rli[r]=__builtin_amdgcn_rcpf(wsf[32+crow(r,hi)]);
  bf16*Ow=O+(rowbase+q0+wid*QBLK)*OP+h*D;
  { bf16*stg=(bf16*)(shm+LDS_OST)+wid*2048;
    #pragma unroll
    for(int r=0;r<16;++r){const int orow=crow(r,hi);
      #pragma unroll
      for(int d0=0;d0<2;++d0)stg[orow*64+d0*32+r32]=__float2bfloat16(o[d0][r]*rli[r]);}
    asm volatile("s_waitcnt lgkmcnt(0)":::"memory");
    #pragma unroll
    for(int i=0;i<4;++i){const int row=i*8+(lane>>3),ch=lane&7; const u32x4 v=*(const u32x4*)(stg+row*64+ch*8); ATTN_STORE16(Ow+(long)row*OP+ch*8,v);} }
  asm volatile("s_waitcnt lgkmcnt(0)\n\ts_barrier":::"memory");
  #undef DMA_K
  #undef DMA_V
  #undef CMASK
  #undef START
  #undef RESC
  #undef ROT
}
constexpr int ATTN_LDS_BYTES=LDS_BYTES;
struct AttnTensors { const bf16* Q; const bf16* K; const bf16* V; bf16* O; };
struct AttnUnit { int bh; int qb; };
struct StaticOrder {
  int vcu,G;
  __device__ __forceinline__ explicit StaticOrder(int grid,int block):vcu((grid%8==0)?(block%8)*(grid/8)+block/8:block),G(grid){}
  __device__ __forceinline__ bool next(int i,AttnUnit&u)const{ const int x=i*G+vcu; if(x>=BATCH*NHEAD*NQB)return false; u.bh=x>>3; u.qb=x&7; return true; }
  __device__ __forceinline__ void a_ready(const AttnUnit&)const{}
  __device__ __forceinline__ void done(const AttnUnit&)const{}
};
template<class Sched,int THRL=8> __device__ __forceinline__ void attn_phase(char*lds,const AttnTensors&T,const Sched&S){
  AttnUnit u;
  for(int i=0;S.next(i,u);++i){ S.a_ready(u); attn_unit<THRL>(u.bh/NHEAD,u.bh%NHEAD,u.qb,T.Q,T.K,T.V,T.O,lds); S.done(u); }
}
#undef SBAR
#undef WAIT_BAR
}
constexpr int NWAVES = 8;
#ifndef DEPTH_
#define DEPTH_ 4
#endif
constexpr int M = 65536, D = 1024, SEQ = 2048, NBATCH = 32, FF = 4096, DPLE = 256, DEPTH = DEPTH_;
constexpr float DN_ALPHA = 1.6817928305074290f;
constexpr float LN_EPS = 1e-6f;
constexpr size_t MiB = 1u << 20;
constexpr size_t WS_W = 2 * MiB;
constexpr size_t WS_WIN = WS_W, WS_WO = WS_W + 28 * MiB, WS_W1G = WS_W + 36 * MiB, WS_W2 = WS_W + 76 * MiB, WS_WP = WS_W + 108 * MiB;
constexpr size_t WS_XN = 114 * MiB;
constexpr size_t WS_PB = 242 * MiB;
constexpr size_t WS_GATES = 274 * MiB;
constexpr size_t WS_QKV = 282 * MiB;
constexpr size_t WS_O = 698 * MiB;
constexpr size_t WS_PP = 826 * MiB;
constexpr size_t WS_H = 282 * MiB;
constexpr size_t WS_END = 954 * MiB;
constexpr int LDS_BYTES = 147456;

#define GAS __attribute__((address_space(1)))
#define LAS __attribute__((address_space(3)))
typedef unsigned short bf16;
typedef unsigned v4u __attribute__((ext_vector_type(4)));
typedef float f32x4 __attribute__((ext_vector_type(4)));
typedef short bf16x8 __attribute__((ext_vector_type(8)));
#define LDS_WAIT() asm volatile("s_waitcnt lgkmcnt(0)" ::: "memory")
__device__ __forceinline__ unsigned f2bf(float f) { unsigned u = __builtin_bit_cast(unsigned, f); return (u + 0x7fffu + ((u >> 16) & 1u)) >> 16; }
__device__ __forceinline__ unsigned pk2(float lo, float hi) { return f2bf(lo) | (f2bf(hi) << 16); }
__device__ __forceinline__ float bf2f(unsigned short h) { return __uint_as_float(((unsigned)h) << 16); }
__device__ __forceinline__ f32x4 mfma16(bf16x8 a, bf16x8 b, f32x4 c) { return __builtin_amdgcn_mfma_f32_16x16x32_bf16(a, b, c, 0, 0, 0); }
__device__ __forceinline__ float wave_sum(float v) {
#pragma unroll
    for (int o = 1; o < 64; o <<= 1) v += __shfl_xor(v, o);
    return v;
}

struct Args { const float* in[21]; float* out; unsigned char* ws; int skip, pad; };

__device__ __forceinline__ void p0_transpose_item(const float* W, int K, int N, bf16* WT, int row_off, LAS float* scr, int item, int lane) {
    const int nblk = N / 32, kb = item / nblk, nb = item % nblk, k0 = 64 * kb, n0 = 32 * nb;
#pragma unroll 8
    for (int i = 0; i < 32; ++i) { const int kk = 2 * i + (lane >> 5); scr[kk * 33 + (lane & 31)] = W[(size_t)(k0 + kk) * N + n0 + (lane & 31)]; }
    LDS_WAIT(); asm volatile("" ::: "memory");
    const int c = lane & 7;
#pragma unroll
    for (int j = 0; j < 4; ++j) { const int n = (lane >> 3) + 8 * j; const LAS float* s = scr + (8 * c) * 33 + n;
        v4u o; o.x = pk2(s[0 * 33], s[1 * 33]); o.y = pk2(s[2 * 33], s[3 * 33]); o.z = pk2(s[4 * 33], s[5 * 33]); o.w = pk2(s[6 * 33], s[7 * 33]);
        *(v4u*)(WT + (size_t)(row_off + n0 + n) * K + k0 + 8 * c) = o; }
    LDS_WAIT(); asm volatile("" ::: "memory");
}
struct WDesc { const float* src; int K, N; bf16* dst; int row_off; };
__device__ __forceinline__ WDesc wdesc(const Args& a, int idx) {
    const int l = idx / 6, kind = idx % 6; WDesc w; unsigned char* ws = a.ws;
    if (kind == 0) { w.K = 1024; w.row_off = 0; w.dst = (bf16*)(ws + WS_WIN + (size_t)l * 7 * MiB);
        if (l == 0) { w.src = a.in[2]; w.N = 3072; } else if (l == 1) { w.src = a.in[5]; w.N = 1536; } else if (l == 2) { w.src = a.in[9]; w.N = 3104; } else { w.src = a.in[2] + (size_t)1024 * 3072; w.N = 3072; } }
    else if (kind == 1) { w.K = 1024; w.N = 1024; w.row_off = 0; w.dst = (bf16*)(ws + WS_WO + (size_t)l * 2 * MiB);
        w.src = (l == 0) ? a.in[4] : (l == 1) ? a.in[8] : (l == 2) ? a.in[12] : a.in[4] + (size_t)1024 * 1024; }
    else if (kind == 2) { w.K = 1024; w.N = 4096; w.row_off = 0; w.dst = (bf16*)(ws + WS_W1G + (size_t)l * 10 * MiB); w.src = a.in[15] + (size_t)l * 1024 * 4096; }
    else if (kind == 3) { w.K = 1024; w.N = 1024; w.row_off = 4096; w.dst = (bf16*)(ws + WS_W1G + (size_t)l * 10 * MiB); w.src = a.in[19] + (size_t)l * 1024 * 1024; }
    else if (kind == 4) { w.K = 4096; w.N = 1024; w.row_off = 0; w.dst = (bf16*)(ws + WS_W2 + (size_t)l * 8 * MiB); w.src = a.in[16] + (size_t)l * 4096 * 1024; }
    else { w.K = 256; w.N = 1024; w.row_off = 0; w.dst = (bf16*)(ws + WS_WP + (size_t)l * (MiB / 2)); w.src = a.in[20] + (size_t)l * 256 * 1024; }
    return w;
}
__device__ __forceinline__ void cvt_rows(const float* src, bf16* dst, size_t n, int G) {
    const size_t nth = (size_t)G * 512, n8 = n / 8;
    for (size_t i = (size_t)blockIdx.x * 512 + threadIdx.x; i < n8; i += nth) {
        const f32x4 a = *(const f32x4*)(src + i * 8), b = *(const f32x4*)(src + i * 8 + 4);
        v4u o; o.x = pk2(a[0], a[1]); o.y = pk2(a[2], a[3]); o.z = pk2(b[0], b[1]); o.w = pk2(b[2], b[3]);
        *(v4u*)(dst + i * 8) = o; }
}
__device__ __forceinline__ void prologue_phase(const Args& a, LAS unsigned char* lds, int G) {
    const int tid = threadIdx.x, lane = tid & 63, wave = tid >> 6;
    LAS float* scr = (LAS float*)(lds + wave * 16384);
    const int gw = blockIdx.x * NWAVES + wave, NGW = G * NWAVES;
    for (int idx = 0; idx < 24; ++idx) { const WDesc w = wdesc(a, idx); const int nitems = (w.K / 64) * (w.N / 32);
        for (int it = gw; it < nitems; it += NGW) p0_transpose_item(w.src, w.K, w.N, w.dst, w.row_off, scr, it, lane); }
    {
        v4u* z = (v4u*)((bf16*)(a.ws + WS_WIN + (size_t)2 * 7 * MiB) + (size_t)3104 * 1024); const size_t n16 = (size_t)224 * 1024 * 2 / 16;
        for (size_t i = (size_t)blockIdx.x * 512 + tid; i < n16; i += (size_t)G * 512) z[i] = (v4u){0u, 0u, 0u, 0u}; }
    cvt_rows(a.in[0], (bf16*)(a.ws + WS_XN), (size_t)M * D, G);
    cvt_rows(a.in[1], (bf16*)(a.ws + WS_PB), (size_t)M * DPLE, G);
}
__device__ __forceinline__ void ln_phase(float* zx, const float* g, const float* bta, bf16* XN, int G) {
    const int lane = threadIdx.x & 63, wave = threadIdx.x >> 6; const int gw = blockIdx.x * NWAVES + wave, NGW = G * NWAVES;
    f32x4 gv[4], bv[4];
#pragma unroll
    for (int j = 0; j < 4; ++j) { gv[j] = *(const f32x4*)(g + 4 * lane + 256 * j); bv[j] = *(const f32x4*)(bta + 4 * lane + 256 * j); }
    for (int m = gw; m < M; m += NGW) {
        f32x4* xr = (f32x4*)(zx + (size_t)m * D) + lane; f32x4 v[4]; float s = 0.f;
#pragma unroll
        for (int j = 0; j < 4; ++j) { v[j] = xr[64 * j]; s += (v[j][0] + v[j][1]) + (v[j][2] + v[j][3]); }
        const float mean = wave_sum(s) * (1.f / D); float s2 = 0.f;
#pragma unroll
        for (int j = 0; j < 4; ++j) { v[j] = v[j] - mean; s2 += (v[j][0] * v[j][0] + v[j][1] * v[j][1]) + (v[j][2] * v[j][2] + v[j][3] * v[j][3]); }
        const float rstd = 1.f / sqrtf(wave_sum(s2) * (1.f / D) + LN_EPS);
        unsigned long long* o8 = (unsigned long long*)(XN + (size_t)m * D) + lane;
#pragma unroll
        for (int j = 0; j < 4; ++j) { const f32x4 y = v[j] * rstd * gv[j] + bv[j]; xr[64 * j] = y;
            o8[64 * j] = (unsigned long long)pk2(y[0], y[1]) | ((unsigned long long)pk2(y[2], y[3]) << 32); }
    }
}
__device__ __forceinline__ void na_phase(const bf16* QKV, const float* rpb, bf16* O, LAS unsigned char* lds, int G) {
    const int tid = threadIdx.x, lane = tid & 63, wave = tid >> 6, l15 = lane & 15, quad = lane >> 4;
    LAS bf16* vt = (LAS bf16*)(lds + wave * 5120);
    const int gw = blockIdx.x * NWAVES + wave, NGW = G * NWAVES;
    for (int uid = gw; uid < 65536; uid += NGW) {
        const int jq = uid & 3, h = (uid >> 2) & 15, r = (uid >> 6) & 31, b = uid >> 11;
        const int r0 = min(max(r - 4, 0), 24);
        const int kc0 = (jq == 0) ? 0 : (jq == 1) ? 8 : (jq == 2) ? 24 : 32;
        const size_t tokb = (size_t)b * 2048;
        const int c = jq * 16 + l15, c0 = min(max(c - 8, 0), 48);
        const bf16* qp = QKV + (tokb + r * 64 + c) * 3072 + h * 64 + quad * 8;
        const bf16x8 qf0 = *(const bf16x8*)qp, qf1 = *(const bf16x8*)(qp + 32);
        const float* rp = rpb + h * (15 * 31);
        f32x4 sc[8][2];
        float mx = -INFINITY;
#pragma unroll
        for (int a = 0; a < 8; ++a) {
            const int dr = r0 + a - r + 7;
#pragma unroll
            for (int cb = 0; cb < 2; ++cb) {
                const bf16* kp = QKV + (tokb + (r0 + a) * 64 + kc0 + cb * 16 + l15) * 3072 + 1024 + h * 64 + quad * 8;
                const bf16x8 k0 = *(const bf16x8*)kp, k1 = *(const bf16x8*)(kp + 32);
                f32x4 acc = {0.f, 0.f, 0.f, 0.f};
                acc = mfma16(k0, qf0, acc); acc = mfma16(k1, qf1, acc);
#pragma unroll
                for (int j = 0; j < 4; ++j) { const int kc = kc0 + cb * 16 + quad * 4 + j; const bool valid = (kc >= c0) && (kc < c0 + 16);
                    const int dc = min(max(kc - c + 15, 0), 30);
                    const float bias = rp[dr * 31 + dc];
                    acc[j] = valid ? acc[j] + bias : -INFINITY; mx = fmaxf(mx, acc[j]); }
                sc[a][cb] = acc;
            }
        }
        mx = fmaxf(mx, __shfl_xor(mx, 16)); mx = fmaxf(mx, __shfl_xor(mx, 32));
        float sum = 0.f;
#pragma unroll
        for (int a = 0; a < 8; ++a)
#pragma unroll
            for (int cb = 0; cb < 2; ++cb)
#pragma unroll
                for (int j = 0; j < 4; ++j) { const float p = __expf(sc[a][cb][j] - mx); sc[a][cb][j] = p; sum += p; }
        sum += __shfl_xor(sum, 16); sum += __shfl_xor(sum, 32);
        f32x4 o[4];
#pragma unroll
        for (int db = 0; db < 4; ++db) o[db] = (f32x4){0.f, 0.f, 0.f, 0.f};
        const int key = lane >> 1, half = lane & 1;
        const int kperm = (key < 16) ? ((key >> 2) * 8 + (key & 3)) : (((key - 16) >> 2) * 8 + 4 + (key & 3));
#pragma unroll
        for (int a = 0; a < 8; ++a) {
            const bf16* vp = QKV + (tokb + (r0 + a) * 64 + kc0 + key) * 3072 + 2048 + h * 64 + half * 32;
            bf16x8 vv[4];
#pragma unroll
            for (int i = 0; i < 4; ++i) vv[i] = *(const bf16x8*)(vp + 8 * i);
#pragma unroll
            for (int i = 0; i < 4; ++i)
#pragma unroll
                for (int e = 0; e < 8; ++e) vt[(half * 32 + i * 8 + e) * 40 + kperm] = (bf16)vv[i][e];
            LDS_WAIT();
            bf16x8 pb;
            { const unsigned w0 = pk2(sc[a][0][0], sc[a][0][1]), w1 = pk2(sc[a][0][2], sc[a][0][3]), w2 = pk2(sc[a][1][0], sc[a][1][1]), w3 = pk2(sc[a][1][2], sc[a][1][3]);
              const v4u w = {w0, w1, w2, w3}; pb = __builtin_bit_cast(bf16x8, w); }
#pragma unroll
            for (int db = 0; db < 4; ++db) { const bf16x8 vf = *(const LAS bf16x8*)(vt + (db * 16 + l15) * 40 + quad * 8); o[db] = mfma16(vf, pb, o[db]); }
            LDS_WAIT();
        }
        const float inv = 1.0f / sum;
        bf16* op = O + (tokb + r * 64 + c) * 1024 + h * 64 + quad * 4;
#pragma unroll
        for (int db = 0; db < 4; ++db) { const unsigned long long w = (unsigned long long)pk2(o[db][0] * inv, o[db][1] * inv) | ((unsigned long long)pk2(o[db][2] * inv, o[db][3] * inv) << 32);
            *(unsigned long long*)(op + db * 16) = w; }
    }
}
__device__ __forceinline__ void gq_normrope_phase(bf16* QKV, const float* qn, const float* kn, int G) {
    const size_t total = (size_t)M * 20 * 8, nth = (size_t)G * 512;
    for (size_t g = (size_t)blockIdx.x * 512 + threadIdx.x; g < total; g += nth) {
        const size_t item = g >> 3; const int l8 = (int)(g & 7); const size_t tok = item / 20; const int hv = (int)(item % 20);
        bf16* p = QKV + tok * 1536 + hv * 64 + l8 * 8;
        const v4u raw = *(const v4u*)p; const unsigned rw[4] = {raw.x, raw.y, raw.z, raw.w};
        float x[8]; float ss = 0.f;
#pragma unroll
        for (int e = 0; e < 4; ++e) { x[2 * e] = __uint_as_float(rw[e] << 16); x[2 * e + 1] = __uint_as_float(rw[e] & 0xffff0000u); ss += x[2 * e] * x[2 * e] + x[2 * e + 1] * x[2 * e + 1]; }
        ss += __shfl_xor(ss, 1); ss += __shfl_xor(ss, 2); ss += __shfl_xor(ss, 4);
        const float rinv = 1.0f / sqrtf(ss * (1.f / 64.f) + 1e-6f);
        const float* gvec = ((hv < 16) ? qn : kn) + l8 * 8;
        const int s = (int)(tok & 2047), row = s >> 6, col = s & 63;
        const float scale = (hv < 16) ? (0.125f * 1.4426950408889634f) : 1.0f;
        unsigned ow[4];
#pragma unroll
        for (int pr = 0; pr < 4; ++pr) { const int i = l8 * 4 + pr; const float pos = (float)((i < 16) ? row : col); const int fi = i & 15;
            const float inv = exp2f(-(float)fi * (13.287712379549449f / 16.f)); const float ang = pos * inv;
            float rev = ang * 0.15915494309189535f; rev -= rintf(rev);
            const float sn = __builtin_amdgcn_sinf(rev), cs = __builtin_amdgcn_cosf(rev);
            const float x0 = x[2 * pr] * rinv * gvec[2 * pr], x1 = x[2 * pr + 1] * rinv * gvec[2 * pr + 1];
            ow[pr] = pk2((x0 * cs - x1 * sn) * scale, (x0 * sn + x1 * cs) * scale); }
        *(v4u*)p = (v4u){ow[0], ow[1], ow[2], ow[3]};
    }
}
__device__ __forceinline__ f32x4 tile_mma64(const LAS bf16* A, int arow0, const LAS bf16* Bt, int brow0, f32x4 acc, int l15, int quad) {
    const LAS bf16* ap = A + (arow0 + l15) * 72 + quad * 8; const LAS bf16* bp = Bt + (brow0 + l15) * 72 + quad * 8;
    acc = mfma16(*(const LAS bf16x8*)ap, *(const LAS bf16x8*)bp, acc);
    acc = mfma16(*(const LAS bf16x8*)(ap + 32), *(const LAS bf16x8*)(bp + 32), acc);
    return acc;
}
__device__ __forceinline__ void ml_phase(const bf16* Z, const float* gates, const float* norm_g, bf16* HFW, bf16* O, LAS unsigned char* lds, int G) {
    const int tid = threadIdx.x, lane = tid & 63, wave = tid >> 6, l15 = lane & 15, quad = lane >> 4;
    LAS bf16* Qs = (LAS bf16*)(lds);
    LAS bf16* Ks = (LAS bf16*)(lds + 9216);
    LAS bf16* Vt = (LAS bf16*)(lds + 18432);
    LAS bf16* Kt = (LAS bf16*)(lds + 39168);
    LAS bf16* Ct = (LAS bf16*)(lds + 48384);
    LAS bf16* As = (LAS bf16*)(lds + 69120);
    LAS float* Hs = (LAS float*)(lds + 78336);
    LAS float* vec = (LAS float*)(lds + 112128);
    for (int unit = blockIdx.x; unit < 256; unit += G) {
        const int b = unit >> 3, h = unit & 7; const size_t tokb = (size_t)b * 2048;
        for (int dir = 0; dir < 2; ++dir) {
            for (int i = tid; i < 144 * 72; i += 512) Ct[i] = 0;
            for (int i = tid; i < 16 * 72; i += 512) Vt[128 * 72 + i] = (i < 72) ? (bf16)0x3F80 : (bf16)0;
            f32x4 cst[4], cst8 = {0.f, 0.f, 0.f, 0.f};
#pragma unroll
            for (int i = 0; i < 4; ++i) cst[i] = (f32x4){0.f, 0.f, 0.f, 0.f};
            float m_run = 0.f;
            __syncthreads();
            for (int cs = 0; cs < 32; ++cs) {
                const int t8 = tid >> 3, ch = tid & 7;
                const size_t tok8 = tokb + (size_t)(dir == 0 ? cs * 64 + t8 : 2047 - (cs * 64 + t8));
                {
                    const bf16* zr = Z + tok8 * 3072;
                    *(LAS v4u*)(Qs + t8 * 72 + ch * 8) = *(const v4u*)(zr + h * 64 + ch * 8);
                    *(LAS v4u*)(Ks + t8 * 72 + ch * 8) = *(const v4u*)(zr + 512 + h * 64 + ch * 8);
#pragma unroll
                    for (int i = 0; i < 2; ++i) { const int c16 = ch + 8 * i; const bf16x8 vv = *(const bf16x8*)(zr + 1024 + h * 128 + c16 * 8);
#pragma unroll
                        for (int e = 0; e < 8; ++e) Vt[(c16 * 8 + e) * 72 + t8] = (bf16)vv[e]; }
                }
                if (wave == 0) {
                    const size_t tok = tokb + (size_t)(dir == 0 ? cs * 64 + lane : 2047 - (cs * 64 + lane));
                    const float li = gates[tok * 32 + dir * 16 + h], f = gates[tok * 32 + dir * 16 + 8 + h];
                    const float lf = fminf(f, 0.f) - log1pf(__expf(-fabsf(f)));
                    float bs = lf;
#pragma unroll
                    for (int o = 1; o < 64; o <<= 1) { const float y = __shfl_up(bs, o); if (lane >= o) bs += y; }
                    const float u = li - bs; float pm = u;
#pragma unroll
                    for (int o = 1; o < 64; o <<= 1) { const float y = __shfl_up(pm, o); if (lane >= o) pm = fmaxf(pm, y); }
                    const float Mt = fmaxf(pm, m_run), sint = __expf(m_run - Mt), mt = bs + Mt;
                    vec[lane] = u; vec[64 + lane] = Mt; vec[128 + lane] = sint; vec[192 + lane] = __expf(-mt);
                    m_run = __shfl(mt, 63);
                }
                __syncthreads();
                {
                    const int tb = wave >> 1;
#pragma unroll
                    for (int i = 0; i < 2; ++i) { const int sb = 2 * (wave & 1) + i;
                        f32x4 acc = {0.f, 0.f, 0.f, 0.f}; if (sb <= tb) acc = tile_mma64(Qs, tb * 16, Ks, sb * 16, acc, l15, quad);
                        const int s = sb * 16 + l15; const float us = vec[s];
#pragma unroll
                        for (int j = 0; j < 4; ++j) { const int t = tb * 16 + 4 * quad + j; const float w = (s <= t) ? __expf(us - vec[64 + t]) : 0.f; As[t * 72 + s] = (bf16)f2bf(acc[j] * w); } }
                    const float w63 = __expf(vec[t8] - vec[64 + 63]);
                    const bf16x8 kk = *(const LAS bf16x8*)(Ks + t8 * 72 + ch * 8);
#pragma unroll
                    for (int e = 0; e < 8; ++e) Kt[(ch * 8 + e) * 72 + t8] = (bf16)f2bf(bf2f((bf16)kk[e]) * w63);
                }
                __syncthreads();
                {
#pragma unroll
                    for (int tb = 0; tb < 4; ++tb) { const f32x4 z4 = {0.f, 0.f, 0.f, 0.f};
                        const f32x4 ah = tile_mma64(As, tb * 16, Vt, wave * 16, z4, l15, quad), ag = tile_mma64(Qs, tb * 16, Ct, wave * 16, z4, l15, quad);
#pragma unroll
                        for (int j = 0; j < 4; ++j) { const int t = tb * 16 + 4 * quad + j; Hs[t * 132 + wave * 16 + l15] = vec[128 + t] * ag[j] + ah[j]; } }
                    if (wave < 4) { const int tb = wave; const f32x4 z4 = {0.f, 0.f, 0.f, 0.f};
                        const f32x4 ah = tile_mma64(As, tb * 16, Vt, 128, z4, l15, quad), ag = tile_mma64(Qs, tb * 16, Ct, 128, z4, l15, quad);
                        if (l15 == 0) {
#pragma unroll
                            for (int j = 0; j < 4; ++j) { const int t = tb * 16 + 4 * quad + j; vec[256 + t] = vec[128 + t] * ag[j] + ah[j]; } } }
                }
                __syncthreads();
                {
                    const float decay = vec[128 + 63];
#pragma unroll
                    for (int db = 0; db < 4; ++db) { cst[db] = tile_mma64(Vt, wave * 16, Kt, db * 16, cst[db] * decay, l15, quad);
#pragma unroll
                        for (int j = 0; j < 4; ++j) Ct[(wave * 16 + 4 * quad + j) * 72 + db * 16 + l15] = (bf16)f2bf(cst[db][j]); }
                    if (wave < 4) { cst8 = tile_mma64(Vt, 128, Kt, wave * 16, cst8 * decay, l15, quad);
#pragma unroll
                        for (int j = 0; j < 4; ++j) Ct[(128 + 4 * quad + j) * 72 + wave * 16 + l15] = (bf16)f2bf(cst8[j]); }
                    const float dn = fmaxf(fabsf(vec[256 + t8]), vec[192 + t8]); const float rd = 1.0f / dn;
                    float hv[16];
#pragma unroll
                    for (int e = 0; e < 16; ++e) hv[e] = Hs[t8 * 132 + ch * 16 + e] * rd;
                    const size_t ho = tok8 * 1024 + h * 128 + ch * 16;
                    if (dir == 0) {
                        v4u w0, w1; w0.x = pk2(hv[0], hv[1]); w0.y = pk2(hv[2], hv[3]); w0.z = pk2(hv[4], hv[5]); w0.w = pk2(hv[6], hv[7]);
                        w1.x = pk2(hv[8], hv[9]); w1.y = pk2(hv[10], hv[11]); w1.z = pk2(hv[12], hv[13]); w1.w = pk2(hv[14], hv[15]);
                        *(v4u*)(HFW + ho) = w0; *(v4u*)(HFW + ho + 8) = w1;
                    } else {
                        const v4u f0 = *(const v4u*)(HFW + ho), f1 = *(const v4u*)(HFW + ho + 8);
                        const unsigned fw[8] = {f0.x, f0.y, f0.z, f0.w, f1.x, f1.y, f1.z, f1.w};
                        float ss = 0.f;
#pragma unroll
                        for (int e = 0; e < 8; ++e) { hv[2 * e] += __uint_as_float(fw[e] << 16); hv[2 * e + 1] += __uint_as_float(fw[e] & 0xffff0000u); ss += hv[2 * e] * hv[2 * e] + hv[2 * e + 1] * hv[2 * e + 1]; }
                        ss += __shfl_xor(ss, 1); ss += __shfl_xor(ss, 2); ss += __shfl_xor(ss, 4);
                        const float rinv = 1.0f / sqrtf(ss * (1.f / 128.f) + 1e-6f);
                        const bf16* og = Z + tok8 * 3072 + 2048 + h * 128 + ch * 16;
                        const v4u g0 = *(const v4u*)og, g1 = *(const v4u*)(og + 8);
                        const unsigned gw_[8] = {g0.x, g0.y, g0.z, g0.w, g1.x, g1.y, g1.z, g1.w};
                        const float* ng = norm_g + h * 128 + ch * 16;
                        unsigned ow[8];
#pragma unroll
                        for (int e = 0; e < 8; ++e) { const float o0 = 1.0f / (1.0f + __expf(-__uint_as_float(gw_[e] << 16))), o1 = 1.0f / (1.0f + __expf(-__uint_as_float(gw_[e] & 0xffff0000u)));
                            ow[e] = pk2(hv[2 * e] * rinv * ng[2 * e] * o0, hv[2 * e + 1] * rinv * ng[2 * e + 1] * o1); }
                        *(v4u*)(O + ho) = (v4u){ow[0], ow[1], ow[2], ow[3]}; *(v4u*)(O + ho + 8) = (v4u){ow[4], ow[5], ow[6], ow[7]};
                    }
                }
                __syncthreads();
            }
        }
    }
}
#define RLX_AGENT __ATOMIC_RELAXED, __HIP_MEMORY_SCOPE_AGENT
#define XB_TMO      128
#define XB_XCNT(j)  (256  + 64 * (j))
#define XB_XSUB(j)  (1280 + 64 * (j))
#define XB_XGEN(j)  (2304 + 64 * (j))
#define XB_TOP      3328
#define XB_TOPGEN   3392
#define XCD_BAR_WORDS 3456
#define XB_SPIN_CAP (1u << 18)

__device__ __forceinline__ unsigned xb_ld(unsigned* p)              { return __hip_atomic_load(p, __ATOMIC_RELAXED, __HIP_MEMORY_SCOPE_AGENT); }
__device__ __forceinline__ unsigned xb_add(unsigned* p, unsigned v) { return __hip_atomic_fetch_add(p, v, __ATOMIC_RELAXED, __HIP_MEMORY_SCOPE_AGENT); }
__device__ __forceinline__ unsigned xb_xcc_id() { return (unsigned)__builtin_amdgcn_s_getreg((3 << 11) | 20) & 0xFu; }
#define XB_SPIN(cond, bar) do { unsigned _sp = 0; while (cond) { __builtin_amdgcn_s_sleep(1); \
    if ((++_sp & 255u) == 0u) { if (xb_ld(&(bar)[XB_TMO])) break; if (_sp > XB_SPIN_CAP) { atomicAdd(&(bar)[XB_TMO], 1u); break; } } } } while (0)

struct XcdBarrier {
    unsigned* bar; unsigned x;
    volatile LAS unsigned* st;
};

__device__ __forceinline__ XcdBarrier xcd_barrier_post(unsigned* bar, volatile LAS unsigned* st) {
    XcdBarrier b; b.bar = bar; b.x = xb_xcc_id(); b.st = st;
    if (threadIdx.x == 0) (void)xb_add(&bar[XB_XCNT(b.x)], 1u);
    return b;
}
__device__ __forceinline__ void xcd_barrier_complete(unsigned* bar, unsigned x, unsigned& nloc, unsigned& nx) {
    const unsigned G = gridDim.x * gridDim.y * gridDim.z;
    unsigned sum, cnt, mine, sp = 0u;
    for (;;) {
        sum = 0u; cnt = 0u; mine = 0u;
#pragma unroll
        for (unsigned j = 0; j < 16; ++j) { const unsigned c = xb_ld(&bar[XB_XCNT(j)]); sum += c; cnt += (c > 0u) ? 1u : 0u; mine = (j == x) ? c : mine; }
        if (sum == G) break;
        __builtin_amdgcn_s_sleep(1);
        if ((++sp & 255u) == 0u) { if (xb_ld(&bar[XB_TMO])) break; if (sp > XB_SPIN_CAP) { atomicAdd(&bar[XB_TMO], 1u); break; } }
    }
    nloc = mine > 0u ? mine : 1u; nx = cnt > 0u ? cnt : 1u;
}

__device__ __forceinline__ void xcd_barrier(const XcdBarrier& b) {
    asm volatile("s_waitcnt vmcnt(0)" ::: "memory");
    __syncthreads();
    if (threadIdx.x == 0) {
        unsigned* bar = b.bar;
        __builtin_amdgcn_s_waitcnt(0);
        unsigned nloc = b.st[0], nx = b.st[1];
        if (nloc == 0u) { xcd_barrier_complete(bar, b.x, nloc, nx); b.st[0] = nloc; b.st[1] = nx; }
        const unsigned old = xb_add(&bar[XB_XSUB(b.x)], 1u);
        const unsigned gen = old / nloc;
        if (old + 1u == (gen + 1u) * nloc) {
            __builtin_amdgcn_fence(__ATOMIC_RELEASE, "agent");
            asm volatile("s_waitcnt vmcnt(0)" ::: "memory");
            const unsigned og = xb_add(&bar[XB_TOP], 1u);
            const unsigned tg = og / nx;
            if (og + 1u == (tg + 1u) * nx) xb_add(&bar[XB_TOPGEN], 1u);
            else XB_SPIN(xb_ld(&bar[XB_TOPGEN]) == tg, bar);
            __builtin_amdgcn_fence(__ATOMIC_ACQUIRE, "agent");
            xb_add(&bar[XB_XGEN(b.x)], 1u);
            asm volatile("s_waitcnt vmcnt(0)" ::: "memory");
        } else {
            XB_SPIN(xb_ld(&bar[XB_XGEN(b.x)]) == gen, bar);
            __builtin_amdgcn_fence(__ATOMIC_ACQUIRE, "agent");
            asm volatile("s_waitcnt vmcnt(0)" ::: "memory");
        }
    }
    __syncthreads();
}

#define GSYNC() xcd_barrier(bar)
#define SKIP(bit) ((skipmask >> (bit)) & 1)
template <int L> __device__ __forceinline__ void layer_program(const Args& a, LAS unsigned char* lds, unsigned char* lds_raw, const int G, const XcdBarrier& bar, const int skipmask) {
    constexpr int kind = L % 3;
    unsigned char* ws = a.ws;
    bf16* XN = (bf16*)(ws + WS_XN); bf16* QKV = (bf16*)(ws + WS_QKV); bf16* OB = (bf16*)(ws + WS_O); bf16* PP = (bf16*)(ws + WS_PP); bf16* HB = (bf16*)(ws + WS_H);
    if (!SKIP(1)) { const bf16* Win = (const bf16*)(ws + WS_WIN + (size_t)L * 7 * MiB);
        if constexpr (kind == 2) { pg8::Gemm g{XN, Win, M, 3328, D}; pg8::StaticOrder S; S.init(M, 3328, G, (int)blockIdx.x);
            pg8::EpiMl E{QKV, (float*)(ws + WS_GATES), a.in[10]};
            pg8::gemm_phase<pg8::EpiMl, pg8::StaticOrder, true, true>(lds, g, S, E); }
        else { constexpr int N = (kind == 0) ? 3072 : 1536; pg8::Gemm g{XN, Win, M, N, D}; pg8::StaticOrder S; S.init(M, N, G, (int)blockIdx.x);
            pg8::EpiPlain E{QKV, N, (kind == 0) ? 1024 : 0, 0.125f};
            pg8::gemm_phase<pg8::EpiPlain, pg8::StaticOrder, true, true>(lds, g, S, E); } }
    if (!SKIP(2)) { pg8::Gemm g{(const bf16*)(ws + WS_PB), (const bf16*)(ws + WS_WP + (size_t)L * (MiB / 2)), M, D, DPLE}; pg8::StaticOrder S; S.init(M, D, G, (int)blockIdx.x);
        pg8::EpiPlain E{PP, D, 0, 1.f};
        pg8::gemm_phase<pg8::EpiPlain, pg8::StaticOrder, true, true>(lds, g, S, E); }
    GSYNC();
    if constexpr (kind == 1) { if (!SKIP(3)) gq_normrope_phase(QKV, a.in[6], a.in[7], G); GSYNC(); }
    if (!SKIP(4)) {
        if constexpr (kind == 0) na_phase(QKV, a.in[3] + (size_t)(L / 3) * 16 * 15 * 31, OB, lds, G);
        else if constexpr (kind == 1) { const attn_body::AttnTensors AT{(const attn_body::bf16*)QKV, (const attn_body::bf16*)(QKV + 1024), (const attn_body::bf16*)(QKV + 1280), (attn_body::bf16*)OB};
            const attn_body::StaticOrder S(G, (int)blockIdx.x); attn_body::attn_phase<attn_body::StaticOrder>((char*)lds_raw, AT, S); }
        else ml_phase(QKV, (const float*)(ws + WS_GATES), a.in[11], XN, OB, lds, G);
    }
    GSYNC();
    if (!SKIP(5)) { pg8::Gemm g{OB, (const bf16*)(ws + WS_WO + (size_t)L * 2 * MiB), M, D, D}; pg8::StaticOrder S; S.init(M, D, G, (int)blockIdx.x);
        pg8::EpiResid E{(L == 0) ? a.in[0] : (const float*)a.out, a.out, nullptr, DN_ALPHA};
        pg8::gemm_phase<pg8::EpiResid, pg8::StaticOrder, true, true>(lds, g, S, E); }
    GSYNC();
    if (!SKIP(6)) ln_phase(a.out, a.in[13] + (size_t)L * D, a.in[14] + (size_t)L * D, XN, G);
    GSYNC();
    if (!SKIP(7)) { pg8::Gemm g{XN, (const bf16*)(ws + WS_W1G + (size_t)L * 10 * MiB), M, FF + D, D}; pg8::StaticOrder S; S.init(M, FF + D, G, (int)blockIdx.x);
        pg8::EpiFf1 E{HB, PP};
        pg8::gemm_phase<pg8::EpiFf1, pg8::StaticOrder, true, true>(lds, g, S, E); }
    GSYNC();
    if (!SKIP(8)) { pg8::Gemm g{HB, (const bf16*)(ws + WS_W2 + (size_t)L * 8 * MiB), M, D, FF}; pg8::StaticOrder S; S.init(M, D, G, (int)blockIdx.x);
        pg8::EpiResid E{(const float*)a.out, a.out, PP, DN_ALPHA};
        pg8::gemm_phase<pg8::EpiResid, pg8::StaticOrder, true, true>(lds, g, S, E); }
    GSYNC();
    if (!SKIP(9)) { ln_phase(a.out, a.in[17] + (size_t)L * D, a.in[18] + (size_t)L * D, XN, G);
        if constexpr (L + 1 < DEPTH) cvt_rows(a.in[1] + (size_t)(L + 1) * M * DPLE, (bf16*)(ws + WS_PB), (size_t)M * DPLE, G); }
    if constexpr (L + 1 < DEPTH) GSYNC();
}
__global__ void __launch_bounds__(NWAVES * 64, 2) fwd_megakernel(Args a) {
    extern __shared__ __attribute__((aligned(16))) unsigned char lds_raw[];
    LAS unsigned char* lds = (LAS unsigned char*)lds_raw;
    cg::grid_group grid = cg::this_grid();
    const int G = gridDim.x;
    { volatile LAS unsigned* z = (volatile LAS unsigned*)(lds + 131072); if (threadIdx.x < 64) z[threadIdx.x] = 0u; }
    __syncthreads();
    const XcdBarrier bar = xcd_barrier_post((unsigned*)a.ws + 4096, (volatile LAS unsigned*)(lds + 131072 + 64));
#ifdef PROBE_SKIP
    {
        const int skipmask = a.skip;
        if (!SKIP(0)) prologue_phase(a, lds, G);
        GSYNC();
        layer_program<0>(a, lds, lds_raw, G, bar, skipmask); GSYNC();
        layer_program<1>(a, lds, lds_raw, G, bar, skipmask); GSYNC();
        layer_program<2>(a, lds, lds_raw, G, bar, skipmask); GSYNC();
        layer_program<3>(a, lds, lds_raw, G, bar, skipmask); GSYNC();
    }
#endif
    {
        const int skipmask = a.pad;
        if (!SKIP(0)) prologue_phase(a, lds, G);
        grid.sync();
        layer_program<0>(a, lds, lds_raw, G, bar, skipmask);
        layer_program<1>(a, lds, lds_raw, G, bar, skipmask);
        layer_program<2>(a, lds, lds_raw, G, bar, skipmask);
        layer_program<3>(a, lds, lds_raw, G, bar, skipmask);
    }
}
#undef SKIP

extern "C" void kernel_launch(void* const* d_in, const int* in_sizes, int n_in, void* d_out, int out_size, void* d_ws, size_t ws_size, hipStream_t stream) {
    static int grid = 0;
    if (grid == 0) {
        if (n_in != 21 || out_size != M * D || ws_size < WS_END) { fprintf(stderr, "kernel_launch: unexpected shapes (n_in %d, out %d, ws %zu)\n", n_in, out_size, ws_size); grid = -1; return; }
        int dev = 0, cus = 0, per_cu = 0;
        hipGetDevice(&dev); hipDeviceGetAttribute(&cus, hipDeviceAttributeMultiprocessorCount, dev);
        if (hipFuncSetAttribute((const void*)fwd_megakernel, hipFuncAttributeMaxDynamicSharedMemorySize, LDS_BYTES) != hipSuccess) { fprintf(stderr, "kernel_launch: hipFuncSetAttribute failed\n"); grid = -1; return; }
        if (hipOccupancyMaxActiveBlocksPerMultiprocessor(&per_cu, (const void*)fwd_megakernel, NWAVES * 64, LDS_BYTES) != hipSuccess || per_cu < 1) per_cu = 1;
        (void)hipGetLastError();
        grid = cus * per_cu;
        fprintf(stderr, "kernel_launch: grid %d (cus %d x %d)\n", grid, cus, per_cu);
    }
    if (grid < 0) return;
    Args a{};
    for (int i = 0; i < 21; ++i) a.in[i] = (const float*)d_in[i];
    a.out = (float*)d_out; a.ws = (unsigned char*)d_ws;
#ifdef PROBE_SKIP
    a.skip = PROBE_SKIP;
#else
    a.skip = 0;
#endif
    a.pad = 0;
    if (hipMemsetAsync(d_ws, 0, 65536, stream) != hipSuccess) { fprintf(stderr, "kernel_launch: hipMemsetAsync failed\n"); return; }
    void* args[] = {&a};
    const hipError_t e = hipLaunchCooperativeKernel((const void*)fwd_megakernel, dim3(grid), dim3(NWAVES * 64), args, LDS_BYTES, stream);
    if (e != hipSuccess) fprintf(stderr, "kernel_launch: cooperative launch failed: %s (grid %d)\n", hipGetErrorString(e), grid);
}
```

```cpp
#include <hip/hip_runtime.h>
#include <hip/hip_cooperative_groups.h>
#include <cstdio>
#include <cstdint>
namespace cg = cooperative_groups;
namespace pg8 {
#define PG8_LAS __attribute__((address_space(3)))
typedef unsigned short bf16_t;
typedef short bf16x8 __attribute__((ext_vector_type(8)));
typedef float f32x4 __attribute__((ext_vector_type(4)));
typedef unsigned u32x4 __attribute__((ext_vector_type(4)));
constexpr int BM = 256, BK = 64, HALF = 128, HTB = HALF * BK * 2  , STAGE_BYTES = 8 * HTB, NXCD = 8, WGM = 8;

__host__ __device__ __forceinline__ int lds_byte(int r, int c) { const int st = (r >> 4) * 2 + (c >> 5), rr = r & 15, cc = c & 31, ob = rr * 64 + cc * 2; return st * 1024 + (ob ^ (((ob >> 9) & 1) << 5)); }
__host__ __device__ __forceinline__ void stage_rc(int b, int& R, int& C) { const int st = b / 1024, sb = b % 1024, swz = sb ^ (((sb >> 9) & 1) << 5); R = (st >> 1) * 16 + swz / 64; C = (st & 1) * 32 + (swz % 64) / 2; }
__host__ __device__ __forceinline__ int perm32(int rho) { const int n = rho >> 4, i = rho & 15; return 8 * (i >> 2) + 4 * n + (i & 3); }

struct Unit { int pm, pn; };
struct Gemm { const bf16_t* A; const bf16_t* Bt; int M, N, K; };

struct StaticOrder {
    int nM, nN, nwg, G, c;
    __host__ __device__ void init(int M, int N, int G_, int c_) { nM = M / BM; nN = N / BM; nwg = nM * nN; G = G_; c = c_; }
    __host__ __device__ bool next(int i, Unit& u) const {
        const long L = (long)i * G + c; if (L >= nwg) return false;
        int wgid = (int)L; { const int q = nwg / NXCD, r = nwg % NXCD, xcd = wgid % NXCD, off = wgid / NXCD; wgid = (xcd < r ? xcd * (q + 1) : r * (q + 1) + (xcd - r) * q) + off; }
        const int nig = WGM * nN, gid = wgid / nig, fm = gid * WGM, gsz = (nM - fm) < WGM ? (nM - fm) : WGM;
        u.pm = fm + ((wgid % nig) % gsz); u.pn = (wgid % nig) / gsz; return true;
    }
    __device__ __forceinline__ void a_ready(const Unit&) const {}
    __device__ __forceinline__ void done(const Unit&) const {}
};

__device__ __forceinline__ unsigned cvt_pk_bf16(float lo, float hi) { unsigned r; asm volatile("v_cvt_pk_bf16_f32 %0, %1, %2" : "=v"(r) : "v"(lo), "v"(hi)); return r; }
typedef float f32x2 __attribute__((ext_vector_type(2)));
__device__ __forceinline__ float bf2f(unsigned short h) { return __uint_as_float(((unsigned)h) << 16); }
__device__ __forceinline__ float sigmoidf_(float x) { return 1.0f / (1.0f + __expf(-x)); }
struct EpiPlain {
    static constexpr bool PERM = true, AFTER_DRAIN = false;
    bf16_t* O; int ldc; int scale_cols; float scale;
    __device__ __forceinline__ void operator()(const f32x4 (&acc)[2][2][4][2], const Unit& u, int wr, int wc, int fr, int fq) const {
        const int row0 = u.pm * BM + wr * 64 + fr, col0 = u.pn * BM + wc * 32 + 8 * fq;
        const float sc = (u.pn * BM < scale_cols) ? scale : 1.f;
#pragma unroll
        for (int ai = 0; ai < 2; ++ai)
#pragma unroll
            for (int m = 0; m < 4; ++m) { bf16_t* rowp = O + (size_t)(row0 + ai * HALF + m * 16) * ldc + col0;
#pragma unroll
                for (int bj = 0; bj < 2; ++bj) { f32x4 v0 = acc[ai][bj][m][0] * sc, v1 = acc[ai][bj][m][1] * sc;
                    u32x4 w; w.x = cvt_pk_bf16(v0[0], v0[1]); w.y = cvt_pk_bf16(v0[2], v0[3]); w.z = cvt_pk_bf16(v1[0], v1[1]); w.w = cvt_pk_bf16(v1[2], v1[3]);
                    *(u32x4*)(rowp + bj * HALF) = w; } }
    }
};
struct EpiMl {
    static constexpr bool PERM = true, AFTER_DRAIN = false;
    bf16_t* O; float* gates; const float* bias;
    __device__ __forceinline__ void operator()(const f32x4 (&acc)[2][2][4][2], const Unit& u, int wr, int wc, int fr, int fq) const {
        const int row0 = u.pm * BM + wr * 64 + fr;
        if (u.pn < 12) {
            const int col0 = u.pn * BM + wc * 32 + 8 * fq; const float sc = (u.pn < 2) ? 0.125f : 1.f;
#pragma unroll
            for (int ai = 0; ai < 2; ++ai)
#pragma unroll
                for (int m = 0; m < 4; ++m) { bf16_t* rowp = O + (size_t)(row0 + ai * HALF + m * 16) * 3072 + col0;
#pragma unroll
                    for (int bj = 0; bj < 2; ++bj) { f32x4 v0 = acc[ai][bj][m][0] * sc, v1 = acc[ai][bj][m][1] * sc;
                        u32x4 w; w.x = cvt_pk_bf16(v0[0], v0[1]); w.y = cvt_pk_bf16(v0[2], v0[3]); w.z = cvt_pk_bf16(v1[0], v1[1]); w.w = cvt_pk_bf16(v1[2], v1[3]);
                        *(u32x4*)(rowp + bj * HALF) = w; } }
        } else if (wc == 0) {
            const f32x4 b0 = *(const f32x4*)(bias + 8 * fq), b1 = *(const f32x4*)(bias + 8 * fq + 4);
#pragma unroll
            for (int ai = 0; ai < 2; ++ai)
#pragma unroll
                for (int m = 0; m < 4; ++m) { float* gp = gates + (size_t)(row0 + ai * HALF + m * 16) * 32 + 8 * fq;
                    *(f32x4*)gp = acc[ai][0][m][0] + b0; *(f32x4*)(gp + 4) = acc[ai][0][m][1] + b1; }
        }
    }
};
struct EpiFf1 {
    static constexpr bool PERM = true, AFTER_DRAIN = false;
    bf16_t* H; bf16_t* PP;
    __device__ __forceinline__ void operator()(const f32x4 (&acc)[2][2][4][2], const Unit& u, int wr, int wc, int fr, int fq) const {
        const int row0 = u.pm * BM + wr * 64 + fr;
        if (u.pn < 16) {
            const int col0 = u.pn * BM + wc * 32 + 8 * fq;
#pragma unroll
            for (int ai = 0; ai < 2; ++ai)
#pragma unroll
                for (int m = 0; m < 4; ++m) { bf16_t* rowp = H + (size_t)(row0 + ai * HALF + m * 16) * 4096 + col0;
#pragma unroll
                    for (int bj = 0; bj < 2; ++bj) { f32x4 v0 = acc[ai][bj][m][0], v1 = acc[ai][bj][m][1];
#pragma unroll
                        for (int e = 0; e < 4; ++e) { const float a = fmaxf(v0[e], 0.f), b = fmaxf(v1[e], 0.f); v0[e] = a * a; v1[e] = b * b; }
                        u32x4 w; w.x = cvt_pk_bf16(v0[0], v0[1]); w.y = cvt_pk_bf16(v0[2], v0[3]); w.z = cvt_pk_bf16(v1[0], v1[1]); w.w = cvt_pk_bf16(v1[2], v1[3]);
                        *(u32x4*)(rowp + bj * HALF) = w; } }
        } else {
            const int col0 = (u.pn - 16) * BM + wc * 32 + 8 * fq;
#pragma unroll
            for (int ai = 0; ai < 2; ++ai)
#pragma unroll
                for (int m = 0; m < 4; ++m) { bf16_t* rowp = PP + (size_t)(row0 + ai * HALF + m * 16) * 1024 + col0;
#pragma unroll
                    for (int bj = 0; bj < 2; ++bj) { f32x4 v0 = acc[ai][bj][m][0], v1 = acc[ai][bj][m][1];
                        const u32x4 pp = *(const u32x4*)(rowp + bj * HALF);
                        const unsigned pw[4] = {pp.x, pp.y, pp.z, pp.w};
#pragma unroll
                        for (int e = 0; e < 2; ++e) {
                            v0[2 * e]     = sigmoidf_(v0[2 * e])     * __uint_as_float(pw[e] << 16);
                            v0[2 * e + 1] = sigmoidf_(v0[2 * e + 1]) * __uint_as_float(pw[e] & 0xffff0000u);
                            v1[2 * e]     = sigmoidf_(v1[2 * e])     * __uint_as_float(pw[2 + e] << 16);
                            v1[2 * e + 1] = sigmoidf_(v1[2 * e + 1]) * __uint_as_float(pw[2 + e] & 0xffff0000u); }
                        u32x4 w; w.x = cvt_pk_bf16(v0[0], v0[1]); w.y = cvt_pk_bf16(v0[2], v0[3]); w.z = cvt_pk_bf16(v1[0], v1[1]); w.w = cvt_pk_bf16(v1[2], v1[3]);
                        *(u32x4*)(rowp + bj * HALF) = w; } }
        }
    }
};
struct EpiResidBf {
    static constexpr bool PERM = true, AFTER_DRAIN = false;
    bf16_t* X; const bf16_t* ple; float alpha;
    __device__ __forceinline__ void operator()(const f32x4 (&acc)[2][2][4][2], const Unit& u, int wr, int wc, int fr, int fq) const {
        const int row0 = u.pm * BM + wr * 64 + fr, col0 = u.pn * BM + wc * 32 + 8 * fq;
#pragma unroll
        for (int ai = 0; ai < 2; ++ai)
#pragma unroll
            for (int m = 0; m < 4; ++m) { const size_t off = (size_t)(row0 + ai * HALF + m * 16) * 1024 + col0;
#pragma unroll
                for (int bj = 0; bj < 2; ++bj) { f32x4 v0 = acc[ai][bj][m][0], v1 = acc[ai][bj][m][1];
                    const u32x4 r = *(const u32x4*)(X + off + bj * HALF);
                    v0[0] += alpha * __uint_as_float(r.x << 16); v0[1] += alpha * __uint_as_float(r.x & 0xffff0000u); v0[2] += alpha * __uint_as_float(r.y << 16); v0[3] += alpha * __uint_as_float(r.y & 0xffff0000u);
                    v1[0] += alpha * __uint_as_float(r.z << 16); v1[1] += alpha * __uint_as_float(r.z & 0xffff0000u); v1[2] += alpha * __uint_as_float(r.w << 16); v1[3] += alpha * __uint_as_float(r.w & 0xffff0000u);
                    if (ple) { const u32x4 p = *(const u32x4*)(ple + off + bj * HALF);
                        v0[0] += __uint_as_float(p.x << 16); v0[1] += __uint_as_float(p.x & 0xffff0000u); v0[2] += __uint_as_float(p.y << 16); v0[3] += __uint_as_float(p.y & 0xffff0000u);
                        v1[0] += __uint_as_float(p.z << 16); v1[1] += __uint_as_float(p.z & 0xffff0000u); v1[2] += __uint_as_float(p.w << 16); v1[3] += __uint_as_float(p.w & 0xffff0000u); }
                    u32x4 w; w.x = cvt_pk_bf16(v0[0], v0[1]); w.y = cvt_pk_bf16(v0[2], v0[3]); w.z = cvt_pk_bf16(v1[0], v1[1]); w.w = cvt_pk_bf16(v1[2], v1[3]);
                    *(u32x4*)(X + off + bj * HALF) = w; } }
    }
};
template <class Epi, class Sched, bool ALIGN_EPI = false, bool SP2 = false>
__device__ __forceinline__ void gemm_phase(PG8_LAS unsigned char* lds, const Gemm g, const Sched& S, const Epi& E) {
    const int tid = threadIdx.x, wid = __builtin_amdgcn_readfirstlane(tid >> 6), lane = tid & 63, wr = wid >> 2, wc = wid & 3, fr = lane & 15, fq = lane >> 4;
    const int K = g.K, nt = K / BK;
    unsigned voffA[2], voffB[2];
#pragma unroll
    for (int i = 0; i < 2; ++i) { int R, C; stage_rc(tid * 16 + i * 8192, R, C); const int Rb = Epi::PERM ? ((R & ~31) + perm32(R & 31)) : R;
        voffA[i] = (unsigned)(R * K + C) * 2u; voffB[i] = (unsigned)(Rb * K + C) * 2u; }
    const size_t kstep = (size_t)(BK * 2);
    const size_t hstep = (size_t)HALF * K * 2;
    const size_t tstep = 2 * hstep;
    const unsigned ldsw = (unsigned)wid * 1024u;
    const int aoff = lds_byte(wr * 64 + fr, fq * 8), boff = lds_byte(wc * 32 + fr, fq * 8);
#define PG8_SA(b, h) (((b) * 2 + (h)) * HTB)
#define PG8_SB(b, h) ((4 + (b) * 2 + (h)) * HTB)
#define PG8_STAGE(bufoff, gbase, voff) do { _Pragma("unroll") for (int _i = 0; _i < 2; ++_i) \
        __builtin_amdgcn_global_load_lds((const unsigned*)((const char*)(gbase) + (voff)[_i]), (PG8_LAS unsigned*)(lds + (bufoff) + ldsw + _i * 8192), 16, 0, 0); } while (0)
#define PG8_LDA(dst, b, h) do { _Pragma("unroll") for (int m = 0; m < 4; ++m) _Pragma("unroll") for (int k = 0; k < 2; ++k) dst[m][k] = *(const PG8_LAS bf16x8*)(lds + PG8_SA(b, h) + aoff + m * 2048 + k * 1024); } while (0)
#define PG8_LDB(dst, b, h) do { _Pragma("unroll") for (int n = 0; n < 2; ++n) _Pragma("unroll") for (int k = 0; k < 2; ++k) dst[n][k] = *(const PG8_LAS bf16x8*)(lds + PG8_SB(b, h) + boff + n * 2048 + k * 1024); } while (0)
#define PG8_MMA(ai, bj, At, Bt) do { __builtin_amdgcn_s_setprio(1); _Pragma("unroll") for (int m = 0; m < 4; ++m) _Pragma("unroll") for (int n = 0; n < 2; ++n) _Pragma("unroll") for (int k = 0; k < 2; ++k) \
        acc[ai][bj][m][n] = __builtin_amdgcn_mfma_f32_16x16x32_bf16(Bt[n][k], At[m][k], acc[ai][bj][m][n], 0, 0, 0); __builtin_amdgcn_s_setprio(0); } while (0)
#define PG8_WAIT_V(n) asm volatile("s_waitcnt vmcnt(" #n ")" ::: "memory")
#define PG8_WAIT_L(n) asm volatile("s_waitcnt lgkmcnt(" #n ")" ::: "memory")
#define PG8_BAR __builtin_amdgcn_s_barrier()
#define PG8_SCHED __builtin_amdgcn_sched_barrier(0)
    Unit cur, nxt; int ui = 0;
    if (!S.next(0, cur)) return;
    f32x4 acc[2][2][4][2];
#pragma unroll
    for (int a = 0; a < 2; ++a)
#pragma unroll
        for (int b = 0; b < 2; ++b)
#pragma unroll
            for (int m = 0; m < 4; ++m)
#pragma unroll
                for (int n = 0; n < 2; ++n) acc[a][b][m][n] = (f32x4){0.f, 0.f, 0.f, 0.f};
    bf16x8 At[4][2], B0[2][2], B1[2][2];
    const char* cA = (const char*)g.A + (size_t)cur.pm * tstep; const char* cB = (const char*)g.Bt + (size_t)cur.pn * tstep;
    S.a_ready(cur);
    if constexpr (SP2) {
        PG8_STAGE(PG8_SB(0, 0), cB, voffB); PG8_STAGE(PG8_SB(0, 1), cB + hstep, voffB); PG8_STAGE(PG8_SA(0, 0), cA, voffA); PG8_STAGE(PG8_SA(0, 1), cA + hstep, voffA);
        if (wr == 1) PG8_BAR;
        PG8_WAIT_V(2); PG8_BAR;
        PG8_STAGE(PG8_SB(1, 0), cB + kstep, voffB); PG8_STAGE(PG8_SA(1, 0), cA + kstep, voffA); PG8_STAGE(PG8_SB(1, 1), cB + hstep + kstep, voffB);
        PG8_WAIT_V(6); PG8_BAR;
    } else {
        PG8_STAGE(PG8_SB(0, 0), cB, voffB); PG8_STAGE(PG8_SA(0, 0), cA, voffA); PG8_STAGE(PG8_SB(0, 1), cB + hstep, voffB); PG8_STAGE(PG8_SA(0, 1), cA + hstep, voffA);
        if (wr == 1) PG8_BAR;
        PG8_WAIT_V(4); PG8_BAR;
        PG8_STAGE(PG8_SB(1, 0), cB + kstep, voffB); PG8_STAGE(PG8_SA(1, 0), cA + kstep, voffA); PG8_STAGE(PG8_SB(1, 1), cB + hstep + kstep, voffB);
        PG8_WAIT_V(6); PG8_BAR;
    }
    for (;;) {
        const bool has_next = S.next(ui + 1, nxt);
        const char* nA = has_next ? (const char*)g.A + (size_t)nxt.pm * tstep : cA; const char* nB = has_next ? (const char*)g.Bt + (size_t)nxt.pn * tstep : cB;
        for (int t = 0; t < nt; t += 2) {
            const bool last = (t == nt - 2);
            const char* a1 = cA + (size_t)(t + 1) * kstep;
            const char* a2 = last ? nA : cA + (size_t)(t + 2) * kstep; const char* b2 = last ? nB : cB + (size_t)(t + 2) * kstep;
            const char* a3 = a2 + kstep; const char* b3 = b2 + kstep;
            if (last && has_next) S.a_ready(nxt);
            if constexpr (SP2) {
            PG8_LDB(B0, 0, 0); PG8_LDB(B1, 0, 1); PG8_SCHED; PG8_LDA(At, 0, 0); PG8_STAGE(PG8_SA(1, 1), a1 + hstep, voffA);
            PG8_WAIT_V(8); PG8_WAIT_L(0); PG8_BAR; PG8_MMA(0, 0, At, B0); PG8_MMA(0, 1, At, B1); PG8_BAR; PG8_SCHED;
            PG8_LDA(At, 0, 1); PG8_STAGE(PG8_SB(0, 0), b2, voffB); PG8_STAGE(PG8_SB(0, 1), b2 + hstep, voffB); PG8_STAGE(PG8_SA(0, 0), a2, voffA);
            PG8_WAIT_V(8); PG8_WAIT_L(0); PG8_BAR; PG8_MMA(1, 0, At, B0); PG8_MMA(1, 1, At, B1); PG8_BAR; PG8_SCHED;
            PG8_LDB(B0, 1, 0); PG8_LDB(B1, 1, 1); PG8_SCHED; PG8_LDA(At, 1, 0); PG8_STAGE(PG8_SA(0, 1), a2 + hstep, voffA);
            PG8_WAIT_V(8); PG8_WAIT_L(0); PG8_BAR; PG8_MMA(0, 0, At, B0); PG8_MMA(0, 1, At, B1); PG8_BAR; PG8_SCHED;
            PG8_LDA(At, 1, 1); PG8_STAGE(PG8_SB(1, 0), b3, voffB); PG8_STAGE(PG8_SB(1, 1), b3 + hstep, voffB); PG8_STAGE(PG8_SA(1, 0), a3, voffA);
            PG8_WAIT_V(8); PG8_WAIT_L(0); PG8_BAR; PG8_MMA(1, 0, At, B0); PG8_MMA(1, 1, At, B1); PG8_BAR; PG8_SCHED;
            } else {
            PG8_LDB(B0, 0, 0); PG8_SCHED; PG8_LDA(At, 0, 0); PG8_STAGE(PG8_SA(1, 1), a1 + hstep, voffA);
            PG8_WAIT_L(8); PG8_BAR; PG8_WAIT_L(0); PG8_MMA(0, 0, At, B0); PG8_BAR; PG8_SCHED;
            PG8_LDB(B1, 0, 1); PG8_STAGE(PG8_SB(0, 0), b2, voffB);
            PG8_BAR; PG8_WAIT_L(0); PG8_MMA(0, 1, At, B1); PG8_BAR;
            PG8_LDA(At, 0, 1); PG8_STAGE(PG8_SA(0, 0), a2, voffA);
            PG8_BAR; PG8_WAIT_L(0); PG8_MMA(1, 0, At, B0); PG8_BAR; PG8_SCHED;
            PG8_STAGE(PG8_SB(0, 1), b2 + hstep, voffB);
            PG8_WAIT_V(6); PG8_BAR; PG8_MMA(1, 1, At, B1); PG8_BAR;
            PG8_LDB(B0, 1, 0); PG8_SCHED; PG8_LDA(At, 1, 0); PG8_STAGE(PG8_SA(0, 1), a2 + hstep, voffA);
            PG8_WAIT_L(8); PG8_BAR; PG8_WAIT_L(0); PG8_MMA(0, 0, At, B0); PG8_BAR; PG8_SCHED;
            PG8_LDB(B1, 1, 1); PG8_STAGE(PG8_SB(1, 0), b3, voffB);
            PG8_BAR; PG8_WAIT_L(0); PG8_MMA(0, 1, At, B1); PG8_BAR;
            PG8_LDA(At, 1, 1); PG8_STAGE(PG8_SA(1, 0), a3, voffA);
            PG8_BAR; PG8_WAIT_L(0); PG8_MMA(1, 0, At, B0); PG8_BAR; PG8_SCHED;
            PG8_STAGE(PG8_SB(1, 1), b3 + hstep, voffB);
            PG8_WAIT_V(6); PG8_BAR; PG8_MMA(1, 1, At, B1); PG8_BAR;
            }
        }
        if constexpr (ALIGN_EPI) { if (wr == 0) PG8_BAR; }
        if constexpr (!Epi::AFTER_DRAIN) { E(acc, cur, wr, wc, fr, fq); S.done(cur); }
        if (!has_next) break;
#pragma unroll
        for (int a = 0; a < 2; ++a)
#pragma unroll
            for (int b = 0; b < 2; ++b)
#pragma unroll
                for (int m = 0; m < 4; ++m)
#pragma unroll
                    for (int n = 0; n < 2; ++n) acc[a][b][m][n] = (f32x4){0.f, 0.f, 0.f, 0.f};
        cur = nxt; cA = nA; cB = nB; ++ui;
        if constexpr (ALIGN_EPI) { if (wr == 1) PG8_BAR; }
    }
    PG8_WAIT_V(0);
    if constexpr (!ALIGN_EPI) { if (wr == 0) PG8_BAR; }
    PG8_BAR;
    if constexpr (Epi::AFTER_DRAIN) { E.fused(acc, cur, wr, wc, fr, fq, lds, wid, lane); S.done(cur); }
#undef PG8_SA
#undef PG8_SB
#undef PG8_STAGE
#undef PG8_LDA
#undef PG8_LDB
#undef PG8_MMA
#undef PG8_WAIT_V
#undef PG8_WAIT_L
#undef PG8_BAR
#undef PG8_SCHED
}
}
#include <hip/hip_bf16.h>
#include <cmath>
namespace attn_body {
using bf16=__hip_bfloat16;
using bf16x8=__attribute__((ext_vector_type(8)))short;
using s16x4=__attribute__((ext_vector_type(4)))short;
using f32x16=__attribute__((ext_vector_type(16)))float;
using u32x4=__attribute__((ext_vector_type(4)))unsigned;
constexpr int BATCH=32,NHEAD=16,SEQ=2048,D=64,DM=1536,OP=1024;
constexpr int NW=8,QBLK=32,QB=QBLK*NW,KVBLK=64,NQB=SEQ/QB;
constexpr int ATTN_PITCH=DM, ATTN_UNIT_ROWS=QB;
__device__ __forceinline__ int crow(int r,int hi){return (r&3)+8*(r>>2)+4*hi;}
#define SBAR() __builtin_amdgcn_sched_barrier(0)
__device__ __forceinline__ void cmask(f32x16&p0,f32x16&p1,int jb,int qrel,int hi){
  const float NEG=-INFINITY; int kb=64*jb+4*hi;
  #pragma unroll
  for(int r=0;r<16;++r){int kv=kb+(r&3)+8*(r>>2); if(kv>qrel)p0[r]=NEG; if(kv+32>qrel)p1[r]=NEG;}
}

constexpr int NSLOT=3, SLOTB=8192;
constexpr int LDS_K=0, LDS_V=NSLOT*SLOTB, LDS_WS=2*NSLOT*SLOTB, LDS_OST=LDS_WS+NW*64*4, LDS_BYTES=LDS_OST+NW*4096;
constexpr float C2=0.125f*1.4426950408889634f;
__device__ __forceinline__ void glds16(const void*gsrc,unsigned lds_dst){unsigned keep;
  asm volatile("s_mov_b32 %0, m0\n\ts_mov_b32 m0, %2\n\ts_nop 0\n\tglobal_load_lds_dwordx4 %1, off\n\ts_mov_b32 m0, %0":"=&s"(keep):"v"(gsrc),"s"(lds_dst):"memory");}
__device__ __forceinline__ float max3f(float a,float b,float c){float r;asm("v_max3_f32 %0, %1, %2, %3":"=v"(r):"v"(a),"v"(b),"v"(c));return r;}
__device__ __forceinline__ float max2f(float a,float b){float r;asm("v_max_f32_e32 %0, %1, %2":"=v"(r):"v"(a),"v"(b));return r;}
__device__ __forceinline__ float fadd_s(float a,float b){float r;asm("v_add_f32_e32 %0, %1, %2":"=v"(r):"v"(a),"v"(b));return r;}
__device__ __forceinline__ float fsub_s(float a,float b){float r;asm("v_sub_f32_e32 %0, %1, %2":"=v"(r):"v"(a),"v"(b));return r;}
typedef float f32x2_t __attribute__((ext_vector_type(2))); typedef __bf16 bf16x2_t __attribute__((ext_vector_type(2)));
__device__ __forceinline__ unsigned cvtpk_s(float lo,float hi){f32x2_t v={lo,hi};bf16x2_t b=__builtin_convertvector(v,bf16x2_t);return __builtin_bit_cast(unsigned,b);}
#define WAIT_BAR(N) asm volatile("s_waitcnt vmcnt(" #N ") lgkmcnt(0)\n\ts_barrier":::"memory")

__device__ __forceinline__ void qkt(f32x16&p0,f32x16&p1,const char*Kslot,const bf16x8*qr,const f32x16&negm,int r32,int hi){
  const char*kb=Kslot+hi*1024+r32*16;
  #pragma unroll
  for(int d0=0;d0<4;++d0){
    const bf16x8 b0=*reinterpret_cast<const bf16x8*>(kb+d0*2048);
    const bf16x8 b1=*reinterpret_cast<const bf16x8*>(kb+d0*2048+512);
    if(d0==0){p0=__builtin_amdgcn_mfma_f32_32x32x16_bf16(b0,qr[0],negm,0,0,0);p1=__builtin_amdgcn_mfma_f32_32x32x16_bf16(b1,qr[0],negm,0,0,0);}
    else{p0=__builtin_amdgcn_mfma_f32_32x32x16_bf16(b0,qr[d0],p0,0,0,0);p1=__builtin_amdgcn_mfma_f32_32x32x16_bf16(b1,qr[d0],p1,0,0,0);}}
}
typedef __attribute__((address_space(3))) const char* lds_cptr;
typedef short v4i16_t __attribute__((ext_vector_type(4)));
__device__ __forceinline__ void kload8(bf16x8*kf,lds_cptr kp){
  kf[0]=*(const __attribute__((address_space(3))) bf16x8*)(kp);      kf[1]=*(const __attribute__((address_space(3))) bf16x8*)(kp+512);
  kf[2]=*(const __attribute__((address_space(3))) bf16x8*)(kp+2048); kf[3]=*(const __attribute__((address_space(3))) bf16x8*)(kp+2560);
  kf[4]=*(const __attribute__((address_space(3))) bf16x8*)(kp+4096); kf[5]=*(const __attribute__((address_space(3))) bf16x8*)(kp+4608);
  kf[6]=*(const __attribute__((address_space(3))) bf16x8*)(kp+6144); kf[7]=*(const __attribute__((address_space(3))) bf16x8*)(kp+6656);
}
__device__ __forceinline__ void kload2(bf16x8*kf,lds_cptr kp,int j){ kf[2*j]=*(const __attribute__((address_space(3))) bf16x8*)(kp+j*2048); kf[2*j+1]=*(const __attribute__((address_space(3))) bf16x8*)(kp+j*2048+512); }
__device__ __forceinline__ s16x4 vtr(lds_cptr p){ return __builtin_bit_cast(s16x4,__builtin_amdgcn_ds_read_tr16_b64_v4i16((__attribute__((address_space(3))) v4i16_t*)p)); }
__device__ __forceinline__ float rowmax(const f32x16&p0,const f32x16&p1){
  float a=max3f(p0[0],p0[1],p1[0]),b=max3f(p0[2],p0[3],p1[1]);a=max3f(a,p1[2],p1[3]);
  #pragma unroll
  for(int r=4;r<16;r+=4){a=max3f(a,p0[r],p0[r+1]);b=max3f(b,p0[r+2],p0[r+3]);a=max3f(a,p1[r],p1[r+1]);b=max3f(b,p1[r+2],p1[r+3]);}
  const float m=max2f(a,b);
  auto rr=__builtin_amdgcn_permlane32_swap(__float_as_uint(m),__float_as_uint(m),false,false);
  return max2f(__uint_as_float(rr[0]),__uint_as_float(rr[1]));
}
__device__ __forceinline__ void pv(f32x16*o,int vb,bf16x8 pa0,bf16x8 pa1,bf16x8 pa2,bf16x8 pa3){
  #pragma unroll
  for(int d0=0;d0<2;++d0){s16x4 lo[4],hi[4];
    #pragma unroll
    for(int ks=0;ks<4;++ks){
      asm volatile("ds_read_b64_tr_b16 %0,%1 offset:%c2":"=&v"(lo[ks]):"v"(vb),"i"(d0*4096+ks*1024):"memory");
      asm volatile("ds_read_b64_tr_b16 %0,%1 offset:%c2":"=&v"(hi[ks]):"v"(vb),"i"(d0*4096+ks*1024+512):"memory");}
    asm volatile("s_waitcnt lgkmcnt(0)":::"memory");SBAR();
    #define PK(k) (bf16x8){lo[k][0],lo[k][1],lo[k][2],lo[k][3],hi[k][0],hi[k][1],hi[k][2],hi[k][3]}
    o[d0]=__builtin_amdgcn_mfma_f32_32x32x16_bf16(pa0,PK(0),o[d0],0,0,0);
    o[d0]=__builtin_amdgcn_mfma_f32_32x32x16_bf16(pa1,PK(1),o[d0],0,0,0);
    o[d0]=__builtin_amdgcn_mfma_f32_32x32x16_bf16(pa2,PK(2),o[d0],0,0,0);
    o[d0]=__builtin_amdgcn_mfma_f32_32x32x16_bf16(pa3,PK(3),o[d0],0,0,0);
    #undef PK
  }
}

#ifndef ATTN_STORE16
#define ATTN_STORE16(p,v) (*(u32x4*)(p)=(v))
#endif
template<int THRL> __device__ __forceinline__ void attn_unit(int b,int h,int qb,const bf16*Q,const bf16*__restrict__ K,const bf16*__restrict__ V,bf16*O,char*shm){
  const int tid=threadIdx.x,lane=tid&63,r32=lane&31,hi=lane>>5; const int wid=__builtin_amdgcn_readfirstlane(tid>>6);
  const long rowbase=(long)b*SEQ; const int q0=qb*QB;
  const bf16*Qw=Q+(rowbase+q0+wid*QBLK)*DM+h*D;
  const bf16*Kh=K+rowbase*DM+(h>>2)*D,*Vh=V+rowbase*DM+(h>>2)*D;
  const unsigned lds0=(unsigned)(uintptr_t)shm;
  float*wsf=(float*)(shm+LDS_WS)+wid*64;
  const bf16*ksrc=Kh+(long)lane*DM+wid*8;
  const bf16*vsrc=Vh+(long)(16*(wid&3)+(lane>>2))*DM+(wid>>2)*32+(lane&3)*8;
  const unsigned kdst=lds0+LDS_K+wid*1024, vdst=lds0+LDS_V+wid*1024;
  #define DMA_K(t,slot) glds16(ksrc+(long)(t)*KVBLK*DM,(unsigned)__builtin_amdgcn_readfirstlane(kdst+(slot)))
  #define DMA_V(t,slot) glds16(vsrc+(long)(t)*KVBLK*DM,(unsigned)__builtin_amdgcn_readfirstlane(vdst+(slot)))
  const int vb0=(int)(lds0+LDS_V)+((lane>>4)&1)*32+(lane&3)*8+(4*hi+((lane&15)>>2))*64;
  const char*Kbase=shm+LDS_K; bf16x8 kf[8];
  const lds_cptr shm3=(lds_cptr)shm; const lds_cptr kp0=shm3+LDS_K+hi*1024+r32*16; const lds_cptr vp0=shm3+LDS_V+((lane>>4)&1)*32+(lane&3)*8+(4*hi+((lane&15)>>2))*64;
  const int NT=SEQ/KVBLK;
  DMA_K(0,0);DMA_V(0,0);DMA_K(1,SLOTB);
  bf16x8 qr[4];
  #pragma unroll
  for(int d0=0;d0<4;++d0)qr[d0]=*reinterpret_cast<const bf16x8*>(&Qw[(long)r32*DM+d0*16+hi*8]);
  float mhat=0.f,l_reg=0.f;f32x16 o[2];o[0]=f32x16{};o[1]=f32x16{};f32x16 negm=f32x16{};asm volatile("":"+v"(negm));

  #define CMASK(P0,P1,t) do{}while(0)
  bool resc=false;
  #define START(P0,P1) do{ const float rm=rowmax(P0,P1); resc=false; \
    { const float dl=rm; mhat=fadd_s(mhat,dl); \
      _Pragma("unroll") for(int r=0;r<16;++r){P0[r]=fsub_s(P0[r],dl);P1[r]=fsub_s(P1[r],dl);} \
      _Pragma("unroll") for(int r=0;r<16;++r)negm[r]=-mhat; asm volatile("":"+v"(negm)); } \
    _Pragma("unroll") for(int r=0;r<16;++r)P0[r]=__builtin_amdgcn_exp2f(P0[r]); }while(0)
  #define RESC() do{ if(resc){ asm volatile("s_waitcnt lgkmcnt(0)":::"memory"); \
      _Pragma("unroll") for(int d_=0;d_<2;++d_) _Pragma("unroll") for(int r=0;r<16;++r)o[d_][r]*=wsf[crow(r,hi)]; } }while(0)
  f32x16 pA0,pA1,pB0,pB1;
  int sl_prev=0,sl_cur=0,sl_next=SLOTB;
  #define ROT() do{sl_prev=sl_cur;sl_cur=sl_next;sl_next=(sl_next==(NSLOT-1)*SLOTB)?0:sl_next+SLOTB;}while(0)
  DMA_K(2,2*SLOTB);
  WAIT_BAR(3);
  qkt(pA0,pA1,Kbase,qr,negm,r32,hi);asm volatile("s_nop 15\n\ts_nop 7":"+v"(pA0),"+v"(pA1));CMASK(pA0,pA1,0);
  START(pA0,pA1);
  _Pragma("unroll") for(int r=0;r<16;++r)pA1[r]=__builtin_amdgcn_exp2f(pA1[r]);
  WAIT_BAR(0);
  DMA_K(3,0);DMA_V(1,SLOTB);
  ROT();
  kload8(kf,kp0+sl_cur);
  WAIT_BAR(2);
  s16x4 vlo[8],vhi[8]; u32x4 pw0,pw1,pw2,pw3;
  #define PKW(P,B) cvtpk_s(P[B],P[B+1])
  #define PAF(k) __builtin_bit_cast(bf16x8,pw##k)
  #define VFR(i) (bf16x8){vlo[i][0],vlo[i][1],vlo[i][2],vlo[i][3],vhi[i][0],vhi[i][1],vhi[i][2],vhi[i][3]}
  #define PIN(x) asm volatile("":"+v"(x))
  #define MX3(a,b,c) __builtin_fmaxf(__builtin_fmaxf((a),(b)),(c))
  #define GAPA(MF,A0,A1,A2,A3,W0,W1,PW) do{ MF; sacc+=A0; sacc+=A1; sacc+=A2; sacc+=A3; PIN(sacc); W0; W1; PIN(PW); SBAR(); }while(0)
  #define EX(v) __builtin_amdgcn_exp2f(v)
  #define GAPB(MF,X,B) do{ MF; X[B]=EX(X[B]); X[B+1]=EX(X[B+1]); X[B+2]=EX(X[B+2]); X[B+3]=EX(X[B+3]); PIN(X); SBAR(); }while(0)
  #define VRD(i) do{ vlo[i]=vtr(vp_+(((i)>>2)*4096+((i)&3)*1024)); vhi[i]=vtr(vp_+(((i)>>2)*4096+((i)&3)*1024+512)); }while(0)
  #define KRD(G,j) do{ if(G){ kload2(kf,kp0+sl_next,j); SBAR(); } }while(0)
  #define STEP(C0,C1,P0,P1,t,GK,GV,GL) do{ SBAR(); \
    const lds_cptr vp_=vp0+sl_prev; \
    VRD(0); SBAR(); float sacc=(P0[0]+P0[1]); \
    GAPA(C0=__builtin_amdgcn_mfma_f32_32x32x16_bf16(kf[0],qr[0],negm,0,0,0), P0[2],P0[3],P0[4],P0[5],     pw0[0]=PKW(P0,0), pw0[1]=PKW(P0,2), pw0); \
    VRD(4); SBAR(); GAPA(C1=__builtin_amdgcn_mfma_f32_32x32x16_bf16(kf[1],qr[0],negm,0,0,0), P0[6],P0[7],P0[8],P0[9],     pw0[2]=PKW(P0,4), pw0[3]=PKW(P0,6), pw0); \
    VRD(1); SBAR(); GAPA(C0=__builtin_amdgcn_mfma_f32_32x32x16_bf16(kf[2],qr[1],C0,0,0,0),   P0[10],P0[11],P0[12],P0[13], pw1[0]=PKW(P0,8), pw1[1]=PKW(P0,10), pw1); \
    VRD(5); SBAR(); GAPA(C1=__builtin_amdgcn_mfma_f32_32x32x16_bf16(kf[3],qr[1],C1,0,0,0),   P0[14],P0[15],P1[0],P1[1],   pw1[2]=PKW(P0,12),pw1[3]=PKW(P0,14), pw1); \
    VRD(2); SBAR(); GAPA(C0=__builtin_amdgcn_mfma_f32_32x32x16_bf16(kf[4],qr[2],C0,0,0,0),   P1[2],P1[3],P1[4],P1[5],     pw2[0]=PKW(P1,0), pw2[1]=PKW(P1,2), pw2); \
    VRD(6); SBAR(); GAPA(C1=__builtin_amdgcn_mfma_f32_32x32x16_bf16(kf[5],qr[2],C1,0,0,0),   P1[6],P1[7],P1[8],P1[9],     pw2[2]=PKW(P1,4), pw2[3]=PKW(P1,6), pw2); \
    VRD(3); SBAR(); GAPA(C0=__builtin_amdgcn_mfma_f32_32x32x16_bf16(kf[6],qr[3],C0,0,0,0),   P1[10],P1[11],P1[12],P1[13], pw3[0]=PKW(P1,8), pw3[1]=PKW(P1,10), pw3); \
    VRD(7); SBAR(); GAPA(C1=__builtin_amdgcn_mfma_f32_32x32x16_bf16(kf[7],qr[3],C1,0,0,0),   P1[14],P1[15],0.f,0.f,       pw3[2]=PKW(P1,12),pw3[3]=PKW(P1,14), pw3); \
    l_reg+=sacc; \
    if(GK){DMA_K((t)+3,sl_cur);} if(GV){DMA_V((t)+1,sl_next);} \
    CMASK(C0,C1,t); \
    { float a=MX3(C0[0],C0[1],C1[0]),b=MX3(C0[2],C0[3],C1[1]); a=MX3(a,C1[2],C1[3]); \
      _Pragma("unroll") for(int r=4;r<16;r+=4){a=MX3(a,C0[r],C0[r+1]);b=MX3(b,C0[r+2],C0[r+3]);a=MX3(a,C1[r],C1[r+1]);b=MX3(b,C1[r+2],C1[r+3]);} \
      float rm=__builtin_fmaxf(a,b); { auto rr=__builtin_amdgcn_permlane32_swap(__float_as_uint(rm),__float_as_uint(rm),false,false); rm=__builtin_fmaxf(__uint_as_float(rr[0]),__uint_as_float(rr[1])); } \
      resc=false; \
      if(__builtin_expect(__any(rm>(float)THRL),0)){ const float dl=__builtin_fmaxf(rm,0.f); mhat+=dl; \
        _Pragma("unroll") for(int r=0;r<16;++r){C0[r]-=dl;C1[r]-=dl;} \
        _Pragma("unroll") for(int r=0;r<16;++r)negm[r]=-mhat; asm volatile("":"+v"(negm)); \
        const float f=__builtin_amdgcn_exp2f(-dl); l_reg*=f; if(hi==0)wsf[r32]=f; resc=true; } } \
    SBAR(); \
    GAPB(o[0]=__builtin_amdgcn_mfma_f32_32x32x16_bf16(PAF(0),VFR(0),o[0],0,0,0), C0,0); \
    GAPB(o[1]=__builtin_amdgcn_mfma_f32_32x32x16_bf16(PAF(0),VFR(4),o[1],0,0,0), C0,4); \
    KRD(GL,0); GAPB(o[0]=__builtin_amdgcn_mfma_f32_32x32x16_bf16(PAF(1),VFR(1),o[0],0,0,0), C0,8); \
    KRD(GL,1); GAPB(o[1]=__builtin_amdgcn_mfma_f32_32x32x16_bf16(PAF(1),VFR(5),o[1],0,0,0), C0,12); \
    KRD(GL,2); GAPB(o[0]=__builtin_amdgcn_mfma_f32_32x32x16_bf16(PAF(2),VFR(2),o[0],0,0,0), C1,0); \
    KRD(GL,3); GAPB(o[1]=__builtin_amdgcn_mfma_f32_32x32x16_bf16(PAF(2),VFR(6),o[1],0,0,0), C1,4); \
    GAPB(o[0]=__builtin_amdgcn_mfma_f32_32x32x16_bf16(PAF(3),VFR(3),o[0],0,0,0), C1,8); \
    GAPB(o[1]=__builtin_amdgcn_mfma_f32_32x32x16_bf16(PAF(3),VFR(7),o[1],0,0,0), C1,12); \
    }while(0)
  int t=1;
  #undef CMASK
  #define CMASK(P0,P1,t) do{}while(0)
  for(;t+5<NT;t+=2){
    STEP(pB0,pB1,pA0,pA1,t,true,true,true);     WAIT_BAR(2); RESC(); ROT();
    STEP(pA0,pA1,pB0,pB1,t+1,true,true,true);   WAIT_BAR(2); RESC(); ROT();
  }
  #undef CMASK
  #define CMASK(P0,P1,t) do{}while(0)
  #define ENDW(tt) do{ if((tt)+3<NT){WAIT_BAR(2);} else if((tt)+2<NT){WAIT_BAR(1);} else {WAIT_BAR(0);} }while(0)
  for(;t+1<NT;t+=2){
    STEP(pB0,pB1,pA0,pA1,t,(t+3<NT),(t+1<NT),(t+1<NT));       ENDW(t);   RESC(); ROT();
    STEP(pA0,pA1,pB0,pB1,t+1,(t+4<NT),(t+2<NT),(t+2<NT));     ENDW(t+1); RESC(); ROT();
  }
  STEP(pB0,pB1,pA0,pA1,NT-1,false,false,false); RESC();
  { float sacc=pB0[0]+pB0[1]; _Pragma("unroll") for(int r=2;r<16;++r)sacc+=pB0[r]; _Pragma("unroll") for(int r=0;r<16;++r)sacc+=pB1[r]; l_reg+=sacc;
    pw0=(u32x4){PKW(pB0,0),PKW(pB0,2),PKW(pB0,4),PKW(pB0,6)};pw1=(u32x4){PKW(pB0,8),PKW(pB0,10),PKW(pB0,12),PKW(pB0,14)};pw2=(u32x4){PKW(pB1,0),PKW(pB1,2),PKW(pB1,4),PKW(pB1,6)};pw3=(u32x4){PKW(pB1,8),PKW(pB1,10),PKW(pB1,12),PKW(pB1,14)};
    SBAR(); pv(o,vb0+sl_cur,PAF(0),PAF(1),PAF(2),PAF(3)); }
  #undef PKW
  #undef PAF
  #undef VFR
  #undef PIN
  #undef MX3
  #undef GAPA
  #undef GAPB
  #undef EX
  #undef VRD
  #undef KRD
  #undef STEP
  #undef ENDW
  {auto rr=__builtin_amdgcn_permlane32_swap(__float_as_uint(l_reg),__float_as_uint(l_reg),false,false);l_reg=__uint_as_float(rr[0])+__uint_as_float(rr[1]);}
  if(hi==0)wsf[32+r32]=l_reg;asm volatile("s_waitcnt lgkmcnt(0)":::"memory");
  float rli[16];
  #pragma unroll
  for(int r=0;r<16;++r)rli[r]=__builtin_amdgcn_rcpf(wsf[32+crow(r,hi)]);
  bf16*Ow=O+(rowbase+q0+wid*QBLK)*OP+h*D;
  { bf16*stg=(bf16*)(shm+LDS_OST)+wid*2048;
    #pragma unroll
    for(int r=0;r<16;++r){const int orow=crow(r,hi);
      #pragma unroll
      for(int d0=0;d0<2;++d0)stg[orow*64+d0*32+r32]=__float2bfloat16(o[d0][r]*rli[r]);}
    asm volatile("s_waitcnt lgkmcnt(0)":::"memory");
    #pragma unroll
    for(int i=0;i<4;++i){const int row=i*8+(lane>>3),ch=lane&7; const u32x4 v=*(const u32x4*)(stg+row*64+ch*8); ATTN_STORE16(Ow+(long)row*OP+ch*8,v);} }
  asm volatile("s_waitcnt lgkmcnt(0)\n\ts_barrier":::"memory");
  #undef DMA_K
  #undef DMA_V
  #undef CMASK
  #undef START
  #undef RESC
  #undef ROT
}
constexpr int ATTN_LDS_BYTES=LDS_BYTES;
struct AttnTensors { const bf16* Q; const bf16* K; const bf16* V; bf16* O; };
struct AttnUnit { int bh; int qb; };
struct StaticOrder {
  int vcu,G;
  __device__ __forceinline__ explicit StaticOrder(int grid,int block):vcu((grid%8==0)?(block%8)*(grid/8)+block/8:block),G(grid){}
  __device__ __forceinline__ bool next(int i,AttnUnit&u)const{ const int x=i*G+vcu; if(x>=BATCH*NHEAD*NQB)return false; u.bh=x>>3; u.qb=x&7; return true; }
  __device__ __forceinline__ void a_ready(const AttnUnit&)const{}
  __device__ __forceinline__ void done(const AttnUnit&)const{}
};
template<class Sched,int THRL=8> __device__ __forceinline__ void attn_phase(char*lds,const AttnTensors&T,const Sched&S){
  AttnUnit u;
  for(int i=0;S.next(i,u);++i){ S.a_ready(u); attn_unit<THRL>(u.bh/NHEAD,u.bh%NHEAD,u.qb,T.Q,T.K,T.V,T.O,lds); S.done(u); }
}
#undef SBAR
#undef WAIT_BAR
}
constexpr int NWAVES = 8;
#ifndef DEPTH_
#define DEPTH_ 4
#endif
constexpr int M = 65536, D = 1024, SEQ = 2048, NBATCH = 32, FF = 4096, DPLE = 256, DEPTH = DEPTH_;
constexpr float DN_ALPHA = 1.6817928305074290f;
constexpr float LN_EPS = 1e-6f;
constexpr size_t MiB = 1u << 20;
constexpr size_t WS_W = 2 * MiB;
constexpr size_t WS_WIN = WS_W, WS_WO = WS_W + 28 * MiB, WS_W1G = WS_W + 36 * MiB, WS_W2 = WS_W + 76 * MiB, WS_WP = WS_W + 108 * MiB;
constexpr size_t WS_XN = 114 * MiB;
constexpr size_t WS_PB = 242 * MiB;
constexpr size_t WS_GATES = 274 * MiB;
constexpr size_t WS_QKV = 282 * MiB;
constexpr size_t WS_O = 698 * MiB;
constexpr size_t WS_PP = 826 * MiB;
constexpr size_t WS_H = 282 * MiB;
constexpr size_t WS_END = 954 * MiB;
constexpr int LDS_BYTES = 147456;

#define GAS __attribute__((address_space(1)))
#define LAS __attribute__((address_space(3)))
typedef unsigned short bf16;
typedef unsigned v4u __attribute__((ext_vector_type(4)));
typedef float f32x4 __attribute__((ext_vector_type(4)));
typedef short bf16x8 __attribute__((ext_vector_type(8)));
#define LDS_WAIT() asm volatile("s_waitcnt lgkmcnt(0)" ::: "memory")
__device__ __forceinline__ unsigned f2bf(float f) { unsigned u = __builtin_bit_cast(unsigned, f); return (u + 0x7fffu + ((u >> 16) & 1u)) >> 16; }
__device__ __forceinline__ unsigned pk2(float lo, float hi) { return f2bf(lo) | (f2bf(hi) << 16); }
__device__ __forceinline__ float bf2f(unsigned short h) { return __uint_as_float(((unsigned)h) << 16); }
__device__ __forceinline__ f32x4 mfma16(bf16x8 a, bf16x8 b, f32x4 c) { return __builtin_amdgcn_mfma_f32_16x16x32_bf16(a, b, c, 0, 0, 0); }
__device__ __forceinline__ float wave_sum(float v) {
#pragma unroll
    for (int o = 1; o < 64; o <<= 1) v += __shfl_xor(v, o);
    return v;
}

struct Args { const float* in[21]; float* out; unsigned char* ws; int skip, pad; };

__device__ __forceinline__ void p0_transpose_item(const float* W, int K, int N, bf16* WT, int row_off, LAS float* scr, int item, int lane) {
    const int nblk = N / 32, kb = item / nblk, nb = item % nblk, k0 = 64 * kb, n0 = 32 * nb;
#pragma unroll 8
    for (int i = 0; i < 32; ++i) { const int kk = 2 * i + (lane >> 5); scr[kk * 33 + (lane & 31)] = W[(size_t)(k0 + kk) * N + n0 + (lane & 31)]; }
    LDS_WAIT(); asm volatile("" ::: "memory");
    const int c = lane & 7;
#pragma unroll
    for (int j = 0; j < 4; ++j) { const int n = (lane >> 3) + 8 * j; const LAS float* s = scr + (8 * c) * 33 + n;
        v4u o; o.x = pk2(s[0 * 33], s[1 * 33]); o.y = pk2(s[2 * 33], s[3 * 33]); o.z = pk2(s[4 * 33], s[5 * 33]); o.w = pk2(s[6 * 33], s[7 * 33]);
        *(v4u*)(WT + (size_t)(row_off + n0 + n) * K + k0 + 8 * c) = o; }
    LDS_WAIT(); asm volatile("" ::: "memory");
}
struct WDesc { const float* src; int K, N; bf16* dst; int row_off; };
__device__ __forceinline__ WDesc wdesc(const Args& a, int idx) {
    const int l = idx / 6, kind = idx % 6; WDesc w; unsigned char* ws = a.ws;
    if (kind == 0) { w.K = 1024; w.row_off = 0; w.dst = (bf16*)(ws + WS_WIN + (size_t)l * 7 * MiB);
        if (l == 0) { w.src = a.in[2]; w.N = 3072; } else if (l == 1) { w.src = a.in[5]; w.N = 1536; } else if (l == 2) { w.src = a.in[9]; w.N = 3104; } else { w.src = a.in[2] + (size_t)1024 * 3072; w.N = 3072; } }
    else if (kind == 1) { w.K = 1024; w.N = 1024; w.row_off = 0; w.dst = (bf16*)(ws + WS_WO + (size_t)l * 2 * MiB);
        w.src = (l == 0) ? a.in[4] : (l == 1) ? a.in[8] : (l == 2) ? a.in[12] : a.in[4] + (size_t)1024 * 1024; }
    else if (kind == 2) { w.K = 1024; w.N = 4096; w.row_off = 0; w.dst = (bf16*)(ws + WS_W1G + (size_t)l * 10 * MiB); w.src = a.in[15] + (size_t)l * 1024 * 4096; }
    else if (kind == 3) { w.K = 1024; w.N = 1024; w.row_off = 4096; w.dst = (bf16*)(ws + WS_W1G + (size_t)l * 10 * MiB); w.src = a.in[19] + (size_t)l * 1024 * 1024; }
    else if (kind == 4) { w.K = 4096; w.N = 1024; w.row_off = 0; w.dst = (bf16*)(ws + WS_W2 + (size_t)l * 8 * MiB); w.src = a.in[16] + (size_t)l * 4096 * 1024; }
    else { w.K = 256; w.N = 1024; w.row_off = 0; w.dst = (bf16*)(ws + WS_WP + (size_t)l * (MiB / 2)); w.src = a.in[20] + (size_t)l * 256 * 1024; }
    return w;
}
__device__ __forceinline__ void cvt_rows(const float* src, bf16* dst, size_t n, int G) {
    const size_t nth = (size_t)G * 512, n8 = n / 8;
    for (size_t i = (size_t)blockIdx.x * 512 + threadIdx.x; i < n8; i += nth) {
        const f32x4 a = *(const f32x4*)(src + i * 8), b = *(const f32x4*)(src + i * 8 + 4);
        v4u o; o.x = pk2(a[0], a[1]); o.y = pk2(a[2], a[3]); o.z = pk2(b[0], b[1]); o.w = pk2(b[2], b[3]);
        *(v4u*)(dst + i * 8) = o; }
}
__device__ __forceinline__ void prologue_phase(const Args& a, LAS unsigned char* lds, int G) {
    const int tid = threadIdx.x, lane = tid & 63, wave = tid >> 6;
    LAS float* scr = (LAS float*)(lds + wave * 16384);
    const int gw = blockIdx.x * NWAVES + wave, NGW = G * NWAVES;
    for (int idx = 0; idx < 24; ++idx) { const WDesc w = wdesc(a, idx); const int nitems = (w.K / 64) * (w.N / 32);
        for (int it = gw; it < nitems; it += NGW) p0_transpose_item(w.src, w.K, w.N, w.dst, w.row_off, scr, it, lane); }
    {
        v4u* z = (v4u*)((bf16*)(a.ws + WS_WIN + (size_t)2 * 7 * MiB) + (size_t)3104 * 1024); const size_t n16 = (size_t)224 * 1024 * 2 / 16;
        for (size_t i = (size_t)blockIdx.x * 512 + tid; i < n16; i += (size_t)G * 512) z[i] = (v4u){0u, 0u, 0u, 0u}; }
    cvt_rows(a.in[0], (bf16*)(a.ws + WS_XN), (size_t)M * D, G);
    cvt_rows(a.in[1], (bf16*)(a.ws + WS_PB), (size_t)M * DPLE, G);
}
__device__ __forceinline__ void ln_phase_bf(bf16* X, const float* g, const float* bta, float* outf, int G) {
    const int lane = threadIdx.x & 63, wave = threadIdx.x >> 6; const int gw = blockIdx.x * NWAVES + wave, NGW = G * NWAVES;
    f32x4 gv[4], bv[4];
#pragma unroll
    for (int j = 0; j < 4; ++j) { const int c = (j >> 1) * 512 + 8 * lane + (j & 1) * 4; gv[j] = *(const f32x4*)(g + c); bv[j] = *(const f32x4*)(bta + c); }
    for (int m = gw; m < M; m += NGW) {
        bf16* xr = X + (size_t)m * D + 8 * lane;
        const v4u r0 = *(const v4u*)xr, r1 = *(const v4u*)(xr + 512);
        f32x4 v[4];
        v[0] = (f32x4){__uint_as_float(r0.x << 16), __uint_as_float(r0.x & 0xffff0000u), __uint_as_float(r0.y << 16), __uint_as_float(r0.y & 0xffff0000u)};
        v[1] = (f32x4){__uint_as_float(r0.z << 16), __uint_as_float(r0.z & 0xffff0000u), __uint_as_float(r0.w << 16), __uint_as_float(r0.w & 0xffff0000u)};
        v[2] = (f32x4){__uint_as_float(r1.x << 16), __uint_as_float(r1.x & 0xffff0000u), __uint_as_float(r1.y << 16), __uint_as_float(r1.y & 0xffff0000u)};
        v[3] = (f32x4){__uint_as_float(r1.z << 16), __uint_as_float(r1.z & 0xffff0000u), __uint_as_float(r1.w << 16), __uint_as_float(r1.w & 0xffff0000u)};
        float s = 0.f;
#pragma unroll
        for (int j = 0; j < 4; ++j) s += (v[j][0] + v[j][1]) + (v[j][2] + v[j][3]);
        const float mean = wave_sum(s) * (1.f / D); float s2 = 0.f;
#pragma unroll
        for (int j = 0; j < 4; ++j) { v[j] = v[j] - mean; s2 += (v[j][0] * v[j][0] + v[j][1] * v[j][1]) + (v[j][2] * v[j][2] + v[j][3] * v[j][3]); }
        const float rstd = 1.f / sqrtf(wave_sum(s2) * (1.f / D) + LN_EPS);
#pragma unroll
        for (int j = 0; j < 4; ++j) v[j] = v[j] * rstd * gv[j] + bv[j];
        if (outf) { float* o = outf + (size_t)m * D + 8 * lane; *(f32x4*)o = v[0]; *(f32x4*)(o + 4) = v[1]; *(f32x4*)(o + 512) = v[2]; *(f32x4*)(o + 516) = v[3]; }
        else { *(v4u*)xr = (v4u){pk2(v[0][0], v[0][1]), pk2(v[0][2], v[0][3]), pk2(v[1][0], v[1][1]), pk2(v[1][2], v[1][3])};
               *(v4u*)(xr + 512) = (v4u){pk2(v[2][0], v[2][1]), pk2(v[2][2], v[2][3]), pk2(v[3][0], v[3][1]), pk2(v[3][2], v[3][3])}; }
    }
}
__device__ __forceinline__ void na_phase(const bf16* QKV, const float* rpb, bf16* O, LAS unsigned char* lds, int G) {
    const int tid = threadIdx.x, lane = tid & 63, wave = tid >> 6, l15 = lane & 15, quad = lane >> 4;
    LAS bf16* vt = (LAS bf16*)(lds + wave * 5120);
    const int gw = blockIdx.x * NWAVES + wave, NGW = G * NWAVES;
    for (int uid = gw; uid < 65536; uid += NGW) {
        const int jq = uid & 3, h = (uid >> 2) & 15, r = (uid >> 6) & 31, b = uid >> 11;
        const int r0 = min(max(r - 4, 0), 24);
        const int kc0 = (jq == 0) ? 0 : (jq == 1) ? 8 : (jq == 2) ? 24 : 32;
        const size_t tokb = (size_t)b * 2048;
        const int c = jq * 16 + l15, c0 = min(max(c - 8, 0), 48);
        const bf16* qp = QKV + (tokb + r * 64 + c) * 3072 + h * 64 + quad * 8;
        const bf16x8 qf0 = *(const bf16x8*)qp, qf1 = *(const bf16x8*)(qp + 32);
        const float* rp = rpb + h * (15 * 31);
        f32x4 sc[8][2];
        float mx = -INFINITY;
#pragma unroll
        for (int a = 0; a < 8; ++a) {
            const int dr = r0 + a - r + 7;
#pragma unroll
            for (int cb = 0; cb < 2; ++cb) {
                const bf16* kp = QKV + (tokb + (r0 + a) * 64 + kc0 + cb * 16 + l15) * 3072 + 1024 + h * 64 + quad * 8;
                const bf16x8 k0 = *(const bf16x8*)kp, k1 = *(const bf16x8*)(kp + 32);
                f32x4 acc = {0.f, 0.f, 0.f, 0.f};
                acc = mfma16(k0, qf0, acc); acc = mfma16(k1, qf1, acc);
#pragma unroll
                for (int j = 0; j < 4; ++j) { const int kc = kc0 + cb * 16 + quad * 4 + j; const bool valid = (kc >= c0) && (kc < c0 + 16);
                    const int dc = min(max(kc - c + 15, 0), 30);
                    const float bias = rp[dr * 31 + dc];
                    acc[j] = valid ? acc[j] + bias : -INFINITY; mx = fmaxf(mx, acc[j]); }
                sc[a][cb] = acc;
            }
        }
        mx = fmaxf(mx, __shfl_xor(mx, 16)); mx = fmaxf(mx, __shfl_xor(mx, 32));
        float sum = 0.f;
#pragma unroll
        for (int a = 0; a < 8; ++a)
#pragma unroll
            for (int cb = 0; cb < 2; ++cb)
#pragma unroll
                for (int j = 0; j < 4; ++j) { const float p = __expf(sc[a][cb][j] - mx); sc[a][cb][j] = p; sum += p; }
        sum += __shfl_xor(sum, 16); sum += __shfl_xor(sum, 32);
        f32x4 o[4];
#pragma unroll
        for (int db = 0; db < 4; ++db) o[db] = (f32x4){0.f, 0.f, 0.f, 0.f};
        const int key = lane >> 1, half = lane & 1;
        const int kperm = (key < 16) ? ((key >> 2) * 8 + (key & 3)) : (((key - 16) >> 2) * 8 + 4 + (key & 3));
#pragma unroll
        for (int a = 0; a < 8; ++a) {
            const bf16* vp = QKV + (tokb + (r0 + a) * 64 + kc0 + key) * 3072 + 2048 + h * 64 + half * 32;
            bf16x8 vv[4];
#pragma unroll
            for (int i = 0; i < 4; ++i) vv[i] = *(const bf16x8*)(vp + 8 * i);
#pragma unroll
            for (int i = 0; i < 4; ++i)
#pragma unroll
                for (int e = 0; e < 8; ++e) vt[(half * 32 + i * 8 + e) * 40 + kperm] = (bf16)vv[i][e];
            LDS_WAIT();
            bf16x8 pb;
            { const unsigned w0 = pk2(sc[a][0][0], sc[a][0][1]), w1 = pk2(sc[a][0][2], sc[a][0][3]), w2 = pk2(sc[a][1][0], sc[a][1][1]), w3 = pk2(sc[a][1][2], sc[a][1][3]);
              const v4u w = {w0, w1, w2, w3}; pb = __builtin_bit_cast(bf16x8, w); }
#pragma unroll
            for (int db = 0; db < 4; ++db) { const bf16x8 vf = *(const LAS bf16x8*)(vt + (db * 16 + l15) * 40 + quad * 8); o[db] = mfma16(vf, pb, o[db]); }
            LDS_WAIT();
        }
        const float inv = 1.0f / sum;
        bf16* op = O + (tokb + r * 64 + c) * 1024 + h * 64 + quad * 4;
#pragma unroll
        for (int db = 0; db < 4; ++db) { const unsigned long long w = (unsigned long long)pk2(o[db][0] * inv, o[db][1] * inv) | ((unsigned long long)pk2(o[db][2] * inv, o[db][3] * inv) << 32);
            *(unsigned long long*)(op + db * 16) = w; }
    }
}
__device__ __forceinline__ void gq_normrope_phase(bf16* QKV, const float* qn, const float* kn, int G) {
    const size_t total = (size_t)M * 20 * 8, nth = (size_t)G * 512;
    for (size_t g = (size_t)blockIdx.x * 512 + threadIdx.x; g < total; g += nth) {
        const size_t item = g >> 3; const int l8 = (int)(g & 7); const size_t tok = item / 20; const int hv = (int)(item % 20);
        bf16* p = QKV + tok * 1536 + hv * 64 + l8 * 8;
        const v4u raw = *(const v4u*)p; const unsigned rw[4] = {raw.x, raw.y, raw.z, raw.w};
        float x[8]; float ss = 0.f;
#pragma unroll
        for (int e = 0; e < 4; ++e) { x[2 * e] = __uint_as_float(rw[e] << 16); x[2 * e + 1] = __uint_as_float(rw[e] & 0xffff0000u); ss += x[2 * e] * x[2 * e] + x[2 * e + 1] * x[2 * e + 1]; }
        ss += __shfl_xor(ss, 1); ss += __shfl_xor(ss, 2); ss += __shfl_xor(ss, 4);
        const float rinv = 1.0f / sqrtf(ss * (1.f / 64.f) + 1e-6f);
        const float* gvec = ((hv < 16) ? qn : kn) + l8 * 8;
        const int s = (int)(tok & 2047), row = s >> 6, col = s & 63;
        const float scale = (hv < 16) ? (0.125f * 1.4426950408889634f) : 1.0f;
        unsigned ow[4];
#pragma unroll
        for (int pr = 0; pr < 4; ++pr) { const int i = l8 * 4 + pr; const float pos = (float)((i < 16) ? row : col); const int fi = i & 15;
            const float inv = exp2f(-(float)fi * (13.287712379549449f / 16.f)); const float ang = pos * inv;
            float rev = ang * 0.15915494309189535f; rev -= rintf(rev);
            const float sn = __builtin_amdgcn_sinf(rev), cs = __builtin_amdgcn_cosf(rev);
            const float x0 = x[2 * pr] * rinv * gvec[2 * pr], x1 = x[2 * pr + 1] * rinv * gvec[2 * pr + 1];
            ow[pr] = pk2((x0 * cs - x1 * sn) * scale, (x0 * sn + x1 * cs) * scale); }
        *(v4u*)p = (v4u){ow[0], ow[1], ow[2], ow[3]};
    }
}
__device__ __forceinline__ f32x4 tile_mma64(const LAS bf16* A, int arow0, const LAS bf16* Bt, int brow0, f32x4 acc, int l15, int quad) {
    const LAS bf16* ap = A + (arow0 + l15) * 72 + quad * 8; const LAS bf16* bp = Bt + (brow0 + l15) * 72 + quad * 8;
    acc = mfma16(*(const LAS bf16x8*)ap, *(const LAS bf16x8*)bp, acc);
    acc = mfma16(*(const LAS bf16x8*)(ap + 32), *(const LAS bf16x8*)(bp + 32), acc);
    return acc;
}
__device__ __forceinline__ void ml_phase(const bf16* Z, const float* gates, const float* norm_g, bf16* HFW, bf16* O, LAS unsigned char* lds, int G) {
    const int tid = threadIdx.x, lane = tid & 63, wave = tid >> 6, l15 = lane & 15, quad = lane >> 4;
    LAS bf16* Qs = (LAS bf16*)(lds);
    LAS bf16* Ks = (LAS bf16*)(lds + 9216);
    LAS bf16* Vt = (LAS bf16*)(lds + 18432);
    LAS bf16* Kt = (LAS bf16*)(lds + 39168);
    LAS bf16* Ct = (LAS bf16*)(lds + 48384);
    LAS bf16* As = (LAS bf16*)(lds + 69120);
    LAS float* Hs = (LAS float*)(lds + 78336);
    LAS float* vec = (LAS float*)(lds + 112128);
    for (int unit = blockIdx.x; unit < 256; unit += G) {
        const int b = unit >> 3, h = unit & 7; const size_t tokb = (size_t)b * 2048;
        for (int dir = 0; dir < 2; ++dir) {
            for (int i = tid; i < 144 * 72; i += 512) Ct[i] = 0;
            for (int i = tid; i < 16 * 72; i += 512) Vt[128 * 72 + i] = (i < 72) ? (bf16)0x3F80 : (bf16)0;
            f32x4 cst[4], cst8 = {0.f, 0.f, 0.f, 0.f};
#pragma unroll
            for (int i = 0; i < 4; ++i) cst[i] = (f32x4){0.f, 0.f, 0.f, 0.f};
            float m_run = 0.f;
            __syncthreads();
            for (int cs = 0; cs < 32; ++cs) {
                const int t8 = tid >> 3, ch = tid & 7;
                const size_t tok8 = tokb + (size_t)(dir == 0 ? cs * 64 + t8 : 2047 - (cs * 64 + t8));
                {
                    const bf16* zr = Z + tok8 * 3072;
                    *(LAS v4u*)(Qs + t8 * 72 + ch * 8) = *(const v4u*)(zr + h * 64 + ch * 8);
                    *(LAS v4u*)(Ks + t8 * 72 + ch * 8) = *(const v4u*)(zr + 512 + h * 64 + ch * 8);
#pragma unroll
                    for (int i = 0; i < 2; ++i) { const int c16 = ch + 8 * i; const bf16x8 vv = *(const bf16x8*)(zr + 1024 + h * 128 + c16 * 8);
#pragma unroll
                        for (int e = 0; e < 8; ++e) Vt[(c16 * 8 + e) * 72 + t8] = (bf16)vv[e]; }
                }
                if (wave == 0) {
                    const size_t tok = tokb + (size_t)(dir == 0 ? cs * 64 + lane : 2047 - (cs * 64 + lane));
                    const float li = gates[tok * 32 + dir * 16 + h], f = gates[tok * 32 + dir * 16 + 8 + h];
                    const float lf = fminf(f, 0.f) - log1pf(__expf(-fabsf(f)));
                    float bs = lf;
#pragma unroll
                    for (int o = 1; o < 64; o <<= 1) { const float y = __shfl_up(bs, o); if (lane >= o) bs += y; }
                    const float u = li - bs; float pm = u;
#pragma unroll
                    for (int o = 1; o < 64; o <<= 1) { const float y = __shfl_up(pm, o); if (lane >= o) pm = fmaxf(pm, y); }
                    const float Mt = fmaxf(pm, m_run), sint = __expf(m_run - Mt), mt = bs + Mt;
                    vec[lane] = u; vec[64 + lane] = Mt; vec[128 + lane] = sint; vec[192 + lane] = __expf(-mt);
                    m_run = __shfl(mt, 63);
                }
                __syncthreads();
                {
                    const int tb = wave >> 1;
#pragma unroll
                    for (int i = 0; i < 2; ++i) { const int sb = 2 * (wave & 1) + i;
                        f32x4 acc = {0.f, 0.f, 0.f, 0.f}; if (sb <= tb) acc = tile_mma64(Qs, tb * 16, Ks, sb * 16, acc, l15, quad);
                        const int s = sb * 16 + l15; const float us = vec[s];
#pragma unroll
                        for (int j = 0; j < 4; ++j) { const int t = tb * 16 + 4 * quad + j; const float w = (s <= t) ? __expf(us - vec[64 + t]) : 0.f; As[t * 72 + s] = (bf16)f2bf(acc[j] * w); } }
                    const float w63 = __expf(vec[t8] - vec[64 + 63]);
                    const bf16x8 kk = *(const LAS bf16x8*)(Ks + t8 * 72 + ch * 8);
#pragma unroll
                    for (int e = 0; e < 8; ++e) Kt[(ch * 8 + e) * 72 + t8] = (bf16)f2bf(bf2f((bf16)kk[e]) * w63);
                }
                __syncthreads();
                {
#pragma unroll
                    for (int tb = 0; tb < 4; ++tb) { const f32x4 z4 = {0.f, 0.f, 0.f, 0.f};
                        const f32x4 ah = tile_mma64(As, tb * 16, Vt, wave * 16, z4, l15, quad), ag = tile_mma64(Qs, tb * 16, Ct, wave * 16, z4, l15, quad);
#pragma unroll
                        for (int j = 0; j < 4; ++j) { const int t = tb * 16 + 4 * quad + j; Hs[t * 132 + wave * 16 + l15] = vec[128 + t] * ag[j] + ah[j]; } }
                    if (wave < 4) { const int tb = wave; const f32x4 z4 = {0.f, 0.f, 0.f, 0.f};
                        const f32x4 ah = tile_mma64(As, tb * 16, Vt, 128, z4, l15, quad), ag = tile_mma64(Qs, tb * 16, Ct, 128, z4, l15, quad);
                        if (l15 == 0) {
#pragma unroll
                            for (int j = 0; j < 4; ++j) { const int t = tb * 16 + 4 * quad + j; vec[256 + t] = vec[128 + t] * ag[j] + ah[j]; } } }
                }
                __syncthreads();
                {
                    const float decay = vec[128 + 63];
#pragma unroll
                    for (int db = 0; db < 4; ++db) { cst[db] = tile_mma64(Vt, wave * 16, Kt, db * 16, cst[db] * decay, l15, quad);
#pragma unroll
                        for (int j = 0; j < 4; ++j) Ct[(wave * 16 + 4 * quad + j) * 72 + db * 16 + l15] = (bf16)f2bf(cst[db][j]); }
                    if (wave < 4) { cst8 = tile_mma64(Vt, 128, Kt, wave * 16, cst8 * decay, l15, quad);
#pragma unroll
                        for (int j = 0; j < 4; ++j) Ct[(128 + 4 * quad + j) * 72 + wave * 16 + l15] = (bf16)f2bf(cst8[j]); }
                    const float dn = fmaxf(fabsf(vec[256 + t8]), vec[192 + t8]); const float rd = 1.0f / dn;
                    float hv[16];
#pragma unroll
                    for (int e = 0; e < 16; ++e) hv[e] = Hs[t8 * 132 + ch * 16 + e] * rd;
                    const size_t ho = tok8 * 1024 + h * 128 + ch * 16;
                    if (dir == 0) {
                        v4u w0, w1; w0.x = pk2(hv[0], hv[1]); w0.y = pk2(hv[2], hv[3]); w0.z = pk2(hv[4], hv[5]); w0.w = pk2(hv[6], hv[7]);
                        w1.x = pk2(hv[8], hv[9]); w1.y = pk2(hv[10], hv[11]); w1.z = pk2(hv[12], hv[13]); w1.w = pk2(hv[14], hv[15]);
                        *(v4u*)(HFW + ho) = w0; *(v4u*)(HFW + ho + 8) = w1;
                    } else {
                        const v4u f0 = *(const v4u*)(HFW + ho), f1 = *(const v4u*)(HFW + ho + 8);
                        const unsigned fw[8] = {f0.x, f0.y, f0.z, f0.w, f1.x, f1.y, f1.z, f1.w};
                        float ss = 0.f;
#pragma unroll
                        for (int e = 0; e < 8; ++e) { hv[2 * e] += __uint_as_float(fw[e] << 16); hv[2 * e + 1] += __uint_as_float(fw[e] & 0xffff0000u); ss += hv[2 * e] * hv[2 * e] + hv[2 * e + 1] * hv[2 * e + 1]; }
                        ss += __shfl_xor(ss, 1); ss += __shfl_xor(ss, 2); ss += __shfl_xor(ss, 4);
                        const float rinv = 1.0f / sqrtf(ss * (1.f / 128.f) + 1e-6f);
                        const bf16* og = Z + tok8 * 3072 + 2048 + h * 128 + ch * 16;
                        const v4u g0 = *(const v4u*)og, g1 = *(const v4u*)(og + 8);
                        const unsigned gw_[8] = {g0.x, g0.y, g0.z, g0.w, g1.x, g1.y, g1.z, g1.w};
                        const float* ng = norm_g + h * 128 + ch * 16;
                        unsigned ow[8];
#pragma unroll
                        for (int e = 0; e < 8; ++e) { const float o0 = 1.0f / (1.0f + __expf(-__uint_as_float(gw_[e] << 16))), o1 = 1.0f / (1.0f + __expf(-__uint_as_float(gw_[e] & 0xffff0000u)));
                            ow[e] = pk2(hv[2 * e] * rinv * ng[2 * e] * o0, hv[2 * e + 1] * rinv * ng[2 * e + 1] * o1); }
                        *(v4u*)(O + ho) = (v4u){ow[0], ow[1], ow[2], ow[3]}; *(v4u*)(O + ho + 8) = (v4u){ow[4], ow[5], ow[6], ow[7]};
                    }
                }
                __syncthreads();
            }
        }
    }
}
#define RLX_AGENT __ATOMIC_RELAXED, __HIP_MEMORY_SCOPE_AGENT
#define XB_TMO      128
#define XB_XCNT(j)  (256  + 64 * (j))
#define XB_XSUB(j)  (1280 + 64 * (j))
#define XB_XGEN(j)  (2304 + 64 * (j))
#define XB_TOP      3328
#define XB_TOPGEN   3392
#define XCD_BAR_WORDS 3456
#define XB_SPIN_CAP (1u << 18)

__device__ __forceinline__ unsigned xb_ld(unsigned* p)              { return __hip_atomic_load(p, __ATOMIC_RELAXED, __HIP_MEMORY_SCOPE_AGENT); }
__device__ __forceinline__ unsigned xb_add(unsigned* p, unsigned v) { return __hip_atomic_fetch_add(p, v, __ATOMIC_RELAXED, __HIP_MEMORY_SCOPE_AGENT); }
__device__ __forceinline__ unsigned xb_xcc_id() { return (unsigned)__builtin_amdgcn_s_getreg((3 << 11) | 20) & 0xFu; }
#define XB_SPIN(cond, bar) do { unsigned _sp = 0; while (cond) { __builtin_amdgcn_s_sleep(1); \
    if ((++_sp & 255u) == 0u) { if (xb_ld(&(bar)[XB_TMO])) break; if (_sp > XB_SPIN_CAP) { atomicAdd(&(bar)[XB_TMO], 1u); break; } } } } while (0)

struct XcdBarrier {
    unsigned* bar; unsigned x;
    volatile LAS unsigned* st;
};

__device__ __forceinline__ XcdBarrier xcd_barrier_post(unsigned* bar, volatile LAS unsigned* st) {
    XcdBarrier b; b.bar = bar; b.x = xb_xcc_id(); b.st = st;
    if (threadIdx.x == 0) (void)xb_add(&bar[XB_XCNT(b.x)], 1u);
    return b;
}
__device__ __forceinline__ void xcd_barrier_complete(unsigned* bar, unsigned x, unsigned& nloc, unsigned& nx) {
    const unsigned G = gridDim.x * gridDim.y * gridDim.z;
    unsigned sum, cnt, mine, sp = 0u;
    for (;;) {
        sum = 0u; cnt = 0u; mine = 0u;
#pragma unroll
        for (unsigned j = 0; j < 16; ++j) { const unsigned c = xb_ld(&bar[XB_XCNT(j)]); sum += c; cnt += (c > 0u) ? 1u : 0u; mine = (j == x) ? c : mine; }
        if (sum == G) break;
        __builtin_amdgcn_s_sleep(1);
        if ((++sp & 255u) == 0u) { if (xb_ld(&bar[XB_TMO])) break; if (sp > XB_SPIN_CAP) { atomicAdd(&bar[XB_TMO], 1u); break; } }
    }
    nloc = mine > 0u ? mine : 1u; nx = cnt > 0u ? cnt : 1u;
}

__device__ __forceinline__ void xcd_barrier(const XcdBarrier& b) {
    asm volatile("s_waitcnt vmcnt(0)" ::: "memory");
    __syncthreads();
    if (threadIdx.x == 0) {
        unsigned* bar = b.bar;
        __builtin_amdgcn_s_waitcnt(0);
        unsigned nloc = b.st[0], nx = b.st[1];
        if (nloc == 0u) { xcd_barrier_complete(bar, b.x, nloc, nx); b.st[0] = nloc; b.st[1] = nx; }
        const unsigned old = xb_add(&bar[XB_XSUB(b.x)], 1u);
        const unsigned gen = old / nloc;
        if (old + 1u == (gen + 1u) * nloc) {
            __builtin_amdgcn_fence(__ATOMIC_RELEASE, "agent");
            asm volatile("s_waitcnt vmcnt(0)" ::: "memory");
            const unsigned og = xb_add(&bar[XB_TOP], 1u);
            const unsigned tg = og / nx;
            if (og + 1u == (tg + 1u) * nx) xb_add(&bar[XB_TOPGEN], 1u);
            else XB_SPIN(xb_ld(&bar[XB_TOPGEN]) == tg, bar);
            __builtin_amdgcn_fence(__ATOMIC_ACQUIRE, "agent");
            xb_add(&bar[XB_XGEN(b.x)], 1u);
            asm volatile("s_waitcnt vmcnt(0)" ::: "memory");
        } else {
            XB_SPIN(xb_ld(&bar[XB_XGEN(b.x)]) == gen, bar);
            __builtin_amdgcn_fence(__ATOMIC_ACQUIRE, "agent");
            asm volatile("s_waitcnt vmcnt(0)" ::: "memory");
        }
    }
    __syncthreads();
}

#define GSYNC() xcd_barrier(bar)
#define SKIP(bit) ((skipmask >> (bit)) & 1)
template <int L> __device__ __forceinline__ void layer_program(const Args& a, LAS unsigned char* lds, unsigned char* lds_raw, const int G, const XcdBarrier& bar, const int skipmask) {
    constexpr int kind = L % 3;
    unsigned char* ws = a.ws;
    bf16* XN = (bf16*)(ws + WS_XN); bf16* QKV = (bf16*)(ws + WS_QKV); bf16* OB = (bf16*)(ws + WS_O); bf16* PP = (bf16*)(ws + WS_PP); bf16* HB = (bf16*)(ws + WS_H);
    if (!SKIP(1)) { const bf16* Win = (const bf16*)(ws + WS_WIN + (size_t)L * 7 * MiB);
        if constexpr (kind == 2) { pg8::Gemm g{XN, Win, M, 3328, D}; pg8::StaticOrder S; S.init(M, 3328, G, (int)blockIdx.x);
            pg8::EpiMl E{QKV, (float*)(ws + WS_GATES), a.in[10]};
            pg8::gemm_phase<pg8::EpiMl, pg8::StaticOrder, true, true>(lds, g, S, E); }
        else { constexpr int N = (kind == 0) ? 3072 : 1536; pg8::Gemm g{XN, Win, M, N, D}; pg8::StaticOrder S; S.init(M, N, G, (int)blockIdx.x);
            pg8::EpiPlain E{QKV, N, (kind == 0) ? 1024 : 0, 0.125f};
            pg8::gemm_phase<pg8::EpiPlain, pg8::StaticOrder, true, true>(lds, g, S, E); } }
    if (!SKIP(2)) { pg8::Gemm g{(const bf16*)(ws + WS_PB), (const bf16*)(ws + WS_WP + (size_t)L * (MiB / 2)), M, D, DPLE}; pg8::StaticOrder S; S.init(M, D, G, (int)blockIdx.x);
        pg8::EpiPlain E{PP, D, 0, 1.f};
        pg8::gemm_phase<pg8::EpiPlain, pg8::StaticOrder, true, true>(lds, g, S, E); }
    GSYNC();
    if constexpr (kind == 1) { if (!SKIP(3)) gq_normrope_phase(QKV, a.in[6], a.in[7], G); GSYNC(); }
    if (!SKIP(4)) {
        if constexpr (kind == 0) na_phase(QKV, a.in[3] + (size_t)(L / 3) * 16 * 15 * 31, OB, lds, G);
        else if constexpr (kind == 1) { const attn_body::AttnTensors AT{(const attn_body::bf16*)QKV, (const attn_body::bf16*)(QKV + 1024), (const attn_body::bf16*)(QKV + 1280), (attn_body::bf16*)OB};
            const attn_body::StaticOrder S(G, (int)blockIdx.x); attn_body::attn_phase<attn_body::StaticOrder>((char*)lds_raw, AT, S); }
        else ml_phase(QKV, (const float*)(ws + WS_GATES), a.in[11], (bf16*)a.out, OB, lds, G);
    }
    GSYNC();
    if (!SKIP(5)) { pg8::Gemm g{OB, (const bf16*)(ws + WS_WO + (size_t)L * 2 * MiB), M, D, D}; pg8::StaticOrder S; S.init(M, D, G, (int)blockIdx.x);
        pg8::EpiResidBf E{XN, nullptr, DN_ALPHA};
        pg8::gemm_phase<pg8::EpiResidBf, pg8::StaticOrder, true, true>(lds, g, S, E); }
    GSYNC();
    if (!SKIP(6)) ln_phase_bf(XN, a.in[13] + (size_t)L * D, a.in[14] + (size_t)L * D, nullptr, G);
    GSYNC();
    if (!SKIP(7)) { pg8::Gemm g{XN, (const bf16*)(ws + WS_W1G + (size_t)L * 10 * MiB), M, FF + D, D}; pg8::StaticOrder S; S.init(M, FF + D, G, (int)blockIdx.x);
        pg8::EpiFf1 E{HB, PP};
        pg8::gemm_phase<pg8::EpiFf1, pg8::StaticOrder, true, true>(lds, g, S, E); }
    GSYNC();
    if (!SKIP(8)) { pg8::Gemm g{HB, (const bf16*)(ws + WS_W2 + (size_t)L * 8 * MiB), M, D, FF}; pg8::StaticOrder S; S.init(M, D, G, (int)blockIdx.x);
        pg8::EpiResidBf E{XN, PP, DN_ALPHA};
        pg8::gemm_phase<pg8::EpiResidBf, pg8::StaticOrder, true, true>(lds, g, S, E); }
    GSYNC();
    if (!SKIP(9)) { ln_phase_bf(XN, a.in[17] + (size_t)L * D, a.in[18] + (size_t)L * D, (L + 1 < DEPTH) ? nullptr : a.out, G);
        if constexpr (L + 1 < DEPTH) cvt_rows(a.in[1] + (size_t)(L + 1) * M * DPLE, (bf16*)(ws + WS_PB), (size_t)M * DPLE, G); }
    if constexpr (L + 1 < DEPTH) GSYNC();
}
__global__ void __launch_bounds__(NWAVES * 64, 2) fwd_megakernel(Args a) {
    extern __shared__ __attribute__((aligned(16))) unsigned char lds_raw[];
    LAS unsigned char* lds = (LAS unsigned char*)lds_raw;
    cg::grid_group grid = cg::this_grid();
    const int G = gridDim.x;
    { volatile LAS unsigned* z = (volatile LAS unsigned*)(lds + 131072); if (threadIdx.x < 64) z[threadIdx.x] = 0u; }
    __syncthreads();
    const XcdBarrier bar = xcd_barrier_post((unsigned*)a.ws + 4096, (volatile LAS unsigned*)(lds + 131072 + 64));
#ifdef PROBE_SKIP
    {
        const int skipmask = a.skip;
        if (!SKIP(0)) prologue_phase(a, lds, G);
        GSYNC();
        layer_program<0>(a, lds, lds_raw, G, bar, skipmask); GSYNC();
        layer_program<1>(a, lds, lds_raw, G, bar, skipmask); GSYNC();
        layer_program<2>(a, lds, lds_raw, G, bar, skipmask); GSYNC();
        layer_program<3>(a, lds, lds_raw, G, bar, skipmask); GSYNC();
    }
#endif
    {
        const int skipmask = a.pad;
        if (!SKIP(0)) prologue_phase(a, lds, G);
        grid.sync();
        layer_program<0>(a, lds, lds_raw, G, bar, skipmask);
        layer_program<1>(a, lds, lds_raw, G, bar, skipmask);
        layer_program<2>(a, lds, lds_raw, G, bar, skipmask);
        layer_program<3>(a, lds, lds_raw, G, bar, skipmask);
    }
}
#undef SKIP

extern "C" void kernel_launch(void* const* d_in, const int* in_sizes, int n_in, void* d_out, int out_size, void* d_ws, size_t ws_size, hipStream_t stream) {
    static int grid = 0;
    if (grid == 0) {
        if (n_in != 21 || out_size != M * D || ws_size < WS_END) { fprintf(stderr, "kernel_launch: unexpected shapes (n_in %d, out %d, ws %zu)\n", n_in, out_size, ws_size); grid = -1; return; }
        int dev = 0, cus = 0, per_cu = 0;
        hipGetDevice(&dev); hipDeviceGetAttribute(&cus, hipDeviceAttributeMultiprocessorCount, dev);
        if (hipFuncSetAttribute((const void*)fwd_megakernel, hipFuncAttributeMaxDynamicSharedMemorySize, LDS_BYTES) != hipSuccess) { fprintf(stderr, "kernel_launch: hipFuncSetAttribute failed\n"); grid = -1; return; }
        if (hipOccupancyMaxActiveBlocksPerMultiprocessor(&per_cu, (const void*)fwd_megakernel, NWAVES * 64, LDS_BYTES) != hipSuccess || per_cu < 1) per_cu = 1;
        (void)hipGetLastError();
        grid = cus * per_cu;
        fprintf(stderr, "kernel_launch: grid %d (cus %d x %d)\n", grid, cus, per_cu);
    }
    if (grid < 0) return;
    Args a{};
    for (int i = 0; i < 21; ++i) a.in[i] = (const float*)d_in[i];
    a.out = (float*)d_out; a.ws = (unsigned char*)d_ws;
#ifdef PROBE_SKIP
    a.skip = PROBE_SKIP;
#else
    a.skip = 0;
#endif
    a.pad = 0;
    if (hipMemsetAsync(d_ws, 0, 65536, stream) != hipSuccess) { fprintf(stderr, "kernel_launch: hipMemsetAsync failed\n"); return; }
    void* args[] = {&a};
    const hipError_t e = hipLaunchCooperativeKernel((const void*)fwd_megakernel, dim3(grid), dim3(NWAVES * 64), args, LDS_BYTES, stream);
    if (e != hipSuccess) fprintf(stderr, "kernel_launch: cooperative launch failed: %s (grid %d)\n", hipGetErrorString(e), grid);
}
```

```cpp
#include <hip/hip_runtime.h>
#include <hip/hip_cooperative_groups.h>
#include <cstdio>
#include <cstdint>
namespace cg = cooperative_groups;
namespace pg8 {
#define PG8_LAS __attribute__((address_space(3)))
typedef unsigned short bf16_t;
typedef short bf16x8 __attribute__((ext_vector_type(8)));
typedef float f32x4 __attribute__((ext_vector_type(4)));
typedef unsigned u32x4 __attribute__((ext_vector_type(4)));
constexpr int BM = 256, BK = 64, HALF = 128, HTB = HALF * BK * 2  , STAGE_BYTES = 8 * HTB, NXCD = 8, WGM = 8;

__host__ __device__ __forceinline__ int lds_byte(int r, int c) { const int st = (r >> 4) * 2 + (c >> 5), rr = r & 15, cc = c & 31, ob = rr * 64 + cc * 2; return st * 1024 + (ob ^ (((ob >> 9) & 1) << 5)); }
__host__ __device__ __forceinline__ void stage_rc(int b, int& R, int& C) { const int st = b / 1024, sb = b % 1024, swz = sb ^ (((sb >> 9) & 1) << 5); R = (st >> 1) * 16 + swz / 64; C = (st & 1) * 32 + (swz % 64) / 2; }
__host__ __device__ __forceinline__ int perm32(int rho) { const int n = rho >> 4, i = rho & 15; return 8 * (i >> 2) + 4 * n + (i & 3); }

struct Unit { int pm, pn; };
struct Gemm { const bf16_t* A; const bf16_t* Bt; int M, N, K; };

struct StaticOrder {
    int nM, nN, nwg, G, c;
    __host__ __device__ void init(int M, int N, int G_, int c_) { nM = M / BM; nN = N / BM; nwg = nM * nN; G = G_; c = c_; }
    __host__ __device__ bool next(int i, Unit& u) const {
        const long L = (long)i * G + c; if (L >= nwg) return false;
        int wgid = (int)L; { const int q = nwg / NXCD, r = nwg % NXCD, xcd = wgid % NXCD, off = wgid / NXCD; wgid = (xcd < r ? xcd * (q + 1) : r * (q + 1) + (xcd - r) * q) + off; }
        const int nig = WGM * nN, gid = wgid / nig, fm = gid * WGM, gsz = (nM - fm) < WGM ? (nM - fm) : WGM;
        u.pm = fm + ((wgid % nig) % gsz); u.pn = (wgid % nig) / gsz; return true;
    }
    __device__ __forceinline__ void a_ready(const Unit&) const {}
    __device__ __forceinline__ void done(const Unit&) const {}
};

__device__ __forceinline__ unsigned cvt_pk_bf16(float lo, float hi) { unsigned r; asm volatile("v_cvt_pk_bf16_f32 %0, %1, %2" : "=v"(r) : "v"(lo), "v"(hi)); return r; }
typedef float f32x2 __attribute__((ext_vector_type(2)));
__device__ __forceinline__ float bf2f(unsigned short h) { return __uint_as_float(((unsigned)h) << 16); }
__device__ __forceinline__ float sigmoidf_(float x) { return 1.0f / (1.0f + __expf(-x)); }
struct EpiPlain {
    static constexpr bool PERM = true, AFTER_DRAIN = false;
    bf16_t* O; int ldc; int scale_cols; float scale;
    __device__ __forceinline__ void operator()(const f32x4 (&acc)[2][2][4][2], const Unit& u, int wr, int wc, int fr, int fq) const {
        const int row0 = u.pm * BM + wr * 64 + fr, col0 = u.pn * BM + wc * 32 + 8 * fq;
        const float sc = (u.pn * BM < scale_cols) ? scale : 1.f;
#pragma unroll
        for (int ai = 0; ai < 2; ++ai)
#pragma unroll
            for (int m = 0; m < 4; ++m) { bf16_t* rowp = O + (size_t)(row0 + ai * HALF + m * 16) * ldc + col0;
#pragma unroll
                for (int bj = 0; bj < 2; ++bj) { f32x4 v0 = acc[ai][bj][m][0] * sc, v1 = acc[ai][bj][m][1] * sc;
                    u32x4 w; w.x = cvt_pk_bf16(v0[0], v0[1]); w.y = cvt_pk_bf16(v0[2], v0[3]); w.z = cvt_pk_bf16(v1[0], v1[1]); w.w = cvt_pk_bf16(v1[2], v1[3]);
                    *(u32x4*)(rowp + bj * HALF) = w; } }
    }
};
struct EpiMl {
    static constexpr bool PERM = true, AFTER_DRAIN = false;
    bf16_t* O; float* gates; const float* bias;
    __device__ __forceinline__ void operator()(const f32x4 (&acc)[2][2][4][2], const Unit& u, int wr, int wc, int fr, int fq) const {
        const int row0 = u.pm * BM + wr * 64 + fr;
        if (u.pn < 12) {
            const int col0 = u.pn * BM + wc * 32 + 8 * fq; const float sc = (u.pn < 2) ? 0.125f : 1.f;
#pragma unroll
            for (int ai = 0; ai < 2; ++ai)
#pragma unroll
                for (int m = 0; m < 4; ++m) { bf16_t* rowp = O + (size_t)(row0 + ai * HALF + m * 16) * 3072 + col0;
#pragma unroll
                    for (int bj = 0; bj < 2; ++bj) { f32x4 v0 = acc[ai][bj][m][0] * sc, v1 = acc[ai][bj][m][1] * sc;
                        u32x4 w; w.x = cvt_pk_bf16(v0[0], v0[1]); w.y = cvt_pk_bf16(v0[2], v0[3]); w.z = cvt_pk_bf16(v1[0], v1[1]); w.w = cvt_pk_bf16(v1[2], v1[3]);
                        *(u32x4*)(rowp + bj * HALF) = w; } }
        } else if (wc == 0) {
            const f32x4 b0 = *(const f32x4*)(bias + 8 * fq), b1 = *(const f32x4*)(bias + 8 * fq + 4);
#pragma unroll
            for (int ai = 0; ai < 2; ++ai)
#pragma unroll
                for (int m = 0; m < 4; ++m) { float* gp = gates + (size_t)(row0 + ai * HALF + m * 16) * 32 + 8 * fq;
                    *(f32x4*)gp = acc[ai][0][m][0] + b0; *(f32x4*)(gp + 4) = acc[ai][0][m][1] + b1; }
        }
    }
};
struct EpiFf1 {
    static constexpr bool PERM = true, AFTER_DRAIN = false;
    bf16_t* H; bf16_t* PP;
    __device__ __forceinline__ void operator()(const f32x4 (&acc)[2][2][4][2], const Unit& u, int wr, int wc, int fr, int fq) const {
        const int row0 = u.pm * BM + wr * 64 + fr;
        if (u.pn < 16) {
            const int col0 = u.pn * BM + wc * 32 + 8 * fq;
#pragma unroll
            for (int ai = 0; ai < 2; ++ai)
#pragma unroll
                for (int m = 0; m < 4; ++m) { bf16_t* rowp = H + (size_t)(row0 + ai * HALF + m * 16) * 4096 + col0;
#pragma unroll
                    for (int bj = 0; bj < 2; ++bj) { f32x4 v0 = acc[ai][bj][m][0], v1 = acc[ai][bj][m][1];
#pragma unroll
                        for (int e = 0; e < 4; ++e) { const float a = fmaxf(v0[e], 0.f), b = fmaxf(v1[e], 0.f); v0[e] = a * a; v1[e] = b * b; }
                        u32x4 w; w.x = cvt_pk_bf16(v0[0], v0[1]); w.y = cvt_pk_bf16(v0[2], v0[3]); w.z = cvt_pk_bf16(v1[0], v1[1]); w.w = cvt_pk_bf16(v1[2], v1[3]);
                        *(u32x4*)(rowp + bj * HALF) = w; } }
        } else {
            const int col0 = (u.pn - 16) * BM + wc * 32 + 8 * fq;
#pragma unroll
            for (int ai = 0; ai < 2; ++ai)
#pragma unroll
                for (int m = 0; m < 4; ++m) { bf16_t* rowp = PP + (size_t)(row0 + ai * HALF + m * 16) * 1024 + col0;
#pragma unroll
                    for (int bj = 0; bj < 2; ++bj) { f32x4 v0 = acc[ai][bj][m][0], v1 = acc[ai][bj][m][1];
                        const u32x4 pp = *(const u32x4*)(rowp + bj * HALF);
                        const unsigned pw[4] = {pp.x, pp.y, pp.z, pp.w};
#pragma unroll
                        for (int e = 0; e < 2; ++e) {
                            v0[2 * e]     = sigmoidf_(v0[2 * e])     * __uint_as_float(pw[e] << 16);
                            v0[2 * e + 1] = sigmoidf_(v0[2 * e + 1]) * __uint_as_float(pw[e] & 0xffff0000u);
                            v1[2 * e]     = sigmoidf_(v1[2 * e])     * __uint_as_float(pw[2 + e] << 16);
                            v1[2 * e + 1] = sigmoidf_(v1[2 * e + 1]) * __uint_as_float(pw[2 + e] & 0xffff0000u); }
                        u32x4 w; w.x = cvt_pk_bf16(v0[0], v0[1]); w.y = cvt_pk_bf16(v0[2], v0[3]); w.z = cvt_pk_bf16(v1[0], v1[1]); w.w = cvt_pk_bf16(v1[2], v1[3]);
                        *(u32x4*)(rowp + bj * HALF) = w; } }
        }
    }
};
struct EpiResidBf {
    static constexpr bool PERM = true, AFTER_DRAIN = false;
    bf16_t* X; const bf16_t* ple; float alpha;
    __device__ __forceinline__ void operator()(const f32x4 (&acc)[2][2][4][2], const Unit& u, int wr, int wc, int fr, int fq) const {
        const int row0 = u.pm * BM + wr * 64 + fr, col0 = u.pn * BM + wc * 32 + 8 * fq;
#pragma unroll
        for (int ai = 0; ai < 2; ++ai)
#pragma unroll
            for (int m = 0; m < 4; ++m) { const size_t off = (size_t)(row0 + ai * HALF + m * 16) * 1024 + col0;
#pragma unroll
                for (int bj = 0; bj < 2; ++bj) { f32x4 v0 = acc[ai][bj][m][0], v1 = acc[ai][bj][m][1];
                    const u32x4 r = *(const u32x4*)(X + off + bj * HALF);
                    v0[0] += alpha * __uint_as_float(r.x << 16); v0[1] += alpha * __uint_as_float(r.x & 0xffff0000u); v0[2] += alpha * __uint_as_float(r.y << 16); v0[3] += alpha * __uint_as_float(r.y & 0xffff0000u);
                    v1[0] += alpha * __uint_as_float(r.z << 16); v1[1] += alpha * __uint_as_float(r.z & 0xffff0000u); v1[2] += alpha * __uint_as_float(r.w << 16); v1[3] += alpha * __uint_as_float(r.w & 0xffff0000u);
                    if (ple) { const u32x4 p = *(const u32x4*)(ple + off + bj * HALF);
                        v0[0] += __uint_as_float(p.x << 16); v0[1] += __uint_as_float(p.x & 0xffff0000u); v0[2] += __uint_as_float(p.y << 16); v0[3] += __uint_as_float(p.y & 0xffff0000u);
                        v1[0] += __uint_as_float(p.z << 16); v1[1] += __uint_as_float(p.z & 0xffff0000u); v1[2] += __uint_as_float(p.w << 16); v1[3] += __uint_as_float(p.w & 0xffff0000u); }
                    u32x4 w; w.x = cvt_pk_bf16(v0[0], v0[1]); w.y = cvt_pk_bf16(v0[2], v0[3]); w.z = cvt_pk_bf16(v1[0], v1[1]); w.w = cvt_pk_bf16(v1[2], v1[3]);
                    *(u32x4*)(X + off + bj * HALF) = w; } }
    }
};
template <class Epi, class Sched, bool ALIGN_EPI = false, bool SP2 = false>
__device__ __forceinline__ void gemm_phase(PG8_LAS unsigned char* lds, const Gemm g, const Sched& S, const Epi& E) {
    const int tid = threadIdx.x, wid = __builtin_amdgcn_readfirstlane(tid >> 6), lane = tid & 63, wr = wid >> 2, wc = wid & 3, fr = lane & 15, fq = lane >> 4;
    const int K = g.K, nt = K / BK;
    unsigned voffA[2], voffB[2];
#pragma unroll
    for (int i = 0; i < 2; ++i) { int R, C; stage_rc(tid * 16 + i * 8192, R, C); const int Rb = Epi::PERM ? ((R & ~31) + perm32(R & 31)) : R;
        voffA[i] = (unsigned)(R * K + C) * 2u; voffB[i] = (unsigned)(Rb * K + C) * 2u; }
    const size_t kstep = (size_t)(BK * 2);
    const size_t hstep = (size_t)HALF * K * 2;
    const size_t tstep = 2 * hstep;
    const unsigned ldsw = (unsigned)wid * 1024u;
    const int aoff = lds_byte(wr * 64 + fr, fq * 8), boff = lds_byte(wc * 32 + fr, fq * 8);
#define PG8_SA(b, h) (((b) * 2 + (h)) * HTB)
#define PG8_SB(b, h) ((4 + (b) * 2 + (h)) * HTB)
#define PG8_STAGE(bufoff, gbase, voff) do { _Pragma("unroll") for (int _i = 0; _i < 2; ++_i) \
        __builtin_amdgcn_global_load_lds((const unsigned*)((const char*)(gbase) + (voff)[_i]), (PG8_LAS unsigned*)(lds + (bufoff) + ldsw + _i * 8192), 16, 0, 0); } while (0)
#define PG8_LDA(dst, b, h) do { _Pragma("unroll") for (int m = 0; m < 4; ++m) _Pragma("unroll") for (int k = 0; k < 2; ++k) dst[m][k] = *(const PG8_LAS bf16x8*)(lds + PG8_SA(b, h) + aoff + m * 2048 + k * 1024); } while (0)
#define PG8_LDB(dst, b, h) do { _Pragma("unroll") for (int n = 0; n < 2; ++n) _Pragma("unroll") for (int k = 0; k < 2; ++k) dst[n][k] = *(const PG8_LAS bf16x8*)(lds + PG8_SB(b, h) + boff + n * 2048 + k * 1024); } while (0)
#define PG8_MMA(ai, bj, At, Bt) do { __builtin_amdgcn_s_setprio(1); _Pragma("unroll") for (int m = 0; m < 4; ++m) _Pragma("unroll") for (int n = 0; n < 2; ++n) _Pragma("unroll") for (int k = 0; k < 2; ++k) \
        acc[ai][bj][m][n] = __builtin_amdgcn_mfma_f32_16x16x32_bf16(Bt[n][k], At[m][k], acc[ai][bj][m][n], 0, 0, 0); __builtin_amdgcn_s_setprio(0); } while (0)
#define PG8_WAIT_V(n) asm volatile("s_waitcnt vmcnt(" #n ")" ::: "memory")
#define PG8_WAIT_L(n) asm volatile("s_waitcnt lgkmcnt(" #n ")" ::: "memory")
#define PG8_BAR __builtin_amdgcn_s_barrier()
#define PG8_SCHED __builtin_amdgcn_sched_barrier(0)
    Unit cur, nxt; int ui = 0;
    if (!S.next(0, cur)) return;
    f32x4 acc[2][2][4][2];
#pragma unroll
    for (int a = 0; a < 2; ++a)
#pragma unroll
        for (int b = 0; b < 2; ++b)
#pragma unroll
            for (int m = 0; m < 4; ++m)
#pragma unroll
                for (int n = 0; n < 2; ++n) acc[a][b][m][n] = (f32x4){0.f, 0.f, 0.f, 0.f};
    bf16x8 At[4][2], B0[2][2], B1[2][2];
    const char* cA = (const char*)g.A + (size_t)cur.pm * tstep; const char* cB = (const char*)g.Bt + (size_t)cur.pn * tstep;
    S.a_ready(cur);
    if constexpr (SP2) {
        PG8_STAGE(PG8_SB(0, 0), cB, voffB); PG8_STAGE(PG8_SB(0, 1), cB + hstep, voffB); PG8_STAGE(PG8_SA(0, 0), cA, voffA); PG8_STAGE(PG8_SA(0, 1), cA + hstep, voffA);
        if (wr == 1) PG8_BAR;
        PG8_WAIT_V(2); PG8_BAR;
        PG8_STAGE(PG8_SB(1, 0), cB + kstep, voffB); PG8_STAGE(PG8_SA(1, 0), cA + kstep, voffA); PG8_STAGE(PG8_SB(1, 1), cB + hstep + kstep, voffB);
        PG8_WAIT_V(6); PG8_BAR;
    } else {
        PG8_STAGE(PG8_SB(0, 0), cB, voffB); PG8_STAGE(PG8_SA(0, 0), cA, voffA); PG8_STAGE(PG8_SB(0, 1), cB + hstep, voffB); PG8_STAGE(PG8_SA(0, 1), cA + hstep, voffA);
        if (wr == 1) PG8_BAR;
        PG8_WAIT_V(4); PG8_BAR;
        PG8_STAGE(PG8_SB(1, 0), cB + kstep, voffB); PG8_STAGE(PG8_SA(1, 0), cA + kstep, voffA); PG8_STAGE(PG8_SB(1, 1), cB + hstep + kstep, voffB);
        PG8_WAIT_V(6); PG8_BAR;
    }
    for (;;) {
        const bool has_next = S.next(ui + 1, nxt);
        const char* nA = has_next ? (const char*)g.A + (size_t)nxt.pm * tstep : cA; const char* nB = has_next ? (const char*)g.Bt + (size_t)nxt.pn * tstep : cB;
        for (int t = 0; t < nt; t += 2) {
            const bool last = (t == nt - 2);
            const char* a1 = cA + (size_t)(t + 1) * kstep;
            const char* a2 = last ? nA : cA + (size_t)(t + 2) * kstep; const char* b2 = last ? nB : cB + (size_t)(t + 2) * kstep;
            const char* a3 = a2 + kstep; const char* b3 = b2 + kstep;
            if (last && has_next) S.a_ready(nxt);
            if constexpr (SP2) {
            PG8_LDB(B0, 0, 0); PG8_LDB(B1, 0, 1); PG8_SCHED; PG8_LDA(At, 0, 0); PG8_STAGE(PG8_SA(1, 1), a1 + hstep, voffA);
            PG8_WAIT_V(8); PG8_WAIT_L(0); PG8_BAR; PG8_MMA(0, 0, At, B0); PG8_MMA(0, 1, At, B1); PG8_BAR; PG8_SCHED;
            PG8_LDA(At, 0, 1); PG8_STAGE(PG8_SB(0, 0), b2, voffB); PG8_STAGE(PG8_SB(0, 1), b2 + hstep, voffB); PG8_STAGE(PG8_SA(0, 0), a2, voffA);
            PG8_WAIT_V(8); PG8_WAIT_L(0); PG8_BAR; PG8_MMA(1, 0, At, B0); PG8_MMA(1, 1, At, B1); PG8_BAR; PG8_SCHED;
            PG8_LDB(B0, 1, 0); PG8_LDB(B1, 1, 1); PG8_SCHED; PG8_LDA(At, 1, 0); PG8_STAGE(PG8_SA(0, 1), a2 + hstep, voffA);
            PG8_WAIT_V(8); PG8_WAIT_L(0); PG8_BAR; PG8_MMA(0, 0, At, B0); PG8_MMA(0, 1, At, B1); PG8_BAR; PG8_SCHED;
            PG8_LDA(At, 1, 1); PG8_STAGE(PG8_SB(1, 0), b3, voffB); PG8_STAGE(PG8_SB(1, 1), b3 + hstep, voffB); PG8_STAGE(PG8_SA(1, 0), a3, voffA);
            PG8_WAIT_V(8); PG8_WAIT_L(0); PG8_BAR; PG8_MMA(1, 0, At, B0); PG8_MMA(1, 1, At, B1); PG8_BAR; PG8_SCHED;
            } else {
            PG8_LDB(B0, 0, 0); PG8_SCHED; PG8_LDA(At, 0, 0); PG8_STAGE(PG8_SA(1, 1), a1 + hstep, voffA);
            PG8_WAIT_L(8); PG8_BAR; PG8_WAIT_L(0); PG8_MMA(0, 0, At, B0); PG8_BAR; PG8_SCHED;
            PG8_LDB(B1, 0, 1); PG8_STAGE(PG8_SB(0, 0), b2, voffB);
            PG8_BAR; PG8_WAIT_L(0); PG8_MMA(0, 1, At, B1); PG8_BAR;
            PG8_LDA(At, 0, 1); PG8_STAGE(PG8_SA(0, 0), a2, voffA);
            PG8_BAR; PG8_WAIT_L(0); PG8_MMA(1, 0, At, B0); PG8_BAR; PG8_SCHED;
            PG8_STAGE(PG8_SB(0, 1), b2 + hstep, voffB);
            PG8_WAIT_V(6); PG8_BAR; PG8_MMA(1, 1, At, B1); PG8_BAR;
            PG8_LDB(B0, 1, 0); PG8_SCHED; PG8_LDA(At, 1, 0); PG8_STAGE(PG8_SA(0, 1), a2 + hstep, voffA);
            PG8_WAIT_L(8); PG8_BAR; PG8_WAIT_L(0); PG8_MMA(0, 0, At, B0); PG8_BAR; PG8_SCHED;
            PG8_LDB(B1, 1, 1); PG8_STAGE(PG8_SB(1, 0), b3, voffB);
            PG8_BAR; PG8_WAIT_L(0); PG8_MMA(0, 1, At, B1); PG8_BAR;
            PG8_LDA(At, 1, 1); PG8_STAGE(PG8_SA(1, 0), a3, voffA);
            PG8_BAR; PG8_WAIT_L(0); PG8_MMA(1, 0, At, B0); PG8_BAR; PG8_SCHED;
            PG8_STAGE(PG8_SB(1, 1), b3 + hstep, voffB);
            PG8_WAIT_V(6); PG8_BAR; PG8_MMA(1, 1, At, B1); PG8_BAR;
            }
        }
        if constexpr (ALIGN_EPI) { if (wr == 0) PG8_BAR; }
        if constexpr (!Epi::AFTER_DRAIN) { E(acc, cur, wr, wc, fr, fq); S.done(cur); }
        if (!has_next) break;
#pragma unroll
        for (int a = 0; a < 2; ++a)
#pragma unroll
            for (int b = 0; b < 2; ++b)
#pragma unroll
                for (int m = 0; m < 4; ++m)
#pragma unroll
                    for (int n = 0; n < 2; ++n) acc[a][b][m][n] = (f32x4){0.f, 0.f, 0.f, 0.f};
        cur = nxt; cA = nA; cB = nB; ++ui;
        if constexpr (ALIGN_EPI) { if (wr == 1) PG8_BAR; }
    }
    PG8_WAIT_V(0);
    if constexpr (!ALIGN_EPI) { if (wr == 0) PG8_BAR; }
    PG8_BAR;
    if constexpr (Epi::AFTER_DRAIN) { E.fused(acc, cur, wr, wc, fr, fq, lds, wid, lane); S.done(cur); }
#undef PG8_SA
#undef PG8_SB
#undef PG8_STAGE
#undef PG8_LDA
#undef PG8_LDB
#undef PG8_MMA
#undef PG8_WAIT_V
#undef PG8_WAIT_L
#undef PG8_BAR
#undef PG8_SCHED
}
}
#include <hip/hip_bf16.h>
#include <cmath>
namespace attn_body {
using bf16=__hip_bfloat16;
using bf16x8=__attribute__((ext_vector_type(8)))short;
using s16x4=__attribute__((ext_vector_type(4)))short;
using f32x16=__attribute__((ext_vector_type(16)))float;
using u32x4=__attribute__((ext_vector_type(4)))unsigned;
constexpr int BATCH=32,NHEAD=16,SEQ=2048,D=64,DM=1536,OP=1024;
constexpr int NW=8,QBLK=32,QB=QBLK*NW,KVBLK=64,NQB=SEQ/QB;
constexpr int ATTN_PITCH=DM, ATTN_UNIT_ROWS=QB;
__device__ __forceinline__ int crow(int r,int hi){return (r&3)+8*(r>>2)+4*hi;}
#define SBAR() __builtin_amdgcn_sched_barrier(0)
__device__ __forceinline__ void cmask(f32x16&p0,f32x16&p1,int jb,int qrel,int hi){
  const float NEG=-INFINITY; int kb=64*jb+4*hi;
  #pragma unroll
  for(int r=0;r<16;++r){int kv=kb+(r&3)+8*(r>>2); if(kv>qrel)p0[r]=NEG; if(kv+32>qrel)p1[r]=NEG;}
}

constexpr int NSLOT=3, SLOTB=8192;
constexpr int LDS_K=0, LDS_V=NSLOT*SLOTB, LDS_WS=2*NSLOT*SLOTB, LDS_OST=LDS_WS+NW*64*4, LDS_BYTES=LDS_OST+NW*4096;
constexpr float C2=0.125f*1.4426950408889634f;
__device__ __forceinline__ void glds16(const void*gsrc,unsigned lds_dst){unsigned keep;
  asm volatile("s_mov_b32 %0, m0\n\ts_mov_b32 m0, %2\n\ts_nop 0\n\tglobal_load_lds_dwordx4 %1, off\n\ts_mov_b32 m0, %0":"=&s"(keep):"v"(gsrc),"s"(lds_dst):"memory");}
__device__ __forceinline__ float max3f(float a,float b,float c){float r;asm("v_max3_f32 %0, %1, %2, %3":"=v"(r):"v"(a),"v"(b),"v"(c));return r;}
__device__ __forceinline__ float max2f(float a,float b){float r;asm("v_max_f32_e32 %0, %1, %2":"=v"(r):"v"(a),"v"(b));return r;}
__device__ __forceinline__ float fadd_s(float a,float b){float r;asm("v_add_f32_e32 %0, %1, %2":"=v"(r):"v"(a),"v"(b));return r;}
__device__ __forceinline__ float fsub_s(float a,float b){float r;asm("v_sub_f32_e32 %0, %1, %2":"=v"(r):"v"(a),"v"(b));return r;}
typedef float f32x2_t __attribute__((ext_vector_type(2))); typedef __bf16 bf16x2_t __attribute__((ext_vector_type(2)));
__device__ __forceinline__ unsigned cvtpk_s(float lo,float hi){f32x2_t v={lo,hi};bf16x2_t b=__builtin_convertvector(v,bf16x2_t);return __builtin_bit_cast(unsigned,b);}
#define WAIT_BAR(N) asm volatile("s_waitcnt vmcnt(" #N ") lgkmcnt(0)\n\ts_barrier":::"memory")

__device__ __forceinline__ void qkt(f32x16&p0,f32x16&p1,const char*Kslot,const bf16x8*qr,const f32x16&negm,int r32,int hi){
  const char*kb=Kslot+hi*1024+r32*16;
  #pragma unroll
  for(int d0=0;d0<4;++d0){
    const bf16x8 b0=*reinterpret_cast<const bf16x8*>(kb+d0*2048);
    const bf16x8 b1=*reinterpret_cast<const bf16x8*>(kb+d0*2048+512);
    if(d0==0){p0=__builtin_amdgcn_mfma_f32_32x32x16_bf16(b0,qr[0],negm,0,0,0);p1=__builtin_amdgcn_mfma_f32_32x32x16_bf16(b1,qr[0],negm,0,0,0);}
    else{p0=__builtin_amdgcn_mfma_f32_32x32x16_bf16(b0,qr[d0],p0,0,0,0);p1=__builtin_amdgcn_mfma_f32_32x32x16_bf16(b1,qr[d0],p1,0,0,0);}}
}
typedef __attribute__((address_space(3))) const char* lds_cptr;
typedef short v4i16_t __attribute__((ext_vector_type(4)));
__device__ __forceinline__ void kload8(bf16x8*kf,lds_cptr kp){
  kf[0]=*(const __attribute__((address_space(3))) bf16x8*)(kp);      kf[1]=*(const __attribute__((address_space(3))) bf16x8*)(kp+512);
  kf[2]=*(const __attribute__((address_space(3))) bf16x8*)(kp+2048); kf[3]=*(const __attribute__((address_space(3))) bf16x8*)(kp+2560);
  kf[4]=*(const __attribute__((address_space(3))) bf16x8*)(kp+4096); kf[5]=*(const __attribute__((address_space(3))) bf16x8*)(kp+4608);
  kf[6]=*(const __attribute__((address_space(3))) bf16x8*)(kp+6144); kf[7]=*(const __attribute__((address_space(3))) bf16x8*)(kp+6656);
}
__device__ __forceinline__ void kload2(bf16x8*kf,lds_cptr kp,int j){ kf[2*j]=*(const __attribute__((address_space(3))) bf16x8*)(kp+j*2048); kf[2*j+1]=*(const __attribute__((address_space(3))) bf16x8*)(kp+j*2048+512); }
__device__ __forceinline__ s16x4 vtr(lds_cptr p){ return __builtin_bit_cast(s16x4,__builtin_amdgcn_ds_read_tr16_b64_v4i16((__attribute__((address_space(3))) v4i16_t*)p)); }
__device__ __forceinline__ float rowmax(const f32x16&p0,const f32x16&p1){
  float a=max3f(p0[0],p0[1],p1[0]),b=max3f(p0[2],p0[3],p1[1]);a=max3f(a,p1[2],p1[3]);
  #pragma unroll
  for(int r=4;r<16;r+=4){a=max3f(a,p0[r],p0[r+1]);b=max3f(b,p0[r+2],p0[r+3]);a=max3f(a,p1[r],p1[r+1]);b=max3f(b,p1[r+2],p1[r+3]);}
  const float m=max2f(a,b);
  auto rr=__builtin_amdgcn_permlane32_swap(__float_as_uint(m),__float_as_uint(m),false,false);
  return max2f(__uint_as_float(rr[0]),__uint_as_float(rr[1]));
}
__device__ __forceinline__ void pv(f32x16*o,int vb,bf16x8 pa0,bf16x8 pa1,bf16x8 pa2,bf16x8 pa3){
  #pragma unroll
  for(int d0=0;d0<2;++d0){s16x4 lo[4],hi[4];
    #pragma unroll
    for(int ks=0;ks<4;++ks){
      asm volatile("ds_read_b64_tr_b16 %0,%1 offset:%c2":"=&v"(lo[ks]):"v"(vb),"i"(d0*4096+ks*1024):"memory");
      asm volatile("ds_read_b64_tr_b16 %0,%1 offset:%c2":"=&v"(hi[ks]):"v"(vb),"i"(d0*4096+ks*1024+512):"memory");}
    asm volatile("s_waitcnt lgkmcnt(0)":::"memory");SBAR();
    #define PK(k) (bf16x8){lo[k][0],lo[k][1],lo[k][2],lo[k][3],hi[k][0],hi[k][1],hi[k][2],hi[k][3]}
    o[d0]=__builtin_amdgcn_mfma_f32_32x32x16_bf16(pa0,PK(0),o[d0],0,0,0);
    o[d0]=__builtin_amdgcn_mfma_f32_32x32x16_bf16(pa1,PK(1),o[d0],0,0,0);
    o[d0]=__builtin_amdgcn_mfma_f32_32x32x16_bf16(pa2,PK(2),o[d0],0,0,0);
    o[d0]=__builtin_amdgcn_mfma_f32_32x32x16_bf16(pa3,PK(3),o[d0],0,0,0);
    #undef PK
  }
}

#ifndef ATTN_STORE16
#define ATTN_STORE16(p,v) (*(u32x4*)(p)=(v))
#endif
template<int THRL> __device__ __forceinline__ void attn_unit(int b,int h,int qb,const bf16*Q,const bf16*__restrict__ K,const bf16*__restrict__ V,bf16*O,char*shm){
  const int tid=threadIdx.x,lane=tid&63,r32=lane&31,hi=lane>>5; const int wid=__builtin_amdgcn_readfirstlane(tid>>6);
  const long rowbase=(long)b*SEQ; const int q0=qb*QB;
  const bf16*Qw=Q+(rowbase+q0+wid*QBLK)*DM+h*D;
  const bf16*Kh=K+rowbase*DM+(h>>2)*D,*Vh=V+rowbase*DM+(h>>2)*D;
  const unsigned lds0=(unsigned)(uintptr_t)shm;
  float*wsf=(float*)(shm+LDS_WS)+wid*64;
  const bf16*ksrc=Kh+(long)lane*DM+wid*8;
  const bf16*vsrc=Vh+(long)(16*(wid&3)+(lane>>2))*DM+(wid>>2)*32+(lane&3)*8;
  const unsigned kdst=lds0+LDS_K+wid*1024, vdst=lds0+LDS_V+wid*1024;
  #define DMA_K(t,slot) glds16(ksrc+(long)(t)*KVBLK*DM,(unsigned)__builtin_amdgcn_readfirstlane(kdst+(slot)))
  #define DMA_V(t,slot) glds16(vsrc+(long)(t)*KVBLK*DM,(unsigned)__builtin_amdgcn_readfirstlane(vdst+(slot)))
  const int vb0=(int)(lds0+LDS_V)+((lane>>4)&1)*32+(lane&3)*8+(4*hi+((lane&15)>>2))*64;
  const char*Kbase=shm+LDS_K; bf16x8 kf[8];
  const lds_cptr shm3=(lds_cptr)shm; const lds_cptr kp0=shm3+LDS_K+hi*1024+r32*16; const lds_cptr vp0=shm3+LDS_V+((lane>>4)&1)*32+(lane&3)*8+(4*hi+((lane&15)>>2))*64;
  const int NT=SEQ/KVBLK;
  DMA_K(0,0);DMA_V(0,0);DMA_K(1,SLOTB);
  bf16x8 qr[4];
  #pragma unroll
  for(int d0=0;d0<4;++d0)qr[d0]=*reinterpret_cast<const bf16x8*>(&Qw[(long)r32*DM+d0*16+hi*8]);
  float mhat=0.f,l_reg=0.f;f32x16 o[2];o[0]=f32x16{};o[1]=f32x16{};f32x16 negm=f32x16{};asm volatile("":"+v"(negm));

  #define CMASK(P0,P1,t) do{}while(0)
  bool resc=false;
  #define START(P0,P1) do{ const float rm=rowmax(P0,P1); resc=false; \
    { const float dl=rm; mhat=fadd_s(mhat,dl); \
      _Pragma("unroll") for(int r=0;r<16;++r){P0[r]=fsub_s(P0[r],dl);P1[r]=fsub_s(P1[r],dl);} \
      _Pragma("unroll") for(int r=0;r<16;++r)negm[r]=-mhat; asm volatile("":"+v"(negm)); } \
    _Pragma("unroll") for(int r=0;r<16;++r)P0[r]=__builtin_amdgcn_exp2f(P0[r]); }while(0)
  #define RESC() do{ if(resc){ asm volatile("s_waitcnt lgkmcnt(0)":::"memory"); \
      _Pragma("unroll") for(int d_=0;d_<2;++d_) _Pragma("unroll") for(int r=0;r<16;++r)o[d_][r]*=wsf[crow(r,hi)]; } }while(0)
  f32x16 pA0,pA1,pB0,pB1;
  int sl_prev=0,sl_cur=0,sl_next=SLOTB;
  #define ROT() do{sl_prev=sl_cur;sl_cur=sl_next;sl_next=(sl_next==(NSLOT-1)*SLOTB)?0:sl_next+SLOTB;}while(0)
  DMA_K(2,2*SLOTB);
  WAIT_BAR(3);
  qkt(pA0,pA1,Kbase,qr,negm,r32,hi);asm volatile("s_nop 15\n\ts_nop 7":"+v"(pA0),"+v"(pA1));CMASK(pA0,pA1,0);
  START(pA0,pA1);
  _Pragma("unroll") for(int r=0;r<16;++r)pA1[r]=__builtin_amdgcn_exp2f(pA1[r]);
  WAIT_BAR(0);
  DMA_K(3,0);DMA_V(1,SLOTB);
  ROT();
  kload8(kf,kp0+sl_cur);
  WAIT_BAR(2);
  s16x4 vlo[8],vhi[8]; u32x4 pw0,pw1,pw2,pw3;
  #define PKW(P,B) cvtpk_s(P[B],P[B+1])
  #define PAF(k) __builtin_bit_cast(bf16x8,pw##k)
  #define VFR(i) (bf16x8){vlo[i][0],vlo[i][1],vlo[i][2],vlo[i][3],vhi[i][0],vhi[i][1],vhi[i][2],vhi[i][3]}
  #define PIN(x) asm volatile("":"+v"(x))
  #define MX3(a,b,c) __builtin_fmaxf(__builtin_fmaxf((a),(b)),(c))
  #define GAPA(MF,A0,A1,A2,A3,W0,W1,PW) do{ MF; sacc+=A0; sacc+=A1; sacc+=A2; sacc+=A3; PIN(sacc); W0; W1; PIN(PW); SBAR(); }while(0)
  #define EX(v) __builtin_amdgcn_exp2f(v)
  #define GAPB(MF,X,B) do{ MF; X[B]=EX(X[B]); X[B+1]=EX(X[B+1]); X[B+2]=EX(X[B+2]); X[B+3]=EX(X[B+3]); PIN(X); SBAR(); }while(0)
  #define VRD(i) do{ vlo[i]=vtr(vp_+(((i)>>2)*4096+((i)&3)*1024)); vhi[i]=vtr(vp_+(((i)>>2)*4096+((i)&3)*1024+512)); }while(0)
  #define KRD(G,j) do{ if(G){ kload2(kf,kp0+sl_next,j); SBAR(); } }while(0)
  #define STEP(C0,C1,P0,P1,t,GK,GV,GL) do{ SBAR(); \
    const lds_cptr vp_=vp0+sl_prev; \
    VRD(0); SBAR(); float sacc=(P0[0]+P0[1]); \
    GAPA(C0=__builtin_amdgcn_mfma_f32_32x32x16_bf16(kf[0],qr[0],negm,0,0,0), P0[2],P0[3],P0[4],P0[5],     pw0[0]=PKW(P0,0), pw0[1]=PKW(P0,2), pw0); \
    VRD(4); SBAR(); GAPA(C1=__builtin_amdgcn_mfma_f32_32x32x16_bf16(kf[1],qr[0],negm,0,0,0), P0[6],P0[7],P0[8],P0[9],     pw0[2]=PKW(P0,4), pw0[3]=PKW(P0,6), pw0); \
    VRD(1); SBAR(); GAPA(C0=__builtin_amdgcn_mfma_f32_32x32x16_bf16(kf[2],qr[1],C0,0,0,0),   P0[10],P0[11],P0[12],P0[13], pw1[0]=PKW(P0,8), pw1[1]=PKW(P0,10), pw1); \
    VRD(5); SBAR(); GAPA(C1=__builtin_amdgcn_mfma_f32_32x32x16_bf16(kf[3],qr[1],C1,0,0,0),   P0[14],P0[15],P1[0],P1[1],   pw1[2]=PKW(P0,12),pw1[3]=PKW(P0,14), pw1); \
    VRD(2); SBAR(); GAPA(C0=__builtin_amdgcn_mfma_f32_32x32x16_bf16(kf[4],qr[2],C0,0,0,0),   P1[2],P1[3],P1[4],P1[5],     pw2[0]=PKW(P1,0), pw2[1]=PKW(P1,2), pw2); \
    VRD(6); SBAR(); GAPA(C1=__builtin_amdgcn_mfma_f32_32x32x16_bf16(kf[5],qr[2],C1,0,0,0),   P1[6],P1[7],P1[8],P1[9],     pw2[2]=PKW(P1,4), pw2[3]=PKW(P1,6), pw2); \
    VRD(3); SBAR(); GAPA(C0=__builtin_amdgcn_mfma_f32_32x32x16_bf16(kf[6],qr[3],C0,0,0,0),   P1[10],P1[11],P1[12],P1[13], pw3[0]=PKW(P1,8), pw3[1]=PKW(P1,10), pw3); \
    VRD(7); SBAR(); GAPA(C1=__builtin_amdgcn_mfma_f32_32x32x16_bf16(kf[7],qr[3],C1,0,0,0),   P1[14],P1[15],0.f,0.f,       pw3[2]=PKW(P1,12),pw3[3]=PKW(P1,14), pw3); \
    l_reg+=sacc; \
    if(GK){DMA_K((t)+3,sl_cur);} if(GV){DMA_V((t)+1,sl_next);} \
    CMASK(C0,C1,t); \
    { float a=MX3(C0[0],C0[1],C1[0]),b=MX3(C0[2],C0[3],C1[1]); a=MX3(a,C1[2],C1[3]); \
      _Pragma("unroll") for(int r=4;r<16;r+=4){a=MX3(a,C0[r],C0[r+1]);b=MX3(b,C0[r+2],C0[r+3]);a=MX3(a,C1[r],C1[r+1]);b=MX3(b,C1[r+2],C1[r+3]);} \
      float rm=__builtin_fmaxf(a,b); { auto rr=__builtin_amdgcn_permlane32_swap(__float_as_uint(rm),__float_as_uint(rm),false,false); rm=__builtin_fmaxf(__uint_as_float(rr[0]),__uint_as_float(rr[1])); } \
      resc=false; \
      if(__builtin_expect(__any(rm>(float)THRL),0)){ const float dl=__builtin_fmaxf(rm,0.f); mhat+=dl; \
        _Pragma("unroll") for(int r=0;r<16;++r){C0[r]-=dl;C1[r]-=dl;} \
        _Pragma("unroll") for(int r=0;r<16;++r)negm[r]=-mhat; asm volatile("":"+v"(negm)); \
        const float f=__builtin_amdgcn_exp2f(-dl); l_reg*=f; if(hi==0)wsf[r32]=f; resc=true; } } \
    SBAR(); \
    GAPB(o[0]=__builtin_amdgcn_mfma_f32_32x32x16_bf16(PAF(0),VFR(0),o[0],0,0,0), C0,0); \
    GAPB(o[1]=__builtin_amdgcn_mfma_f32_32x32x16_bf16(PAF(0),VFR(4),o[1],0,0,0), C0,4); \
    KRD(GL,0); GAPB(o[0]=__builtin_amdgcn_mfma_f32_32x32x16_bf16(PAF(1),VFR(1),o[0],0,0,0), C0,8); \
    KRD(GL,1); GAPB(o[1]=__builtin_amdgcn_mfma_f32_32x32x16_bf16(PAF(1),VFR(5),o[1],0,0,0), C0,12); \
    KRD(GL,2); GAPB(o[0]=__builtin_amdgcn_mfma_f32_32x32x16_bf16(PAF(2),VFR(2),o[0],0,0,0), C1,0); \
    KRD(GL,3); GAPB(o[1]=__builtin_amdgcn_mfma_f32_32x32x16_bf16(PAF(2),VFR(6),o[1],0,0,0), C1,4); \
    GAPB(o[0]=__builtin_amdgcn_mfma_f32_32x32x16_bf16(PAF(3),VFR(3),o[0],0,0,0), C1,8); \
    GAPB(o[1]=__builtin_amdgcn_mfma_f32_32x32x16_bf16(PAF(3),VFR(7),o[1],0,0,0), C1,12); \
    }while(0)
  int t=1;
  #undef CMASK
  #define CMASK(P0,P1,t) do{}while(0)
  for(;t+5<NT;t+=2){
    STEP(pB0,pB1,pA0,pA1,t,true,true,true);     WAIT_BAR(2); RESC(); ROT();
    STEP(pA0,pA1,pB0,pB1,t+1,true,true,true);   WAIT_BAR(2); RESC(); ROT();
  }
  #undef CMASK
  #define CMASK(P0,P1,t) do{}while(0)
  #define ENDW(tt) do{ if((tt)+3<NT){WAIT_BAR(2);} else if((tt)+2<NT){WAIT_BAR(1);} else {WAIT_BAR(0);} }while(0)
  for(;t+1<NT;t+=2){
    STEP(pB0,pB1,pA0,pA1,t,(t+3<NT),(t+1<NT),(t+1<NT));       ENDW(t);   RESC(); ROT();
    STEP(pA0,pA1,pB0,pB1,t+1,(t+4<NT),(t+2<NT),(t+2<NT));     ENDW(t+1); RESC(); ROT();
  }
  STEP(pB0,pB1,pA0,pA1,NT-1,false,false,false); RESC();
  { float sacc=pB0[0]+pB0[1]; _Pragma("unroll") for(int r=2;r<16;++r)sacc+=pB0[r]; _Pragma("unroll") for(int r=0;r<16;++r)sacc+=pB1[r]; l_reg+=sacc;
    pw0=(u32x4){PKW(pB0,0),PKW(pB0,2),PKW(pB0,4),PKW(pB0,6)};pw1=(u32x4){PKW(pB0,8),PKW(pB0,10),PKW(pB0,12),PKW(pB0,14)};pw2=(u32x4){PKW(pB1,0),PKW(pB1,2),PKW(pB1,4),PKW(pB1,6)};pw3=(u32x4){PKW(pB1,8),PKW(pB1,10),PKW(pB1,12),PKW(pB1,14)};
    SBAR(); pv(o,vb0+sl_cur,PAF(0),PAF(1),PAF(2),PAF(3)); }
  #undef PKW
  #undef PAF
  #undef VFR
  #undef PIN
  #undef MX3
  #undef GAPA
  #undef GAPB
  #undef EX
  #undef VRD
  #undef KRD
  #undef STEP
  #undef ENDW
  {auto rr=__builtin_amdgcn_permlane32_swap(__float_as_uint(l_reg),__float_as_uint(l_reg),false,false);l_reg=__uint_as_float(rr[0])+__uint_as_float(rr[1]);}
  if(hi==0)wsf[32+r32]=l_reg;asm volatile("s_waitcnt lgkmcnt(0)":::"memory");
  float rli[16];
  #pragma unroll
  for(int r=0;r<16;++r)rli[r]=__builtin_amdgcn_rcpf(wsf[32+crow(r,hi)]);
  bf16*Ow=O+(rowbase+q0+wid*QBLK)*OP+h*D;
  { bf16*stg=(bf16*)(shm+LDS_OST)+wid*2048;
    #pragma unroll
    for(int r=0;r<16;++r){const int orow=crow(r,hi);
      #pragma unroll
      for(int d0=0;d0<2;++d0)stg[orow*64+d0*32+r32]=__float2bfloat16(o[d0][r]*rli[r]);}
    asm volatile("s_waitcnt lgkmcnt(0)":::"memory");
    #pragma unroll
    for(int i=0;i<4;++i){const int row=i*8+(lane>>3),ch=lane&7; const u32x4 v=*(const u32x4*)(stg+row*64+ch*8); ATTN_STORE16(Ow+(long)row*OP+ch*8,v);} }
  asm volatile("s_waitcnt lgkmcnt(0)\n\ts_barrier":::"memory");
  #undef DMA_K
  #undef DMA_V
  #undef CMASK
  #undef START
  #undef RESC
  #undef ROT
}
constexpr int ATTN_LDS_BYTES=LDS_BYTES;
struct AttnTensors { const bf16* Q; const bf16* K; const bf16* V; bf16* O; };
struct AttnUnit { int bh; int qb; };
struct StaticOrder {
  int vcu,G;
  __device__ __forceinline__ explicit StaticOrder(int grid,int block):vcu((grid%8==0)?(block%8)*(grid/8)+block/8:block),G(grid){}
  __device__ __forceinline__ bool next(int i,AttnUnit&u)const{ const int x=i*G+vcu; if(x>=BATCH*NHEAD*NQB)return false; u.bh=x>>3; u.qb=x&7; return true; }
  __device__ __forceinline__ void a_ready(const AttnUnit&)const{}
  __device__ __forceinline__ void done(const AttnUnit&)const{}
};
template<class Sched,int THRL=8> __device__ __forceinline__ void attn_phase(char*lds,const AttnTensors&T,const Sched&S){
  AttnUnit u;
  for(int i=0;S.next(i,u);++i){ S.a_ready(u); attn_unit<THRL>(u.bh/NHEAD,u.bh%NHEAD,u.qb,T.Q,T.K,T.V,T.O,lds); S.done(u); }
}
#undef SBAR
#undef WAIT_BAR
}
constexpr int NWAVES = 8;
#ifndef DEPTH_
#define DEPTH_ 4
#endif
constexpr int M = 65536, D = 1024, SEQ = 2048, NBATCH = 32, FF = 4096, DPLE = 256, DEPTH = DEPTH_;
constexpr float DN_ALPHA = 1.6817928305074290f;
constexpr float LN_EPS = 1e-6f;
constexpr size_t MiB = 1u << 20;
constexpr size_t WS_W = 2 * MiB;
constexpr size_t WS_WIN = WS_W, WS_WO = WS_W + 28 * MiB, WS_W1G = WS_W + 36 * MiB, WS_W2 = WS_W + 76 * MiB, WS_WP = WS_W + 108 * MiB;
constexpr size_t WS_XN = 114 * MiB;
constexpr size_t WS_PB = 242 * MiB;
constexpr size_t WS_GATES = 274 * MiB;
constexpr size_t WS_QKV = 282 * MiB;
constexpr size_t WS_O = 698 * MiB;
constexpr size_t WS_PP = 826 * MiB;
constexpr size_t WS_H = 282 * MiB;
constexpr size_t WS_END = 954 * MiB;
constexpr int LDS_BYTES = 163840, LDS_CTL = LDS_BYTES - 512;

#define GAS __attribute__((address_space(1)))
#define LAS __attribute__((address_space(3)))
typedef unsigned short bf16;
typedef unsigned v4u __attribute__((ext_vector_type(4)));
typedef float f32x4 __attribute__((ext_vector_type(4)));
typedef short bf16x8 __attribute__((ext_vector_type(8)));
#define LDS_WAIT() asm volatile("s_waitcnt lgkmcnt(0)" ::: "memory")
__device__ __forceinline__ unsigned f2bf(float f) { unsigned u = __builtin_bit_cast(unsigned, f); return (u + 0x7fffu + ((u >> 16) & 1u)) >> 16; }
__device__ __forceinline__ unsigned pk2(float lo, float hi) { return f2bf(lo) | (f2bf(hi) << 16); }
__device__ __forceinline__ float bf2f(unsigned short h) { return __uint_as_float(((unsigned)h) << 16); }
__device__ __forceinline__ f32x4 mfma16(bf16x8 a, bf16x8 b, f32x4 c) { return __builtin_amdgcn_mfma_f32_16x16x32_bf16(a, b, c, 0, 0, 0); }
__device__ __forceinline__ float wave_sum(float v) {
#pragma unroll
    for (int o = 1; o < 64; o <<= 1) v += __shfl_xor(v, o);
    return v;
}

struct Args { const float* in[21]; float* out; unsigned char* ws; int skip, pad; };

__device__ __forceinline__ void p0_transpose_item(const float* W, int K, int N, bf16* WT, int row_off, LAS float* scr, int item, int lane) {
    const int nblk = N / 32, kb = item / nblk, nb = item % nblk, k0 = 64 * kb, n0 = 32 * nb;
#pragma unroll 8
    for (int i = 0; i < 32; ++i) { const int kk = 2 * i + (lane >> 5); scr[kk * 33 + (lane & 31)] = W[(size_t)(k0 + kk) * N + n0 + (lane & 31)]; }
    LDS_WAIT(); asm volatile("" ::: "memory");
    const int c = lane & 7;
#pragma unroll
    for (int j = 0; j < 4; ++j) { const int n = (lane >> 3) + 8 * j; const LAS float* s = scr + (8 * c) * 33 + n;
        v4u o; o.x = pk2(s[0 * 33], s[1 * 33]); o.y = pk2(s[2 * 33], s[3 * 33]); o.z = pk2(s[4 * 33], s[5 * 33]); o.w = pk2(s[6 * 33], s[7 * 33]);
        *(v4u*)(WT + (size_t)(row_off + n0 + n) * K + k0 + 8 * c) = o; }
    LDS_WAIT(); asm volatile("" ::: "memory");
}
struct WDesc { const float* src; int K, N; bf16* dst; int row_off; };
__device__ __forceinline__ WDesc wdesc(const Args& a, int idx) {
    const int l = idx / 6, kind = idx % 6; WDesc w; unsigned char* ws = a.ws;
    if (kind == 0) { w.K = 1024; w.row_off = 0; w.dst = (bf16*)(ws + WS_WIN + (size_t)l * 7 * MiB);
        if (l == 0) { w.src = a.in[2]; w.N = 3072; } else if (l == 1) { w.src = a.in[5]; w.N = 1536; } else if (l == 2) { w.src = a.in[9]; w.N = 3104; } else { w.src = a.in[2] + (size_t)1024 * 3072; w.N = 3072; } }
    else if (kind == 1) { w.K = 1024; w.N = 1024; w.row_off = 0; w.dst = (bf16*)(ws + WS_WO + (size_t)l * 2 * MiB);
        w.src = (l == 0) ? a.in[4] : (l == 1) ? a.in[8] : (l == 2) ? a.in[12] : a.in[4] + (size_t)1024 * 1024; }
    else if (kind == 2) { w.K = 1024; w.N = 4096; w.row_off = 0; w.dst = (bf16*)(ws + WS_W1G + (size_t)l * 10 * MiB); w.src = a.in[15] + (size_t)l * 1024 * 4096; }
    else if (kind == 3) { w.K = 1024; w.N = 1024; w.row_off = 4096; w.dst = (bf16*)(ws + WS_W1G + (size_t)l * 10 * MiB); w.src = a.in[19] + (size_t)l * 1024 * 1024; }
    else if (kind == 4) { w.K = 4096; w.N = 1024; w.row_off = 0; w.dst = (bf16*)(ws + WS_W2 + (size_t)l * 8 * MiB); w.src = a.in[16] + (size_t)l * 4096 * 1024; }
    else { w.K = 256; w.N = 1024; w.row_off = 0; w.dst = (bf16*)(ws + WS_WP + (size_t)l * (MiB / 2)); w.src = a.in[20] + (size_t)l * 256 * 1024; }
    return w;
}
__device__ __forceinline__ void cvt_rows(const float* src, bf16* dst, size_t n, int G) {
    const size_t nth = (size_t)G * 512, n8 = n / 8;
    for (size_t i = (size_t)blockIdx.x * 512 + threadIdx.x; i < n8; i += nth) {
        const f32x4 a = *(const f32x4*)(src + i * 8), b = *(const f32x4*)(src + i * 8 + 4);
        v4u o; o.x = pk2(a[0], a[1]); o.y = pk2(a[2], a[3]); o.z = pk2(b[0], b[1]); o.w = pk2(b[2], b[3]);
        *(v4u*)(dst + i * 8) = o; }
}
__device__ __forceinline__ void prologue_phase(const Args& a, LAS unsigned char* lds, int G) {
    const int tid = threadIdx.x, lane = tid & 63, wave = tid >> 6;
    LAS float* scr = (LAS float*)(lds + wave * 16384);
    const int gw = blockIdx.x * NWAVES + wave, NGW = G * NWAVES;
    for (int idx = 0; idx < 24; ++idx) { const WDesc w = wdesc(a, idx); const int nitems = (w.K / 64) * (w.N / 32);
        for (int it = gw; it < nitems; it += NGW) p0_transpose_item(w.src, w.K, w.N, w.dst, w.row_off, scr, it, lane); }
    {
        v4u* z = (v4u*)((bf16*)(a.ws + WS_WIN + (size_t)2 * 7 * MiB) + (size_t)3104 * 1024); const size_t n16 = (size_t)224 * 1024 * 2 / 16;
        for (size_t i = (size_t)blockIdx.x * 512 + tid; i < n16; i += (size_t)G * 512) z[i] = (v4u){0u, 0u, 0u, 0u}; }
    cvt_rows(a.in[0], (bf16*)(a.ws + WS_XN), (size_t)M * D, G);
    cvt_rows(a.in[1], (bf16*)(a.ws + WS_PB), (size_t)M * DPLE, G);
}
__device__ __forceinline__ void ln_phase_bf(bf16* X, const float* g, const float* bta, float* outf, int G) {
    const int lane = threadIdx.x & 63, wave = threadIdx.x >> 6; const int gw = blockIdx.x * NWAVES + wave, NGW = G * NWAVES;
    f32x4 gv[4], bv[4];
#pragma unroll
    for (int j = 0; j < 4; ++j) { const int c = (j >> 1) * 512 + 8 * lane + (j & 1) * 4; gv[j] = *(const f32x4*)(g + c); bv[j] = *(const f32x4*)(bta + c); }
    for (int m = gw; m < M; m += NGW) {
        bf16* xr = X + (size_t)m * D + 8 * lane;
        const v4u r0 = *(const v4u*)xr, r1 = *(const v4u*)(xr + 512);
        f32x4 v[4];
        v[0] = (f32x4){__uint_as_float(r0.x << 16), __uint_as_float(r0.x & 0xffff0000u), __uint_as_float(r0.y << 16), __uint_as_float(r0.y & 0xffff0000u)};
        v[1] = (f32x4){__uint_as_float(r0.z << 16), __uint_as_float(r0.z & 0xffff0000u), __uint_as_float(r0.w << 16), __uint_as_float(r0.w & 0xffff0000u)};
        v[2] = (f32x4){__uint_as_float(r1.x << 16), __uint_as_float(r1.x & 0xffff0000u), __uint_as_float(r1.y << 16), __uint_as_float(r1.y & 0xffff0000u)};
        v[3] = (f32x4){__uint_as_float(r1.z << 16), __uint_as_float(r1.z & 0xffff0000u), __uint_as_float(r1.w << 16), __uint_as_float(r1.w & 0xffff0000u)};
        float s = 0.f;
#pragma unroll
        for (int j = 0; j < 4; ++j) s += (v[j][0] + v[j][1]) + (v[j][2] + v[j][3]);
        const float mean = wave_sum(s) * (1.f / D); float s2 = 0.f;
#pragma unroll
        for (int j = 0; j < 4; ++j) { v[j] = v[j] - mean; s2 += (v[j][0] * v[j][0] + v[j][1] * v[j][1]) + (v[j][2] * v[j][2] + v[j][3] * v[j][3]); }
        const float rstd = 1.f / sqrtf(wave_sum(s2) * (1.f / D) + LN_EPS);
#pragma unroll
        for (int j = 0; j < 4; ++j) v[j] = v[j] * rstd * gv[j] + bv[j];
        if (outf) { float* o = outf + (size_t)m * D + 8 * lane; *(f32x4*)o = v[0]; *(f32x4*)(o + 4) = v[1]; *(f32x4*)(o + 512) = v[2]; *(f32x4*)(o + 516) = v[3]; }
        else { *(v4u*)xr = (v4u){pk2(v[0][0], v[0][1]), pk2(v[0][2], v[0][3]), pk2(v[1][0], v[1][1]), pk2(v[1][2], v[1][3])};
               *(v4u*)(xr + 512) = (v4u){pk2(v[2][0], v[2][1]), pk2(v[2][2], v[2][3]), pk2(v[3][0], v[3][1]), pk2(v[3][2], v[3][3])}; }
    }
}
typedef unsigned long long u64_t;
__device__ __forceinline__ void na_phase(const bf16* QKV, const float* rpb, bf16* O, LAS unsigned char* lds, int G) {
    const int tid = threadIdx.x, lane = tid & 63, wave = tid >> 6, l15 = lane & 15, quad = lane >> 4;
    const int jq = wave & 3, half = wave >> 2;
    LAS unsigned char* Kimg = lds;
    LAS unsigned char* Vimg = lds + 65536;
    LAS float* scr = (LAS float*)(lds + 131072);
    const int kc0 = (jq == 0) ? 0 : (jq == 1) ? 8 : (jq == 2) ? 24 : 32;
    const int c = jq * 16 + l15, c0 = min(max(c - 8, 0), 48);
    const int scol = tid >> 3, sch = tid & 7;
    for (int bh = blockIdx.x; bh < 512; bh += G) {
        const int b = bh >> 4, h = bh & 15; const size_t tokb = (size_t)b * 2048;
        const bf16* kbase = QKV + (tokb + scol) * 3072 + 1024 + h * 64 + sch * 8;
        const bf16* qbase = QKV + (tokb + c) * 3072 + h * 64 + quad * 8;
        const float* rp = rpb + h * (15 * 31);
        __syncthreads();
#define NA_STAGE_WRITE(kv, vv, slot) do { const int kidx_ = (slot) * 64 + scol; \
            *(LAS v4u*)(Kimg + kidx_ * 128 + ((sch ^ (kidx_ & 7)) * 16)) = (kv); \
            const unsigned vw_[4] = {(vv).x, (vv).y, (vv).z, (vv).w}; \
            _Pragma("unroll") for (int e_ = 0; e_ < 8; ++e_) { const int dh_ = sch * 8 + e_; \
                *(LAS bf16*)(Vimg + ((slot) * 64 + dh_) * 128 + (((scol >> 2) ^ (dh_ & 15)) * 8) + (scol & 3) * 2) = (bf16)((e_ & 1) ? (vw_[e_ >> 1] >> 16) : (vw_[e_ >> 1] & 0xffffu)); } } while (0)
#pragma unroll
        for (int g4 = 0; g4 < 2; ++g4) { v4u kk[4], vv[4];
#pragma unroll
            for (int i = 0; i < 4; ++i) { const bf16* p = kbase + (size_t)(g4 * 4 + i) * 64 * 3072; kk[i] = *(const v4u*)p; vv[i] = *(const v4u*)(p + 1024); }
#pragma unroll
            for (int i = 0; i < 4; ++i) NA_STAGE_WRITE(kk[i], vv[i], g4 * 4 + i); }
        bf16x8 qn0 = *(const bf16x8*)qbase, qn1 = *(const bf16x8*)(qbase + 32);
        __syncthreads();
        int prev_off = 1000; f32x4 bt[4][2];
#pragma unroll
        for (int ai = 0; ai < 4; ++ai) { bt[ai][0] = (f32x4){0.f, 0.f, 0.f, 0.f}; bt[ai][1] = (f32x4){0.f, 0.f, 0.f, 0.f}; }
        for (int r = 0; r < 32; ++r) {
            const int r0 = min(max(r - 4, 0), 24);
            const bf16x8 qf0 = qn0, qf1 = qn1;
            const bool slide = (r + 1 < 32) && (min(max(r - 3, 0), 24) != r0);
            v4u nk = {0u, 0u, 0u, 0u}, nv = {0u, 0u, 0u, 0u};
            if (slide) { const bf16* p = kbase + (size_t)(r0 + 8) * 64 * 3072; nk = *(const v4u*)p; nv = *(const v4u*)(p + 1024); }
            if (r + 1 < 32) { const bf16* p = qbase + (size_t)(r + 1) * 64 * 3072; qn0 = *(const bf16x8*)p; qn1 = *(const bf16x8*)(p + 32); }
            const int off = r0 - r;
            if (off != prev_off) { prev_off = off;
#pragma unroll
                for (int ai = 0; ai < 4; ++ai) { const int dr = off + half * 4 + ai + 7;
#pragma unroll
                    for (int cb = 0; cb < 2; ++cb)
#pragma unroll
                        for (int j = 0; j < 4; ++j) { const int kc = kc0 + cb * 16 + quad * 4 + j; const bool valid = (kc >= c0) && (kc < c0 + 16);
                            const int dc = min(max(kc - c + 15, 0), 30); const float bias = rp[dr * 31 + dc]; bt[ai][cb][j] = valid ? bias : -INFINITY; } } }
            f32x4 sc[4][2]; float mx = -INFINITY;
#pragma unroll
            for (int ai = 0; ai < 4; ++ai) { const int slot = (r0 + half * 4 + ai) & 7;
#pragma unroll
                for (int cb = 0; cb < 2; ++cb) { const int kidx = slot * 64 + kc0 + cb * 16 + l15; const LAS unsigned char* ka = Kimg + kidx * 128;
                    const bf16x8 k0 = *(const LAS bf16x8*)(ka + ((quad ^ (kidx & 7)) * 16)), k1 = *(const LAS bf16x8*)(ka + (((quad + 4) ^ (kidx & 7)) * 16));
                    f32x4 acc = {0.f, 0.f, 0.f, 0.f}; acc = mfma16(k0, qf0, acc); acc = mfma16(k1, qf1, acc);
                    acc = acc + bt[ai][cb];
                    mx = fmaxf(fmaxf(fmaxf(mx, acc[0]), fmaxf(acc[1], acc[2])), acc[3]); sc[ai][cb] = acc; } }
            mx = fmaxf(mx, __shfl_xor(mx, 16)); mx = fmaxf(mx, __shfl_xor(mx, 32));
            float sum = 0.f;
#pragma unroll
            for (int ai = 0; ai < 4; ++ai)
#pragma unroll
                for (int cb = 0; cb < 2; ++cb)
#pragma unroll
                    for (int j = 0; j < 4; ++j) { const float p = __expf(sc[ai][cb][j] - mx); sc[ai][cb][j] = p; sum += p; }
            sum += __shfl_xor(sum, 16); sum += __shfl_xor(sum, 32);
            f32x4 o[4];
#pragma unroll
            for (int db = 0; db < 4; ++db) o[db] = (f32x4){0.f, 0.f, 0.f, 0.f};
#pragma unroll
            for (int ai = 0; ai < 4; ++ai) { const int slot = (r0 + half * 4 + ai) & 7;
                const v4u pw = {pk2(sc[ai][0][0], sc[ai][0][1]), pk2(sc[ai][0][2], sc[ai][0][3]), pk2(sc[ai][1][0], sc[ai][1][1]), pk2(sc[ai][1][2], sc[ai][1][3])};
                const bf16x8 pb = __builtin_bit_cast(bf16x8, pw);
                const int ch = (kc0 >> 2) + quad;
#pragma unroll
                for (int db = 0; db < 4; ++db) { const LAS unsigned char* va = Vimg + (slot * 64 + db * 16 + l15) * 128;
                    const u64_t lo = *(const LAS u64_t*)(va + ((ch ^ l15) * 8)), hi = *(const LAS u64_t*)(va + (((ch + 4) ^ l15) * 8));
                    const v4u vw = {(unsigned)lo, (unsigned)(lo >> 32), (unsigned)hi, (unsigned)(hi >> 32)};
                    o[db] = mfma16(__builtin_bit_cast(bf16x8, vw), pb, o[db]); } }
            if (half == 1) { LAS float* s = scr + jq * 18 * 64 + lane; s[0] = mx; s[64] = sum;
#pragma unroll
                for (int db = 0; db < 4; ++db)
#pragma unroll
                    for (int j = 0; j < 4; ++j) s[(2 + db * 4 + j) * 64] = o[db][j]; }
            __syncthreads();
            if (half == 0) { const LAS float* s = scr + jq * 18 * 64 + lane; const float m1 = s[0], l1 = s[64];
                const float m = fmaxf(mx, m1), f0 = __expf(mx - m), f1 = __expf(m1 - m); const float inv = 1.0f / (sum * f0 + l1 * f1);
                const float g0 = f0 * inv, g1 = f1 * inv;
                bf16* op = O + (tokb + r * 64 + c) * 1024 + h * 64 + quad * 4;
#pragma unroll
                for (int db = 0; db < 4; ++db) { float v[4];
#pragma unroll
                    for (int j = 0; j < 4; ++j) v[j] = o[db][j] * g0 + s[(2 + db * 4 + j) * 64] * g1;
                    *(u64_t*)(op + db * 16) = (u64_t)pk2(v[0], v[1]) | ((u64_t)pk2(v[2], v[3]) << 32); } }
            if (slide) NA_STAGE_WRITE(nk, nv, r0 & 7);
            __syncthreads();
        }
#undef NA_STAGE_WRITE
    }
}
__device__ __forceinline__ void gq_normrope_phase(bf16* QKV, const float* qn, const float* kn, int G) {
    const size_t total = (size_t)M * 20 * 8, nth = (size_t)G * 512;
    for (size_t g = (size_t)blockIdx.x * 512 + threadIdx.x; g < total; g += nth) {
        const size_t item = g >> 3; const int l8 = (int)(g & 7); const size_t tok = item / 20; const int hv = (int)(item % 20);
        bf16* p = QKV + tok * 1536 + hv * 64 + l8 * 8;
        const v4u raw = *(const v4u*)p; const unsigned rw[4] = {raw.x, raw.y, raw.z, raw.w};
        float x[8]; float ss = 0.f;
#pragma unroll
        for (int e = 0; e < 4; ++e) { x[2 * e] = __uint_as_float(rw[e] << 16); x[2 * e + 1] = __uint_as_float(rw[e] & 0xffff0000u); ss += x[2 * e] * x[2 * e] + x[2 * e + 1] * x[2 * e + 1]; }
        ss += __shfl_xor(ss, 1); ss += __shfl_xor(ss, 2); ss += __shfl_xor(ss, 4);
        const float rinv = 1.0f / sqrtf(ss * (1.f / 64.f) + 1e-6f);
        const float* gvec = ((hv < 16) ? qn : kn) + l8 * 8;
        const int s = (int)(tok & 2047), row = s >> 6, col = s & 63;
        const float scale = (hv < 16) ? (0.125f * 1.4426950408889634f) : 1.0f;
        unsigned ow[4];
#pragma unroll
        for (int pr = 0; pr < 4; ++pr) { const int i = l8 * 4 + pr; const float pos = (float)((i < 16) ? row : col); const int fi = i & 15;
            const float inv = exp2f(-(float)fi * (13.287712379549449f / 16.f)); const float ang = pos * inv;
            float rev = ang * 0.15915494309189535f; rev -= rintf(rev);
            const float sn = __builtin_amdgcn_sinf(rev), cs = __builtin_amdgcn_cosf(rev);
            const float x0 = x[2 * pr] * rinv * gvec[2 * pr], x1 = x[2 * pr + 1] * rinv * gvec[2 * pr + 1];
            ow[pr] = pk2((x0 * cs - x1 * sn) * scale, (x0 * sn + x1 * cs) * scale); }
        *(v4u*)p = (v4u){ow[0], ow[1], ow[2], ow[3]};
    }
}
__device__ __forceinline__ f32x4 tile_mma64(const LAS bf16* A, int arow0, const LAS bf16* Bt, int brow0, f32x4 acc, int l15, int quad) {
    const LAS bf16* ap = A + (arow0 + l15) * 72 + quad * 8; const LAS bf16* bp = Bt + (brow0 + l15) * 72 + quad * 8;
    acc = mfma16(*(const LAS bf16x8*)ap, *(const LAS bf16x8*)bp, acc);
    acc = mfma16(*(const LAS bf16x8*)(ap + 32), *(const LAS bf16x8*)(bp + 32), acc);
    return acc;
}
__device__ __forceinline__ void ml_phase(const bf16* Z, const float* gates, const float* norm_g, bf16* HFW, bf16* O, LAS unsigned char* lds, int G) {
    const int tid = threadIdx.x, lane = tid & 63, wave = tid >> 6, l15 = lane & 15, quad = lane >> 4;
    LAS bf16* Qs = (LAS bf16*)(lds);
    LAS bf16* Ks = (LAS bf16*)(lds + 9216);
    LAS bf16* Vt = (LAS bf16*)(lds + 18432);
    LAS bf16* Kt = (LAS bf16*)(lds + 39168);
    LAS bf16* Ct = (LAS bf16*)(lds + 48384);
    LAS bf16* As = (LAS bf16*)(lds + 69120);
    LAS float* Hs = (LAS float*)(lds + 78336);
    LAS float* vec = (LAS float*)(lds + 112128);
    for (int unit = blockIdx.x; unit < 256; unit += G) {
        const int b = unit >> 3, h = unit & 7; const size_t tokb = (size_t)b * 2048;
        for (int dir = 0; dir < 2; ++dir) {
            for (int i = tid; i < 144 * 72; i += 512) Ct[i] = 0;
            for (int i = tid; i < 16 * 72; i += 512) Vt[128 * 72 + i] = (i < 72) ? (bf16)0x3F80 : (bf16)0;
            f32x4 cst[4], cst8 = {0.f, 0.f, 0.f, 0.f};
#pragma unroll
            for (int i = 0; i < 4; ++i) cst[i] = (f32x4){0.f, 0.f, 0.f, 0.f};
            float m_run = 0.f;
            __syncthreads();
            for (int cs = 0; cs < 32; ++cs) {
                const int t8 = tid >> 3, ch = tid & 7;
                const size_t tok8 = tokb + (size_t)(dir == 0 ? cs * 64 + t8 : 2047 - (cs * 64 + t8));
                {
                    const bf16* zr = Z + tok8 * 3072;
                    *(LAS v4u*)(Qs + t8 * 72 + ch * 8) = *(const v4u*)(zr + h * 64 + ch * 8);
                    *(LAS v4u*)(Ks + t8 * 72 + ch * 8) = *(const v4u*)(zr + 512 + h * 64 + ch * 8);
#pragma unroll
                    for (int i = 0; i < 2; ++i) { const int c16 = ch + 8 * i; const bf16x8 vv = *(const bf16x8*)(zr + 1024 + h * 128 + c16 * 8);
#pragma unroll
                        for (int e = 0; e < 8; ++e) Vt[(c16 * 8 + e) * 72 + t8] = (bf16)vv[e]; }
                }
                if (wave == 0) {
                    const size_t tok = tokb + (size_t)(dir == 0 ? cs * 64 + lane : 2047 - (cs * 64 + lane));
                    const float li = gates[tok * 32 + dir * 16 + h], f = gates[tok * 32 + dir * 16 + 8 + h];
                    const float lf = fminf(f, 0.f) - log1pf(__expf(-fabsf(f)));
                    float bs = lf;
#pragma unroll
                    for (int o = 1; o < 64; o <<= 1) { const float y = __shfl_up(bs, o); if (lane >= o) bs += y; }
                    const float u = li - bs; float pm = u;
#pragma unroll
                    for (int o = 1; o < 64; o <<= 1) { const float y = __shfl_up(pm, o); if (lane >= o) pm = fmaxf(pm, y); }
                    const float Mt = fmaxf(pm, m_run), sint = __expf(m_run - Mt), mt = bs + Mt;
                    vec[lane] = u; vec[64 + lane] = Mt; vec[128 + lane] = sint; vec[192 + lane] = __expf(-mt);
                    m_run = __shfl(mt, 63);
                }
                __syncthreads();
                {
                    const int tb = wave >> 1;
#pragma unroll
                    for (int i = 0; i < 2; ++i) { const int sb = 2 * (wave & 1) + i;
                        f32x4 acc = {0.f, 0.f, 0.f, 0.f}; if (sb <= tb) acc = tile_mma64(Qs, tb * 16, Ks, sb * 16, acc, l15, quad);
                        const int s = sb * 16 + l15; const float us = vec[s];
#pragma unroll
                        for (int j = 0; j < 4; ++j) { const int t = tb * 16 + 4 * quad + j; const float w = (s <= t) ? __expf(us - vec[64 + t]) : 0.f; As[t * 72 + s] = (bf16)f2bf(acc[j] * w); } }
                    const float w63 = __expf(vec[t8] - vec[64 + 63]);
                    const bf16x8 kk = *(const LAS bf16x8*)(Ks + t8 * 72 + ch * 8);
#pragma unroll
                    for (int e = 0; e < 8; ++e) Kt[(ch * 8 + e) * 72 + t8] = (bf16)f2bf(bf2f((bf16)kk[e]) * w63);
                }
                __syncthreads();
                {
#pragma unroll
                    for (int tb = 0; tb < 4; ++tb) { const f32x4 z4 = {0.f, 0.f, 0.f, 0.f};
                        const f32x4 ah = tile_mma64(As, tb * 16, Vt, wave * 16, z4, l15, quad), ag = tile_mma64(Qs, tb * 16, Ct, wave * 16, z4, l15, quad);
#pragma unroll
                        for (int j = 0; j < 4; ++j) { const int t = tb * 16 + 4 * quad + j; Hs[t * 132 + wave * 16 + l15] = vec[128 + t] * ag[j] + ah[j]; } }
                    if (wave < 4) { const int tb = wave; const f32x4 z4 = {0.f, 0.f, 0.f, 0.f};
                        const f32x4 ah = tile_mma64(As, tb * 16, Vt, 128, z4, l15, quad), ag = tile_mma64(Qs, tb * 16, Ct, 128, z4, l15, quad);
                        if (l15 == 0) {
#pragma unroll
                            for (int j = 0; j < 4; ++j) { const int t = tb * 16 + 4 * quad + j; vec[256 + t] = vec[128 + t] * ag[j] + ah[j]; } } }
                }
                __syncthreads();
                {
                    const float decay = vec[128 + 63];
#pragma unroll
                    for (int db = 0; db < 4; ++db) { cst[db] = tile_mma64(Vt, wave * 16, Kt, db * 16, cst[db] * decay, l15, quad);
#pragma unroll
                        for (int j = 0; j < 4; ++j) Ct[(wave * 16 + 4 * quad + j) * 72 + db * 16 + l15] = (bf16)f2bf(cst[db][j]); }
                    if (wave < 4) { cst8 = tile_mma64(Vt, 128, Kt, wave * 16, cst8 * decay, l15, quad);
#pragma unroll
                        for (int j = 0; j < 4; ++j) Ct[(128 + 4 * quad + j) * 72 + wave * 16 + l15] = (bf16)f2bf(cst8[j]); }
                    const float dn = fmaxf(fabsf(vec[256 + t8]), vec[192 + t8]); const float rd = 1.0f / dn;
                    float hv[16];
#pragma unroll
                    for (int e = 0; e < 16; ++e) hv[e] = Hs[t8 * 132 + ch * 16 + e] * rd;
                    const size_t ho = tok8 * 1024 + h * 128 + ch * 16;
                    if (dir == 0) {
                        v4u w0, w1; w0.x = pk2(hv[0], hv[1]); w0.y = pk2(hv[2], hv[3]); w0.z = pk2(hv[4], hv[5]); w0.w = pk2(hv[6], hv[7]);
                        w1.x = pk2(hv[8], hv[9]); w1.y = pk2(hv[10], hv[11]); w1.z = pk2(hv[12], hv[13]); w1.w = pk2(hv[14], hv[15]);
                        *(v4u*)(HFW + ho) = w0; *(v4u*)(HFW + ho + 8) = w1;
                    } else {
                        const v4u f0 = *(const v4u*)(HFW + ho), f1 = *(const v4u*)(HFW + ho + 8);
                        const unsigned fw[8] = {f0.x, f0.y, f0.z, f0.w, f1.x, f1.y, f1.z, f1.w};
                        float ss = 0.f;
#pragma unroll
                        for (int e = 0; e < 8; ++e) { hv[2 * e] += __uint_as_float(fw[e] << 16); hv[2 * e + 1] += __uint_as_float(fw[e] & 0xffff0000u); ss += hv[2 * e] * hv[2 * e] + hv[2 * e + 1] * hv[2 * e + 1]; }
                        ss += __shfl_xor(ss, 1); ss += __shfl_xor(ss, 2); ss += __shfl_xor(ss, 4);
                        const float rinv = 1.0f / sqrtf(ss * (1.f / 128.f) + 1e-6f);
                        const bf16* og = Z + tok8 * 3072 + 2048 + h * 128 + ch * 16;
                        const v4u g0 = *(const v4u*)og, g1 = *(const v4u*)(og + 8);
                        const unsigned gw_[8] = {g0.x, g0.y, g0.z, g0.w, g1.x, g1.y, g1.z, g1.w};
                        const float* ng = norm_g + h * 128 + ch * 16;
                        unsigned ow[8];
#pragma unroll
                        for (int e = 0; e < 8; ++e) { const float o0 = 1.0f / (1.0f + __expf(-__uint_as_float(gw_[e] << 16))), o1 = 1.0f / (1.0f + __expf(-__uint_as_float(gw_[e] & 0xffff0000u)));
                            ow[e] = pk2(hv[2 * e] * rinv * ng[2 * e] * o0, hv[2 * e + 1] * rinv * ng[2 * e + 1] * o1); }
                        *(v4u*)(O + ho) = (v4u){ow[0], ow[1], ow[2], ow[3]}; *(v4u*)(O + ho + 8) = (v4u){ow[4], ow[5], ow[6], ow[7]};
                    }
                }
                __syncthreads();
            }
        }
    }
}
#define RLX_AGENT __ATOMIC_RELAXED, __HIP_MEMORY_SCOPE_AGENT
#define XB_TMO      128
#define XB_XCNT(j)  (256  + 64 * (j))
#define XB_XSUB(j)  (1280 + 64 * (j))
#define XB_XGEN(j)  (2304 + 64 * (j))
#define XB_TOP      3328
#define XB_TOPGEN   3392
#define XCD_BAR_WORDS 3456
#define XB_SPIN_CAP (1u << 18)

__device__ __forceinline__ unsigned xb_ld(unsigned* p)              { return __hip_atomic_load(p, __ATOMIC_RELAXED, __HIP_MEMORY_SCOPE_AGENT); }
__device__ __forceinline__ unsigned xb_add(unsigned* p, unsigned v) { return __hip_atomic_fetch_add(p, v, __ATOMIC_RELAXED, __HIP_MEMORY_SCOPE_AGENT); }
__device__ __forceinline__ unsigned xb_xcc_id() { return (unsigned)__builtin_amdgcn_s_getreg((3 << 11) | 20) & 0xFu; }
#define XB_SPIN(cond, bar) do { unsigned _sp = 0; while (cond) { __builtin_amdgcn_s_sleep(1); \
    if ((++_sp & 255u) == 0u) { if (xb_ld(&(bar)[XB_TMO])) break; if (_sp > XB_SPIN_CAP) { atomicAdd(&(bar)[XB_TMO], 1u); break; } } } } while (0)

struct XcdBarrier {
    unsigned* bar; unsigned x;
    volatile LAS unsigned* st;
};

__device__ __forceinline__ XcdBarrier xcd_barrier_post(unsigned* bar, volatile LAS unsigned* st) {
    XcdBarrier b; b.bar = bar; b.x = xb_xcc_id(); b.st = st;
    if (threadIdx.x == 0) (void)xb_add(&bar[XB_XCNT(b.x)], 1u);
    return b;
}
__device__ __forceinline__ void xcd_barrier_complete(unsigned* bar, unsigned x, unsigned& nloc, unsigned& nx) {
    const unsigned G = gridDim.x * gridDim.y * gridDim.z;
    unsigned sum, cnt, mine, sp = 0u;
    for (;;) {
        sum = 0u; cnt = 0u; mine = 0u;
#pragma unroll
        for (unsigned j = 0; j < 16; ++j) { const unsigned c = xb_ld(&bar[XB_XCNT(j)]); sum += c; cnt += (c > 0u) ? 1u : 0u; mine = (j == x) ? c : mine; }
        if (sum == G) break;
        __builtin_amdgcn_s_sleep(1);
        if ((++sp & 255u) == 0u) { if (xb_ld(&bar[XB_TMO])) break; if (sp > XB_SPIN_CAP) { atomicAdd(&bar[XB_TMO], 1u); break; } }
    }
    nloc = mine > 0u ? mine : 1u; nx = cnt > 0u ? cnt : 1u;
}

__device__ __forceinline__ void xcd_barrier(const XcdBarrier& b) {
    asm volatile("s_waitcnt vmcnt(0)" ::: "memory");
    __syncthreads();
    if (threadIdx.x == 0) {
        unsigned* bar = b.bar;
        __builtin_amdgcn_s_waitcnt(0);
        unsigned nloc = b.st[0], nx = b.st[1];
        if (nloc == 0u) { xcd_barrier_complete(bar, b.x, nloc, nx); b.st[0] = nloc; b.st[1] = nx; }
        const unsigned old = xb_add(&bar[XB_XSUB(b.x)], 1u);
        const unsigned gen = old / nloc;
        if (old + 1u == (gen + 1u) * nloc) {
            __builtin_amdgcn_fence(__ATOMIC_RELEASE, "agent");
            asm volatile("s_waitcnt vmcnt(0)" ::: "memory");
            const unsigned og = xb_add(&bar[XB_TOP], 1u);
            const unsigned tg = og / nx;
            if (og + 1u == (tg + 1u) * nx) xb_add(&bar[XB_TOPGEN], 1u);
            else XB_SPIN(xb_ld(&bar[XB_TOPGEN]) == tg, bar);
            __builtin_amdgcn_fence(__ATOMIC_ACQUIRE, "agent");
            xb_add(&bar[XB_XGEN(b.x)], 1u);
            asm volatile("s_waitcnt vmcnt(0)" ::: "memory");
        } else {
            XB_SPIN(xb_ld(&bar[XB_XGEN(b.x)]) == gen, bar);
            __builtin_amdgcn_fence(__ATOMIC_ACQUIRE, "agent");
            asm volatile("s_waitcnt vmcnt(0)" ::: "memory");
        }
    }
    __syncthreads();
}

#define GSYNC() xcd_barrier(bar)
#define SKIP(bit) ((skipmask >> (bit)) & 1)
template <int L> __device__ __forceinline__ void layer_program(const Args& a, LAS unsigned char* lds, unsigned char* lds_raw, const int G, const XcdBarrier& bar, const int skipmask) {
    constexpr int kind = L % 3;
    unsigned char* ws = a.ws;
    bf16* XN = (bf16*)(ws + WS_XN); bf16* QKV = (bf16*)(ws + WS_QKV); bf16* OB = (bf16*)(ws + WS_O); bf16* PP = (bf16*)(ws + WS_PP); bf16* HB = (bf16*)(ws + WS_H);
    if (!SKIP(1)) { const bf16* Win = (const bf16*)(ws + WS_WIN + (size_t)L * 7 * MiB);
        if constexpr (kind == 2) { pg8::Gemm g{XN, Win, M, 3328, D}; pg8::StaticOrder S; S.init(M, 3328, G, (int)blockIdx.x);
            pg8::EpiMl E{QKV, (float*)(ws + WS_GATES), a.in[10]};
            pg8::gemm_phase<pg8::EpiMl, pg8::StaticOrder, true, true>(lds, g, S, E); }
        else { constexpr int N = (kind == 0) ? 3072 : 1536; pg8::Gemm g{XN, Win, M, N, D}; pg8::StaticOrder S; S.init(M, N, G, (int)blockIdx.x);
            pg8::EpiPlain E{QKV, N, (kind == 0) ? 1024 : 0, 0.125f};
            pg8::gemm_phase<pg8::EpiPlain, pg8::StaticOrder, true, true>(lds, g, S, E); } }
    if (!SKIP(2)) { pg8::Gemm g{(const bf16*)(ws + WS_PB), (const bf16*)(ws + WS_WP + (size_t)L * (MiB / 2)), M, D, DPLE}; pg8::StaticOrder S; S.init(M, D, G, (int)blockIdx.x);
        pg8::EpiPlain E{PP, D, 0, 1.f};
        pg8::gemm_phase<pg8::EpiPlain, pg8::StaticOrder, true, true>(lds, g, S, E); }
    GSYNC();
    if constexpr (kind == 1) { if (!SKIP(3)) gq_normrope_phase(QKV, a.in[6], a.in[7], G); GSYNC(); }
    if (!SKIP(4)) {
        if constexpr (kind == 0) na_phase(QKV, a.in[3] + (size_t)(L / 3) * 16 * 15 * 31, OB, lds, G);
        else if constexpr (kind == 1) { const attn_body::AttnTensors AT{(const attn_body::bf16*)QKV, (const attn_body::bf16*)(QKV + 1024), (const attn_body::bf16*)(QKV + 1280), (attn_body::bf16*)OB};
            const attn_body::StaticOrder S(G, (int)blockIdx.x); attn_body::attn_phase<attn_body::StaticOrder>((char*)lds_raw, AT, S); }
        else ml_phase(QKV, (const float*)(ws + WS_GATES), a.in[11], (bf16*)a.out, OB, lds, G);
    }
    GSYNC();
    if (!SKIP(5)) { pg8::Gemm g{OB, (const bf16*)(ws + WS_WO + (size_t)L * 2 * MiB), M, D, D}; pg8::StaticOrder S; S.init(M, D, G, (int)blockIdx.x);
        pg8::EpiResidBf E{XN, nullptr, DN_ALPHA};
        pg8::gemm_phase<pg8::EpiResidBf, pg8::StaticOrder, true, true>(lds, g, S, E); }
    GSYNC();
    if (!SKIP(6)) ln_phase_bf(XN, a.in[13] + (size_t)L * D, a.in[14] + (size_t)L * D, nullptr, G);
    GSYNC();
    if (!SKIP(7)) { pg8::Gemm g{XN, (const bf16*)(ws + WS_W1G + (size_t)L * 10 * MiB), M, FF + D, D}; pg8::StaticOrder S; S.init(M, FF + D, G, (int)blockIdx.x);
        pg8::EpiFf1 E{HB, PP};
        pg8::gemm_phase<pg8::EpiFf1, pg8::StaticOrder, true, true>(lds, g, S, E); }
    GSYNC();
    if (!SKIP(8)) { pg8::Gemm g{HB, (const bf16*)(ws + WS_W2 + (size_t)L * 8 * MiB), M, D, FF}; pg8::StaticOrder S; S.init(M, D, G, (int)blockIdx.x);
        pg8::EpiResidBf E{XN, PP, DN_ALPHA};
        pg8::gemm_phase<pg8::EpiResidBf, pg8::StaticOrder, true, true>(lds, g, S, E); }
    GSYNC();
    if (!SKIP(9)) { ln_phase_bf(XN, a.in[17] + (size_t)L * D, a.in[18] + (size_t)L * D, (L + 1 < DEPTH) ? nullptr : a.out, G);
        if constexpr (L + 1 < DEPTH) cvt_rows(a.in[1] + (size_t)(L + 1) * M * DPLE, (bf16*)(ws + WS_PB), (size_t)M * DPLE, G); }
    if constexpr (L + 1 < DEPTH) GSYNC();
}
__global__ void __launch_bounds__(NWAVES * 64, 2) fwd_megakernel(Args a) {
    extern __shared__ __attribute__((aligned(16))) unsigned char lds_raw[];
    LAS unsigned char* lds = (LAS unsigned char*)lds_raw;
    cg::grid_group grid = cg::this_grid();
    const int G = gridDim.x;
    { volatile LAS unsigned* z = (volatile LAS unsigned*)(lds + LDS_CTL); if (threadIdx.x < 64) z[threadIdx.x] = 0u; }
    __syncthreads();
    const XcdBarrier bar = xcd_barrier_post((unsigned*)a.ws + 4096, (volatile LAS unsigned*)(lds + LDS_CTL + 64));
#ifdef PROBE_SKIP
#ifndef PROBE_LAYERS
#define PROBE_LAYERS 15
#endif
    {
        const int skipmask = a.skip;
        if (!SKIP(0)) prologue_phase(a, lds, G);
        GSYNC();
        if ((PROBE_LAYERS >> 0) & 1) layer_program<0>(a, lds, lds_raw, G, bar, skipmask); GSYNC();
        if ((PROBE_LAYERS >> 1) & 1) layer_program<1>(a, lds, lds_raw, G, bar, skipmask); GSYNC();
        if ((PROBE_LAYERS >> 2) & 1) layer_program<2>(a, lds, lds_raw, G, bar, skipmask); GSYNC();
        if ((PROBE_LAYERS >> 3) & 1) layer_program<3>(a, lds, lds_raw, G, bar, skipmask); GSYNC();
    }
#endif
    {
        const int skipmask = a.pad;
        if (!SKIP(0)) prologue_phase(a, lds, G);
        grid.sync();
        layer_program<0>(a, lds, lds_raw, G, bar, skipmask);
        layer_program<1>(a, lds, lds_raw, G, bar, skipmask);
        layer_program<2>(a, lds, lds_raw, G, bar, skipmask);
        layer_program<3>(a, lds, lds_raw, G, bar, skipmask);
    }
}
#undef SKIP

extern "C" void kernel_launch(void* const* d_in, const int* in_sizes, int n_in, void* d_out, int out_size, void* d_ws, size_t ws_size, hipStream_t stream) {
    static int grid = 0;
    if (grid == 0) {
        if (n_in != 21 || out_size != M * D || ws_size < WS_END) { fprintf(stderr, "kernel_launch: unexpected shapes (n_in %d, out %d, ws %zu)\n", n_in, out_size, ws_size); grid = -1; return; }
        int dev = 0, cus = 0, per_cu = 0;
        hipGetDevice(&dev); hipDeviceGetAttribute(&cus, hipDeviceAttributeMultiprocessorCount, dev);
        if (hipFuncSetAttribute((const void*)fwd_megakernel, hipFuncAttributeMaxDynamicSharedMemorySize, LDS_BYTES) != hipSuccess) { fprintf(stderr, "kernel_launch: hipFuncSetAttribute failed\n"); grid = -1; return; }
        if (hipOccupancyMaxActiveBlocksPerMultiprocessor(&per_cu, (const void*)fwd_megakernel, NWAVES * 64, LDS_BYTES) != hipSuccess || per_cu < 1) per_cu = 1;
        (void)hipGetLastError();
        grid = cus * per_cu;
        fprintf(stderr, "kernel_launch: grid %d (cus %d x %d)\n", grid, cus, per_cu);
    }
    if (grid < 0) return;
    Args a{};
    for (int i = 0; i < 21; ++i) a.in[i] = (const float*)d_in[i];
    a.out = (float*)d_out; a.ws = (unsigned char*)d_ws;
#ifdef PROBE_SKIP
    a.skip = PROBE_SKIP;
#else
    a.skip = 0;
#endif
    a.pad = 0;
    if (hipMemsetAsync(d_ws, 0, 65536, stream) != hipSuccess) { fprintf(stderr, "kernel_launch: hipMemsetAsync failed\n"); return; }
    void* args[] = {&a};
    const hipError_t e = hipLaunchCooperativeKernel((const void*)fwd_megakernel, dim3(grid), dim3(NWAVES * 64), args, LDS_BYTES, stream);
    if (e != hipSuccess) fprintf(stderr, "kernel_launch: cooperative launch failed: %s (grid %d)\n", hipGetErrorString(e), grid);
}
```

```cpp
#include <hip/hip_runtime.h>
#include <hip/hip_cooperative_groups.h>
#include <cstdio>
#include <cstdint>
namespace cg = cooperative_groups;
namespace pg8 {
#define PG8_LAS __attribute__((address_space(3)))
typedef unsigned short bf16_t;
typedef short bf16x8 __attribute__((ext_vector_type(8)));
typedef float f32x4 __attribute__((ext_vector_type(4)));
typedef unsigned u32x4 __attribute__((ext_vector_type(4)));
constexpr int BM = 256, BK = 64, HALF = 128, HTB = HALF * BK * 2  , STAGE_BYTES = 8 * HTB, NXCD = 8, WGM = 8;

__host__ __device__ __forceinline__ int lds_byte(int r, int c) { const int st = (r >> 4) * 2 + (c >> 5), rr = r & 15, cc = c & 31, ob = rr * 64 + cc * 2; return st * 1024 + (ob ^ (((ob >> 9) & 1) << 5)); }
__host__ __device__ __forceinline__ void stage_rc(int b, int& R, int& C) { const int st = b / 1024, sb = b % 1024, swz = sb ^ (((sb >> 9) & 1) << 5); R = (st >> 1) * 16 + swz / 64; C = (st & 1) * 32 + (swz % 64) / 2; }
__host__ __device__ __forceinline__ int perm32(int rho) { const int n = rho >> 4, i = rho & 15; return 8 * (i >> 2) + 4 * n + (i & 3); }

struct Unit { int pm, pn; };
struct Gemm { const bf16_t* A; const bf16_t* Bt; int M, N, K; };

struct StaticOrder {
    int nM, nN, nwg, G, c;
    __host__ __device__ void init(int M, int N, int G_, int c_) { nM = M / BM; nN = N / BM; nwg = nM * nN; G = G_; c = c_; }
    __host__ __device__ bool next(int i, Unit& u) const {
        const long L = (long)i * G + c; if (L >= nwg) return false;
        int wgid = (int)L; { const int q = nwg / NXCD, r = nwg % NXCD, xcd = wgid % NXCD, off = wgid / NXCD; wgid = (xcd < r ? xcd * (q + 1) : r * (q + 1) + (xcd - r) * q) + off; }
        const int nig = WGM * nN, gid = wgid / nig, fm = gid * WGM, gsz = (nM - fm) < WGM ? (nM - fm) : WGM;
        u.pm = fm + ((wgid % nig) % gsz); u.pn = (wgid % nig) / gsz; return true;
    }
    __device__ __forceinline__ void a_ready(const Unit&) const {}
    __device__ __forceinline__ void done(const Unit&) const {}
};

__device__ __forceinline__ unsigned cvt_pk_bf16(float lo, float hi) { unsigned r; asm volatile("v_cvt_pk_bf16_f32 %0, %1, %2" : "=v"(r) : "v"(lo), "v"(hi)); return r; }
typedef float f32x2 __attribute__((ext_vector_type(2)));
__device__ __forceinline__ float bf2f(unsigned short h) { return __uint_as_float(((unsigned)h) << 16); }
__device__ __forceinline__ float sigmoidf_(float x) { return 1.0f / (1.0f + __expf(-x)); }
struct EpiPlain {
    static constexpr bool PERM = true, AFTER_DRAIN = false;
    bf16_t* O; int ldc; int scale_cols; float scale;
    __device__ __forceinline__ void operator()(const f32x4 (&acc)[2][2][4][2], const Unit& u, int wr, int wc, int fr, int fq) const {
        const int row0 = u.pm * BM + wr * 64 + fr, col0 = u.pn * BM + wc * 32 + 8 * fq;
        const float sc = (u.pn * BM < scale_cols) ? scale : 1.f;
#pragma unroll
        for (int ai = 0; ai < 2; ++ai)
#pragma unroll
            for (int m = 0; m < 4; ++m) { bf16_t* rowp = O + (size_t)(row0 + ai * HALF + m * 16) * ldc + col0;
#pragma unroll
                for (int bj = 0; bj < 2; ++bj) { f32x4 v0 = acc[ai][bj][m][0] * sc, v1 = acc[ai][bj][m][1] * sc;
                    u32x4 w; w.x = cvt_pk_bf16(v0[0], v0[1]); w.y = cvt_pk_bf16(v0[2], v0[3]); w.z = cvt_pk_bf16(v1[0], v1[1]); w.w = cvt_pk_bf16(v1[2], v1[3]);
                    *(u32x4*)(rowp + bj * HALF) = w; } }
    }
};
struct EpiMl {
    static constexpr bool PERM = true, AFTER_DRAIN = false;
    bf16_t* O; float* gates; const float* bias;
    __device__ __forceinline__ void operator()(const f32x4 (&acc)[2][2][4][2], const Unit& u, int wr, int wc, int fr, int fq) const {
        const int row0 = u.pm * BM + wr * 64 + fr;
        if (u.pn < 12) {
            const int col0 = u.pn * BM + wc * 32 + 8 * fq; const float sc = (u.pn < 2) ? 0.125f : 1.f;
#pragma unroll
            for (int ai = 0; ai < 2; ++ai)
#pragma unroll
                for (int m = 0; m < 4; ++m) { bf16_t* rowp = O + (size_t)(row0 + ai * HALF + m * 16) * 3072 + col0;
#pragma unroll
                    for (int bj = 0; bj < 2; ++bj) { f32x4 v0 = acc[ai][bj][m][0] * sc, v1 = acc[ai][bj][m][1] * sc;
                        u32x4 w; w.x = cvt_pk_bf16(v0[0], v0[1]); w.y = cvt_pk_bf16(v0[2], v0[3]); w.z = cvt_pk_bf16(v1[0], v1[1]); w.w = cvt_pk_bf16(v1[2], v1[3]);
                        *(u32x4*)(rowp + bj * HALF) = w; } }
        } else if (wc == 0) {
            const f32x4 b0 = *(const f32x4*)(bias + 8 * fq), b1 = *(const f32x4*)(bias + 8 * fq + 4);
#pragma unroll
            for (int ai = 0; ai < 2; ++ai)
#pragma unroll
                for (int m = 0; m < 4; ++m) { float* gp = gates + (size_t)(row0 + ai * HALF + m * 16) * 32 + 8 * fq;
                    *(f32x4*)gp = acc[ai][0][m][0] + b0; *(f32x4*)(gp + 4) = acc[ai][0][m][1] + b1; }
        }
    }
};
struct EpiFf1 {
    static constexpr bool PERM = true, AFTER_DRAIN = false;
    bf16_t* H; bf16_t* PP;
    __device__ __forceinline__ void operator()(const f32x4 (&acc)[2][2][4][2], const Unit& u, int wr, int wc, int fr, int fq) const {
        const int row0 = u.pm * BM + wr * 64 + fr;
        if (u.pn < 16) {
            const int col0 = u.pn * BM + wc * 32 + 8 * fq;
#pragma unroll
            for (int ai = 0; ai < 2; ++ai)
#pragma unroll
                for (int m = 0; m < 4; ++m) { bf16_t* rowp = H + (size_t)(row0 + ai * HALF + m * 16) * 4096 + col0;
#pragma unroll
                    for (int bj = 0; bj < 2; ++bj) { f32x4 v0 = acc[ai][bj][m][0], v1 = acc[ai][bj][m][1];
#pragma unroll
                        for (int e = 0; e < 4; ++e) { const float a = fmaxf(v0[e], 0.f), b = fmaxf(v1[e], 0.f); v0[e] = a * a; v1[e] = b * b; }
                        u32x4 w; w.x = cvt_pk_bf16(v0[0], v0[1]); w.y = cvt_pk_bf16(v0[2], v0[3]); w.z = cvt_pk_bf16(v1[0], v1[1]); w.w = cvt_pk_bf16(v1[2], v1[3]);
                        *(u32x4*)(rowp + bj * HALF) = w; } }
        } else {
            const int col0 = (u.pn - 16) * BM + wc * 32 + 8 * fq;
#pragma unroll
            for (int ai = 0; ai < 2; ++ai)
#pragma unroll
                for (int m = 0; m < 4; ++m) { bf16_t* rowp = PP + (size_t)(row0 + ai * HALF + m * 16) * 1024 + col0;
#pragma unroll
                    for (int bj = 0; bj < 2; ++bj) { f32x4 v0 = acc[ai][bj][m][0], v1 = acc[ai][bj][m][1];
                        const u32x4 pp = *(const u32x4*)(rowp + bj * HALF);
                        const unsigned pw[4] = {pp.x, pp.y, pp.z, pp.w};
#pragma unroll
                        for (int e = 0; e < 2; ++e) {
                            v0[2 * e]     = sigmoidf_(v0[2 * e])     * __uint_as_float(pw[e] << 16);
                            v0[2 * e + 1] = sigmoidf_(v0[2 * e + 1]) * __uint_as_float(pw[e] & 0xffff0000u);
                            v1[2 * e]     = sigmoidf_(v1[2 * e])     * __uint_as_float(pw[2 + e] << 16);
                            v1[2 * e + 1] = sigmoidf_(v1[2 * e + 1]) * __uint_as_float(pw[2 + e] & 0xffff0000u); }
                        u32x4 w; w.x = cvt_pk_bf16(v0[0], v0[1]); w.y = cvt_pk_bf16(v0[2], v0[3]); w.z = cvt_pk_bf16(v1[0], v1[1]); w.w = cvt_pk_bf16(v1[2], v1[3]);
                        *(u32x4*)(rowp + bj * HALF) = w; } }
        }
    }
};
struct EpiResidBf {
    static constexpr bool PERM = true, AFTER_DRAIN = false;
    bf16_t* X; const bf16_t* ple; float alpha;
    __device__ __forceinline__ void operator()(const f32x4 (&acc)[2][2][4][2], const Unit& u, int wr, int wc, int fr, int fq) const {
        const int row0 = u.pm * BM + wr * 64 + fr, col0 = u.pn * BM + wc * 32 + 8 * fq;
#pragma unroll
        for (int ai = 0; ai < 2; ++ai)
#pragma unroll
            for (int m = 0; m < 4; ++m) { const size_t off = (size_t)(row0 + ai * HALF + m * 16) * 1024 + col0;
#pragma unroll
                for (int bj = 0; bj < 2; ++bj) { f32x4 v0 = acc[ai][bj][m][0], v1 = acc[ai][bj][m][1];
                    const u32x4 r = *(const u32x4*)(X + off + bj * HALF);
                    v0[0] += alpha * __uint_as_float(r.x << 16); v0[1] += alpha * __uint_as_float(r.x & 0xffff0000u); v0[2] += alpha * __uint_as_float(r.y << 16); v0[3] += alpha * __uint_as_float(r.y & 0xffff0000u);
                    v1[0] += alpha * __uint_as_float(r.z << 16); v1[1] += alpha * __uint_as_float(r.z & 0xffff0000u); v1[2] += alpha * __uint_as_float(r.w << 16); v1[3] += alpha * __uint_as_float(r.w & 0xffff0000u);
                    if (ple) { const u32x4 p = *(const u32x4*)(ple + off + bj * HALF);
                        v0[0] += __uint_as_float(p.x << 16); v0[1] += __uint_as_float(p.x & 0xffff0000u); v0[2] += __uint_as_float(p.y << 16); v0[3] += __uint_as_float(p.y & 0xffff0000u);
                        v1[0] += __uint_as_float(p.z << 16); v1[1] += __uint_as_float(p.z & 0xffff0000u); v1[2] += __uint_as_float(p.w << 16); v1[3] += __uint_as_float(p.w & 0xffff0000u); }
                    u32x4 w; w.x = cvt_pk_bf16(v0[0], v0[1]); w.y = cvt_pk_bf16(v0[2], v0[3]); w.z = cvt_pk_bf16(v1[0], v1[1]); w.w = cvt_pk_bf16(v1[2], v1[3]);
                    *(u32x4*)(X + off + bj * HALF) = w; } }
    }
};
template <class Epi, class Sched, bool ALIGN_EPI = false, bool SP2 = false>
__device__ __forceinline__ void gemm_phase(PG8_LAS unsigned char* lds, const Gemm g, const Sched& S, const Epi& E) {
    const int tid = threadIdx.x, wid = __builtin_amdgcn_readfirstlane(tid >> 6), lane = tid & 63, wr = wid >> 2, wc = wid & 3, fr = lane & 15, fq = lane >> 4;
    const int K = g.K, nt = K / BK;
    unsigned voffA[2], voffB[2];
#pragma unroll
    for (int i = 0; i < 2; ++i) { int R, C; stage_rc(tid * 16 + i * 8192, R, C); const int Rb = Epi::PERM ? ((R & ~31) + perm32(R & 31)) : R;
        voffA[i] = (unsigned)(R * K + C) * 2u; voffB[i] = (unsigned)(Rb * K + C) * 2u; }
    const size_t kstep = (size_t)(BK * 2);
    const size_t hstep = (size_t)HALF * K * 2;
    const size_t tstep = 2 * hstep;
    const unsigned ldsw = (unsigned)wid * 1024u;
    const int aoff = lds_byte(wr * 64 + fr, fq * 8), boff = lds_byte(wc * 32 + fr, fq * 8);
#define PG8_SA(b, h) (((b) * 2 + (h)) * HTB)
#define PG8_SB(b, h) ((4 + (b) * 2 + (h)) * HTB)
#define PG8_STAGE(bufoff, gbase, voff) do { _Pragma("unroll") for (int _i = 0; _i < 2; ++_i) \
        __builtin_amdgcn_global_load_lds((const unsigned*)((const char*)(gbase) + (voff)[_i]), (PG8_LAS unsigned*)(lds + (bufoff) + ldsw + _i * 8192), 16, 0, 0); } while (0)
#define PG8_LDA(dst, b, h) do { _Pragma("unroll") for (int m = 0; m < 4; ++m) _Pragma("unroll") for (int k = 0; k < 2; ++k) dst[m][k] = *(const PG8_LAS bf16x8*)(lds + PG8_SA(b, h) + aoff + m * 2048 + k * 1024); } while (0)
#define PG8_LDB(dst, b, h) do { _Pragma("unroll") for (int n = 0; n < 2; ++n) _Pragma("unroll") for (int k = 0; k < 2; ++k) dst[n][k] = *(const PG8_LAS bf16x8*)(lds + PG8_SB(b, h) + boff + n * 2048 + k * 1024); } while (0)
#define PG8_MMA(ai, bj, At, Bt) do { __builtin_amdgcn_s_setprio(1); _Pragma("unroll") for (int m = 0; m < 4; ++m) _Pragma("unroll") for (int n = 0; n < 2; ++n) _Pragma("unroll") for (int k = 0; k < 2; ++k) \
        acc[ai][bj][m][n] = __builtin_amdgcn_mfma_f32_16x16x32_bf16(Bt[n][k], At[m][k], acc[ai][bj][m][n], 0, 0, 0); __builtin_amdgcn_s_setprio(0); } while (0)
#define PG8_WAIT_V(n) asm volatile("s_waitcnt vmcnt(" #n ")" ::: "memory")
#define PG8_WAIT_L(n) asm volatile("s_waitcnt lgkmcnt(" #n ")" ::: "memory")
#define PG8_BAR __builtin_amdgcn_s_barrier()
#define PG8_SCHED __builtin_amdgcn_sched_barrier(0)
    Unit cur, nxt; int ui = 0;
    if (!S.next(0, cur)) return;
    f32x4 acc[2][2][4][2];
#pragma unroll
    for (int a = 0; a < 2; ++a)
#pragma unroll
        for (int b = 0; b < 2; ++b)
#pragma unroll
            for (int m = 0; m < 4; ++m)
#pragma unroll
                for (int n = 0; n < 2; ++n) acc[a][b][m][n] = (f32x4){0.f, 0.f, 0.f, 0.f};
    bf16x8 At[4][2], B0[2][2], B1[2][2];
    const char* cA = (const char*)g.A + (size_t)cur.pm * tstep; const char* cB = (const char*)g.Bt + (size_t)cur.pn * tstep;
    S.a_ready(cur);
    if constexpr (SP2) {
        PG8_STAGE(PG8_SB(0, 0), cB, voffB); PG8_STAGE(PG8_SB(0, 1), cB + hstep, voffB); PG8_STAGE(PG8_SA(0, 0), cA, voffA); PG8_STAGE(PG8_SA(0, 1), cA + hstep, voffA);
        if (wr == 1) PG8_BAR;
        PG8_WAIT_V(2); PG8_BAR;
        PG8_STAGE(PG8_SB(1, 0), cB + kstep, voffB); PG8_STAGE(PG8_SA(1, 0), cA + kstep, voffA); PG8_STAGE(PG8_SB(1, 1), cB + hstep + kstep, voffB);
        PG8_WAIT_V(6); PG8_BAR;
    } else {
        PG8_STAGE(PG8_SB(0, 0), cB, voffB); PG8_STAGE(PG8_SA(0, 0), cA, voffA); PG8_STAGE(PG8_SB(0, 1), cB + hstep, voffB); PG8_STAGE(PG8_SA(0, 1), cA + hstep, voffA);
        if (wr == 1) PG8_BAR;
        PG8_WAIT_V(4); PG8_BAR;
        PG8_STAGE(PG8_SB(1, 0), cB + kstep, voffB); PG8_STAGE(PG8_SA(1, 0), cA + kstep, voffA); PG8_STAGE(PG8_SB(1, 1), cB + hstep + kstep, voffB);
        PG8_WAIT_V(6); PG8_BAR;
    }
    for (;;) {
        const bool has_next = S.next(ui + 1, nxt);
        const char* nA = has_next ? (const char*)g.A + (size_t)nxt.pm * tstep : cA; const char* nB = has_next ? (const char*)g.Bt + (size_t)nxt.pn * tstep : cB;
        for (int t = 0; t < nt; t += 2) {
            const bool last = (t == nt - 2);
            const char* a1 = cA + (size_t)(t + 1) * kstep;
            const char* a2 = last ? nA : cA + (size_t)(t + 2) * kstep; const char* b2 = last ? nB : cB + (size_t)(t + 2) * kstep;
            const char* a3 = a2 + kstep; const char* b3 = b2 + kstep;
            if (last && has_next) S.a_ready(nxt);
            if constexpr (SP2) {
            PG8_LDB(B0, 0, 0); PG8_LDB(B1, 0, 1); PG8_SCHED; PG8_LDA(At, 0, 0); PG8_STAGE(PG8_SA(1, 1), a1 + hstep, voffA);
            PG8_WAIT_V(8); PG8_WAIT_L(0); PG8_BAR; PG8_MMA(0, 0, At, B0); PG8_MMA(0, 1, At, B1); PG8_BAR; PG8_SCHED;
            PG8_LDA(At, 0, 1); PG8_STAGE(PG8_SB(0, 0), b2, voffB); PG8_STAGE(PG8_SB(0, 1), b2 + hstep, voffB); PG8_STAGE(PG8_SA(0, 0), a2, voffA);
            PG8_WAIT_V(8); PG8_WAIT_L(0); PG8_BAR; PG8_MMA(1, 0, At, B0); PG8_MMA(1, 1, At, B1); PG8_BAR; PG8_SCHED;
            PG8_LDB(B0, 1, 0); PG8_LDB(B1, 1, 1); PG8_SCHED; PG8_LDA(At, 1, 0); PG8_STAGE(PG8_SA(0, 1), a2 + hstep, voffA);
            PG8_WAIT_V(8); PG8_WAIT_L(0); PG8_BAR; PG8_MMA(0, 0, At, B0); PG8_MMA(0, 1, At, B1); PG8_BAR; PG8_SCHED;
            PG8_LDA(At, 1, 1); PG8_STAGE(PG8_SB(1, 0), b3, voffB); PG8_STAGE(PG8_SB(1, 1), b3 + hstep, voffB); PG8_STAGE(PG8_SA(1, 0), a3, voffA);
            PG8_WAIT_V(8); PG8_WAIT_L(0); PG8_BAR; PG8_MMA(1, 0, At, B0); PG8_MMA(1, 1, At, B1); PG8_BAR; PG8_SCHED;
            } else {
            PG8_LDB(B0, 0, 0); PG8_SCHED; PG8_LDA(At, 0, 0); PG8_STAGE(PG8_SA(1, 1), a1 + hstep, voffA);
            PG8_WAIT_L(8); PG8_BAR; PG8_WAIT_L(0); PG8_MMA(0, 0, At, B0); PG8_BAR; PG8_SCHED;
            PG8_LDB(B1, 0, 1); PG8_STAGE(PG8_SB(0, 0), b2, voffB);
            PG8_BAR; PG8_WAIT_L(0); PG8_MMA(0, 1, At, B1); PG8_BAR;
            PG8_LDA(At, 0, 1); PG8_STAGE(PG8_SA(0, 0), a2, voffA);
            PG8_BAR; PG8_WAIT_L(0); PG8_MMA(1, 0, At, B0); PG8_BAR; PG8_SCHED;
            PG8_STAGE(PG8_SB(0, 1), b2 + hstep, voffB);
            PG8_WAIT_V(6); PG8_BAR; PG8_MMA(1, 1, At, B1); PG8_BAR;
            PG8_LDB(B0, 1, 0); PG8_SCHED; PG8_LDA(At, 1, 0); PG8_STAGE(PG8_SA(0, 1), a2 + hstep, voffA);
            PG8_WAIT_L(8); PG8_BAR; PG8_WAIT_L(0); PG8_MMA(0, 0, At, B0); PG8_BAR; PG8_SCHED;
            PG8_LDB(B1, 1, 1); PG8_STAGE(PG8_SB(1, 0), b3, voffB);
            PG8_BAR; PG8_WAIT_L(0); PG8_MMA(0, 1, At, B1); PG8_BAR;
            PG8_LDA(At, 1, 1); PG8_STAGE(PG8_SA(1, 0), a3, voffA);
            PG8_BAR; PG8_WAIT_L(0); PG8_MMA(1, 0, At, B0); PG8_BAR; PG8_SCHED;
            PG8_STAGE(PG8_SB(1, 1), b3 + hstep, voffB);
            PG8_WAIT_V(6); PG8_BAR; PG8_MMA(1, 1, At, B1); PG8_BAR;
            }
        }
        if constexpr (ALIGN_EPI) { if (wr == 0) PG8_BAR; }
        if constexpr (!Epi::AFTER_DRAIN) { E(acc, cur, wr, wc, fr, fq); S.done(cur); }
        if (!has_next) break;
#pragma unroll
        for (int a = 0; a < 2; ++a)
#pragma unroll
            for (int b = 0; b < 2; ++b)
#pragma unroll
                for (int m = 0; m < 4; ++m)
#pragma unroll
                    for (int n = 0; n < 2; ++n) acc[a][b][m][n] = (f32x4){0.f, 0.f, 0.f, 0.f};
        cur = nxt; cA = nA; cB = nB; ++ui;
        if constexpr (ALIGN_EPI) { if (wr == 1) PG8_BAR; }
    }
    PG8_WAIT_V(0);
    if constexpr (!ALIGN_EPI) { if (wr == 0) PG8_BAR; }
    PG8_BAR;
    if constexpr (Epi::AFTER_DRAIN) { E.fused(acc, cur, wr, wc, fr, fq, lds, wid, lane); S.done(cur); }
#undef PG8_SA
#undef PG8_SB
#undef PG8_STAGE
#undef PG8_LDA
#undef PG8_LDB
#undef PG8_MMA
#undef PG8_WAIT_V
#undef PG8_WAIT_L
#undef PG8_BAR
#undef PG8_SCHED
}
}
#include <hip/hip_bf16.h>
#include <cmath>
namespace attn_body {
using bf16=__hip_bfloat16;
using bf16x8=__attribute__((ext_vector_type(8)))short;
using s16x4=__attribute__((ext_vector_type(4)))short;
using f32x16=__attribute__((ext_vector_type(16)))float;
using u32x4=__attribute__((ext_vector_type(4)))unsigned;
constexpr int BATCH=32,NHEAD=16,SEQ=2048,D=64,DM=1536,OP=1024;
constexpr int NW=8,QBLK=32,QB=QBLK*NW,KVBLK=64,NQB=SEQ/QB;
constexpr int ATTN_PITCH=DM, ATTN_UNIT_ROWS=QB;
__device__ __forceinline__ int crow(int r,int hi){return (r&3)+8*(r>>2)+4*hi;}
#define SBAR() __builtin_amdgcn_sched_barrier(0)
__device__ __forceinline__ void cmask(f32x16&p0,f32x16&p1,int jb,int qrel,int hi){
  const float NEG=-INFINITY; int kb=64*jb+4*hi;
  #pragma unroll
  for(int r=0;r<16;++r){int kv=kb+(r&3)+8*(r>>2); if(kv>qrel)p0[r]=NEG; if(kv+32>qrel)p1[r]=NEG;}
}

constexpr int NSLOT=3, SLOTB=8192;
constexpr int LDS_K=0, LDS_V=NSLOT*SLOTB, LDS_WS=2*NSLOT*SLOTB, LDS_OST=LDS_WS+NW*64*4, LDS_BYTES=LDS_OST+NW*4096;
constexpr float C2=0.125f*1.4426950408889634f;
__device__ __forceinline__ void glds16(const void*gsrc,unsigned lds_dst){unsigned keep;
  asm volatile("s_mov_b32 %0, m0\n\ts_mov_b32 m0, %2\n\ts_nop 0\n\tglobal_load_lds_dwordx4 %1, off\n\ts_mov_b32 m0, %0":"=&s"(keep):"v"(gsrc),"s"(lds_dst):"memory");}
__device__ __forceinline__ float max3f(float a,float b,float c){float r;asm("v_max3_f32 %0, %1, %2, %3":"=v"(r):"v"(a),"v"(b),"v"(c));return r;}
__device__ __forceinline__ float max2f(float a,float b){float r;asm("v_max_f32_e32 %0, %1, %2":"=v"(r):"v"(a),"v"(b));return r;}
__device__ __forceinline__ float fadd_s(float a,float b){float r;asm("v_add_f32_e32 %0, %1, %2":"=v"(r):"v"(a),"v"(b));return r;}
__device__ __forceinline__ float fsub_s(float a,float b){float r;asm("v_sub_f32_e32 %0, %1, %2":"=v"(r):"v"(a),"v"(b));return r;}
typedef float f32x2_t __attribute__((ext_vector_type(2))); typedef __bf16 bf16x2_t __attribute__((ext_vector_type(2)));
__device__ __forceinline__ unsigned cvtpk_s(float lo,float hi){f32x2_t v={lo,hi};bf16x2_t b=__builtin_convertvector(v,bf16x2_t);return __builtin_bit_cast(unsigned,b);}
#define WAIT_BAR(N) asm volatile("s_waitcnt vmcnt(" #N ") lgkmcnt(0)\n\ts_barrier":::"memory")

__device__ __forceinline__ void qkt(f32x16&p0,f32x16&p1,const char*Kslot,const bf16x8*qr,const f32x16&negm,int r32,int hi){
  const char*kb=Kslot+hi*1024+r32*16;
  #pragma unroll
  for(int d0=0;d0<4;++d0){
    const bf16x8 b0=*reinterpret_cast<const bf16x8*>(kb+d0*2048);
    const bf16x8 b1=*reinterpret_cast<const bf16x8*>(kb+d0*2048+512);
    if(d0==0){p0=__builtin_amdgcn_mfma_f32_32x32x16_bf16(b0,qr[0],negm,0,0,0);p1=__builtin_amdgcn_mfma_f32_32x32x16_bf16(b1,qr[0],negm,0,0,0);}
    else{p0=__builtin_amdgcn_mfma_f32_32x32x16_bf16(b0,qr[d0],p0,0,0,0);p1=__builtin_amdgcn_mfma_f32_32x32x16_bf16(b1,qr[d0],p1,0,0,0);}}
}
typedef __attribute__((address_space(3))) const char* lds_cptr;
typedef short v4i16_t __attribute__((ext_vector_type(4)));
__device__ __forceinline__ void kload8(bf16x8*kf,lds_cptr kp){
  kf[0]=*(const __attribute__((address_space(3))) bf16x8*)(kp);      kf[1]=*(const __attribute__((address_space(3))) bf16x8*)(kp+512);
  kf[2]=*(const __attribute__((address_space(3))) bf16x8*)(kp+2048); kf[3]=*(const __attribute__((address_space(3))) bf16x8*)(kp+2560);
  kf[4]=*(const __attribute__((address_space(3))) bf16x8*)(kp+4096); kf[5]=*(const __attribute__((address_space(3))) bf16x8*)(kp+4608);
  kf[6]=*(const __attribute__((address_space(3))) bf16x8*)(kp+6144); kf[7]=*(const __attribute__((address_space(3))) bf16x8*)(kp+6656);
}
__device__ __forceinline__ void kload2(bf16x8*kf,lds_cptr kp,int j){ kf[2*j]=*(const __attribute__((address_space(3))) bf16x8*)(kp+j*2048); kf[2*j+1]=*(const __attribute__((address_space(3))) bf16x8*)(kp+j*2048+512); }
__device__ __forceinline__ s16x4 vtr(lds_cptr p){ return __builtin_bit_cast(s16x4,__builtin_amdgcn_ds_read_tr16_b64_v4i16((__attribute__((address_space(3))) v4i16_t*)p)); }
__device__ __forceinline__ float rowmax(const f32x16&p0,const f32x16&p1){
  float a=max3f(p0[0],p0[1],p1[0]),b=max3f(p0[2],p0[3],p1[1]);a=max3f(a,p1[2],p1[3]);
  #pragma unroll
  for(int r=4;r<16;r+=4){a=max3f(a,p0[r],p0[r+1]);b=max3f(b,p0[r+2],p0[r+3]);a=max3f(a,p1[r],p1[r+1]);b=max3f(b,p1[r+2],p1[r+3]);}
  const float m=max2f(a,b);
  auto rr=__builtin_amdgcn_permlane32_swap(__float_as_uint(m),__float_as_uint(m),false,false);
  return max2f(__uint_as_float(rr[0]),__uint_as_float(rr[1]));
}
__device__ __forceinline__ void pv(f32x16*o,int vb,bf16x8 pa0,bf16x8 pa1,bf16x8 pa2,bf16x8 pa3){
  #pragma unroll
  for(int d0=0;d0<2;++d0){s16x4 lo[4],hi[4];
    #pragma unroll
    for(int ks=0;ks<4;++ks){
      asm volatile("ds_read_b64_tr_b16 %0,%1 offset:%c2":"=&v"(lo[ks]):"v"(vb),"i"(d0*4096+ks*1024):"memory");
      asm volatile("ds_read_b64_tr_b16 %0,%1 offset:%c2":"=&v"(hi[ks]):"v"(vb),"i"(d0*4096+ks*1024+512):"memory");}
    asm volatile("s_waitcnt lgkmcnt(0)":::"memory");SBAR();
    #define PK(k) (bf16x8){lo[k][0],lo[k][1],lo[k][2],lo[k][3],hi[k][0],hi[k][1],hi[k][2],hi[k][3]}
    o[d0]=__builtin_amdgcn_mfma_f32_32x32x16_bf16(pa0,PK(0),o[d0],0,0,0);
    o[d0]=__builtin_amdgcn_mfma_f32_32x32x16_bf16(pa1,PK(1),o[d0],0,0,0);
    o[d0]=__builtin_amdgcn_mfma_f32_32x32x16_bf16(pa2,PK(2),o[d0],0,0,0);
    o[d0]=__builtin_amdgcn_mfma_f32_32x32x16_bf16(pa3,PK(3),o[d0],0,0,0);
    #undef PK
  }
}

#ifndef ATTN_STORE16
#define ATTN_STORE16(p,v) (*(u32x4*)(p)=(v))
#endif
template<int THRL> __device__ __forceinline__ void attn_unit(int b,int h,int qb,const bf16*Q,const bf16*__restrict__ K,const bf16*__restrict__ V,bf16*O,char*shm){
  const int tid=threadIdx.x,lane=tid&63,r32=lane&31,hi=lane>>5; const int wid=__builtin_amdgcn_readfirstlane(tid>>6);
  const long rowbase=(long)b*SEQ; const int q0=qb*QB;
  const bf16*Qw=Q+(rowbase+q0+wid*QBLK)*DM+h*D;
  const bf16*Kh=K+rowbase*DM+(h>>2)*D,*Vh=V+rowbase*DM+(h>>2)*D;
  const unsigned lds0=(unsigned)(uintptr_t)shm;
  float*wsf=(float*)(shm+LDS_WS)+wid*64;
  const bf16*ksrc=Kh+(long)lane*DM+wid*8;
  const bf16*vsrc=Vh+(long)(16*(wid&3)+(lane>>2))*DM+(wid>>2)*32+(lane&3)*8;
  const unsigned kdst=lds0+LDS_K+wid*1024, vdst=lds0+LDS_V+wid*1024;
  #define DMA_K(t,slot) glds16(ksrc+(long)(t)*KVBLK*DM,(unsigned)__builtin_amdgcn_readfirstlane(kdst+(slot)))
  #define DMA_V(t,slot) glds16(vsrc+(long)(t)*KVBLK*DM,(unsigned)__builtin_amdgcn_readfirstlane(vdst+(slot)))
  const int vb0=(int)(lds0+LDS_V)+((lane>>4)&1)*32+(lane&3)*8+(4*hi+((lane&15)>>2))*64;
  const char*Kbase=shm+LDS_K; bf16x8 kf[8];
  const lds_cptr shm3=(lds_cptr)shm; const lds_cptr kp0=shm3+LDS_K+hi*1024+r32*16; const lds_cptr vp0=shm3+LDS_V+((lane>>4)&1)*32+(lane&3)*8+(4*hi+((lane&15)>>2))*64;
  const int NT=SEQ/KVBLK;
  DMA_K(0,0);DMA_V(0,0);DMA_K(1,SLOTB);
  bf16x8 qr[4];
  #pragma unroll
  for(int d0=0;d0<4;++d0)qr[d0]=*reinterpret_cast<const bf16x8*>(&Qw[(long)r32*DM+d0*16+hi*8]);
  float mhat=0.f,l_reg=0.f;f32x16 o[2];o[0]=f32x16{};o[1]=f32x16{};f32x16 negm=f32x16{};asm volatile("":"+v"(negm));

  #define CMASK(P0,P1,t) do{}while(0)
  bool resc=false;
  #define START(P0,P1) do{ const float rm=rowmax(P0,P1); resc=false; \
    { const float dl=rm; mhat=fadd_s(mhat,dl); \
      _Pragma("unroll") for(int r=0;r<16;++r){P0[r]=fsub_s(P0[r],dl);P1[r]=fsub_s(P1[r],dl);} \
      _Pragma("unroll") for(int r=0;r<16;++r)negm[r]=-mhat; asm volatile("":"+v"(negm)); } \
    _Pragma("unroll") for(int r=0;r<16;++r)P0[r]=__builtin_amdgcn_exp2f(P0[r]); }while(0)
  #define RESC() do{ if(resc){ asm volatile("s_waitcnt lgkmcnt(0)":::"memory"); \
      _Pragma("unroll") for(int d_=0;d_<2;++d_) _Pragma("unroll") for(int r=0;r<16;++r)o[d_][r]*=wsf[crow(r,hi)]; } }while(0)
  f32x16 pA0,pA1,pB0,pB1;
  int sl_prev=0,sl_cur=0,sl_next=SLOTB;
  #define ROT() do{sl_prev=sl_cur;sl_cur=sl_next;sl_next=(sl_next==(NSLOT-1)*SLOTB)?0:sl_next+SLOTB;}while(0)
  DMA_K(2,2*SLOTB);
  WAIT_BAR(3);
  qkt(pA0,pA1,Kbase,qr,negm,r32,hi);asm volatile("s_nop 15\n\ts_nop 7":"+v"(pA0),"+v"(pA1));CMASK(pA0,pA1,0);
  START(pA0,pA1);
  _Pragma("unroll") for(int r=0;r<16;++r)pA1[r]=__builtin_amdgcn_exp2f(pA1[r]);
  WAIT_BAR(0);
  DMA_K(3,0);DMA_V(1,SLOTB);
  ROT();
  kload8(kf,kp0+sl_cur);
  WAIT_BAR(2);
  s16x4 vlo[8],vhi[8]; u32x4 pw0,pw1,pw2,pw3;
  #define PKW(P,B) cvtpk_s(P[B],P[B+1])
  #define PAF(k) __builtin_bit_cast(bf16x8,pw##k)
  #define VFR(i) (bf16x8){vlo[i][0],vlo[i][1],vlo[i][2],vlo[i][3],vhi[i][0],vhi[i][1],vhi[i][2],vhi[i][3]}
  #define PIN(x) asm volatile("":"+v"(x))
  #define MX3(a,b,c) __builtin_fmaxf(__builtin_fmaxf((a),(b)),(c))
  #define GAPA(MF,A0,A1,A2,A3,W0,W1,PW) do{ MF; sacc+=A0; sacc+=A1; sacc+=A2; sacc+=A3; PIN(sacc); W0; W1; PIN(PW); SBAR(); }while(0)
  #define EX(v) __builtin_amdgcn_exp2f(v)
  #define GAPB(MF,X,B) do{ MF; X[B]=EX(X[B]); X[B+1]=EX(X[B+1]); X[B+2]=EX(X[B+2]); X[B+3]=EX(X[B+3]); PIN(X); SBAR(); }while(0)
  #define VRD(i) do{ vlo[i]=vtr(vp_+(((i)>>2)*4096+((i)&3)*1024)); vhi[i]=vtr(vp_+(((i)>>2)*4096+((i)&3)*1024+512)); }while(0)
  #define KRD(G,j) do{ if(G){ kload2(kf,kp0+sl_next,j); SBAR(); } }while(0)
  #define STEP(C0,C1,P0,P1,t,GK,GV,GL) do{ SBAR(); \
    const lds_cptr vp_=vp0+sl_prev; \
    VRD(0); SBAR(); float sacc=(P0[0]+P0[1]); \
    GAPA(C0=__builtin_amdgcn_mfma_f32_32x32x16_bf16(kf[0],qr[0],negm,0,0,0), P0[2],P0[3],P0[4],P0[5],     pw0[0]=PKW(P0,0), pw0[1]=PKW(P0,2), pw0); \
    VRD(4); SBAR(); GAPA(C1=__builtin_amdgcn_mfma_f32_32x32x16_bf16(kf[1],qr[0],negm,0,0,0), P0[6],P0[7],P0[8],P0[9],     pw0[2]=PKW(P0,4), pw0[3]=PKW(P0,6), pw0); \
    VRD(1); SBAR(); GAPA(C0=__builtin_amdgcn_mfma_f32_32x32x16_bf16(kf[2],qr[1],C0,0,0,0),   P0[10],P0[11],P0[12],P0[13], pw1[0]=PKW(P0,8), pw1[1]=PKW(P0,10), pw1); \
    VRD(5); SBAR(); GAPA(C1=__builtin_amdgcn_mfma_f32_32x32x16_bf16(kf[3],qr[1],C1,0,0,0),   P0[14],P0[15],P1[0],P1[1],   pw1[2]=PKW(P0,12),pw1[3]=PKW(P0,14), pw1); \
    VRD(2); SBAR(); GAPA(C0=__builtin_amdgcn_mfma_f32_32x32x16_bf16(kf[4],qr[2],C0,0,0,0),   P1[2],P1[3],P1[4],P1[5],     pw2[0]=PKW(P1,0), pw2[1]=PKW(P1,2), pw2); \
    VRD(6); SBAR(); GAPA(C1=__builtin_amdgcn_mfma_f32_32x32x16_bf16(kf[5],qr[2],C1,0,0,0),   P1[6],P1[7],P1[8],P1[9],     pw2[2]=PKW(P1,4), pw2[3]=PKW(P1,6), pw2); \
    VRD(3); SBAR(); GAPA(C0=__builtin_amdgcn_mfma_f32_32x32x16_bf16(kf[6],qr[3],C0,0,0,0),   P1[10],P1[11],P1[12],P1[13], pw3[0]=PKW(P1,8), pw3[1]=PKW(P1,10), pw3); \
    VRD(7); SBAR(); GAPA(C1=__builtin_amdgcn_mfma_f32_32x32x16_bf16(kf[7],qr[3],C1,0,0,0),   P1[14],P1[15],0.f,0.f,       pw3[2]=PKW(P1,12),pw3[3]=PKW(P1,14), pw3); \
    l_reg+=sacc; \
    if(GK){DMA_K((t)+3,sl_cur);} if(GV){DMA_V((t)+1,sl_next);} \
    CMASK(C0,C1,t); \
    { float a=MX3(C0[0],C0[1],C1[0]),b=MX3(C0[2],C0[3],C1[1]); a=MX3(a,C1[2],C1[3]); \
      _Pragma("unroll") for(int r=4;r<16;r+=4){a=MX3(a,C0[r],C0[r+1]);b=MX3(b,C0[r+2],C0[r+3]);a=MX3(a,C1[r],C1[r+1]);b=MX3(b,C1[r+2],C1[r+3]);} \
      float rm=__builtin_fmaxf(a,b); { auto rr=__builtin_amdgcn_permlane32_swap(__float_as_uint(rm),__float_as_uint(rm),false,false); rm=__builtin_fmaxf(__uint_as_float(rr[0]),__uint_as_float(rr[1])); } \
      resc=false; \
      if(__builtin_expect(__any(rm>(float)THRL),0)){ const float dl=__builtin_fmaxf(rm,0.f); mhat+=dl; \
        _Pragma("unroll") for(int r=0;r<16;++r){C0[r]-=dl;C1[r]-=dl;} \
        _Pragma("unroll") for(int r=0;r<16;++r)negm[r]=-mhat; asm volatile("":"+v"(negm)); \
        const float f=__builtin_amdgcn_exp2f(-dl); l_reg*=f; if(hi==0)wsf[r32]=f; resc=true; } } \
    SBAR(); \
    GAPB(o[0]=__builtin_amdgcn_mfma_f32_32x32x16_bf16(PAF(0),VFR(0),o[0],0,0,0), C0,0); \
    GAPB(o[1]=__builtin_amdgcn_mfma_f32_32x32x16_bf16(PAF(0),VFR(4),o[1],0,0,0), C0,4); \
    KRD(GL,0); GAPB(o[0]=__builtin_amdgcn_mfma_f32_32x32x16_bf16(PAF(1),VFR(1),o[0],0,0,0), C0,8); \
    KRD(GL,1); GAPB(o[1]=__builtin_amdgcn_mfma_f32_32x32x16_bf16(PAF(1),VFR(5),o[1],0,0,0), C0,12); \
    KRD(GL,2); GAPB(o[0]=__builtin_amdgcn_mfma_f32_32x32x16_bf16(PAF(2),VFR(2),o[0],0,0,0), C1,0); \
    KRD(GL,3); GAPB(o[1]=__builtin_amdgcn_mfma_f32_32x32x16_bf16(PAF(2),VFR(6),o[1],0,0,0), C1,4); \
    GAPB(o[0]=__builtin_amdgcn_mfma_f32_32x32x16_bf16(PAF(3),VFR(3),o[0],0,0,0), C1,8); \
    GAPB(o[1]=__builtin_amdgcn_mfma_f32_32x32x16_bf16(PAF(3),VFR(7),o[1],0,0,0), C1,12); \
    }while(0)
  int t=1;
  #undef CMASK
  #define CMASK(P0,P1,t) do{}while(0)
  for(;t+5<NT;t+=2){
    STEP(pB0,pB1,pA0,pA1,t,true,true,true);     WAIT_BAR(2); RESC(); ROT();
    STEP(pA0,pA1,pB0,pB1,t+1,true,true,true);   WAIT_BAR(2); RESC(); ROT();
  }
  #undef CMASK
  #define CMASK(P0,P1,t) do{}while(0)
  #define ENDW(tt) do{ if((tt)+3<NT){WAIT_BAR(2);} else if((tt)+2<NT){WAIT_BAR(1);} else {WAIT_BAR(0);} }while(0)
  for(;t+1<NT;t+=2){
    STEP(pB0,pB1,pA0,pA1,t,(t+3<NT),(t+1<NT),(t+1<NT));       ENDW(t);   RESC(); ROT();
    STEP(pA0,pA1,pB0,pB1,t+1,(t+4<NT),(t+2<NT),(t+2<NT));     ENDW(t+1); RESC(); ROT();
  }
  STEP(pB0,pB1,pA0,pA1,NT-1,false,false,false); RESC();
  { float sacc=pB0[0]+pB0[1]; _Pragma("unroll") for(int r=2;r<16;++r)sacc+=pB0[r]; _Pragma("unroll") for(int r=0;r<16;++r)sacc+=pB1[r]; l_reg+=sacc;
    pw0=(u32x4){PKW(pB0,0),PKW(pB0,2),PKW(pB0,4),PKW(pB0,6)};pw1=(u32x4){PKW(pB0,8),PKW(pB0,10),PKW(pB0,12),PKW(pB0,14)};pw2=(u32x4){PKW(pB1,0),PKW(pB1,2),PKW(pB1,4),PKW(pB1,6)};pw3=(u32x4){PKW(pB1,8),PKW(pB1,10),PKW(pB1,12),PKW(pB1,14)};
    SBAR(); pv(o,vb0+sl_cur,PAF(0),PAF(1),PAF(2),PAF(3)); }
  #undef PKW
  #undef PAF
  #undef VFR
  #undef PIN
  #undef MX3
  #undef GAPA
  #undef GAPB
  #undef EX
  #undef VRD
  #undef KRD
  #undef STEP
  #undef ENDW
  {auto rr=__builtin_amdgcn_permlane32_swap(__float_as_uint(l_reg),__float_as_uint(l_reg),false,false);l_reg=__uint_as_float(rr[0])+__uint_as_float(rr[1]);}
  if(hi==0)wsf[32+r32]=l_reg;asm volatile("s_waitcnt lgkmcnt(0)":::"memory");
  float rli[16];
  #pragma unroll
  for(int r=0;r<16;++r)rli[r]=__builtin_amdgcn_rcpf(wsf[32+crow(r,hi)]);
  bf16*Ow=O+(rowbase+q0+wid*QBLK)*OP+h*D;
  { bf16*stg=(bf16*)(shm+LDS_OST)+wid*2048;
    #pragma unroll
    for(int r=0;r<16;++r){const int orow=crow(r,hi);
      #pragma unroll
      for(int d0=0;d0<2;++d0)stg[orow*64+d0*32+r32]=__float2bfloat16(o[d0][r]*rli[r]);}
    asm volatile("s_waitcnt lgkmcnt(0)":::"memory");
    #pragma unroll
    for(int i=0;i<4;++i){const int row=i*8+(lane>>3),ch=lane&7; const u32x4 v=*(const u32x4*)(stg+row*64+ch*8); ATTN_STORE16(Ow+(long)row*OP+ch*8,v);} }
  asm volatile("s_waitcnt lgkmcnt(0)\n\ts_barrier":::"memory");
  #undef DMA_K
  #undef DMA_V
  #undef CMASK
  #undef START
  #undef RESC
  #undef ROT
}
constexpr int ATTN_LDS_BYTES=LDS_BYTES;
struct AttnTensors { const bf16* Q; const bf16* K; const bf16* V; bf16* O; };
struct AttnUnit { int bh; int qb; };
struct StaticOrder {
  int vcu,G;
  __device__ __forceinline__ explicit StaticOrder(int grid,int block):vcu((grid%8==0)?(block%8)*(grid/8)+block/8:block),G(grid){}
  __device__ __forceinline__ bool next(int i,AttnUnit&u)const{ const int x=i*G+vcu; if(x>=BATCH*NHEAD*NQB)return false; u.bh=x>>3; u.qb=x&7; return true; }
  __device__ __forceinline__ void a_ready(const AttnUnit&)const{}
  __device__ __forceinline__ void done(const AttnUnit&)const{}
};
template<class Sched,int THRL=8> __device__ __forceinline__ void attn_phase(char*lds,const AttnTensors&T,const Sched&S){
  AttnUnit u;
  for(int i=0;S.next(i,u);++i){ S.a_ready(u); attn_unit<THRL>(u.bh/NHEAD,u.bh%NHEAD,u.qb,T.Q,T.K,T.V,T.O,lds); S.done(u); }
}
#undef SBAR
#undef WAIT_BAR
}
constexpr int NWAVES = 8;
#ifndef DEPTH_
#define DEPTH_ 4
#endif
constexpr int M = 65536, D = 1024, SEQ = 2048, NBATCH = 32, FF = 4096, DPLE = 256, DEPTH = DEPTH_;
constexpr float DN_ALPHA = 1.6817928305074290f;
constexpr float LN_EPS = 1e-6f;
constexpr size_t MiB = 1u << 20;
constexpr size_t WS_W = 2 * MiB;
constexpr size_t WS_WIN = WS_W, WS_WO = WS_W + 28 * MiB, WS_W1G = WS_W + 36 * MiB, WS_W2 = WS_W + 76 * MiB, WS_WP = WS_W + 108 * MiB;
constexpr size_t WS_XN = 114 * MiB;
constexpr size_t WS_PB = 242 * MiB;
constexpr size_t WS_GATES = 274 * MiB;
constexpr size_t WS_QKV = 282 * MiB;
constexpr size_t WS_O = 698 * MiB;
constexpr size_t WS_PP = 826 * MiB;
constexpr size_t WS_H = 282 * MiB;
constexpr size_t WS_END = 954 * MiB;
constexpr int LDS_BYTES = 163840, LDS_CTL = LDS_BYTES - 512;

#define GAS __attribute__((address_space(1)))
#define LAS __attribute__((address_space(3)))
typedef unsigned short bf16;
typedef unsigned v4u __attribute__((ext_vector_type(4)));
typedef float f32x4 __attribute__((ext_vector_type(4)));
typedef short bf16x8 __attribute__((ext_vector_type(8)));
#define LDS_WAIT() asm volatile("s_waitcnt lgkmcnt(0)" ::: "memory")
typedef float f32x2_t_ __attribute__((ext_vector_type(2))); typedef __bf16 bf16x2_t_ __attribute__((ext_vector_type(2)));
__device__ __forceinline__ unsigned pk2(float lo, float hi) { const f32x2_t_ v = {lo, hi}; const bf16x2_t_ b = __builtin_convertvector(v, bf16x2_t_); return __builtin_bit_cast(unsigned, b); }
__device__ __forceinline__ unsigned f2bf(float f) { return pk2(f, f) & 0xffffu; }
__device__ __forceinline__ float bf2f(unsigned short h) { return __uint_as_float(((unsigned)h) << 16); }
__device__ __forceinline__ f32x4 mfma16(bf16x8 a, bf16x8 b, f32x4 c) { return __builtin_amdgcn_mfma_f32_16x16x32_bf16(a, b, c, 0, 0, 0); }
__device__ __forceinline__ float wave_sum(float v) {
#pragma unroll
    for (int o = 1; o < 64; o <<= 1) v += __shfl_xor(v, o);
    return v;
}

struct Args { const float* in[21]; float* out; unsigned char* ws; int skip, pad; };

__device__ __forceinline__ void p0_transpose_item(const float* W, int K, int N, bf16* WT, int row_off, LAS float* scr, int item, int lane) {
    const int nblk = N / 32, kb = item / nblk, nb = item % nblk, k0 = 64 * kb, n0 = 32 * nb;
#pragma unroll
    for (int i = 0; i < 32; ++i) { const int kk = 2 * i + (lane >> 5); scr[kk * 33 + (lane & 31)] = W[(size_t)(k0 + kk) * N + n0 + (lane & 31)]; }
    LDS_WAIT(); asm volatile("" ::: "memory");
    const int c = lane & 7;
#pragma unroll
    for (int j = 0; j < 4; ++j) { const int n = (lane >> 3) + 8 * j; const LAS float* s = scr + (8 * c) * 33 + n;
        v4u o; o.x = pk2(s[0 * 33], s[1 * 33]); o.y = pk2(s[2 * 33], s[3 * 33]); o.z = pk2(s[4 * 33], s[5 * 33]); o.w = pk2(s[6 * 33], s[7 * 33]);
        *(v4u*)(WT + (size_t)(row_off + n0 + n) * K + k0 + 8 * c) = o; }
    LDS_WAIT(); asm volatile("" ::: "memory");
}
struct WDesc { const float* src; int K, N; bf16* dst; int row_off; };
__device__ __forceinline__ WDesc wdesc(const Args& a, int idx) {
    const int l = idx / 6, kind = idx % 6; WDesc w; unsigned char* ws = a.ws;
    if (kind == 0) { w.K = 1024; w.row_off = 0; w.dst = (bf16*)(ws + WS_WIN + (size_t)l * 7 * MiB);
        if (l == 0) { w.src = a.in[2]; w.N = 3072; } else if (l == 1) { w.src = a.in[5]; w.N = 1536; } else if (l == 2) { w.src = a.in[9]; w.N = 3104; } else { w.src = a.in[2] + (size_t)1024 * 3072; w.N = 3072; } }
    else if (kind == 1) { w.K = 1024; w.N = 1024; w.row_off = 0; w.dst = (bf16*)(ws + WS_WO + (size_t)l * 2 * MiB);
        w.src = (l == 0) ? a.in[4] : (l == 1) ? a.in[8] : (l == 2) ? a.in[12] : a.in[4] + (size_t)1024 * 1024; }
    else if (kind == 2) { w.K = 1024; w.N = 4096; w.row_off = 0; w.dst = (bf16*)(ws + WS_W1G + (size_t)l * 10 * MiB); w.src = a.in[15] + (size_t)l * 1024 * 4096; }
    else if (kind == 3) { w.K = 1024; w.N = 1024; w.row_off = 4096; w.dst = (bf16*)(ws + WS_W1G + (size_t)l * 10 * MiB); w.src = a.in[19] + (size_t)l * 1024 * 1024; }
    else if (kind == 4) { w.K = 4096; w.N = 1024; w.row_off = 0; w.dst = (bf16*)(ws + WS_W2 + (size_t)l * 8 * MiB); w.src = a.in[16] + (size_t)l * 4096 * 1024; }
    else { w.K = 256; w.N = 1024; w.row_off = 0; w.dst = (bf16*)(ws + WS_WP + (size_t)l * (MiB / 2)); w.src = a.in[20] + (size_t)l * 256 * 1024; }
    return w;
}
__device__ __forceinline__ void cvt_rows(const float* src, bf16* dst, size_t n, int G) {
    const size_t nth = (size_t)G * 512, n8 = n / 8;
    for (size_t i = (size_t)blockIdx.x * 512 + threadIdx.x; i < n8; i += nth) {
        const f32x4 a = *(const f32x4*)(src + i * 8), b = *(const f32x4*)(src + i * 8 + 4);
        v4u o; o.x = pk2(a[0], a[1]); o.y = pk2(a[2], a[3]); o.z = pk2(b[0], b[1]); o.w = pk2(b[2], b[3]);
        *(v4u*)(dst + i * 8) = o; }
}
__device__ __forceinline__ void prologue_phase(const Args& a, LAS unsigned char* lds, int G) {
    const int tid = threadIdx.x, lane = tid & 63, wave = tid >> 6;
    LAS float* scr = (LAS float*)(lds + wave * 16384);
    const int gw = blockIdx.x * NWAVES + wave, NGW = G * NWAVES;
    for (int idx = 0; idx < 24; ++idx) { const WDesc w = wdesc(a, idx); const int nitems = (w.K / 64) * (w.N / 32);
        for (int it = gw; it < nitems; it += NGW) p0_transpose_item(w.src, w.K, w.N, w.dst, w.row_off, scr, it, lane); }
    {
        v4u* z = (v4u*)((bf16*)(a.ws + WS_WIN + (size_t)2 * 7 * MiB) + (size_t)3104 * 1024); const size_t n16 = (size_t)224 * 1024 * 2 / 16;
        for (size_t i = (size_t)blockIdx.x * 512 + tid; i < n16; i += (size_t)G * 512) z[i] = (v4u){0u, 0u, 0u, 0u}; }
    cvt_rows(a.in[0], (bf16*)(a.ws + WS_XN), (size_t)M * D, G);
    cvt_rows(a.in[1], (bf16*)(a.ws + WS_PB), (size_t)M * DPLE, G);
}
__device__ __forceinline__ void ln_phase_bf(bf16* X, const float* g, const float* bta, float* outf, int G) {
    const int lane = threadIdx.x & 63, wave = threadIdx.x >> 6; const int gw = blockIdx.x * NWAVES + wave, NGW = G * NWAVES;
    f32x4 gv[4], bv[4];
#pragma unroll
    for (int j = 0; j < 4; ++j) { const int c = (j >> 1) * 512 + 8 * lane + (j & 1) * 4; gv[j] = *(const f32x4*)(g + c); bv[j] = *(const f32x4*)(bta + c); }
    for (int m = gw; m < M; m += NGW) {
        bf16* xr = X + (size_t)m * D + 8 * lane;
        const v4u r0 = *(const v4u*)xr, r1 = *(const v4u*)(xr + 512);
        f32x4 v[4];
        v[0] = (f32x4){__uint_as_float(r0.x << 16), __uint_as_float(r0.x & 0xffff0000u), __uint_as_float(r0.y << 16), __uint_as_float(r0.y & 0xffff0000u)};
        v[1] = (f32x4){__uint_as_float(r0.z << 16), __uint_as_float(r0.z & 0xffff0000u), __uint_as_float(r0.w << 16), __uint_as_float(r0.w & 0xffff0000u)};
        v[2] = (f32x4){__uint_as_float(r1.x << 16), __uint_as_float(r1.x & 0xffff0000u), __uint_as_float(r1.y << 16), __uint_as_float(r1.y & 0xffff0000u)};
        v[3] = (f32x4){__uint_as_float(r1.z << 16), __uint_as_float(r1.z & 0xffff0000u), __uint_as_float(r1.w << 16), __uint_as_float(r1.w & 0xffff0000u)};
        float s = 0.f;
#pragma unroll
        for (int j = 0; j < 4; ++j) s += (v[j][0] + v[j][1]) + (v[j][2] + v[j][3]);
        const float mean = wave_sum(s) * (1.f / D); float s2 = 0.f;
#pragma unroll
        for (int j = 0; j < 4; ++j) { v[j] = v[j] - mean; s2 += (v[j][0] * v[j][0] + v[j][1] * v[j][1]) + (v[j][2] * v[j][2] + v[j][3] * v[j][3]); }
        const float rstd = 1.f / sqrtf(wave_sum(s2) * (1.f / D) + LN_EPS);
#pragma unroll
        for (int j = 0; j < 4; ++j) v[j] = v[j] * rstd * gv[j] + bv[j];
        if (outf) { float* o = outf + (size_t)m * D + 8 * lane; *(f32x4*)o = v[0]; *(f32x4*)(o + 4) = v[1]; *(f32x4*)(o + 512) = v[2]; *(f32x4*)(o + 516) = v[3]; }
        else { *(v4u*)xr = (v4u){pk2(v[0][0], v[0][1]), pk2(v[0][2], v[0][3]), pk2(v[1][0], v[1][1]), pk2(v[1][2], v[1][3])};
               *(v4u*)(xr + 512) = (v4u){pk2(v[2][0], v[2][1]), pk2(v[2][2], v[2][3]), pk2(v[3][0], v[3][1]), pk2(v[3][2], v[3][3])}; }
    }
}

__device__ __forceinline__ void ln_rows32(bf16* X, int row0, const float* g, const float* bta, float* outf) {
    const int lane = threadIdx.x & 63;
    f32x4 gv[4], bv[4];
#pragma unroll
    for (int j = 0; j < 4; ++j) { const int c = (j >> 1) * 512 + 8 * lane + (j & 1) * 4; gv[j] = *(const f32x4*)(g + c); bv[j] = *(const f32x4*)(bta + c); }
    for (int it = 0; it < 8; ++it) {
        v4u r0[4], r1[4];
#pragma unroll
        for (int q = 0; q < 4; ++q) { const bf16* xr = X + (size_t)(row0 + it * 4 + q) * D + 8 * lane; r0[q] = *(const v4u*)xr; r1[q] = *(const v4u*)(xr + 512); }
#pragma unroll
        for (int q = 0; q < 4; ++q) {
            f32x4 v[4];
            v[0] = (f32x4){__uint_as_float(r0[q].x << 16), __uint_as_float(r0[q].x & 0xffff0000u), __uint_as_float(r0[q].y << 16), __uint_as_float(r0[q].y & 0xffff0000u)};
            v[1] = (f32x4){__uint_as_float(r0[q].z << 16), __uint_as_float(r0[q].z & 0xffff0000u), __uint_as_float(r0[q].w << 16), __uint_as_float(r0[q].w & 0xffff0000u)};
            v[2] = (f32x4){__uint_as_float(r1[q].x << 16), __uint_as_float(r1[q].x & 0xffff0000u), __uint_as_float(r1[q].y << 16), __uint_as_float(r1[q].y & 0xffff0000u)};
            v[3] = (f32x4){__uint_as_float(r1[q].z << 16), __uint_as_float(r1[q].z & 0xffff0000u), __uint_as_float(r1[q].w << 16), __uint_as_float(r1[q].w & 0xffff0000u)};
            float s = 0.f;
#pragma unroll
            for (int j = 0; j < 4; ++j) s += (v[j][0] + v[j][1]) + (v[j][2] + v[j][3]);
            const float mean = wave_sum(s) * (1.f / D); float s2 = 0.f;
#pragma unroll
            for (int j = 0; j < 4; ++j) { v[j] = v[j] - mean; s2 += (v[j][0] * v[j][0] + v[j][1] * v[j][1]) + (v[j][2] * v[j][2] + v[j][3] * v[j][3]); }
            const float rstd = 1.f / sqrtf(wave_sum(s2) * (1.f / D) + LN_EPS);
#pragma unroll
            for (int j = 0; j < 4; ++j) v[j] = v[j] * rstd * gv[j] + bv[j];
            const size_t ro = (size_t)(row0 + it * 4 + q) * D + 8 * lane;
            if (outf) { float* o = outf + ro; *(f32x4*)o = v[0]; *(f32x4*)(o + 4) = v[1]; *(f32x4*)(o + 512) = v[2]; *(f32x4*)(o + 516) = v[3]; }
            else { bf16* xr = X + ro; *(v4u*)xr = (v4u){pk2(v[0][0], v[0][1]), pk2(v[0][2], v[0][3]), pk2(v[1][0], v[1][1]), pk2(v[1][2], v[1][3])};
                   *(v4u*)(xr + 512) = (v4u){pk2(v[2][0], v[2][1]), pk2(v[2][2], v[2][3]), pk2(v[3][0], v[3][1]), pk2(v[3][2], v[3][3])}; }
        }
    }
}
struct LnOrder {
    pg8::StaticOrder base; bf16* X; const float* g; const float* bta; float* outf; unsigned* cnt; volatile LAS unsigned* flag;
    __device__ __forceinline__ bool next(int i, pg8::Unit& u) const { return base.next(i, u); }
    __device__ __forceinline__ void a_ready(const pg8::Unit&) const {}
    __device__ __forceinline__ void done(const pg8::Unit& u) const {
        asm volatile("s_waitcnt vmcnt(0)" ::: "memory");
        __builtin_amdgcn_s_barrier();
        if (threadIdx.x == 0) {
            __builtin_amdgcn_fence(__ATOMIC_RELEASE, "agent");
            const unsigned old = __hip_atomic_fetch_add(cnt + u.pm, 1u, __ATOMIC_RELAXED, __HIP_MEMORY_SCOPE_AGENT);
            if (old == 3u) __builtin_amdgcn_fence(__ATOMIC_ACQUIRE, "agent");
            flag[0] = old;
        }
        asm volatile("s_waitcnt vmcnt(0) lgkmcnt(0)" ::: "memory");
        __builtin_amdgcn_s_barrier();
        asm volatile("" ::: "memory");
        if (flag[0] == 3u) ln_rows32(X, u.pm * 256 + (int)(threadIdx.x >> 6) * 32, g, bta, outf);
    }
};

struct PanelLnOrder {
    int nM, G, c; bf16* X; const float* g; const float* bta; float* outf;
    __device__ __forceinline__ bool next(int i, pg8::Unit& u) const { const int p = (i >> 2) * G + c; if (p >= nM) return false; u.pm = p; u.pn = i & 3; return true; }
    __device__ __forceinline__ void a_ready(const pg8::Unit&) const {}
    __device__ __forceinline__ void done(const pg8::Unit& u) const {
        if (u.pn == 3) {
            asm volatile("s_waitcnt vmcnt(0)" ::: "memory");
            __builtin_amdgcn_s_barrier();
            asm volatile("" ::: "memory");
            ln_rows32(X, u.pm * 256 + (int)(threadIdx.x >> 6) * 32, g, bta, outf);
        }
    }
};
typedef unsigned long long u64_t;
__device__ __forceinline__ void na_phase(const bf16* QKV, const float* rpb, bf16* O, LAS unsigned char* lds, int G) {
    const int tid = threadIdx.x, lane = tid & 63, wave = tid >> 6, l15 = lane & 15, quad = lane >> 4;
    const int jq = wave & 3, half = wave >> 2;
    LAS unsigned char* Kimg = lds;
    LAS unsigned char* Vimg = lds + 65536;
    LAS float* scr = (LAS float*)(lds + 131072);
    const int kc0 = (jq == 0) ? 0 : (jq == 1) ? 8 : (jq == 2) ? 24 : 32;
    const int c = jq * 16 + l15, c0 = min(max(c - 8, 0), 48);
    const int scol = tid >> 3, sch = tid & 7;
    for (int bh = blockIdx.x; bh < 512; bh += G) {
        const int b = bh >> 4, h = bh & 15; const size_t tokb = (size_t)b * 2048;
        const bf16* kbase = QKV + (tokb + scol) * 3072 + 1024 + h * 64 + sch * 8;
        const bf16* qbase = QKV + (tokb + c) * 3072 + h * 64 + quad * 8;
        const float* rp = rpb + h * (15 * 31);
        __syncthreads();
#define NA_STAGE_WRITE(kv, vv, slot) do { const int kidx_ = (slot) * 64 + scol; \
            *(LAS v4u*)(Kimg + kidx_ * 128 + ((sch ^ (kidx_ & 7)) * 16)) = (kv); \
            const unsigned vw_[4] = {(vv).x, (vv).y, (vv).z, (vv).w}; \
            _Pragma("unroll") for (int e_ = 0; e_ < 8; ++e_) { const int dh_ = sch * 8 + e_; \
                *(LAS bf16*)(Vimg + ((slot) * 64 + dh_) * 128 + (((scol >> 2) ^ (dh_ & 15)) * 8) + (scol & 3) * 2) = (bf16)((e_ & 1) ? (vw_[e_ >> 1] >> 16) : (vw_[e_ >> 1] & 0xffffu)); } } while (0)
#pragma unroll
        for (int g4 = 0; g4 < 2; ++g4) { v4u kk[4], vv[4];
#pragma unroll
            for (int i = 0; i < 4; ++i) { const bf16* p = kbase + (size_t)(g4 * 4 + i) * 64 * 3072; kk[i] = *(const v4u*)p; vv[i] = *(const v4u*)(p + 1024); }
#pragma unroll
            for (int i = 0; i < 4; ++i) NA_STAGE_WRITE(kk[i], vv[i], g4 * 4 + i); }
        bf16x8 qn0 = *(const bf16x8*)qbase, qn1 = *(const bf16x8*)(qbase + 32);
        __syncthreads();
        int prev_off = 1000; f32x4 bt[4][2];
#pragma unroll
        for (int ai = 0; ai < 4; ++ai) { bt[ai][0] = (f32x4){0.f, 0.f, 0.f, 0.f}; bt[ai][1] = (f32x4){0.f, 0.f, 0.f, 0.f}; }
        for (int r = 0; r < 32; ++r) {
            const int r0 = min(max(r - 4, 0), 24);
            const bf16x8 qf0 = qn0, qf1 = qn1;
            const bool slide = (r + 1 < 32) && (min(max(r - 3, 0), 24) != r0);
            v4u nk = {0u, 0u, 0u, 0u}, nv = {0u, 0u, 0u, 0u};
            if (slide) { const bf16* p = kbase + (size_t)(r0 + 8) * 64 * 3072; nk = *(const v4u*)p; nv = *(const v4u*)(p + 1024); }
            if (r + 1 < 32) { const bf16* p = qbase + (size_t)(r + 1) * 64 * 3072; qn0 = *(const bf16x8*)p; qn1 = *(const bf16x8*)(p + 32); }
            const int off = r0 - r;
            if (off != prev_off) { prev_off = off;
#pragma unroll
                for (int ai = 0; ai < 4; ++ai) { const int dr = off + half * 4 + ai + 7;
#pragma unroll
                    for (int cb = 0; cb < 2; ++cb)
#pragma unroll
                        for (int j = 0; j < 4; ++j) { const int kc = kc0 + cb * 16 + quad * 4 + j; const bool valid = (kc >= c0) && (kc < c0 + 16);
                            const int dc = min(max(kc - c + 15, 0), 30); const float bias = rp[dr * 31 + dc] * 1.4426950408889634f; bt[ai][cb][j] = valid ? bias : -INFINITY; } } }
            f32x4 sc[4][2]; float mx = -INFINITY;
#pragma unroll
            for (int ai = 0; ai < 4; ++ai) { const int slot = (r0 + half * 4 + ai) & 7;
#pragma unroll
                for (int cb = 0; cb < 2; ++cb) { const int kidx = slot * 64 + kc0 + cb * 16 + l15; const LAS unsigned char* ka = Kimg + kidx * 128;
                    const bf16x8 k0 = *(const LAS bf16x8*)(ka + ((quad ^ (kidx & 7)) * 16)), k1 = *(const LAS bf16x8*)(ka + (((quad + 4) ^ (kidx & 7)) * 16));
                    f32x4 acc = {0.f, 0.f, 0.f, 0.f}; acc = mfma16(k0, qf0, acc); acc = mfma16(k1, qf1, acc);
                    acc = acc + bt[ai][cb];
                    mx = fmaxf(fmaxf(fmaxf(mx, acc[0]), fmaxf(acc[1], acc[2])), acc[3]); sc[ai][cb] = acc; } }
            mx = fmaxf(mx, __shfl_xor(mx, 16)); mx = fmaxf(mx, __shfl_xor(mx, 32));
            float sum = 0.f;
#pragma unroll
            for (int ai = 0; ai < 4; ++ai)
#pragma unroll
                for (int cb = 0; cb < 2; ++cb)
#pragma unroll
                    for (int j = 0; j < 4; ++j) { const float p = __builtin_amdgcn_exp2f(sc[ai][cb][j] - mx); sc[ai][cb][j] = p; sum += p; }
            sum += __shfl_xor(sum, 16); sum += __shfl_xor(sum, 32);
            f32x4 o[4];
#pragma unroll
            for (int db = 0; db < 4; ++db) o[db] = (f32x4){0.f, 0.f, 0.f, 0.f};
#pragma unroll
            for (int ai = 0; ai < 4; ++ai) { const int slot = (r0 + half * 4 + ai) & 7;
                const v4u pw = {pk2(sc[ai][0][0], sc[ai][0][1]), pk2(sc[ai][0][2], sc[ai][0][3]), pk2(sc[ai][1][0], sc[ai][1][1]), pk2(sc[ai][1][2], sc[ai][1][3])};
                const bf16x8 pb = __builtin_bit_cast(bf16x8, pw);
                const int ch = (kc0 >> 2) + quad;
#pragma unroll
                for (int db = 0; db < 4; ++db) { const LAS unsigned char* va = Vimg + (slot * 64 + db * 16 + l15) * 128;
                    const u64_t lo = *(const LAS u64_t*)(va + ((ch ^ l15) * 8)), hi = *(const LAS u64_t*)(va + (((ch + 4) ^ l15) * 8));
                    const v4u vw = {(unsigned)lo, (unsigned)(lo >> 32), (unsigned)hi, (unsigned)(hi >> 32)};
                    o[db] = mfma16(__builtin_bit_cast(bf16x8, vw), pb, o[db]); } }
            if (half == 1) { LAS float* s = scr + jq * 18 * 64 + lane; s[0] = mx; s[64] = sum;
#pragma unroll
                for (int db = 0; db < 4; ++db)
#pragma unroll
                    for (int j = 0; j < 4; ++j) s[(2 + db * 4 + j) * 64] = o[db][j]; }
            __syncthreads();
            if (half == 0) { const LAS float* s = scr + jq * 18 * 64 + lane; const float m1 = s[0], l1 = s[64];
                const float m = fmaxf(mx, m1), f0 = __builtin_amdgcn_exp2f(mx - m), f1 = __builtin_amdgcn_exp2f(m1 - m); const float inv = 1.0f / (sum * f0 + l1 * f1);
                const float g0 = f0 * inv, g1 = f1 * inv;
                bf16* op = O + (tokb + r * 64 + c) * 1024 + h * 64 + quad * 4;
#pragma unroll
                for (int db = 0; db < 4; ++db) { float v[4];
#pragma unroll
                    for (int j = 0; j < 4; ++j) v[j] = o[db][j] * g0 + s[(2 + db * 4 + j) * 64] * g1;
                    *(u64_t*)(op + db * 16) = (u64_t)pk2(v[0], v[1]) | ((u64_t)pk2(v[2], v[3]) << 32); } }
            if (slide) NA_STAGE_WRITE(nk, nv, r0 & 7);
            __syncthreads();
        }
#undef NA_STAGE_WRITE
    }
}
__device__ __forceinline__ void gq_normrope_phase(bf16* QKV, const float* qn, const float* kn, int G) {
    const size_t total = (size_t)M * 20 * 8, nth = (size_t)G * 512;
    for (size_t g = (size_t)blockIdx.x * 512 + threadIdx.x; g < total; g += nth) {
        const size_t item = g >> 3; const int l8 = (int)(g & 7); const size_t tok = item / 20; const int hv = (int)(item % 20);
        bf16* p = QKV + tok * 1536 + hv * 64 + l8 * 8;
        const v4u raw = *(const v4u*)p; const unsigned rw[4] = {raw.x, raw.y, raw.z, raw.w};
        float x[8]; float ss = 0.f;
#pragma unroll
        for (int e = 0; e < 4; ++e) { x[2 * e] = __uint_as_float(rw[e] << 16); x[2 * e + 1] = __uint_as_float(rw[e] & 0xffff0000u); ss += x[2 * e] * x[2 * e] + x[2 * e + 1] * x[2 * e + 1]; }
        ss += __shfl_xor(ss, 1); ss += __shfl_xor(ss, 2); ss += __shfl_xor(ss, 4);
        const float rinv = 1.0f / sqrtf(ss * (1.f / 64.f) + 1e-6f);
        const float* gvec = ((hv < 16) ? qn : kn) + l8 * 8;
        const int s = (int)(tok & 2047), row = s >> 6, col = s & 63;
        const float scale = (hv < 16) ? (0.125f * 1.4426950408889634f) : 1.0f;
        unsigned ow[4];
#pragma unroll
        for (int pr = 0; pr < 4; ++pr) { const int i = l8 * 4 + pr; const float pos = (float)((i < 16) ? row : col); const int fi = i & 15;
            const float inv = exp2f(-(float)fi * (13.287712379549449f / 16.f)); const float ang = pos * inv;
            float rev = ang * 0.15915494309189535f; rev -= rintf(rev);
            const float sn = __builtin_amdgcn_sinf(rev), cs = __builtin_amdgcn_cosf(rev);
            const float x0 = x[2 * pr] * rinv * gvec[2 * pr], x1 = x[2 * pr + 1] * rinv * gvec[2 * pr + 1];
            ow[pr] = pk2((x0 * cs - x1 * sn) * scale, (x0 * sn + x1 * cs) * scale); }
        *(v4u*)p = (v4u){ow[0], ow[1], ow[2], ow[3]};
    }
}
__device__ __forceinline__ f32x4 tile_mma64(const LAS bf16* A, int arow0, const LAS bf16* Bt, int brow0, f32x4 acc, int l15, int quad) {
    const LAS bf16* ap = A + (arow0 + l15) * 72 + quad * 8; const LAS bf16* bp = Bt + (brow0 + l15) * 72 + quad * 8;
    acc = mfma16(*(const LAS bf16x8*)ap, *(const LAS bf16x8*)bp, acc);
    acc = mfma16(*(const LAS bf16x8*)(ap + 32), *(const LAS bf16x8*)(bp + 32), acc);
    return acc;
}
__device__ __forceinline__ void ml_phase(const bf16* Z, const float* gates, const float* norm_g, bf16* HFW, bf16* O, LAS unsigned char* lds, int G) {
    const int tid = threadIdx.x, lane = tid & 63, wave = tid >> 6, l15 = lane & 15, quad = lane >> 4;
    LAS bf16* Qs = (LAS bf16*)(lds);
    LAS bf16* Ks = (LAS bf16*)(lds + 9216);
    LAS bf16* Vt = (LAS bf16*)(lds + 18432);
    LAS bf16* Kt = (LAS bf16*)(lds + 39168);
    LAS bf16* Ct = (LAS bf16*)(lds + 48384);
    LAS bf16* As = (LAS bf16*)(lds + 69120);
    LAS float* Hs = (LAS float*)(lds + 78336);
    LAS float* vec = (LAS float*)(lds + 112128);
    for (int unit = blockIdx.x; unit < 256; unit += G) {
        const int b = unit >> 3, h = unit & 7; const size_t tokb = (size_t)b * 2048;
        for (int dir = 0; dir < 2; ++dir) {
            for (int i = tid; i < 144 * 72; i += 512) Ct[i] = 0;
            for (int i = tid; i < 16 * 72; i += 512) Vt[128 * 72 + i] = (i < 72) ? (bf16)0x3F80 : (bf16)0;
            f32x4 cst[4], cst8 = {0.f, 0.f, 0.f, 0.f};
#pragma unroll
            for (int i = 0; i < 4; ++i) cst[i] = (f32x4){0.f, 0.f, 0.f, 0.f};
            float m_run = 0.f;
            const int t8 = tid >> 3, ch = tid & 7;
#define ML_TOK(cs_, t_) (tokb + (size_t)(dir == 0 ? (cs_) * 64 + (t_) : 2047 - ((cs_) * 64 + (t_))))
            v4u pq, pk; bf16x8 pv[2]; float pli = 0.f, pf = 0.f;
#define ML_FETCH(cs_) do { const bf16* zr_ = Z + ML_TOK(cs_, t8) * 3072; pq = *(const v4u*)(zr_ + h * 64 + ch * 8); pk = *(const v4u*)(zr_ + 512 + h * 64 + ch * 8); \
                pv[0] = *(const bf16x8*)(zr_ + 1024 + h * 128 + ch * 8); pv[1] = *(const bf16x8*)(zr_ + 1024 + h * 128 + (ch + 8) * 8); \
                if (wave == 0) { const size_t tk_ = ML_TOK(cs_, lane); pli = gates[tk_ * 32 + dir * 16 + h]; pf = gates[tk_ * 32 + dir * 16 + 8 + h]; } } while (0)
            ML_FETCH(0);
            __syncthreads();
            for (int cs = 0; cs < 32; ++cs) {
                const size_t tok8 = ML_TOK(cs, t8);
                {
                    *(LAS v4u*)(Qs + t8 * 72 + ch * 8) = pq;
                    *(LAS v4u*)(Ks + t8 * 72 + ch * 8) = pk;
#pragma unroll
                    for (int i = 0; i < 2; ++i) { const int c16 = ch + 8 * i;
#pragma unroll
                        for (int e = 0; e < 8; ++e) Vt[(c16 * 8 + e) * 72 + t8] = (bf16)pv[i][e]; }
                }
                const float li = pli, f = pf;
                if (cs + 1 < 32) ML_FETCH(cs + 1);
                v4u hf0 = {0u, 0u, 0u, 0u}, hf1 = {0u, 0u, 0u, 0u}, og0 = {0u, 0u, 0u, 0u}, og1 = {0u, 0u, 0u, 0u};
                if (dir == 1) { const bf16* hp = HFW + tok8 * 1024 + h * 128 + ch * 16; hf0 = *(const v4u*)hp; hf1 = *(const v4u*)(hp + 8);
                    const bf16* og = Z + tok8 * 3072 + 2048 + h * 128 + ch * 16; og0 = *(const v4u*)og; og1 = *(const v4u*)(og + 8); }
                if (wave == 0) {
                    const float lf = fminf(f, 0.f) - log1pf(__expf(-fabsf(f)));
                    float bs = lf;
#pragma unroll
                    for (int o = 1; o < 64; o <<= 1) { const float y = __shfl_up(bs, o); if (lane >= o) bs += y; }
                    const float u = li - bs; float pm = u;
#pragma unroll
                    for (int o = 1; o < 64; o <<= 1) { const float y = __shfl_up(pm, o); if (lane >= o) pm = fmaxf(pm, y); }
                    const float Mt = fmaxf(pm, m_run), sint = __expf(m_run - Mt), mt = bs + Mt;
                    vec[lane] = u; vec[64 + lane] = Mt; vec[128 + lane] = sint; vec[192 + lane] = __expf(-mt);
                    m_run = __shfl(mt, 63);
                }
                __syncthreads();
                {
                    const int tb = wave >> 1;
#pragma unroll
                    for (int i = 0; i < 2; ++i) { const int sb = 2 * (wave & 1) + i;
                        f32x4 acc = {0.f, 0.f, 0.f, 0.f}; if (sb <= tb) acc = tile_mma64(Qs, tb * 16, Ks, sb * 16, acc, l15, quad);
                        const int s = sb * 16 + l15; const float us = vec[s];
#pragma unroll
                        for (int j = 0; j < 4; ++j) { const int t = tb * 16 + 4 * quad + j; const float w = (s <= t) ? __expf(us - vec[64 + t]) : 0.f; As[t * 72 + s] = (bf16)f2bf(acc[j] * w); } }
                    const float w63 = __expf(vec[t8] - vec[64 + 63]);
                    const bf16x8 kk = *(const LAS bf16x8*)(Ks + t8 * 72 + ch * 8);
#pragma unroll
                    for (int e = 0; e < 8; ++e) Kt[(ch * 8 + e) * 72 + t8] = (bf16)f2bf(bf2f((bf16)kk[e]) * w63);
                }
                __syncthreads();
                {
#pragma unroll
                    for (int tb = 0; tb < 4; ++tb) { const f32x4 z4 = {0.f, 0.f, 0.f, 0.f};
                        const f32x4 ah = tile_mma64(As, tb * 16, Vt, wave * 16, z4, l15, quad), ag = tile_mma64(Qs, tb * 16, Ct, wave * 16, z4, l15, quad);
#pragma unroll
                        for (int j = 0; j < 4; ++j) { const int t = tb * 16 + 4 * quad + j; Hs[t * 132 + wave * 16 + l15] = vec[128 + t] * ag[j] + ah[j]; } }
                    if (wave < 4) { const int tb = wave; const f32x4 z4 = {0.f, 0.f, 0.f, 0.f};
                        const f32x4 ah = tile_mma64(As, tb * 16, Vt, 128, z4, l15, quad), ag = tile_mma64(Qs, tb * 16, Ct, 128, z4, l15, quad);
                        if (l15 == 0) {
#pragma unroll
                            for (int j = 0; j < 4; ++j) { const int t = tb * 16 + 4 * quad + j; vec[256 + t] = vec[128 + t] * ag[j] + ah[j]; } } }
                }
                __syncthreads();
                {
                    const float decay = vec[128 + 63];
#pragma unroll
                    for (int db = 0; db < 4; ++db) { cst[db] = tile_mma64(Vt, wave * 16, Kt, db * 16, cst[db] * decay, l15, quad);
#pragma unroll
                        for (int j = 0; j < 4; ++j) Ct[(wave * 16 + 4 * quad + j) * 72 + db * 16 + l15] = (bf16)f2bf(cst[db][j]); }
                    if (wave < 4) { cst8 = tile_mma64(Vt, 128, Kt, wave * 16, cst8 * decay, l15, quad);
#pragma unroll
                        for (int j = 0; j < 4; ++j) Ct[(128 + 4 * quad + j) * 72 + wave * 16 + l15] = (bf16)f2bf(cst8[j]); }
                    const float dn = fmaxf(fabsf(vec[256 + t8]), vec[192 + t8]); const float rd = 1.0f / dn;
                    float hv[16];
#pragma unroll
                    for (int e = 0; e < 16; ++e) hv[e] = Hs[t8 * 132 + ch * 16 + e] * rd;
                    const size_t ho = tok8 * 1024 + h * 128 + ch * 16;
                    if (dir == 0) {
                        v4u w0, w1; w0.x = pk2(hv[0], hv[1]); w0.y = pk2(hv[2], hv[3]); w0.z = pk2(hv[4], hv[5]); w0.w = pk2(hv[6], hv[7]);
                        w1.x = pk2(hv[8], hv[9]); w1.y = pk2(hv[10], hv[11]); w1.z = pk2(hv[12], hv[13]); w1.w = pk2(hv[14], hv[15]);
                        *(v4u*)(HFW + ho) = w0; *(v4u*)(HFW + ho + 8) = w1;
                    } else {
                        const unsigned fw[8] = {hf0.x, hf0.y, hf0.z, hf0.w, hf1.x, hf1.y, hf1.z, hf1.w};
                        float ss = 0.f;
#pragma unroll
                        for (int e = 0; e < 8; ++e) { hv[2 * e] += __uint_as_float(fw[e] << 16); hv[2 * e + 1] += __uint_as_float(fw[e] & 0xffff0000u); ss += hv[2 * e] * hv[2 * e] + hv[2 * e + 1] * hv[2 * e + 1]; }
                        ss += __shfl_xor(ss, 1); ss += __shfl_xor(ss, 2); ss += __shfl_xor(ss, 4);
                        const float rinv = 1.0f / sqrtf(ss * (1.f / 128.f) + 1e-6f);
                        const unsigned gw_[8] = {og0.x, og0.y, og0.z, og0.w, og1.x, og1.y, og1.z, og1.w};
                        const float* ng = norm_g + h * 128 + ch * 16;
                        unsigned ow[8];
#pragma unroll
                        for (int e = 0; e < 8; ++e) { const float o0 = 1.0f / (1.0f + __expf(-__uint_as_float(gw_[e] << 16))), o1 = 1.0f / (1.0f + __expf(-__uint_as_float(gw_[e] & 0xffff0000u)));
                            ow[e] = pk2(hv[2 * e] * rinv * ng[2 * e] * o0, hv[2 * e + 1] * rinv * ng[2 * e + 1] * o1); }
                        *(v4u*)(O + ho) = (v4u){ow[0], ow[1], ow[2], ow[3]}; *(v4u*)(O + ho + 8) = (v4u){ow[4], ow[5], ow[6], ow[7]};
                    }
                }
                __syncthreads();
            }
#undef ML_FETCH
#undef ML_TOK
        }
    }
}
#define RLX_AGENT __ATOMIC_RELAXED, __HIP_MEMORY_SCOPE_AGENT
#define XB_TMO      128
#define XB_XCNT(j)  (256  + 64 * (j))
#define XB_XSUB(j)  (1280 + 64 * (j))
#define XB_XGEN(j)  (2304 + 64 * (j))
#define XB_TOP      3328
#define XB_TOPGEN   3392
#define XCD_BAR_WORDS 3456
#define XB_SPIN_CAP (1u << 18)

__device__ __forceinline__ unsigned xb_ld(unsigned* p)              { return __hip_atomic_load(p, __ATOMIC_RELAXED, __HIP_MEMORY_SCOPE_AGENT); }
__device__ __forceinline__ unsigned xb_add(unsigned* p, unsigned v) { return __hip_atomic_fetch_add(p, v, __ATOMIC_RELAXED, __HIP_MEMORY_SCOPE_AGENT); }
__device__ __forceinline__ unsigned xb_xcc_id() { return (unsigned)__builtin_amdgcn_s_getreg((3 << 11) | 20) & 0xFu; }
#define XB_SPIN(cond, bar) do { unsigned _sp = 0; while (cond) { __builtin_amdgcn_s_sleep(1); \
    if ((++_sp & 255u) == 0u) { if (xb_ld(&(bar)[XB_TMO])) break; if (_sp > XB_SPIN_CAP) { atomicAdd(&(bar)[XB_TMO], 1u); break; } } } } while (0)

struct XcdBarrier {
    unsigned* bar; unsigned x;
    volatile LAS unsigned* st;
};

__device__ __forceinline__ XcdBarrier xcd_barrier_post(unsigned* bar, volatile LAS unsigned* st) {
    XcdBarrier b; b.bar = bar; b.x = xb_xcc_id(); b.st = st;
    if (threadIdx.x == 0) (void)xb_add(&bar[XB_XCNT(b.x)], 1u);
    return b;
}
__device__ __forceinline__ void xcd_barrier_complete(unsigned* bar, unsigned x, unsigned& nloc, unsigned& nx) {
    const unsigned G = gridDim.x * gridDim.y * gridDim.z;
    unsigned sum, cnt, mine, sp = 0u;
    for (;;) {
        sum = 0u; cnt = 0u; mine = 0u;
#pragma unroll
        for (unsigned j = 0; j < 16; ++j) { const unsigned c = xb_ld(&bar[XB_XCNT(j)]); sum += c; cnt += (c > 0u) ? 1u : 0u; mine = (j == x) ? c : mine; }
        if (sum == G) break;
        __builtin_amdgcn_s_sleep(1);
        if ((++sp & 255u) == 0u) { if (xb_ld(&bar[XB_TMO])) break; if (sp > XB_SPIN_CAP) { atomicAdd(&bar[XB_TMO], 1u); break; } }
    }
    nloc = mine > 0u ? mine : 1u; nx = cnt > 0u ? cnt : 1u;
}

__device__ __forceinline__ void xcd_barrier(const XcdBarrier& b) {
    asm volatile("s_waitcnt vmcnt(0)" ::: "memory");
    __syncthreads();
    if (threadIdx.x == 0) {
        unsigned* bar = b.bar;
        __builtin_amdgcn_s_waitcnt(0);
        unsigned nloc = b.st[0], nx = b.st[1];
        if (nloc == 0u) { xcd_barrier_complete(bar, b.x, nloc, nx); b.st[0] = nloc; b.st[1] = nx; }
        const unsigned old = xb_add(&bar[XB_XSUB(b.x)], 1u);
        const unsigned gen = old / nloc;
        if (old + 1u == (gen + 1u) * nloc) {
            __builtin_amdgcn_fence(__ATOMIC_RELEASE, "agent");
            asm volatile("s_waitcnt vmcnt(0)" ::: "memory");
            const unsigned og = xb_add(&bar[XB_TOP], 1u);
            const unsigned tg = og / nx;
            if (og + 1u == (tg + 1u) * nx) xb_add(&bar[XB_TOPGEN], 1u);
            else XB_SPIN(xb_ld(&bar[XB_TOPGEN]) == tg, bar);
            __builtin_amdgcn_fence(__ATOMIC_ACQUIRE, "agent");
            xb_add(&bar[XB_XGEN(b.x)], 1u);
            asm volatile("s_waitcnt vmcnt(0)" ::: "memory");
        } else {
            XB_SPIN(xb_ld(&bar[XB_XGEN(b.x)]) == gen, bar);
            __builtin_amdgcn_fence(__ATOMIC_ACQUIRE, "agent");
            asm volatile("s_waitcnt vmcnt(0)" ::: "memory");
        }
    }
    __syncthreads();
}

#define GSYNC() xcd_barrier(bar)
#define SKIP(bit) ((skipmask >> (bit)) & 1)
template <int L> __device__ __forceinline__ void layer_program(const Args& a, LAS unsigned char* lds, unsigned char* lds_raw, const int G, const XcdBarrier& bar, const int skipmask) {
    constexpr int kind = L % 3;
    unsigned char* ws = a.ws;
    bf16* XN = (bf16*)(ws + WS_XN); bf16* QKV = (bf16*)(ws + WS_QKV); bf16* OB = (bf16*)(ws + WS_O); bf16* PP = (bf16*)(ws + WS_PP); bf16* HB = (bf16*)(ws + WS_H);
    if (!SKIP(1)) { const bf16* Win = (const bf16*)(ws + WS_WIN + (size_t)L * 7 * MiB);
        if constexpr (kind == 2) { pg8::Gemm g{XN, Win, M, 3328, D}; pg8::StaticOrder S; S.init(M, 3328, G, (int)blockIdx.x);
            pg8::EpiMl E{QKV, (float*)(ws + WS_GATES), a.in[10]};
            pg8::gemm_phase<pg8::EpiMl, pg8::StaticOrder, true, true>(lds, g, S, E); }
        else { constexpr int N = (kind == 0) ? 3072 : 1536; pg8::Gemm g{XN, Win, M, N, D}; pg8::StaticOrder S; S.init(M, N, G, (int)blockIdx.x);
            pg8::EpiPlain E{QKV, N, (kind == 0) ? 1024 : 0, 0.125f * 1.4426950408889634f};
            pg8::gemm_phase<pg8::EpiPlain, pg8::StaticOrder, true, true>(lds, g, S, E); } }
    if (!SKIP(2)) { pg8::Gemm g{(const bf16*)(ws + WS_PB), (const bf16*)(ws + WS_WP + (size_t)L * (MiB / 2)), M, D, DPLE}; pg8::StaticOrder S; S.init(M, D, G, (int)blockIdx.x);
        pg8::EpiPlain E{PP, D, 0, 1.f};
        pg8::gemm_phase<pg8::EpiPlain, pg8::StaticOrder, true, true>(lds, g, S, E); }
    GSYNC();
    if constexpr (kind == 1) { if (!SKIP(3)) gq_normrope_phase(QKV, a.in[6], a.in[7], G); GSYNC(); }
    if (!SKIP(4)) {
        if constexpr (kind == 0) na_phase(QKV, a.in[3] + (size_t)(L / 3) * 16 * 15 * 31, OB, lds, G);
        else if constexpr (kind == 1) { const attn_body::AttnTensors AT{(const attn_body::bf16*)QKV, (const attn_body::bf16*)(QKV + 1024), (const attn_body::bf16*)(QKV + 1280), (attn_body::bf16*)OB};
            const attn_body::StaticOrder S(G, (int)blockIdx.x); attn_body::attn_phase<attn_body::StaticOrder>((char*)lds_raw, AT, S); }
        else ml_phase(QKV, (const float*)(ws + WS_GATES), a.in[11], (bf16*)a.out, OB, lds, G);
    }
    GSYNC();
    if (!SKIP(5)) { pg8::Gemm g{OB, (const bf16*)(ws + WS_WO + (size_t)L * 2 * MiB), M, D, D};
        PanelLnOrder S; S.nM = M / 256; S.G = G; S.c = (int)blockIdx.x; S.X = XN; S.g = a.in[13] + (size_t)L * D; S.bta = a.in[14] + (size_t)L * D; S.outf = nullptr;
        pg8::EpiResidBf E{XN, nullptr, DN_ALPHA};
        pg8::gemm_phase<pg8::EpiResidBf, PanelLnOrder, true, true>(lds, g, S, E); }
    GSYNC();
    if (!SKIP(7)) { if constexpr (L + 1 < DEPTH) cvt_rows(a.in[1] + (size_t)(L + 1) * M * DPLE, (bf16*)(ws + WS_PB), (size_t)M * DPLE, G);
        pg8::Gemm g{XN, (const bf16*)(ws + WS_W1G + (size_t)L * 10 * MiB), M, FF + D, D}; pg8::StaticOrder S; S.init(M, FF + D, G, (int)blockIdx.x);
        pg8::EpiFf1 E{HB, PP};
        pg8::gemm_phase<pg8::EpiFf1, pg8::StaticOrder, true, true>(lds, g, S, E); }
    GSYNC();
    if (!SKIP(8)) { pg8::Gemm g{HB, (const bf16*)(ws + WS_W2 + (size_t)L * 8 * MiB), M, D, FF}; pg8::StaticOrder S; S.init(M, D, G, (int)blockIdx.x);
        pg8::EpiResidBf E{XN, PP, DN_ALPHA};
        pg8::gemm_phase<pg8::EpiResidBf, pg8::StaticOrder, true, true>(lds, g, S, E); }
    GSYNC();
    if (!SKIP(9)) ln_phase_bf(XN, a.in[17] + (size_t)L * D, a.in[18] + (size_t)L * D, (L + 1 < DEPTH) ? nullptr : a.out, G);
    if constexpr (L + 1 < DEPTH) GSYNC();
}
__global__ void __launch_bounds__(NWAVES * 64, 2) fwd_megakernel(Args a) {
    extern __shared__ __attribute__((aligned(16))) unsigned char lds_raw[];
    LAS unsigned char* lds = (LAS unsigned char*)lds_raw;
    cg::grid_group grid = cg::this_grid();
    const int G = gridDim.x;
    { volatile LAS unsigned* z = (volatile LAS unsigned*)(lds + LDS_CTL); if (threadIdx.x < 64) z[threadIdx.x] = 0u; }
    __syncthreads();
    const XcdBarrier bar = xcd_barrier_post((unsigned*)a.ws + 4096, (volatile LAS unsigned*)(lds + LDS_CTL + 64));
#ifdef PROBE_SKIP
#ifndef PROBE_LAYERS
#define PROBE_LAYERS 15
#endif
    {
        const int skipmask = a.skip;
        if (!SKIP(0)) prologue_phase(a, lds, G);
        GSYNC();
        if ((PROBE_LAYERS >> 0) & 1) layer_program<0>(a, lds, lds_raw, G, bar, skipmask); GSYNC();
        if ((PROBE_LAYERS >> 1) & 1) layer_program<1>(a, lds, lds_raw, G, bar, skipmask); GSYNC();
        if ((PROBE_LAYERS >> 2) & 1) layer_program<2>(a, lds, lds_raw, G, bar, skipmask); GSYNC();
        if ((PROBE_LAYERS >> 3) & 1) layer_program<3>(a, lds, lds_raw, G, bar, skipmask); GSYNC();
    }
#endif
    {
        const int skipmask = a.pad;
        if (!SKIP(0)) prologue_phase(a, lds, G);
        grid.sync();
        layer_program<0>(a, lds, lds_raw, G, bar, skipmask);
        layer_program<1>(a, lds, lds_raw, G, bar, skipmask);
        layer_program<2>(a, lds, lds_raw, G, bar, skipmask);
        layer_program<3>(a, lds, lds_raw, G, bar, skipmask);
    }
}
#undef SKIP

extern "C" void kernel_launch(void* const* d_in, const int* in_sizes, int n_in, void* d_out, int out_size, void* d_ws, size_t ws_size, hipStream_t stream) {
    static int grid = 0;
    if (grid == 0) {
        if (n_in != 21 || out_size != M * D || ws_size < WS_END) { fprintf(stderr, "kernel_launch: unexpected shapes (n_in %d, out %d, ws %zu)\n", n_in, out_size, ws_size); grid = -1; return; }
        int dev = 0, cus = 0, per_cu = 0;
        hipGetDevice(&dev); hipDeviceGetAttribute(&cus, hipDeviceAttributeMultiprocessorCount, dev);
        if (hipFuncSetAttribute((const void*)fwd_megakernel, hipFuncAttributeMaxDynamicSharedMemorySize, LDS_BYTES) != hipSuccess) { fprintf(stderr, "kernel_launch: hipFuncSetAttribute failed\n"); grid = -1; return; }
        if (hipOccupancyMaxActiveBlocksPerMultiprocessor(&per_cu, (const void*)fwd_megakernel, NWAVES * 64, LDS_BYTES) != hipSuccess || per_cu < 1) per_cu = 1;
        (void)hipGetLastError();
        grid = cus * per_cu;
        fprintf(stderr, "kernel_launch: grid %d (cus %d x %d)\n", grid, cus, per_cu);
    }
    if (grid < 0) return;
    Args a{};
    for (int i = 0; i < 21; ++i) a.in[i] = (const float*)d_in[i];
    a.out = (float*)d_out; a.ws = (unsigned char*)d_ws;
#ifdef PROBE_SKIP
    a.skip = PROBE_SKIP;
#else
    a.skip = 0;
#endif
    a.pad = 0;
    if (hipMemsetAsync(d_ws, 0, 65536, stream) != hipSuccess) { fprintf(stderr, "kernel_launch: hipMemsetAsync failed\n"); return; }
    void* args[] = {&a};
    const hipError_t e = hipLaunchCooperativeKernel((const void*)fwd_megakernel, dim3(grid), dim3(NWAVES * 64), args, LDS_BYTES, stream);
    if (e != hipSuccess) fprintf(stderr, "kernel_launch: cooperative launch failed: %s (grid %d)\n", hipGetErrorString(e), grid);
}
```

```cpp
#include <hip/hip_runtime.h>
#include <hip/hip_cooperative_groups.h>
#include <cstdio>
#include <cstdint>
namespace cg = cooperative_groups;
namespace pg8 {
#define PG8_LAS __attribute__((address_space(3)))
typedef unsigned short bf16_t;
typedef short bf16x8 __attribute__((ext_vector_type(8)));
typedef float f32x4 __attribute__((ext_vector_type(4)));
typedef unsigned u32x4 __attribute__((ext_vector_type(4)));
constexpr int BM = 256, BK = 64, HALF = 128, HTB = HALF * BK * 2  , STAGE_BYTES = 8 * HTB, NXCD = 8, WGM = 8;

__host__ __device__ __forceinline__ int lds_byte(int r, int c) { const int st = (r >> 4) * 2 + (c >> 5), rr = r & 15, cc = c & 31, ob = rr * 64 + cc * 2; return st * 1024 + (ob ^ (((ob >> 9) & 1) << 5)); }
__host__ __device__ __forceinline__ void stage_rc(int b, int& R, int& C) { const int st = b / 1024, sb = b % 1024, swz = sb ^ (((sb >> 9) & 1) << 5); R = (st >> 1) * 16 + swz / 64; C = (st & 1) * 32 + (swz % 64) / 2; }
__host__ __device__ __forceinline__ int perm32(int rho) { const int n = rho >> 4, i = rho & 15; return 8 * (i >> 2) + 4 * n + (i & 3); }

struct Unit { int pm, pn; };
struct Gemm { const bf16_t* A; const bf16_t* Bt; int M, N, K; };

struct StaticOrder {
    int nM, nN, nwg, G, c;
    __host__ __device__ void init(int M, int N, int G_, int c_) { nM = M / BM; nN = N / BM; nwg = nM * nN; G = G_; c = c_; }
    __host__ __device__ bool next(int i, Unit& u) const {
        const long L = (long)i * G + c; if (L >= nwg) return false;
        int wgid = (int)L; { const int q = nwg / NXCD, r = nwg % NXCD, xcd = wgid % NXCD, off = wgid / NXCD; wgid = (xcd < r ? xcd * (q + 1) : r * (q + 1) + (xcd - r) * q) + off; }
        const int nig = WGM * nN, gid = wgid / nig, fm = gid * WGM, gsz = (nM - fm) < WGM ? (nM - fm) : WGM;
        u.pm = fm + ((wgid % nig) % gsz); u.pn = (wgid % nig) / gsz; return true;
    }
    __device__ __forceinline__ void a_ready(const Unit&) const {}
    __device__ __forceinline__ void done(const Unit&) const {}
};

__device__ __forceinline__ unsigned cvt_pk_bf16(float lo, float hi) { unsigned r; asm volatile("v_cvt_pk_bf16_f32 %0, %1, %2" : "=v"(r) : "v"(lo), "v"(hi)); return r; }
typedef float f32x2 __attribute__((ext_vector_type(2)));
__device__ __forceinline__ float bf2f(unsigned short h) { return __uint_as_float(((unsigned)h) << 16); }
__device__ __forceinline__ float sigmoidf_(float x) { return 1.0f / (1.0f + __expf(-x)); }
struct EpiPlain {
    static constexpr bool PERM = true, AFTER_DRAIN = false;
    bf16_t* O; int ldc; int scale_cols; float scale;
    __device__ __forceinline__ void operator()(const f32x4 (&acc)[2][2][4][2], const Unit& u, int wr, int wc, int fr, int fq) const {
        const int row0 = u.pm * BM + wr * 64 + fr, col0 = u.pn * BM + wc * 32 + 8 * fq;
        const float sc = (u.pn * BM < scale_cols) ? scale : 1.f;
#pragma unroll
        for (int ai = 0; ai < 2; ++ai)
#pragma unroll
            for (int m = 0; m < 4; ++m) { bf16_t* rowp = O + (size_t)(row0 + ai * HALF + m * 16) * ldc + col0;
#pragma unroll
                for (int bj = 0; bj < 2; ++bj) { f32x4 v0 = acc[ai][bj][m][0] * sc, v1 = acc[ai][bj][m][1] * sc;
                    u32x4 w; w.x = cvt_pk_bf16(v0[0], v0[1]); w.y = cvt_pk_bf16(v0[2], v0[3]); w.z = cvt_pk_bf16(v1[0], v1[1]); w.w = cvt_pk_bf16(v1[2], v1[3]);
                    *(u32x4*)(rowp + bj * HALF) = w; } }
    }
};
struct EpiMl {
    static constexpr bool PERM = true, AFTER_DRAIN = false;
    bf16_t* O; float* gates; const float* bias;
    __device__ __forceinline__ void operator()(const f32x4 (&acc)[2][2][4][2], const Unit& u, int wr, int wc, int fr, int fq) const {
        const int row0 = u.pm * BM + wr * 64 + fr;
        if (u.pn < 12) {
            const int col0 = u.pn * BM + wc * 32 + 8 * fq; const float sc = (u.pn < 2) ? 0.125f : 1.f;
#pragma unroll
            for (int ai = 0; ai < 2; ++ai)
#pragma unroll
                for (int m = 0; m < 4; ++m) { bf16_t* rowp = O + (size_t)(row0 + ai * HALF + m * 16) * 3072 + col0;
#pragma unroll
                    for (int bj = 0; bj < 2; ++bj) { f32x4 v0 = acc[ai][bj][m][0] * sc, v1 = acc[ai][bj][m][1] * sc;
                        u32x4 w; w.x = cvt_pk_bf16(v0[0], v0[1]); w.y = cvt_pk_bf16(v0[2], v0[3]); w.z = cvt_pk_bf16(v1[0], v1[1]); w.w = cvt_pk_bf16(v1[2], v1[3]);
                        *(u32x4*)(rowp + bj * HALF) = w; } }
        } else if (wc == 0) {
            const f32x4 b0 = *(const f32x4*)(bias + 8 * fq), b1 = *(const f32x4*)(bias + 8 * fq + 4);
#pragma unroll
            for (int ai = 0; ai < 2; ++ai)
#pragma unroll
                for (int m = 0; m < 4; ++m) { float* gp = gates + (size_t)(row0 + ai * HALF + m * 16) * 32 + 8 * fq;
                    *(f32x4*)gp = acc[ai][0][m][0] + b0; *(f32x4*)(gp + 4) = acc[ai][0][m][1] + b1; }
        }
    }
};
struct EpiFf1 {
    static constexpr bool PERM = true, AFTER_DRAIN = false;
    bf16_t* H; bf16_t* PP;
    __device__ __forceinline__ void operator()(const f32x4 (&acc)[2][2][4][2], const Unit& u, int wr, int wc, int fr, int fq) const {
        const int row0 = u.pm * BM + wr * 64 + fr;
        if (u.pn < 16) {
            const int col0 = u.pn * BM + wc * 32 + 8 * fq;
#pragma unroll
            for (int ai = 0; ai < 2; ++ai)
#pragma unroll
                for (int m = 0; m < 4; ++m) { bf16_t* rowp = H + (size_t)(row0 + ai * HALF + m * 16) * 4096 + col0;
#pragma unroll
                    for (int bj = 0; bj < 2; ++bj) { f32x4 v0 = acc[ai][bj][m][0], v1 = acc[ai][bj][m][1];
#pragma unroll
                        for (int e = 0; e < 4; ++e) { const float a = fmaxf(v0[e], 0.f), b = fmaxf(v1[e], 0.f); v0[e] = a * a; v1[e] = b * b; }
                        u32x4 w; w.x = cvt_pk_bf16(v0[0], v0[1]); w.y = cvt_pk_bf16(v0[2], v0[3]); w.z = cvt_pk_bf16(v1[0], v1[1]); w.w = cvt_pk_bf16(v1[2], v1[3]);
                        *(u32x4*)(rowp + bj * HALF) = w; } }
        } else {
            const int col0 = (u.pn - 16) * BM + wc * 32 + 8 * fq;
#pragma unroll
            for (int ai = 0; ai < 2; ++ai)
#pragma unroll
                for (int m = 0; m < 4; ++m) { bf16_t* rowp = PP + (size_t)(row0 + ai * HALF + m * 16) * 1024 + col0;
#pragma unroll
                    for (int bj = 0; bj < 2; ++bj) { f32x4 v0 = acc[ai][bj][m][0], v1 = acc[ai][bj][m][1];
                        const u32x4 pp = *(const u32x4*)(rowp + bj * HALF);
                        const unsigned pw[4] = {pp.x, pp.y, pp.z, pp.w};
#pragma unroll
                        for (int e = 0; e < 2; ++e) {
                            v0[2 * e]     = sigmoidf_(v0[2 * e])     * __uint_as_float(pw[e] << 16);
                            v0[2 * e + 1] = sigmoidf_(v0[2 * e + 1]) * __uint_as_float(pw[e] & 0xffff0000u);
                            v1[2 * e]     = sigmoidf_(v1[2 * e])     * __uint_as_float(pw[2 + e] << 16);
                            v1[2 * e + 1] = sigmoidf_(v1[2 * e + 1]) * __uint_as_float(pw[2 + e] & 0xffff0000u); }
                        u32x4 w; w.x = cvt_pk_bf16(v0[0], v0[1]); w.y = cvt_pk_bf16(v0[2], v0[3]); w.z = cvt_pk_bf16(v1[0], v1[1]); w.w = cvt_pk_bf16(v1[2], v1[3]);
                        *(u32x4*)(rowp + bj * HALF) = w; } }
        }
    }
};
struct EpiResidBf {
    static constexpr bool PERM = true, AFTER_DRAIN = false;
    bf16_t* X; const bf16_t* ple; float alpha;
    __device__ __forceinline__ void operator()(const f32x4 (&acc)[2][2][4][2], const Unit& u, int wr, int wc, int fr, int fq) const {
        const int row0 = u.pm * BM + wr * 64 + fr, col0 = u.pn * BM + wc * 32 + 8 * fq;
#pragma unroll
        for (int ai = 0; ai < 2; ++ai)
#pragma unroll
            for (int m = 0; m < 4; ++m) { const size_t off = (size_t)(row0 + ai * HALF + m * 16) * 1024 + col0;
#pragma unroll
                for (int bj = 0; bj < 2; ++bj) { f32x4 v0 = acc[ai][bj][m][0], v1 = acc[ai][bj][m][1];
                    const u32x4 r = *(const u32x4*)(X + off + bj * HALF);
                    v0[0] += alpha * __uint_as_float(r.x << 16); v0[1] += alpha * __uint_as_float(r.x & 0xffff0000u); v0[2] += alpha * __uint_as_float(r.y << 16); v0[3] += alpha * __uint_as_float(r.y & 0xffff0000u);
                    v1[0] += alpha * __uint_as_float(r.z << 16); v1[1] += alpha * __uint_as_float(r.z & 0xffff0000u); v1[2] += alpha * __uint_as_float(r.w << 16); v1[3] += alpha * __uint_as_float(r.w & 0xffff0000u);
                    if (ple) { const u32x4 p = *(const u32x4*)(ple + off + bj * HALF);
                        v0[0] += __uint_as_float(p.x << 16); v0[1] += __uint_as_float(p.x & 0xffff0000u); v0[2] += __uint_as_float(p.y << 16); v0[3] += __uint_as_float(p.y & 0xffff0000u);
                        v1[0] += __uint_as_float(p.z << 16); v1[1] += __uint_as_float(p.z & 0xffff0000u); v1[2] += __uint_as_float(p.w << 16); v1[3] += __uint_as_float(p.w & 0xffff0000u); }
                    u32x4 w; w.x = cvt_pk_bf16(v0[0], v0[1]); w.y = cvt_pk_bf16(v0[2], v0[3]); w.z = cvt_pk_bf16(v1[0], v1[1]); w.w = cvt_pk_bf16(v1[2], v1[3]);
                    *(u32x4*)(X + off + bj * HALF) = w; } }
    }
};
template <class Epi, class Sched, bool ALIGN_EPI = false, bool SP2 = false>
__device__ __forceinline__ void gemm_phase(PG8_LAS unsigned char* lds, const Gemm g, const Sched& S, const Epi& E) {
    const int tid = threadIdx.x, wid = __builtin_amdgcn_readfirstlane(tid >> 6), lane = tid & 63, wr = wid >> 2, wc = wid & 3, fr = lane & 15, fq = lane >> 4;
    const int K = g.K, nt = K / BK;
    unsigned voffA[2], voffB[2];
#pragma unroll
    for (int i = 0; i < 2; ++i) { int R, C; stage_rc(tid * 16 + i * 8192, R, C); const int Rb = Epi::PERM ? ((R & ~31) + perm32(R & 31)) : R;
        voffA[i] = (unsigned)(R * K + C) * 2u; voffB[i] = (unsigned)(Rb * K + C) * 2u; }
    const size_t kstep = (size_t)(BK * 2);
    const size_t hstep = (size_t)HALF * K * 2;
    const size_t tstep = 2 * hstep;
    const unsigned ldsw = (unsigned)wid * 1024u;
    const int aoff = lds_byte(wr * 64 + fr, fq * 8), boff = lds_byte(wc * 32 + fr, fq * 8);
#define PG8_SA(b, h) (((b) * 2 + (h)) * HTB)
#define PG8_SB(b, h) ((4 + (b) * 2 + (h)) * HTB)
#define PG8_STAGE(bufoff, gbase, voff) do { _Pragma("unroll") for (int _i = 0; _i < 2; ++_i) \
        __builtin_amdgcn_global_load_lds((const unsigned*)((const char*)(gbase) + (voff)[_i]), (PG8_LAS unsigned*)(lds + (bufoff) + ldsw + _i * 8192), 16, 0, 0); } while (0)
#define PG8_LDA(dst, b, h) do { _Pragma("unroll") for (int m = 0; m < 4; ++m) _Pragma("unroll") for (int k = 0; k < 2; ++k) dst[m][k] = *(const PG8_LAS bf16x8*)(lds + PG8_SA(b, h) + aoff + m * 2048 + k * 1024); } while (0)
#define PG8_LDB(dst, b, h) do { _Pragma("unroll") for (int n = 0; n < 2; ++n) _Pragma("unroll") for (int k = 0; k < 2; ++k) dst[n][k] = *(const PG8_LAS bf16x8*)(lds + PG8_SB(b, h) + boff + n * 2048 + k * 1024); } while (0)
#define PG8_MMA(ai, bj, At, Bt) do { __builtin_amdgcn_s_setprio(1); _Pragma("unroll") for (int m = 0; m < 4; ++m) _Pragma("unroll") for (int n = 0; n < 2; ++n) _Pragma("unroll") for (int k = 0; k < 2; ++k) \
        acc[ai][bj][m][n] = __builtin_amdgcn_mfma_f32_16x16x32_bf16(Bt[n][k], At[m][k], acc[ai][bj][m][n], 0, 0, 0); __builtin_amdgcn_s_setprio(0); } while (0)
#define PG8_WAIT_V(n) asm volatile("s_waitcnt vmcnt(" #n ")" ::: "memory")
#define PG8_WAIT_L(n) asm volatile("s_waitcnt lgkmcnt(" #n ")" ::: "memory")
#define PG8_BAR __builtin_amdgcn_s_barrier()
#define PG8_SCHED __builtin_amdgcn_sched_barrier(0)
    Unit cur, nxt; int ui = 0;
    if (!S.next(0, cur)) return;
    f32x4 acc[2][2][4][2];
#pragma unroll
    for (int a = 0; a < 2; ++a)
#pragma unroll
        for (int b = 0; b < 2; ++b)
#pragma unroll
            for (int m = 0; m < 4; ++m)
#pragma unroll
                for (int n = 0; n < 2; ++n) acc[a][b][m][n] = (f32x4){0.f, 0.f, 0.f, 0.f};
    bf16x8 At[4][2], B0[2][2], B1[2][2];
    const char* cA = (const char*)g.A + (size_t)cur.pm * tstep; const char* cB = (const char*)g.Bt + (size_t)cur.pn * tstep;
    S.a_ready(cur);
    if constexpr (SP2) {
        PG8_STAGE(PG8_SB(0, 0), cB, voffB); PG8_STAGE(PG8_SB(0, 1), cB + hstep, voffB); PG8_STAGE(PG8_SA(0, 0), cA, voffA); PG8_STAGE(PG8_SA(0, 1), cA + hstep, voffA);
        if (wr == 1) PG8_BAR;
        PG8_WAIT_V(2); PG8_BAR;
        PG8_STAGE(PG8_SB(1, 0), cB + kstep, voffB); PG8_STAGE(PG8_SA(1, 0), cA + kstep, voffA); PG8_STAGE(PG8_SB(1, 1), cB + hstep + kstep, voffB);
        PG8_WAIT_V(6); PG8_BAR;
    } else {
        PG8_STAGE(PG8_SB(0, 0), cB, voffB); PG8_STAGE(PG8_SA(0, 0), cA, voffA); PG8_STAGE(PG8_SB(0, 1), cB + hstep, voffB); PG8_STAGE(PG8_SA(0, 1), cA + hstep, voffA);
        if (wr == 1) PG8_BAR;
        PG8_WAIT_V(4); PG8_BAR;
        PG8_STAGE(PG8_SB(1, 0), cB + kstep, voffB); PG8_STAGE(PG8_SA(1, 0), cA + kstep, voffA); PG8_STAGE(PG8_SB(1, 1), cB + hstep + kstep, voffB);
        PG8_WAIT_V(6); PG8_BAR;
    }
    for (;;) {
        const bool has_next = S.next(ui + 1, nxt);
        const char* nA = has_next ? (const char*)g.A + (size_t)nxt.pm * tstep : cA; const char* nB = has_next ? (const char*)g.Bt + (size_t)nxt.pn * tstep : cB;
        for (int t = 0; t < nt; t += 2) {
            const bool last = (t == nt - 2);
            const char* a1 = cA + (size_t)(t + 1) * kstep;
            const char* a2 = last ? nA : cA + (size_t)(t + 2) * kstep; const char* b2 = last ? nB : cB + (size_t)(t + 2) * kstep;
            const char* a3 = a2 + kstep; const char* b3 = b2 + kstep;
            if (last && has_next) S.a_ready(nxt);
            if constexpr (SP2) {
            PG8_LDB(B0, 0, 0); PG8_LDB(B1, 0, 1); PG8_SCHED; PG8_LDA(At, 0, 0); PG8_STAGE(PG8_SA(1, 1), a1 + hstep, voffA);
            PG8_WAIT_V(8); PG8_WAIT_L(0); PG8_BAR; PG8_MMA(0, 0, At, B0); PG8_MMA(0, 1, At, B1); PG8_BAR; PG8_SCHED;
            PG8_LDA(At, 0, 1); PG8_STAGE(PG8_SB(0, 0), b2, voffB); PG8_STAGE(PG8_SB(0, 1), b2 + hstep, voffB); PG8_STAGE(PG8_SA(0, 0), a2, voffA);
            PG8_WAIT_V(8); PG8_WAIT_L(0); PG8_BAR; PG8_MMA(1, 0, At, B0); PG8_MMA(1, 1, At, B1); PG8_BAR; PG8_SCHED;
            PG8_LDB(B0, 1, 0); PG8_LDB(B1, 1, 1); PG8_SCHED; PG8_LDA(At, 1, 0); PG8_STAGE(PG8_SA(0, 1), a2 + hstep, voffA);
            PG8_WAIT_V(8); PG8_WAIT_L(0); PG8_BAR; PG8_MMA(0, 0, At, B0); PG8_MMA(0, 1, At, B1); PG8_BAR; PG8_SCHED;
            PG8_LDA(At, 1, 1); PG8_STAGE(PG8_SB(1, 0), b3, voffB); PG8_STAGE(PG8_SB(1, 1), b3 + hstep, voffB); PG8_STAGE(PG8_SA(1, 0), a3, voffA);
            PG8_WAIT_V(8); PG8_WAIT_L(0); PG8_BAR; PG8_MMA(1, 0, At, B0); PG8_MMA(1, 1, At, B1); PG8_BAR; PG8_SCHED;
            } else {
            PG8_LDB(B0, 0, 0); PG8_SCHED; PG8_LDA(At, 0, 0); PG8_STAGE(PG8_SA(1, 1), a1 + hstep, voffA);
            PG8_WAIT_L(8); PG8_BAR; PG8_WAIT_L(0); PG8_MMA(0, 0, At, B0); PG8_BAR; PG8_SCHED;
            PG8_LDB(B1, 0, 1); PG8_STAGE(PG8_SB(0, 0), b2, voffB);
            PG8_BAR; PG8_WAIT_L(0); PG8_MMA(0, 1, At, B1); PG8_BAR;
            PG8_LDA(At, 0, 1); PG8_STAGE(PG8_SA(0, 0), a2, voffA);
            PG8_BAR; PG8_WAIT_L(0); PG8_MMA(1, 0, At, B0); PG8_BAR; PG8_SCHED;
            PG8_STAGE(PG8_SB(0, 1), b2 + hstep, voffB);
            PG8_WAIT_V(6); PG8_BAR; PG8_MMA(1, 1, At, B1); PG8_BAR;
            PG8_LDB(B0, 1, 0); PG8_SCHED; PG8_LDA(At, 1, 0); PG8_STAGE(PG8_SA(0, 1), a2 + hstep, voffA);
            PG8_WAIT_L(8); PG8_BAR; PG8_WAIT_L(0); PG8_MMA(0, 0, At, B0); PG8_BAR; PG8_SCHED;
            PG8_LDB(B1, 1, 1); PG8_STAGE(PG8_SB(1, 0), b3, voffB);
            PG8_BAR; PG8_WAIT_L(0); PG8_MMA(0, 1, At, B1); PG8_BAR;
            PG8_LDA(At, 1, 1); PG8_STAGE(PG8_SA(1, 0), a3, voffA);
            PG8_BAR; PG8_WAIT_L(0); PG8_MMA(1, 0, At, B0); PG8_BAR; PG8_SCHED;
            PG8_STAGE(PG8_SB(1, 1), b3 + hstep, voffB);
            PG8_WAIT_V(6); PG8_BAR; PG8_MMA(1, 1, At, B1); PG8_BAR;
            }
        }
        if constexpr (ALIGN_EPI) { if (wr == 0) PG8_BAR; }
        if constexpr (!Epi::AFTER_DRAIN) { E(acc, cur, wr, wc, fr, fq); S.done(cur); }
        if (!has_next) break;
#pragma unroll
        for (int a = 0; a < 2; ++a)
#pragma unroll
            for (int b = 0; b < 2; ++b)
#pragma unroll
                for (int m = 0; m < 4; ++m)
#pragma unroll
                    for (int n = 0; n < 2; ++n) acc[a][b][m][n] = (f32x4){0.f, 0.f, 0.f, 0.f};
        cur = nxt; cA = nA; cB = nB; ++ui;
        if constexpr (ALIGN_EPI) { if (wr == 1) PG8_BAR; }
    }
    PG8_WAIT_V(0);
    if constexpr (!ALIGN_EPI) { if (wr == 0) PG8_BAR; }
    PG8_BAR;
    if constexpr (Epi::AFTER_DRAIN) { E.fused(acc, cur, wr, wc, fr, fq, lds, wid, lane); S.done(cur); }
#undef PG8_SA
#undef PG8_SB
#undef PG8_STAGE
#undef PG8_LDA
#undef PG8_LDB
#undef PG8_MMA
#undef PG8_WAIT_V
#undef PG8_WAIT_L
#undef PG8_BAR
#undef PG8_SCHED
}
}
#include <hip/hip_bf16.h>
#include <cmath>
namespace attn_body {
using bf16=__hip_bfloat16;
using bf16x8=__attribute__((ext_vector_type(8)))short;
using s16x4=__attribute__((ext_vector_type(4)))short;
using f32x16=__attribute__((ext_vector_type(16)))float;
using u32x4=__attribute__((ext_vector_type(4)))unsigned;
constexpr int BATCH=32,NHEAD=16,SEQ=2048,D=64,DM=1536,OP=1024;
constexpr int NW=8,QBLK=32,QB=QBLK*NW,KVBLK=64,NQB=SEQ/QB;
constexpr int ATTN_PITCH=DM, ATTN_UNIT_ROWS=QB;
__device__ __forceinline__ int crow(int r,int hi){return (r&3)+8*(r>>2)+4*hi;}
#define SBAR() __builtin_amdgcn_sched_barrier(0)
__device__ __forceinline__ void cmask(f32x16&p0,f32x16&p1,int jb,int qrel,int hi){
  const float NEG=-INFINITY; int kb=64*jb+4*hi;
  #pragma unroll
  for(int r=0;r<16;++r){int kv=kb+(r&3)+8*(r>>2); if(kv>qrel)p0[r]=NEG; if(kv+32>qrel)p1[r]=NEG;}
}

constexpr int NSLOT=3, SLOTB=8192;
constexpr int LDS_K=0, LDS_V=NSLOT*SLOTB, LDS_WS=2*NSLOT*SLOTB, LDS_OST=LDS_WS+NW*64*4, LDS_BYTES=LDS_OST+NW*4096;
constexpr float C2=0.125f*1.4426950408889634f;
__device__ __forceinline__ void glds16(const void*gsrc,unsigned lds_dst){unsigned keep;
  asm volatile("s_mov_b32 %0, m0\n\ts_mov_b32 m0, %2\n\ts_nop 0\n\tglobal_load_lds_dwordx4 %1, off\n\ts_mov_b32 m0, %0":"=&s"(keep):"v"(gsrc),"s"(lds_dst):"memory");}
__device__ __forceinline__ float max3f(float a,float b,float c){float r;asm("v_max3_f32 %0, %1, %2, %3":"=v"(r):"v"(a),"v"(b),"v"(c));return r;}
__device__ __forceinline__ float max2f(float a,float b){float r;asm("v_max_f32_e32 %0, %1, %2":"=v"(r):"v"(a),"v"(b));return r;}
__device__ __forceinline__ float fadd_s(float a,float b){float r;asm("v_add_f32_e32 %0, %1, %2":"=v"(r):"v"(a),"v"(b));return r;}
__device__ __forceinline__ float fsub_s(float a,float b){float r;asm("v_sub_f32_e32 %0, %1, %2":"=v"(r):"v"(a),"v"(b));return r;}
typedef float f32x2_t __attribute__((ext_vector_type(2))); typedef __bf16 bf16x2_t __attribute__((ext_vector_type(2)));
__device__ __forceinline__ unsigned cvtpk_s(float lo,float hi){f32x2_t v={lo,hi};bf16x2_t b=__builtin_convertvector(v,bf16x2_t);return __builtin_bit_cast(unsigned,b);}
#define WAIT_BAR(N) asm volatile("s_waitcnt vmcnt(" #N ") lgkmcnt(0)\n\ts_barrier":::"memory")

__device__ __forceinline__ void qkt(f32x16&p0,f32x16&p1,const char*Kslot,const bf16x8*qr,const f32x16&negm,int r32,int hi){
  const char*kb=Kslot+hi*1024+r32*16;
  #pragma unroll
  for(int d0=0;d0<4;++d0){
    const bf16x8 b0=*reinterpret_cast<const bf16x8*>(kb+d0*2048);
    const bf16x8 b1=*reinterpret_cast<const bf16x8*>(kb+d0*2048+512);
    if(d0==0){p0=__builtin_amdgcn_mfma_f32_32x32x16_bf16(b0,qr[0],negm,0,0,0);p1=__builtin_amdgcn_mfma_f32_32x32x16_bf16(b1,qr[0],negm,0,0,0);}
    else{p0=__builtin_amdgcn_mfma_f32_32x32x16_bf16(b0,qr[d0],p0,0,0,0);p1=__builtin_amdgcn_mfma_f32_32x32x16_bf16(b1,qr[d0],p1,0,0,0);}}
}
typedef __attribute__((address_space(3))) const char* lds_cptr;
typedef short v4i16_t __attribute__((ext_vector_type(4)));
__device__ __forceinline__ void kload8(bf16x8*kf,lds_cptr kp){
  kf[0]=*(const __attribute__((address_space(3))) bf16x8*)(kp);      kf[1]=*(const __attribute__((address_space(3))) bf16x8*)(kp+512);
  kf[2]=*(const __attribute__((address_space(3))) bf16x8*)(kp+2048); kf[3]=*(const __attribute__((address_space(3))) bf16x8*)(kp+2560);
  kf[4]=*(const __attribute__((address_space(3))) bf16x8*)(kp+4096); kf[5]=*(const __attribute__((address_space(3))) bf16x8*)(kp+4608);
  kf[6]=*(const __attribute__((address_space(3))) bf16x8*)(kp+6144); kf[7]=*(const __attribute__((address_space(3))) bf16x8*)(kp+6656);
}
__device__ __forceinline__ void kload2(bf16x8*kf,lds_cptr kp,int j){ kf[2*j]=*(const __attribute__((address_space(3))) bf16x8*)(kp+j*2048); kf[2*j+1]=*(const __attribute__((address_space(3))) bf16x8*)(kp+j*2048+512); }
__device__ __forceinline__ s16x4 vtr(lds_cptr p){ return __builtin_bit_cast(s16x4,__builtin_amdgcn_ds_read_tr16_b64_v4i16((__attribute__((address_space(3))) v4i16_t*)p)); }
__device__ __forceinline__ float rowmax(const f32x16&p0,const f32x16&p1){
  float a=max3f(p0[0],p0[1],p1[0]),b=max3f(p0[2],p0[3],p1[1]);a=max3f(a,p1[2],p1[3]);
  #pragma unroll
  for(int r=4;r<16;r+=4){a=max3f(a,p0[r],p0[r+1]);b=max3f(b,p0[r+2],p0[r+3]);a=max3f(a,p1[r],p1[r+1]);b=max3f(b,p1[r+2],p1[r+3]);}
  const float m=max2f(a,b);
  auto rr=__builtin_amdgcn_permlane32_swap(__float_as_uint(m),__float_as_uint(m),false,false);
  return max2f(__uint_as_float(rr[0]),__uint_as_float(rr[1]));
}
__device__ __forceinline__ void pv(f32x16*o,int vb,bf16x8 pa0,bf16x8 pa1,bf16x8 pa2,bf16x8 pa3){
  #pragma unroll
  for(int d0=0;d0<2;++d0){s16x4 lo[4],hi[4];
    #pragma unroll
    for(int ks=0;ks<4;++ks){
      asm volatile("ds_read_b64_tr_b16 %0,%1 offset:%c2":"=&v"(lo[ks]):"v"(vb),"i"(d0*4096+ks*1024):"memory");
      asm volatile("ds_read_b64_tr_b16 %0,%1 offset:%c2":"=&v"(hi[ks]):"v"(vb),"i"(d0*4096+ks*1024+512):"memory");}
    asm volatile("s_waitcnt lgkmcnt(0)":::"memory");SBAR();
    #define PK(k) (bf16x8){lo[k][0],lo[k][1],lo[k][2],lo[k][3],hi[k][0],hi[k][1],hi[k][2],hi[k][3]}
    o[d0]=__builtin_amdgcn_mfma_f32_32x32x16_bf16(pa0,PK(0),o[d0],0,0,0);
    o[d0]=__builtin_amdgcn_mfma_f32_32x32x16_bf16(pa1,PK(1),o[d0],0,0,0);
    o[d0]=__builtin_amdgcn_mfma_f32_32x32x16_bf16(pa2,PK(2),o[d0],0,0,0);
    o[d0]=__builtin_amdgcn_mfma_f32_32x32x16_bf16(pa3,PK(3),o[d0],0,0,0);
    #undef PK
  }
}

#ifndef ATTN_STORE16
#define ATTN_STORE16(p,v) (*(u32x4*)(p)=(v))
#endif
template<int THRL> __device__ __forceinline__ void attn_unit(int b,int h,int qb,const bf16*Q,const bf16*__restrict__ K,const bf16*__restrict__ V,bf16*O,char*shm){
  const int tid=threadIdx.x,lane=tid&63,r32=lane&31,hi=lane>>5; const int wid=__builtin_amdgcn_readfirstlane(tid>>6);
  const long rowbase=(long)b*SEQ; const int q0=qb*QB;
  const bf16*Qw=Q+(rowbase+q0+wid*QBLK)*DM+h*D;
  const bf16*Kh=K+rowbase*DM+(h>>2)*D,*Vh=V+rowbase*DM+(h>>2)*D;
  const unsigned lds0=(unsigned)(uintptr_t)shm;
  float*wsf=(float*)(shm+LDS_WS)+wid*64;
  const bf16*ksrc=Kh+(long)lane*DM+wid*8;
  const bf16*vsrc=Vh+(long)(16*(wid&3)+(lane>>2))*DM+(wid>>2)*32+(lane&3)*8;
  const unsigned kdst=lds0+LDS_K+wid*1024, vdst=lds0+LDS_V+wid*1024;
  #define DMA_K(t,slot) glds16(ksrc+(long)(t)*KVBLK*DM,(unsigned)__builtin_amdgcn_readfirstlane(kdst+(slot)))
  #define DMA_V(t,slot) glds16(vsrc+(long)(t)*KVBLK*DM,(unsigned)__builtin_amdgcn_readfirstlane(vdst+(slot)))
  const int vb0=(int)(lds0+LDS_V)+((lane>>4)&1)*32+(lane&3)*8+(4*hi+((lane&15)>>2))*64;
  const char*Kbase=shm+LDS_K; bf16x8 kf[8];
  const lds_cptr shm3=(lds_cptr)shm; const lds_cptr kp0=shm3+LDS_K+hi*1024+r32*16; const lds_cptr vp0=shm3+LDS_V+((lane>>4)&1)*32+(lane&3)*8+(4*hi+((lane&15)>>2))*64;
  const int NT=SEQ/KVBLK;
  DMA_K(0,0);DMA_V(0,0);DMA_K(1,SLOTB);
  bf16x8 qr[4];
  #pragma unroll
  for(int d0=0;d0<4;++d0)qr[d0]=*reinterpret_cast<const bf16x8*>(&Qw[(long)r32*DM+d0*16+hi*8]);
  float mhat=0.f,l_reg=0.f;f32x16 o[2];o[0]=f32x16{};o[1]=f32x16{};f32x16 negm=f32x16{};asm volatile("":"+v"(negm));

  #define CMASK(P0,P1,t) do{}while(0)
  bool resc=false;
  #define START(P0,P1) do{ const float rm=rowmax(P0,P1); resc=false; \
    { const float dl=rm; mhat=fadd_s(mhat,dl); \
      _Pragma("unroll") for(int r=0;r<16;++r){P0[r]=fsub_s(P0[r],dl);P1[r]=fsub_s(P1[r],dl);} \
      _Pragma("unroll") for(int r=0;r<16;++r)negm[r]=-mhat; asm volatile("":"+v"(negm)); } \
    _Pragma("unroll") for(int r=0;r<16;++r)P0[r]=__builtin_amdgcn_exp2f(P0[r]); }while(0)
  #define RESC() do{ if(resc){ asm volatile("s_waitcnt lgkmcnt(0)":::"memory"); \
      _Pragma("unroll") for(int d_=0;d_<2;++d_) _Pragma("unroll") for(int r=0;r<16;++r)o[d_][r]*=wsf[crow(r,hi)]; } }while(0)
  f32x16 pA0,pA1,pB0,pB1;
  int sl_prev=0,sl_cur=0,sl_next=SLOTB;
  #define ROT() do{sl_prev=sl_cur;sl_cur=sl_next;sl_next=(sl_next==(NSLOT-1)*SLOTB)?0:sl_next+SLOTB;}while(0)
  DMA_K(2,2*SLOTB);
  WAIT_BAR(3);
  qkt(pA0,pA1,Kbase,qr,negm,r32,hi);asm volatile("s_nop 15\n\ts_nop 7":"+v"(pA0),"+v"(pA1));CMASK(pA0,pA1,0);
  START(pA0,pA1);
  _Pragma("unroll") for(int r=0;r<16;++r)pA1[r]=__builtin_amdgcn_exp2f(pA1[r]);
  WAIT_BAR(0);
  DMA_K(3,0);DMA_V(1,SLOTB);
  ROT();
  kload8(kf,kp0+sl_cur);
  WAIT_BAR(2);
  s16x4 vlo[8],vhi[8]; u32x4 pw0,pw1,pw2,pw3;
  #define PKW(P,B) cvtpk_s(P[B],P[B+1])
  #define PAF(k) __builtin_bit_cast(bf16x8,pw##k)
  #define VFR(i) (bf16x8){vlo[i][0],vlo[i][1],vlo[i][2],vlo[i][3],vhi[i][0],vhi[i][1],vhi[i][2],vhi[i][3]}
  #define PIN(x) asm volatile("":"+v"(x))
  #define MX3(a,b,c) __builtin_fmaxf(__builtin_fmaxf((a),(b)),(c))
  #define GAPA(MF,A0,A1,A2,A3,W0,W1,PW) do{ MF; sacc+=A0; sacc+=A1; sacc+=A2; sacc+=A3; PIN(sacc); W0; W1; PIN(PW); SBAR(); }while(0)
  #define EX(v) __builtin_amdgcn_exp2f(v)
  #define GAPB(MF,X,B) do{ MF; X[B]=EX(X[B]); X[B+1]=EX(X[B+1]); X[B+2]=EX(X[B+2]); X[B+3]=EX(X[B+3]); PIN(X); SBAR(); }while(0)
  #define VRD(i) do{ vlo[i]=vtr(vp_+(((i)>>2)*4096+((i)&3)*1024)); vhi[i]=vtr(vp_+(((i)>>2)*4096+((i)&3)*1024+512)); }while(0)
  #define KRD(G,j) do{ if(G){ kload2(kf,kp0+sl_next,j); SBAR(); } }while(0)
  #define STEP(C0,C1,P0,P1,t,GK,GV,GL) do{ SBAR(); \
    const lds_cptr vp_=vp0+sl_prev; \
    VRD(0); SBAR(); float sacc=(P0[0]+P0[1]); \
    GAPA(C0=__builtin_amdgcn_mfma_f32_32x32x16_bf16(kf[0],qr[0],negm,0,0,0), P0[2],P0[3],P0[4],P0[5],     pw0[0]=PKW(P0,0), pw0[1]=PKW(P0,2), pw0); \
    VRD(4); SBAR(); GAPA(C1=__builtin_amdgcn_mfma_f32_32x32x16_bf16(kf[1],qr[0],negm,0,0,0), P0[6],P0[7],P0[8],P0[9],     pw0[2]=PKW(P0,4), pw0[3]=PKW(P0,6), pw0); \
    VRD(1); SBAR(); GAPA(C0=__builtin_amdgcn_mfma_f32_32x32x16_bf16(kf[2],qr[1],C0,0,0,0),   P0[10],P0[11],P0[12],P0[13], pw1[0]=PKW(P0,8), pw1[1]=PKW(P0,10), pw1); \
    VRD(5); SBAR(); GAPA(C1=__builtin_amdgcn_mfma_f32_32x32x16_bf16(kf[3],qr[1],C1,0,0,0),   P0[14],P0[15],P1[0],P1[1],   pw1[2]=PKW(P0,12),pw1[3]=PKW(P0,14), pw1); \
    VRD(2); SBAR(); GAPA(C0=__builtin_amdgcn_mfma_f32_32x32x16_bf16(kf[4],qr[2],C0,0,0,0),   P1[2],P1[3],P1[4],P1[5],     pw2[0]=PKW(P1,0), pw2[1]=PKW(P1,2), pw2); \
    VRD(6); SBAR(); GAPA(C1=__builtin_amdgcn_mfma_f32_32x32x16_bf16(kf[5],qr[2],C1,0,0,0),   P1[6],P1[7],P1[8],P1[9],     pw2[2]=PKW(P1,4), pw2[3]=PKW(P1,6), pw2); \
    VRD(3); SBAR(); GAPA(C0=__builtin_amdgcn_mfma_f32_32x32x16_bf16(kf[6],qr[3],C0,0,0,0),   P1[10],P1[11],P1[12],P1[13], pw3[0]=PKW(P1,8), pw3[1]=PKW(P1,10), pw3); \
    VRD(7); SBAR(); GAPA(C1=__builtin_amdgcn_mfma_f32_32x32x16_bf16(kf[7],qr[3],C1,0,0,0),   P1[14],P1[15],0.f,0.f,       pw3[2]=PKW(P1,12),pw3[3]=PKW(P1,14), pw3); \
    l_reg+=sacc; \
    if(GK){DMA_K((t)+3,sl_cur);} if(GV){DMA_V((t)+1,sl_next);} \
    CMASK(C0,C1,t); \
    { float a=MX3(C0[0],C0[1],C1[0]),b=MX3(C0[2],C0[3],C1[1]); a=MX3(a,C1[2],C1[3]); \
      _Pragma("unroll") for(int r=4;r<16;r+=4){a=MX3(a,C0[r],C0[r+1]);b=MX3(b,C0[r+2],C0[r+3]);a=MX3(a,C1[r],C1[r+1]);b=MX3(b,C1[r+2],C1[r+3]);} \
      float rm=__builtin_fmaxf(a,b); { auto rr=__builtin_amdgcn_permlane32_swap(__float_as_uint(rm),__float_as_uint(rm),false,false); rm=__builtin_fmaxf(__uint_as_float(rr[0]),__uint_as_float(rr[1])); } \
      resc=false; \
      if(__builtin_expect(__any(rm>(float)THRL),0)){ const float dl=__builtin_fmaxf(rm,0.f); mhat+=dl; \
        _Pragma("unroll") for(int r=0;r<16;++r){C0[r]-=dl;C1[r]-=dl;} \
        _Pragma("unroll") for(int r=0;r<16;++r)negm[r]=-mhat; asm volatile("":"+v"(negm)); \
        const float f=__builtin_amdgcn_exp2f(-dl); l_reg*=f; if(hi==0)wsf[r32]=f; resc=true; } } \
    SBAR(); \
    GAPB(o[0]=__builtin_amdgcn_mfma_f32_32x32x16_bf16(PAF(0),VFR(0),o[0],0,0,0), C0,0); \
    GAPB(o[1]=__builtin_amdgcn_mfma_f32_32x32x16_bf16(PAF(0),VFR(4),o[1],0,0,0), C0,4); \
    KRD(GL,0); GAPB(o[0]=__builtin_amdgcn_mfma_f32_32x32x16_bf16(PAF(1),VFR(1),o[0],0,0,0), C0,8); \
    KRD(GL,1); GAPB(o[1]=__builtin_amdgcn_mfma_f32_32x32x16_bf16(PAF(1),VFR(5),o[1],0,0,0), C0,12); \
    KRD(GL,2); GAPB(o[0]=__builtin_amdgcn_mfma_f32_32x32x16_bf16(PAF(2),VFR(2),o[0],0,0,0), C1,0); \
    KRD(GL,3); GAPB(o[1]=__builtin_amdgcn_mfma_f32_32x32x16_bf16(PAF(2),VFR(6),o[1],0,0,0), C1,4); \
    GAPB(o[0]=__builtin_amdgcn_mfma_f32_32x32x16_bf16(PAF(3),VFR(3),o[0],0,0,0), C1,8); \
    GAPB(o[1]=__builtin_amdgcn_mfma_f32_32x32x16_bf16(PAF(3),VFR(7),o[1],0,0,0), C1,12); \
    }while(0)
  int t=1;
  #undef CMASK
  #define CMASK(P0,P1,t) do{}while(0)
  for(;t+5<NT;t+=2){
    STEP(pB0,pB1,pA0,pA1,t,true,true,true);     WAIT_BAR(2); RESC(); ROT();
    STEP(pA0,pA1,pB0,pB1,t+1,true,true,true);   WAIT_BAR(2); RESC(); ROT();
  }
  #undef CMASK
  #define CMASK(P0,P1,t) do{}while(0)
  #define ENDW(tt) do{ if((tt)+3<NT){WAIT_BAR(2);} else if((tt)+2<NT){WAIT_BAR(1);} else {WAIT_BAR(0);} }while(0)
  for(;t+1<NT;t+=2){
    STEP(pB0,pB1,pA0,pA1,t,(t+3<NT),(t+1<NT),(t+1<NT));       ENDW(t);   RESC(); ROT();
    STEP(pA0,pA1,pB0,pB1,t+1,(t+4<NT),(t+2<NT),(t+2<NT));     ENDW(t+1); RESC(); ROT();
  }
  STEP(pB0,pB1,pA0,pA1,NT-1,false,false,false); RESC();
  { float sacc=pB0[0]+pB0[1]; _Pragma("unroll") for(int r=2;r<16;++r)sacc+=pB0[r]; _Pragma("unroll") for(int r=0;r<16;++r)sacc+=pB1[r]; l_reg+=sacc;
    pw0=(u32x4){PKW(pB0,0),PKW(pB0,2),PKW(pB0,4),PKW(pB0,6)};pw1=(u32x4){PKW(pB0,8),PKW(pB0,10),PKW(pB0,12),PKW(pB0,14)};pw2=(u32x4){PKW(pB1,0),PKW(pB1,2),PKW(pB1,4),PKW(pB1,6)};pw3=(u32x4){PKW(pB1,8),PKW(pB1,10),PKW(pB1,12),PKW(pB1,14)};
    SBAR(); pv(o,vb0+sl_cur,PAF(0),PAF(1),PAF(2),PAF(3)); }
  #undef PKW
  #undef PAF
  #undef VFR
  #undef PIN
  #undef MX3
  #undef GAPA
  #undef GAPB
  #undef EX
  #undef VRD
  #undef KRD
  #undef STEP
  #undef ENDW
  {auto rr=__builtin_amdgcn_permlane32_swap(__float_as_uint(l_reg),__float_as_uint(l_reg),false,false);l_reg=__uint_as_float(rr[0])+__uint_as_float(rr[1]);}
  if(hi==0)wsf[32+r32]=l_reg;asm volatile("s_waitcnt lgkmcnt(0)":::"memory");
  float rli[16];
  #pragma unroll
  for(int r=0;r<16;++r)rli[r]=__builtin_amdgcn_rcpf(wsf[32+crow(r,hi)]);
  bf16*Ow=O+(rowbase+q0+wid*QBLK)*OP+h*D;
  { bf16*stg=(bf16*)(shm+LDS_OST)+wid*2048;
    #pragma unroll
    for(int r=0;r<16;++r){const int orow=crow(r,hi);
      #pragma unroll
      for(int d0=0;d0<2;++d0)stg[orow*64+d0*32+r32]=__float2bfloat16(o[d0][r]*rli[r]);}
    asm volatile("s_waitcnt lgkmcnt(0)":::"memory");
    #pragma unroll
    for(int i=0;i<4;++i){const int row=i*8+(lane>>3),ch=lane&7; const u32x4 v=*(const u32x4*)(stg+row*64+ch*8); ATTN_STORE16(Ow+(long)row*OP+ch*8,v);} }
  asm volatile("s_waitcnt lgkmcnt(0)\n\ts_barrier":::"memory");
  #undef DMA_K
  #undef DMA_V
  #undef CMASK
  #undef START
  #undef RESC
  #undef ROT
}
constexpr int ATTN_LDS_BYTES=LDS_BYTES;
struct AttnTensors { const bf16* Q; const bf16* K; const bf16* V; bf16* O; };
struct AttnUnit { int bh; int qb; };
struct StaticOrder {
  int vcu,G;
  __device__ __forceinline__ explicit StaticOrder(int grid,int block):vcu((grid%8==0)?(block%8)*(grid/8)+block/8:block),G(grid){}
  __device__ __forceinline__ bool next(int i,AttnUnit&u)const{ const int x=i*G+vcu; if(x>=BATCH*NHEAD*NQB)return false; u.bh=x>>3; u.qb=x&7; return true; }
  __device__ __forceinline__ void a_ready(const AttnUnit&)const{}
  __device__ __forceinline__ void done(const AttnUnit&)const{}
};
template<class Sched,int THRL=8> __device__ __forceinline__ void attn_phase(char*lds,const AttnTensors&T,const Sched&S){
  AttnUnit u;
  for(int i=0;S.next(i,u);++i){ S.a_ready(u); attn_unit<THRL>(u.bh/NHEAD,u.bh%NHEAD,u.qb,T.Q,T.K,T.V,T.O,lds); S.done(u); }
}
#undef SBAR
#undef WAIT_BAR
}
constexpr int NWAVES = 8;
#ifndef DEPTH_
#define DEPTH_ 4
#endif
constexpr int M = 65536, D = 1024, SEQ = 2048, NBATCH = 32, FF = 4096, DPLE = 256, DEPTH = DEPTH_;
constexpr float DN_ALPHA = 1.6817928305074290f;
constexpr float LN_EPS = 1e-6f;
constexpr size_t MiB = 1u << 20;
constexpr size_t WS_W = 2 * MiB;
constexpr size_t WS_WIN = WS_W, WS_WO = WS_W + 28 * MiB, WS_W1G = WS_W + 36 * MiB, WS_W2 = WS_W + 76 * MiB, WS_WP = WS_W + 108 * MiB;
constexpr size_t WS_XN = 114 * MiB;
constexpr size_t WS_PB = 242 * MiB;
constexpr size_t WS_GATES = 274 * MiB;
constexpr size_t WS_QKV = 282 * MiB;
constexpr size_t WS_O = 698 * MiB;
constexpr size_t WS_PP = 826 * MiB;
constexpr size_t WS_H = 282 * MiB;
constexpr size_t WS_END = 954 * MiB;
constexpr int LDS_BYTES = 163840, LDS_CTL = LDS_BYTES - 512;

#define GAS __attribute__((address_space(1)))
#define LAS __attribute__((address_space(3)))
typedef unsigned short bf16;
typedef unsigned v4u __attribute__((ext_vector_type(4)));
typedef float f32x4 __attribute__((ext_vector_type(4)));
typedef short bf16x8 __attribute__((ext_vector_type(8)));
#define LDS_WAIT() asm volatile("s_waitcnt lgkmcnt(0)" ::: "memory")
typedef float f32x2_t_ __attribute__((ext_vector_type(2))); typedef __bf16 bf16x2_t_ __attribute__((ext_vector_type(2)));
__device__ __forceinline__ unsigned pk2(float lo, float hi) { const f32x2_t_ v = {lo, hi}; const bf16x2_t_ b = __builtin_convertvector(v, bf16x2_t_); return __builtin_bit_cast(unsigned, b); }
__device__ __forceinline__ unsigned f2bf(float f) { return pk2(f, f) & 0xffffu; }
__device__ __forceinline__ float bf2f(unsigned short h) { return __uint_as_float(((unsigned)h) << 16); }
__device__ __forceinline__ f32x4 mfma16(bf16x8 a, bf16x8 b, f32x4 c) { return __builtin_amdgcn_mfma_f32_16x16x32_bf16(a, b, c, 0, 0, 0); }
__device__ __forceinline__ float wave_sum(float v) {
#pragma unroll
    for (int o = 1; o < 64; o <<= 1) v += __shfl_xor(v, o);
    return v;
}

struct Args { const float* in[21]; float* out; unsigned char* ws; int skip, pad; };

__device__ __forceinline__ void p0_transpose_item(const float* W, int K, int N, bf16* WT, int row_off, LAS float* scr, int item, int lane) {
    const int nblk = N / 32, kb = item / nblk, nb = item % nblk, k0 = 64 * kb, n0 = 32 * nb;
#pragma unroll
    for (int i = 0; i < 32; ++i) { const int kk = 2 * i + (lane >> 5); scr[kk * 33 + (lane & 31)] = W[(size_t)(k0 + kk) * N + n0 + (lane & 31)]; }
    LDS_WAIT(); asm volatile("" ::: "memory");
    const int c = lane & 7;
#pragma unroll
    for (int j = 0; j < 4; ++j) { const int n = (lane >> 3) + 8 * j; const LAS float* s = scr + (8 * c) * 33 + n;
        v4u o; o.x = pk2(s[0 * 33], s[1 * 33]); o.y = pk2(s[2 * 33], s[3 * 33]); o.z = pk2(s[4 * 33], s[5 * 33]); o.w = pk2(s[6 * 33], s[7 * 33]);
        *(v4u*)(WT + (size_t)(row_off + n0 + n) * K + k0 + 8 * c) = o; }
    LDS_WAIT(); asm volatile("" ::: "memory");
}
struct WDesc { const float* src; int K, N; bf16* dst; int row_off; };
__device__ __forceinline__ WDesc wdesc(const Args& a, int idx) {
    const int l = idx / 6, kind = idx % 6; WDesc w; unsigned char* ws = a.ws;
    if (kind == 0) { w.K = 1024; w.row_off = 0; w.dst = (bf16*)(ws + WS_WIN + (size_t)l * 7 * MiB);
        if (l == 0) { w.src = a.in[2]; w.N = 3072; } else if (l == 1) { w.src = a.in[5]; w.N = 1536; } else if (l == 2) { w.src = a.in[9]; w.N = 3104; } else { w.src = a.in[2] + (size_t)1024 * 3072; w.N = 3072; } }
    else if (kind == 1) { w.K = 1024; w.N = 1024; w.row_off = 0; w.dst = (bf16*)(ws + WS_WO + (size_t)l * 2 * MiB);
        w.src = (l == 0) ? a.in[4] : (l == 1) ? a.in[8] : (l == 2) ? a.in[12] : a.in[4] + (size_t)1024 * 1024; }
    else if (kind == 2) { w.K = 1024; w.N = 4096; w.row_off = 0; w.dst = (bf16*)(ws + WS_W1G + (size_t)l * 10 * MiB); w.src = a.in[15] + (size_t)l * 1024 * 4096; }
    else if (kind == 3) { w.K = 1024; w.N = 1024; w.row_off = 4096; w.dst = (bf16*)(ws + WS_W1G + (size_t)l * 10 * MiB); w.src = a.in[19] + (size_t)l * 1024 * 1024; }
    else if (kind == 4) { w.K = 4096; w.N = 1024; w.row_off = 0; w.dst = (bf16*)(ws + WS_W2 + (size_t)l * 8 * MiB); w.src = a.in[16] + (size_t)l * 4096 * 1024; }
    else { w.K = 256; w.N = 1024; w.row_off = 0; w.dst = (bf16*)(ws + WS_WP + (size_t)l * (MiB / 2)); w.src = a.in[20] + (size_t)l * 256 * 1024; }
    return w;
}
__device__ __forceinline__ void cvt_rows(const float* src, bf16* dst, size_t n, int G) {
    const size_t nth = (size_t)G * 512, n8 = n / 8;
    for (size_t i0 = (size_t)blockIdx.x * 512 + threadIdx.x; i0 < n8; i0 += 4 * nth) {
        f32x4 a[4], b[4];
#pragma unroll
        for (int q = 0; q < 4; ++q) { const size_t i = i0 + q * nth; if (i < n8) { a[q] = *(const f32x4*)(src + i * 8); b[q] = *(const f32x4*)(src + i * 8 + 4); } }
#pragma unroll
        for (int q = 0; q < 4; ++q) { const size_t i = i0 + q * nth; if (i < n8) { v4u o; o.x = pk2(a[q][0], a[q][1]); o.y = pk2(a[q][2], a[q][3]); o.z = pk2(b[q][0], b[q][1]); o.w = pk2(b[q][2], b[q][3]);
            *(v4u*)(dst + i * 8) = o; } }
    }
}
__device__ __forceinline__ void prologue_phase(const Args& a, LAS unsigned char* lds, int G) {
    const int tid = threadIdx.x, lane = tid & 63, wave = tid >> 6;
    LAS float* scr = (LAS float*)(lds + wave * 16384);
    const int gw = blockIdx.x * NWAVES + wave, NGW = G * NWAVES;
    for (int idx = 0; idx < 24; ++idx) { const WDesc w = wdesc(a, idx); const int nitems = (w.K / 64) * (w.N / 32);
        for (int it = gw; it < nitems; it += NGW) p0_transpose_item(w.src, w.K, w.N, w.dst, w.row_off, scr, it, lane); }
    {
        v4u* z = (v4u*)((bf16*)(a.ws + WS_WIN + (size_t)2 * 7 * MiB) + (size_t)3104 * 1024); const size_t n16 = (size_t)224 * 1024 * 2 / 16;
        for (size_t i = (size_t)blockIdx.x * 512 + tid; i < n16; i += (size_t)G * 512) z[i] = (v4u){0u, 0u, 0u, 0u}; }
    cvt_rows(a.in[0], (bf16*)(a.ws + WS_XN), (size_t)M * D, G);
    cvt_rows(a.in[1], (bf16*)(a.ws + WS_PB), (size_t)M * DPLE, G);
}
__device__ __forceinline__ void ln_phase_bf(bf16* X, const float* g, const float* bta, float* outf, int G) {
    const int lane = threadIdx.x & 63, wave = threadIdx.x >> 6; const int gw = blockIdx.x * NWAVES + wave, NGW = G * NWAVES;
    f32x4 gv[4], bv[4];
#pragma unroll
    for (int j = 0; j < 4; ++j) { const int c = (j >> 1) * 512 + 8 * lane + (j & 1) * 4; gv[j] = *(const f32x4*)(g + c); bv[j] = *(const f32x4*)(bta + c); }
    for (int m = gw; m < M; m += NGW) {
        bf16* xr = X + (size_t)m * D + 8 * lane;
        const v4u r0 = *(const v4u*)xr, r1 = *(const v4u*)(xr + 512);
        f32x4 v[4];
        v[0] = (f32x4){__uint_as_float(r0.x << 16), __uint_as_float(r0.x & 0xffff0000u), __uint_as_float(r0.y << 16), __uint_as_float(r0.y & 0xffff0000u)};
        v[1] = (f32x4){__uint_as_float(r0.z << 16), __uint_as_float(r0.z & 0xffff0000u), __uint_as_float(r0.w << 16), __uint_as_float(r0.w & 0xffff0000u)};
        v[2] = (f32x4){__uint_as_float(r1.x << 16), __uint_as_float(r1.x & 0xffff0000u), __uint_as_float(r1.y << 16), __uint_as_float(r1.y & 0xffff0000u)};
        v[3] = (f32x4){__uint_as_float(r1.z << 16), __uint_as_float(r1.z & 0xffff0000u), __uint_as_float(r1.w << 16), __uint_as_float(r1.w & 0xffff0000u)};
        float s = 0.f;
#pragma unroll
        for (int j = 0; j < 4; ++j) s += (v[j][0] + v[j][1]) + (v[j][2] + v[j][3]);
        const float mean = wave_sum(s) * (1.f / D); float s2 = 0.f;
#pragma unroll
        for (int j = 0; j < 4; ++j) { v[j] = v[j] - mean; s2 += (v[j][0] * v[j][0] + v[j][1] * v[j][1]) + (v[j][2] * v[j][2] + v[j][3] * v[j][3]); }
        const float rstd = 1.f / sqrtf(wave_sum(s2) * (1.f / D) + LN_EPS);
#pragma unroll
        for (int j = 0; j < 4; ++j) v[j] = v[j] * rstd * gv[j] + bv[j];
        if (outf) { float* o = outf + (size_t)m * D + 8 * lane; *(f32x4*)o = v[0]; *(f32x4*)(o + 4) = v[1]; *(f32x4*)(o + 512) = v[2]; *(f32x4*)(o + 516) = v[3]; }
        else { *(v4u*)xr = (v4u){pk2(v[0][0], v[0][1]), pk2(v[0][2], v[0][3]), pk2(v[1][0], v[1][1]), pk2(v[1][2], v[1][3])};
               *(v4u*)(xr + 512) = (v4u){pk2(v[2][0], v[2][1]), pk2(v[2][2], v[2][3]), pk2(v[3][0], v[3][1]), pk2(v[3][2], v[3][3])}; }
    }
}

__device__ __forceinline__ void ln_rows32(bf16* X, int row0, const float* g, const float* bta, float* outf) {
    const int lane = threadIdx.x & 63;
    f32x4 gv[4], bv[4];
#pragma unroll
    for (int j = 0; j < 4; ++j) { const int c = (j >> 1) * 512 + 8 * lane + (j & 1) * 4; gv[j] = *(const f32x4*)(g + c); bv[j] = *(const f32x4*)(bta + c); }
    for (int it = 0; it < 8; ++it) {
        v4u r0[4], r1[4];
#pragma unroll
        for (int q = 0; q < 4; ++q) { const bf16* xr = X + (size_t)(row0 + it * 4 + q) * D + 8 * lane; r0[q] = *(const v4u*)xr; r1[q] = *(const v4u*)(xr + 512); }
#pragma unroll
        for (int q = 0; q < 4; ++q) {
            f32x4 v[4];
            v[0] = (f32x4){__uint_as_float(r0[q].x << 16), __uint_as_float(r0[q].x & 0xffff0000u), __uint_as_float(r0[q].y << 16), __uint_as_float(r0[q].y & 0xffff0000u)};
            v[1] = (f32x4){__uint_as_float(r0[q].z << 16), __uint_as_float(r0[q].z & 0xffff0000u), __uint_as_float(r0[q].w << 16), __uint_as_float(r0[q].w & 0xffff0000u)};
            v[2] = (f32x4){__uint_as_float(r1[q].x << 16), __uint_as_float(r1[q].x & 0xffff0000u), __uint_as_float(r1[q].y << 16), __uint_as_float(r1[q].y & 0xffff0000u)};
            v[3] = (f32x4){__uint_as_float(r1[q].z << 16), __uint_as_float(r1[q].z & 0xffff0000u), __uint_as_float(r1[q].w << 16), __uint_as_float(r1[q].w & 0xffff0000u)};
            float s = 0.f;
#pragma unroll
            for (int j = 0; j < 4; ++j) s += (v[j][0] + v[j][1]) + (v[j][2] + v[j][3]);
            const float mean = wave_sum(s) * (1.f / D); float s2 = 0.f;
#pragma unroll
            for (int j = 0; j < 4; ++j) { v[j] = v[j] - mean; s2 += (v[j][0] * v[j][0] + v[j][1] * v[j][1]) + (v[j][2] * v[j][2] + v[j][3] * v[j][3]); }
            const float rstd = 1.f / sqrtf(wave_sum(s2) * (1.f / D) + LN_EPS);
#pragma unroll
            for (int j = 0; j < 4; ++j) v[j] = v[j] * rstd * gv[j] + bv[j];
            const size_t ro = (size_t)(row0 + it * 4 + q) * D + 8 * lane;
            if (outf) { float* o = outf + ro; *(f32x4*)o = v[0]; *(f32x4*)(o + 4) = v[1]; *(f32x4*)(o + 512) = v[2]; *(f32x4*)(o + 516) = v[3]; }
            else { bf16* xr = X + ro; *(v4u*)xr = (v4u){pk2(v[0][0], v[0][1]), pk2(v[0][2], v[0][3]), pk2(v[1][0], v[1][1]), pk2(v[1][2], v[1][3])};
                   *(v4u*)(xr + 512) = (v4u){pk2(v[2][0], v[2][1]), pk2(v[2][2], v[2][3]), pk2(v[3][0], v[3][1]), pk2(v[3][2], v[3][3])}; }
        }
    }
}
struct LnOrder {
    pg8::StaticOrder base; bf16* X; const float* g; const float* bta; float* outf; unsigned* cnt; volatile LAS unsigned* flag;
    __device__ __forceinline__ bool next(int i, pg8::Unit& u) const { return base.next(i, u); }
    __device__ __forceinline__ void a_ready(const pg8::Unit&) const {}
    __device__ __forceinline__ void done(const pg8::Unit& u) const {
        asm volatile("s_waitcnt vmcnt(0)" ::: "memory");
        __builtin_amdgcn_s_barrier();
        if (threadIdx.x == 0) {
            __builtin_amdgcn_fence(__ATOMIC_RELEASE, "agent");
            const unsigned old = __hip_atomic_fetch_add(cnt + u.pm, 1u, __ATOMIC_RELAXED, __HIP_MEMORY_SCOPE_AGENT);
            if (old == 3u) __builtin_amdgcn_fence(__ATOMIC_ACQUIRE, "agent");
            flag[0] = old;
        }
        asm volatile("s_waitcnt vmcnt(0) lgkmcnt(0)" ::: "memory");
        __builtin_amdgcn_s_barrier();
        asm volatile("" ::: "memory");
        if (flag[0] == 3u) ln_rows32(X, u.pm * 256 + (int)(threadIdx.x >> 6) * 32, g, bta, outf);
    }
};

struct PanelLnOrder {
    int nM, G, c; bf16* X; const float* g; const float* bta; float* outf;
    __device__ __forceinline__ bool next(int i, pg8::Unit& u) const { const int p = (i >> 2) * G + c; if (p >= nM) return false; u.pm = p; u.pn = i & 3; return true; }
    __device__ __forceinline__ void a_ready(const pg8::Unit&) const {}
    __device__ __forceinline__ void done(const pg8::Unit& u) const {
        if (u.pn == 3) {
            asm volatile("s_waitcnt vmcnt(0)" ::: "memory");
            __builtin_amdgcn_s_barrier();
            asm volatile("" ::: "memory");
            ln_rows32(X, u.pm * 256 + (int)(threadIdx.x >> 6) * 32, g, bta, outf);
        }
    }
};
typedef unsigned long long u64_t;
__device__ __forceinline__ void na_phase(const bf16* QKV, const float* rpb, bf16* O, LAS unsigned char* lds, int G) {
    const int tid = threadIdx.x, lane = tid & 63, wave = tid >> 6, l15 = lane & 15, quad = lane >> 4;
    const int jq = wave & 3, half = wave >> 2;
    LAS unsigned char* Kimg = lds;
    LAS unsigned char* Vimg = lds + 65536;
    LAS float* scr = (LAS float*)(lds + 131072);
    const int kc0 = (jq == 0) ? 0 : (jq == 1) ? 8 : (jq == 2) ? 24 : 32;
    const int c = jq * 16 + l15, c0 = min(max(c - 8, 0), 48);
    const int scol = tid >> 3, sch = tid & 7;
    for (int bh = blockIdx.x; bh < 512; bh += G) {
        const int b = bh >> 4, h = bh & 15; const size_t tokb = (size_t)b * 2048;
        const bf16* kbase = QKV + (tokb + scol) * 3072 + 1024 + h * 64 + sch * 8;
        const bf16* qbase = QKV + (tokb + c) * 3072 + h * 64 + quad * 8;
        const float* rp = rpb + h * (15 * 31);
        __syncthreads();
#define NA_STAGE_WRITE(kv, vv, slot) do { const int kidx_ = (slot) * 64 + scol; \
            *(LAS v4u*)(Kimg + kidx_ * 128 + ((sch ^ (kidx_ & 7)) * 16)) = (kv); \
            const unsigned vw_[4] = {(vv).x, (vv).y, (vv).z, (vv).w}; \
            _Pragma("unroll") for (int e_ = 0; e_ < 8; ++e_) { const int dh_ = sch * 8 + e_; \
                *(LAS bf16*)(Vimg + ((slot) * 64 + dh_) * 128 + (((scol >> 2) ^ (dh_ & 15)) * 8) + (scol & 3) * 2) = (bf16)((e_ & 1) ? (vw_[e_ >> 1] >> 16) : (vw_[e_ >> 1] & 0xffffu)); } } while (0)
#pragma unroll
        for (int g4 = 0; g4 < 2; ++g4) { v4u kk[4], vv[4];
#pragma unroll
            for (int i = 0; i < 4; ++i) { const bf16* p = kbase + (size_t)(g4 * 4 + i) * 64 * 3072; kk[i] = *(const v4u*)p; vv[i] = *(const v4u*)(p + 1024); }
#pragma unroll
            for (int i = 0; i < 4; ++i) NA_STAGE_WRITE(kk[i], vv[i], g4 * 4 + i); }
        bf16x8 qn0 = *(const bf16x8*)qbase, qn1 = *(const bf16x8*)(qbase + 32);
        __syncthreads();
        int prev_off = 1000; f32x4 bt[4][2];
#pragma unroll
        for (int ai = 0; ai < 4; ++ai) { bt[ai][0] = (f32x4){0.f, 0.f, 0.f, 0.f}; bt[ai][1] = (f32x4){0.f, 0.f, 0.f, 0.f}; }
        for (int r = 0; r < 32; ++r) {
            const int r0 = min(max(r - 4, 0), 24);
            const bf16x8 qf0 = qn0, qf1 = qn1;
            const bool slide = (r + 1 < 32) && (min(max(r - 3, 0), 24) != r0);
            v4u nk = {0u, 0u, 0u, 0u}, nv = {0u, 0u, 0u, 0u};
            if (slide) { const bf16* p = kbase + (size_t)(r0 + 8) * 64 * 3072; nk = *(const v4u*)p; nv = *(const v4u*)(p + 1024); }
            if (r + 1 < 32) { const bf16* p = qbase + (size_t)(r + 1) * 64 * 3072; qn0 = *(const bf16x8*)p; qn1 = *(const bf16x8*)(p + 32); }
            const int off = r0 - r;
            if (off != prev_off) { prev_off = off;
#pragma unroll
                for (int ai = 0; ai < 4; ++ai) { const int dr = off + half * 4 + ai + 7;
#pragma unroll
                    for (int cb = 0; cb < 2; ++cb)
#pragma unroll
                        for (int j = 0; j < 4; ++j) { const int kc = kc0 + cb * 16 + quad * 4 + j; const bool valid = (kc >= c0) && (kc < c0 + 16);
                            const int dc = min(max(kc - c + 15, 0), 30); const float bias = rp[dr * 31 + dc] * 1.4426950408889634f; bt[ai][cb][j] = valid ? bias : -INFINITY; } } }
            f32x4 sc[4][2]; float mx = -INFINITY;
#pragma unroll
            for (int ai = 0; ai < 4; ++ai) { const int slot = (r0 + half * 4 + ai) & 7;
#pragma unroll
                for (int cb = 0; cb < 2; ++cb) { const int kidx = slot * 64 + kc0 + cb * 16 + l15; const LAS unsigned char* ka = Kimg + kidx * 128;
                    const bf16x8 k0 = *(const LAS bf16x8*)(ka + ((quad ^ (kidx & 7)) * 16)), k1 = *(const LAS bf16x8*)(ka + (((quad + 4) ^ (kidx & 7)) * 16));
                    f32x4 acc = {0.f, 0.f, 0.f, 0.f}; acc = mfma16(k0, qf0, acc); acc = mfma16(k1, qf1, acc);
                    acc = acc + bt[ai][cb];
                    mx = fmaxf(fmaxf(fmaxf(mx, acc[0]), fmaxf(acc[1], acc[2])), acc[3]); sc[ai][cb] = acc; } }
            mx = fmaxf(mx, __shfl_xor(mx, 16)); mx = fmaxf(mx, __shfl_xor(mx, 32));
            float sum = 0.f;
#pragma unroll
            for (int ai = 0; ai < 4; ++ai)
#pragma unroll
                for (int cb = 0; cb < 2; ++cb)
#pragma unroll
                    for (int j = 0; j < 4; ++j) { const float p = __builtin_amdgcn_exp2f(sc[ai][cb][j] - mx); sc[ai][cb][j] = p; sum += p; }
            sum += __shfl_xor(sum, 16); sum += __shfl_xor(sum, 32);
            f32x4 o[4];
#pragma unroll
            for (int db = 0; db < 4; ++db) o[db] = (f32x4){0.f, 0.f, 0.f, 0.f};
#pragma unroll
            for (int ai = 0; ai < 4; ++ai) { const int slot = (r0 + half * 4 + ai) & 7;
                const v4u pw = {pk2(sc[ai][0][0], sc[ai][0][1]), pk2(sc[ai][0][2], sc[ai][0][3]), pk2(sc[ai][1][0], sc[ai][1][1]), pk2(sc[ai][1][2], sc[ai][1][3])};
                const bf16x8 pb = __builtin_bit_cast(bf16x8, pw);
                const int ch = (kc0 >> 2) + quad;
#pragma unroll
                for (int db = 0; db < 4; ++db) { const LAS unsigned char* va = Vimg + (slot * 64 + db * 16 + l15) * 128;
                    const u64_t lo = *(const LAS u64_t*)(va + ((ch ^ l15) * 8)), hi = *(const LAS u64_t*)(va + (((ch + 4) ^ l15) * 8));
                    const v4u vw = {(unsigned)lo, (unsigned)(lo >> 32), (unsigned)hi, (unsigned)(hi >> 32)};
                    o[db] = mfma16(__builtin_bit_cast(bf16x8, vw), pb, o[db]); } }
            if (half == 1) { LAS float* s = scr + jq * 18 * 64 + lane; s[0] = mx; s[64] = sum;
#pragma unroll
                for (int db = 0; db < 4; ++db)
#pragma unroll
                    for (int j = 0; j < 4; ++j) s[(2 + db * 4 + j) * 64] = o[db][j]; }
            __syncthreads();
            if (half == 0) { const LAS float* s = scr + jq * 18 * 64 + lane; const float m1 = s[0], l1 = s[64];
                const float m = fmaxf(mx, m1), f0 = __builtin_amdgcn_exp2f(mx - m), f1 = __builtin_amdgcn_exp2f(m1 - m); const float inv = 1.0f / (sum * f0 + l1 * f1);
                const float g0 = f0 * inv, g1 = f1 * inv;
                bf16* op = O + (tokb + r * 64 + c) * 1024 + h * 64 + quad * 4;
#pragma unroll
                for (int db = 0; db < 4; ++db) { float v[4];
#pragma unroll
                    for (int j = 0; j < 4; ++j) v[j] = o[db][j] * g0 + s[(2 + db * 4 + j) * 64] * g1;
                    *(u64_t*)(op + db * 16) = (u64_t)pk2(v[0], v[1]) | ((u64_t)pk2(v[2], v[3]) << 32); } }
            if (slide) NA_STAGE_WRITE(nk, nv, r0 & 7);
            __syncthreads();
        }
#undef NA_STAGE_WRITE
    }
}
__device__ __forceinline__ void gq_normrope_item(bf16* QKV, const float* qn, const float* kn, size_t g, const v4u raw) {
    const size_t item = g >> 3; const int l8 = (int)(g & 7); const size_t tok = item / 20; const int hv = (int)(item % 20);
    bf16* p = QKV + tok * 1536 + hv * 64 + l8 * 8;
    const unsigned rw[4] = {raw.x, raw.y, raw.z, raw.w};
    float x[8]; float ss = 0.f;
#pragma unroll
    for (int e = 0; e < 4; ++e) { x[2 * e] = __uint_as_float(rw[e] << 16); x[2 * e + 1] = __uint_as_float(rw[e] & 0xffff0000u); ss += x[2 * e] * x[2 * e] + x[2 * e + 1] * x[2 * e + 1]; }
    ss += __shfl_xor(ss, 1); ss += __shfl_xor(ss, 2); ss += __shfl_xor(ss, 4);
    const float rinv = 1.0f / sqrtf(ss * (1.f / 64.f) + 1e-6f);
    const float* gvec = ((hv < 16) ? qn : kn) + l8 * 8;
    const int s = (int)(tok & 2047), row = s >> 6, col = s & 63;
    const float scale = (hv < 16) ? (0.125f * 1.4426950408889634f) : 1.0f;
    unsigned ow[4];
#pragma unroll
    for (int pr = 0; pr < 4; ++pr) { const int i = l8 * 4 + pr; const float pos = (float)((i < 16) ? row : col); const int fi = i & 15;
        const float inv = exp2f(-(float)fi * (13.287712379549449f / 16.f)); const float ang = pos * inv;
        float rev = ang * 0.15915494309189535f; rev -= rintf(rev);
        const float sn = __builtin_amdgcn_sinf(rev), cs = __builtin_amdgcn_cosf(rev);
        const float x0 = x[2 * pr] * rinv * gvec[2 * pr], x1 = x[2 * pr + 1] * rinv * gvec[2 * pr + 1];
        ow[pr] = pk2((x0 * cs - x1 * sn) * scale, (x0 * sn + x1 * cs) * scale); }
    *(v4u*)p = (v4u){ow[0], ow[1], ow[2], ow[3]};
}
__device__ __forceinline__ void gq_normrope_phase(bf16* QKV, const float* qn, const float* kn, int G) {
    const size_t total = (size_t)M * 20 * 8, nth = (size_t)G * 512;
    size_t g = (size_t)blockIdx.x * 512 + threadIdx.x;
    for (; g + 3 * nth < total; g += 4 * nth) {
        v4u raw[4];
#pragma unroll
        for (int q = 0; q < 4; ++q) { const size_t gi = g + q * nth; const size_t item = gi >> 3; raw[q] = *(const v4u*)(QKV + (item / 20) * 1536 + (item % 20) * 64 + (gi & 7) * 8); }
#pragma unroll
        for (int q = 0; q < 4; ++q) gq_normrope_item(QKV, qn, kn, g + q * nth, raw[q]);
    }
    for (; g < total; g += nth) { const size_t item = g >> 3; const v4u raw = *(const v4u*)(QKV + (item / 20) * 1536 + (item % 20) * 64 + (g & 7) * 8); gq_normrope_item(QKV, qn, kn, g, raw); }
}
__device__ __forceinline__ f32x4 tile_mma64(const LAS bf16* A, int arow0, const LAS bf16* Bt, int brow0, f32x4 acc, int l15, int quad) {
    const LAS bf16* ap = A + (arow0 + l15) * 72 + quad * 8; const LAS bf16* bp = Bt + (brow0 + l15) * 72 + quad * 8;
    acc = mfma16(*(const LAS bf16x8*)ap, *(const LAS bf16x8*)bp, acc);
    acc = mfma16(*(const LAS bf16x8*)(ap + 32), *(const LAS bf16x8*)(bp + 32), acc);
    return acc;
}
__device__ __forceinline__ bf16x8 ml_fp(const LAS bf16* base, int row, int chunk) { return *(const LAS bf16x8*)(base + row * 72 + chunk * 8); }
__device__ __forceinline__ bf16x8 ml_fs(const LAS bf16* base, int row, int chunk) { return *(const LAS bf16x8*)((const LAS unsigned char*)base + row * 128 + ((chunk ^ (row & 7) ^ ((row >> 3) & 7)) * 16)); }
#define ML_TILE(acc_, FA, A_, ar_, FB, B_, br_) do { const int ra_ = (ar_) + l15, rb_ = (br_) + l15; \
    acc_ = mfma16(FA(A_, ra_, quad), FB(B_, rb_, quad), acc_); acc_ = mfma16(FA(A_, ra_, quad + 4), FB(B_, rb_, quad + 4), acc_); } while (0)
__device__ __forceinline__ void ml_phase(const bf16* Z, const float* gates, const float* norm_g, bf16* HFW, bf16* O, LAS unsigned char* lds, int G) {
    const int tid = threadIdx.x, lane = tid & 63, wave = tid >> 6, l15 = lane & 15, quad = lane >> 4;
    LAS bf16* Qs = (LAS bf16*)(lds);
    LAS bf16* Ks = (LAS bf16*)(lds + 9216);
    LAS bf16* Vt = (LAS bf16*)(lds + 18432);
    LAS bf16* Kt = (LAS bf16*)(lds + 39168);
    LAS bf16* Ct = (LAS bf16*)(lds + 48384);
    LAS bf16* As = (LAS bf16*)(lds + 69120);
    LAS float* Hs = (LAS float*)(lds + 78336);
    LAS float* vec = (LAS float*)(lds + 112128);
    for (int unit = blockIdx.x; unit < 256; unit += G) {
        const int b = unit >> 3, h = unit & 7; const size_t tokb = (size_t)b * 2048;
        for (int dir = 0; dir < 2; ++dir) {
            for (int i = tid; i < 144 * 72; i += 512) Ct[i] = 0;
            for (int i = tid; i < 16 * 64; i += 512) Vt[128 * 64 + i] = (i < 64) ? (bf16)0x3F80 : (bf16)0;
            f32x4 cst[4], cst8 = {0.f, 0.f, 0.f, 0.f};
#pragma unroll
            for (int i = 0; i < 4; ++i) cst[i] = (f32x4){0.f, 0.f, 0.f, 0.f};
            float m_run = 0.f;
            const int t8 = tid >> 3, ch = tid & 7;
#define ML_TOK(cs_, t_) (tokb + (size_t)(dir == 0 ? (cs_) * 64 + (t_) : 2047 - ((cs_) * 64 + (t_))))
            v4u pq, pk; bf16x8 pv[2]; float pli = 0.f, pf = 0.f;
#define ML_FETCH(cs_) do { const bf16* zr_ = Z + ML_TOK(cs_, t8) * 3072; pq = *(const v4u*)(zr_ + h * 64 + ch * 8); pk = *(const v4u*)(zr_ + 512 + h * 64 + ch * 8); \
                pv[0] = *(const bf16x8*)(zr_ + 1024 + h * 128 + ch * 8); pv[1] = *(const bf16x8*)(zr_ + 1024 + h * 128 + (ch + 8) * 8); \
                if (wave == 0) { const size_t tk_ = ML_TOK(cs_, lane); pli = gates[tk_ * 32 + dir * 16 + h]; pf = gates[tk_ * 32 + dir * 16 + 8 + h]; } } while (0)
            ML_FETCH(0);
            __syncthreads();
            for (int cs = 0; cs < 32; ++cs) {
                const size_t tok8 = ML_TOK(cs, t8);
                {
                    *(LAS v4u*)(Qs + t8 * 72 + ch * 8) = pq;
                    *(LAS v4u*)(Ks + t8 * 72 + ch * 8) = pk;
#pragma unroll
                    for (int i = 0; i < 2; ++i) { const int c16 = ch + 8 * i;
#pragma unroll
                        for (int e = 0; e < 8; ++e) Vt[(c16 * 8 + e) * 64 + ((((t8 >> 3) ^ e ^ ch) & 7) * 8) + (t8 & 7)] = (bf16)pv[i][e]; }
                }
                const float li = pli, f = pf;
                if (cs + 1 < 32) ML_FETCH(cs + 1);
                v4u hf0 = {0u, 0u, 0u, 0u}, hf1 = {0u, 0u, 0u, 0u}, og0 = {0u, 0u, 0u, 0u}, og1 = {0u, 0u, 0u, 0u};
                if (dir == 1) { const bf16* hp = HFW + tok8 * 1024 + h * 128 + ch * 16; hf0 = *(const v4u*)hp; hf1 = *(const v4u*)(hp + 8);
                    const bf16* og = Z + tok8 * 3072 + 2048 + h * 128 + ch * 16; og0 = *(const v4u*)og; og1 = *(const v4u*)(og + 8); }
                if (wave == 0) {
                    const float lf = fminf(f, 0.f) - log1pf(__expf(-fabsf(f)));
                    float bs = lf;
#pragma unroll
                    for (int o = 1; o < 64; o <<= 1) { const float y = __shfl_up(bs, o); if (lane >= o) bs += y; }
                    const float u = li - bs; float pm = u;
#pragma unroll
                    for (int o = 1; o < 64; o <<= 1) { const float y = __shfl_up(pm, o); if (lane >= o) pm = fmaxf(pm, y); }
                    const float Mt = fmaxf(pm, m_run), sint = __expf(m_run - Mt), mt = bs + Mt;
                    vec[lane] = u; vec[64 + lane] = Mt; vec[128 + lane] = sint; vec[192 + lane] = __expf(-mt);
                    m_run = __shfl(mt, 63);
                }
                __syncthreads();
                {
                    const int tb = wave >> 1;
#pragma unroll
                    for (int i = 0; i < 2; ++i) { const int sb = 2 * (wave & 1) + i;
                        f32x4 acc = {0.f, 0.f, 0.f, 0.f}; if (sb <= tb) ML_TILE(acc, ml_fp, Qs, tb * 16, ml_fp, Ks, sb * 16);
                        const int s = sb * 16 + l15; const float us = vec[s];
#pragma unroll
                        for (int j = 0; j < 4; ++j) { const int t = tb * 16 + 4 * quad + j; const float w = (s <= t) ? __expf(us - vec[64 + t]) : 0.f; As[t * 72 + s] = (bf16)f2bf(acc[j] * w); } }
                    const float w63 = __expf(vec[t8] - vec[64 + 63]);
                    const bf16x8 kk = *(const LAS bf16x8*)(Ks + t8 * 72 + ch * 8);
#pragma unroll
                    for (int e = 0; e < 8; ++e) Kt[(ch * 8 + e) * 64 + ((((t8 >> 3) ^ e ^ ch) & 7) * 8) + (t8 & 7)] = (bf16)f2bf(bf2f((bf16)kk[e]) * w63);
                }
                __syncthreads();
                {
#pragma unroll
                    for (int tb = 0; tb < 4; ++tb) { const f32x4 z4 = {0.f, 0.f, 0.f, 0.f};
                        f32x4 ah = z4, ag = z4; ML_TILE(ah, ml_fp, As, tb * 16, ml_fs, Vt, wave * 16); ML_TILE(ag, ml_fp, Qs, tb * 16, ml_fp, Ct, wave * 16);
#pragma unroll
                        for (int j = 0; j < 4; ++j) { const int t = tb * 16 + 4 * quad + j; Hs[t * 132 + wave * 16 + l15] = vec[128 + t] * ag[j] + ah[j]; } }
                    if (wave < 4) { const int tb = wave; const f32x4 z4 = {0.f, 0.f, 0.f, 0.f};
                        f32x4 ah = z4, ag = z4; ML_TILE(ah, ml_fp, As, tb * 16, ml_fs, Vt, 128); ML_TILE(ag, ml_fp, Qs, tb * 16, ml_fp, Ct, 128);
                        if (l15 == 0) {
#pragma unroll
                            for (int j = 0; j < 4; ++j) { const int t = tb * 16 + 4 * quad + j; vec[256 + t] = vec[128 + t] * ag[j] + ah[j]; } } }
                }
                __syncthreads();
                {
                    const float decay = vec[128 + 63];
#pragma unroll
                    for (int db = 0; db < 4; ++db) { cst[db] = cst[db] * decay; ML_TILE(cst[db], ml_fs, Vt, wave * 16, ml_fs, Kt, db * 16);
#pragma unroll
                        for (int j = 0; j < 4; ++j) Ct[(wave * 16 + 4 * quad + j) * 72 + db * 16 + l15] = (bf16)f2bf(cst[db][j]); }
                    if (wave < 4) { cst8 = cst8 * decay; ML_TILE(cst8, ml_fs, Vt, 128, ml_fs, Kt, wave * 16);
#pragma unroll
                        for (int j = 0; j < 4; ++j) Ct[(128 + 4 * quad + j) * 72 + wave * 16 + l15] = (bf16)f2bf(cst8[j]); }
                    const float dn = fmaxf(fabsf(vec[256 + t8]), vec[192 + t8]); const float rd = 1.0f / dn;
                    float hv[16];
#pragma unroll
                    for (int e = 0; e < 16; ++e) hv[e] = Hs[t8 * 132 + ch * 16 + e] * rd;
                    const size_t ho = tok8 * 1024 + h * 128 + ch * 16;
                    if (dir == 0) {
                        v4u w0, w1; w0.x = pk2(hv[0], hv[1]); w0.y = pk2(hv[2], hv[3]); w0.z = pk2(hv[4], hv[5]); w0.w = pk2(hv[6], hv[7]);
                        w1.x = pk2(hv[8], hv[9]); w1.y = pk2(hv[10], hv[11]); w1.z = pk2(hv[12], hv[13]); w1.w = pk2(hv[14], hv[15]);
                        *(v4u*)(HFW + ho) = w0; *(v4u*)(HFW + ho + 8) = w1;
                    } else {
                        const unsigned fw[8] = {hf0.x, hf0.y, hf0.z, hf0.w, hf1.x, hf1.y, hf1.z, hf1.w};
                        float ss = 0.f;
#pragma unroll
                        for (int e = 0; e < 8; ++e) { hv[2 * e] += __uint_as_float(fw[e] << 16); hv[2 * e + 1] += __uint_as_float(fw[e] & 0xffff0000u); ss += hv[2 * e] * hv[2 * e] + hv[2 * e + 1] * hv[2 * e + 1]; }
                        ss += __shfl_xor(ss, 1); ss += __shfl_xor(ss, 2); ss += __shfl_xor(ss, 4);
                        const float rinv = 1.0f / sqrtf(ss * (1.f / 128.f) + 1e-6f);
                        const unsigned gw_[8] = {og0.x, og0.y, og0.z, og0.w, og1.x, og1.y, og1.z, og1.w};
                        const float* ng = norm_g + h * 128 + ch * 16;
                        unsigned ow[8];
#pragma unroll
                        for (int e = 0; e < 8; ++e) { const float o0 = 1.0f / (1.0f + __expf(-__uint_as_float(gw_[e] << 16))), o1 = 1.0f / (1.0f + __expf(-__uint_as_float(gw_[e] & 0xffff0000u)));
                            ow[e] = pk2(hv[2 * e] * rinv * ng[2 * e] * o0, hv[2 * e + 1] * rinv * ng[2 * e + 1] * o1); }
                        *(v4u*)(O + ho) = (v4u){ow[0], ow[1], ow[2], ow[3]}; *(v4u*)(O + ho + 8) = (v4u){ow[4], ow[5], ow[6], ow[7]};
                    }
                }
                __syncthreads();
            }
#undef ML_FETCH
#undef ML_TOK
        }
    }
}
#define RLX_AGENT __ATOMIC_RELAXED, __HIP_MEMORY_SCOPE_AGENT
#define XB_TMO      128
#define XB_XCNT(j)  (256  + 64 * (j))
#define XB_XSUB(j)  (1280 + 64 * (j))
#define XB_XGEN(j)  (2304 + 64 * (j))
#define XB_TOP      3328
#define XB_TOPGEN   3392
#define XCD_BAR_WORDS 3456
#define XB_SPIN_CAP (1u << 18)

__device__ __forceinline__ unsigned xb_ld(unsigned* p)              { return __hip_atomic_load(p, __ATOMIC_RELAXED, __HIP_MEMORY_SCOPE_AGENT); }
__device__ __forceinline__ unsigned xb_add(unsigned* p, unsigned v) { return __hip_atomic_fetch_add(p, v, __ATOMIC_RELAXED, __HIP_MEMORY_SCOPE_AGENT); }
__device__ __forceinline__ unsigned xb_xcc_id() { return (unsigned)__builtin_amdgcn_s_getreg((3 << 11) | 20) & 0xFu; }
#define XB_SPIN(cond, bar) do { unsigned _sp = 0; while (cond) { __builtin_amdgcn_s_sleep(1); \
    if ((++_sp & 255u) == 0u) { if (xb_ld(&(bar)[XB_TMO])) break; if (_sp > XB_SPIN_CAP) { atomicAdd(&(bar)[XB_TMO], 1u); break; } } } } while (0)

struct XcdBarrier {
    unsigned* bar; unsigned x;
    volatile LAS unsigned* st;
};

__device__ __forceinline__ XcdBarrier xcd_barrier_post(unsigned* bar, volatile LAS unsigned* st) {
    XcdBarrier b; b.bar = bar; b.x = xb_xcc_id(); b.st = st;
    if (threadIdx.x == 0) (void)xb_add(&bar[XB_XCNT(b.x)], 1u);
    return b;
}
__device__ __forceinline__ void xcd_barrier_complete(unsigned* bar, unsigned x, unsigned& nloc, unsigned& nx) {
    const unsigned G = gridDim.x * gridDim.y * gridDim.z;
    unsigned sum, cnt, mine, sp = 0u;
    for (;;) {
        sum = 0u; cnt = 0u; mine = 0u;
#pragma unroll
        for (unsigned j = 0; j < 16; ++j) { const unsigned c = xb_ld(&bar[XB_XCNT(j)]); sum += c; cnt += (c > 0u) ? 1u : 0u; mine = (j == x) ? c : mine; }
        if (sum == G) break;
        __builtin_amdgcn_s_sleep(1);
        if ((++sp & 255u) == 0u) { if (xb_ld(&bar[XB_TMO])) break; if (sp > XB_SPIN_CAP) { atomicAdd(&bar[XB_TMO], 1u); break; } }
    }
    nloc = mine > 0u ? mine : 1u; nx = cnt > 0u ? cnt : 1u;
}

__device__ __forceinline__ void xcd_barrier(const XcdBarrier& b) {
    asm volatile("s_waitcnt vmcnt(0)" ::: "memory");
    __syncthreads();
    if (threadIdx.x == 0) {
        unsigned* bar = b.bar;
        __builtin_amdgcn_s_waitcnt(0);
        unsigned nloc = b.st[0], nx = b.st[1];
        if (nloc == 0u) { xcd_barrier_complete(bar, b.x, nloc, nx); b.st[0] = nloc; b.st[1] = nx; }
        const unsigned old = xb_add(&bar[XB_XSUB(b.x)], 1u);
        const unsigned gen = old / nloc;
        if (old + 1u == (gen + 1u) * nloc) {
            __builtin_amdgcn_fence(__ATOMIC_RELEASE, "agent");
            asm volatile("s_waitcnt vmcnt(0)" ::: "memory");
            const unsigned og = xb_add(&bar[XB_TOP], 1u);
            const unsigned tg = og / nx;
            if (og + 1u == (tg + 1u) * nx) xb_add(&bar[XB_TOPGEN], 1u);
            else XB_SPIN(xb_ld(&bar[XB_TOPGEN]) == tg, bar);
            __builtin_amdgcn_fence(__ATOMIC_ACQUIRE, "agent");
            xb_add(&bar[XB_XGEN(b.x)], 1u);
            asm volatile("s_waitcnt vmcnt(0)" ::: "memory");
        } else {
            XB_SPIN(xb_ld(&bar[XB_XGEN(b.x)]) == gen, bar);
            __builtin_amdgcn_fence(__ATOMIC_ACQUIRE, "agent");
            asm volatile("s_waitcnt vmcnt(0)" ::: "memory");
        }
    }
    __syncthreads();
}

#define GSYNC() xcd_barrier(bar)
#define SKIP(bit) ((skipmask >> (bit)) & 1)
template <int L> __device__ __forceinline__ void layer_program(const Args& a, LAS unsigned char* lds, unsigned char* lds_raw, const int G, const XcdBarrier& bar, const int skipmask) {
    constexpr int kind = L % 3;
    unsigned char* ws = a.ws;
    bf16* XN = (bf16*)(ws + WS_XN); bf16* QKV = (bf16*)(ws + WS_QKV); bf16* OB = (bf16*)(ws + WS_O); bf16* PP = (bf16*)(ws + WS_PP); bf16* HB = (bf16*)(ws + WS_H);
    if (!SKIP(1)) { const bf16* Win = (const bf16*)(ws + WS_WIN + (size_t)L * 7 * MiB);
        if constexpr (kind == 2) { pg8::Gemm g{XN, Win, M, 3328, D}; pg8::StaticOrder S; S.init(M, 3328, G, (int)blockIdx.x);
            pg8::EpiMl E{QKV, (float*)(ws + WS_GATES), a.in[10]};
            pg8::gemm_phase<pg8::EpiMl, pg8::StaticOrder, true, true>(lds, g, S, E); }
        else { constexpr int N = (kind == 0) ? 3072 : 1536; pg8::Gemm g{XN, Win, M, N, D}; pg8::StaticOrder S; S.init(M, N, G, (int)blockIdx.x);
            pg8::EpiPlain E{QKV, N, (kind == 0) ? 1024 : 0, 0.125f * 1.4426950408889634f};
            pg8::gemm_phase<pg8::EpiPlain, pg8::StaticOrder, true, true>(lds, g, S, E); } }
    if (!SKIP(2)) { pg8::Gemm g{(const bf16*)(ws + WS_PB), (const bf16*)(ws + WS_WP + (size_t)L * (MiB / 2)), M, D, DPLE}; pg8::StaticOrder S; S.init(M, D, G, (int)blockIdx.x);
        pg8::EpiPlain E{PP, D, 0, 1.f};
        pg8::gemm_phase<pg8::EpiPlain, pg8::StaticOrder, true, true>(lds, g, S, E); }
    GSYNC();
    if constexpr (kind == 1) { if (!SKIP(3)) gq_normrope_phase(QKV, a.in[6], a.in[7], G); GSYNC(); }
    if (!SKIP(4)) {
        if constexpr (kind == 0) na_phase(QKV, a.in[3] + (size_t)(L / 3) * 16 * 15 * 31, OB, lds, G);
        else if constexpr (kind == 1) { const attn_body::AttnTensors AT{(const attn_body::bf16*)QKV, (const attn_body::bf16*)(QKV + 1024), (const attn_body::bf16*)(QKV + 1280), (attn_body::bf16*)OB};
            const attn_body::StaticOrder S(G, (int)blockIdx.x); attn_body::attn_phase<attn_body::StaticOrder>((char*)lds_raw, AT, S); }
        else ml_phase(QKV, (const float*)(ws + WS_GATES), a.in[11], (bf16*)a.out, OB, lds, G);
    }
    GSYNC();
    if (!SKIP(5)) { pg8::Gemm g{OB, (const bf16*)(ws + WS_WO + (size_t)L * 2 * MiB), M, D, D};
        PanelLnOrder S; S.nM = M / 256; S.G = G; S.c = (int)blockIdx.x; S.X = XN; S.g = a.in[13] + (size_t)L * D; S.bta = a.in[14] + (size_t)L * D; S.outf = nullptr;
        pg8::EpiResidBf E{XN, nullptr, DN_ALPHA};
        pg8::gemm_phase<pg8::EpiResidBf, PanelLnOrder, true, true>(lds, g, S, E); }
    GSYNC();
    if (!SKIP(7)) { if constexpr (L + 1 < DEPTH) cvt_rows(a.in[1] + (size_t)(L + 1) * M * DPLE, (bf16*)(ws + WS_PB), (size_t)M * DPLE, G);
        pg8::Gemm g{XN, (const bf16*)(ws + WS_W1G + (size_t)L * 10 * MiB), M, FF + D, D}; pg8::StaticOrder S; S.init(M, FF + D, G, (int)blockIdx.x);
        pg8::EpiFf1 E{HB, PP};
        pg8::gemm_phase<pg8::EpiFf1, pg8::StaticOrder, true, true>(lds, g, S, E); }
    GSYNC();
    if (!SKIP(8)) { pg8::Gemm g{HB, (const bf16*)(ws + WS_W2 + (size_t)L * 8 * MiB), M, D, FF}; pg8::StaticOrder S; S.init(M, D, G, (int)blockIdx.x);
        pg8::EpiResidBf E{XN, PP, DN_ALPHA};
        pg8::gemm_phase<pg8::EpiResidBf, pg8::StaticOrder, true, true>(lds, g, S, E); }
    GSYNC();
    if (!SKIP(9)) { for (int r0 = ((int)blockIdx.x * NWAVES + (int)(threadIdx.x >> 6)) * 32; r0 < M; r0 += G * NWAVES * 32)
            ln_rows32(XN, r0, a.in[17] + (size_t)L * D, a.in[18] + (size_t)L * D, (L + 1 < DEPTH) ? nullptr : a.out); }
    if constexpr (L + 1 < DEPTH) GSYNC();
}
__global__ void __launch_bounds__(NWAVES * 64, 2) fwd_megakernel(Args a) {
    extern __shared__ __attribute__((aligned(16))) unsigned char lds_raw[];
    LAS unsigned char* lds = (LAS unsigned char*)lds_raw;
    cg::grid_group grid = cg::this_grid();
    const int G = gridDim.x;
    { volatile LAS unsigned* z = (volatile LAS unsigned*)(lds + LDS_CTL); if (threadIdx.x < 64) z[threadIdx.x] = 0u; }
    __syncthreads();
    const XcdBarrier bar = xcd_barrier_post((unsigned*)a.ws + 4096, (volatile LAS unsigned*)(lds + LDS_CTL + 64));
#ifdef PROBE_SKIP
#ifndef PROBE_LAYERS
#define PROBE_LAYERS 15
#endif
    {
        const int skipmask = a.skip;
        if (!SKIP(0)) prologue_phase(a, lds, G);
        GSYNC();
        if ((PROBE_LAYERS >> 0) & 1) layer_program<0>(a, lds, lds_raw, G, bar, skipmask); GSYNC();
        if ((PROBE_LAYERS >> 1) & 1) layer_program<1>(a, lds, lds_raw, G, bar, skipmask); GSYNC();
        if ((PROBE_LAYERS >> 2) & 1) layer_program<2>(a, lds, lds_raw, G, bar, skipmask); GSYNC();
        if ((PROBE_LAYERS >> 3) & 1) layer_program<3>(a, lds, lds_raw, G, bar, skipmask); GSYNC();
    }
#endif
    {
        const int skipmask = a.pad;
        if (!SKIP(0)) prologue_phase(a, lds, G);
        grid.sync();
        layer_program<0>(a, lds, lds_raw, G, bar, skipmask);
        layer_program<1>(a, lds, lds_raw, G, bar, skipmask);
        layer_program<2>(a, lds, lds_raw, G, bar, skipmask);
        layer_program<3>(a, lds, lds_raw, G, bar, skipmask);
    }
}
#undef SKIP

extern "C" void kernel_launch(void* const* d_in, const int* in_sizes, int n_in, void* d_out, int out_size, void* d_ws, size_t ws_size, hipStream_t stream) {
    static int grid = 0;
    if (grid == 0) {
        if (n_in != 21 || out_size != M * D || ws_size < WS_END) { fprintf(stderr, "kernel_launch: unexpected shapes (n_in %d, out %d, ws %zu)\n", n_in, out_size, ws_size); grid = -1; return; }
        int dev = 0, cus = 0, per_cu = 0;
        hipGetDevice(&dev); hipDeviceGetAttribute(&cus, hipDeviceAttributeMultiprocessorCount, dev);
        if (hipFuncSetAttribute((const void*)fwd_megakernel, hipFuncAttributeMaxDynamicSharedMemorySize, LDS_BYTES) != hipSuccess) { fprintf(stderr, "kernel_launch: hipFuncSetAttribute failed\n"); grid = -1; return; }
        if (hipOccupancyMaxActiveBlocksPerMultiprocessor(&per_cu, (const void*)fwd_megakernel, NWAVES * 64, LDS_BYTES) != hipSuccess || per_cu < 1) per_cu = 1;
        (void)hipGetLastError();
        grid = cus * per_cu;
        fprintf(stderr, "kernel_launch: grid %d (cus %d x %d)\n", grid, cus, per_cu);
    }
    if (grid < 0) return;
    Args a{};
    for (int i = 0; i < 21; ++i) a.in[i] = (const float*)d_in[i];
    a.out = (float*)d_out; a.ws = (unsigned char*)d_ws;
#ifdef PROBE_SKIP
    a.skip = PROBE_SKIP;
#else
    a.skip = 0;
#endif
    a.pad = 0;
    if (hipMemsetAsync(d_ws, 0, 65536, stream) != hipSuccess) { fprintf(stderr, "kernel_launch: hipMemsetAsync failed\n"); return; }
    void* args[] = {&a};
    const hipError_t e = hipLaunchCooperativeKernel((const void*)fwd_megakernel, dim3(grid), dim3(NWAVES * 64), args, LDS_BYTES, stream);
    if (e != hipSuccess) fprintf(stderr, "kernel_launch: cooperative launch failed: %s (grid %d)\n", hipGetErrorString(e), grid);
}
```

```cpp
#include <hip/hip_runtime.h>
#include <hip/hip_cooperative_groups.h>
#include <cstdio>
#include <cstdint>
namespace cg = cooperative_groups;
namespace pg8 {
#define PG8_LAS __attribute__((address_space(3)))
typedef unsigned short bf16_t;
typedef short bf16x8 __attribute__((ext_vector_type(8)));
typedef float f32x4 __attribute__((ext_vector_type(4)));
typedef unsigned u32x4 __attribute__((ext_vector_type(4)));
constexpr int BM = 256, BK = 64, HALF = 128, HTB = HALF * BK * 2  , STAGE_BYTES = 8 * HTB, NXCD = 8, WGM = 8;

__host__ __device__ __forceinline__ int lds_byte(int r, int c) { const int st = (r >> 4) * 2 + (c >> 5), rr = r & 15, cc = c & 31, ob = rr * 64 + cc * 2; return st * 1024 + (ob ^ (((ob >> 9) & 1) << 5)); }
__host__ __device__ __forceinline__ void stage_rc(int b, int& R, int& C) { const int st = b / 1024, sb = b % 1024, swz = sb ^ (((sb >> 9) & 1) << 5); R = (st >> 1) * 16 + swz / 64; C = (st & 1) * 32 + (swz % 64) / 2; }
__host__ __device__ __forceinline__ int perm32(int rho) { const int n = rho >> 4, i = rho & 15; return 8 * (i >> 2) + 4 * n + (i & 3); }

struct Unit { int pm, pn; };
struct Gemm { const bf16_t* A; const bf16_t* Bt; int M, N, K; };

struct StaticOrder {
    int nM, nN, nwg, G, c;
    __host__ __device__ void init(int M, int N, int G_, int c_) { nM = M / BM; nN = N / BM; nwg = nM * nN; G = G_; c = c_; }
    __host__ __device__ bool next(int i, Unit& u) const {
        const long L = (long)i * G + c; if (L >= nwg) return false;
        int wgid = (int)L; { const int q = nwg / NXCD, r = nwg % NXCD, xcd = wgid % NXCD, off = wgid / NXCD; wgid = (xcd < r ? xcd * (q + 1) : r * (q + 1) + (xcd - r) * q) + off; }
        const int nig = WGM * nN, gid = wgid / nig, fm = gid * WGM, gsz = (nM - fm) < WGM ? (nM - fm) : WGM;
        u.pm = fm + ((wgid % nig) % gsz); u.pn = (wgid % nig) / gsz; return true;
    }
    __device__ __forceinline__ void a_ready(const Unit&) const {}
    __device__ __forceinline__ void done(const Unit&) const {}
};

__device__ __forceinline__ unsigned cvt_pk_bf16(float lo, float hi) { unsigned r; asm volatile("v_cvt_pk_bf16_f32 %0, %1, %2" : "=v"(r) : "v"(lo), "v"(hi)); return r; }
typedef float f32x2 __attribute__((ext_vector_type(2)));
__device__ __forceinline__ float bf2f(unsigned short h) { return __uint_as_float(((unsigned)h) << 16); }
__device__ __forceinline__ float sigmoidf_(float x) { return 1.0f / (1.0f + __expf(-x)); }
struct EpiPlain {
    static constexpr bool PERM = true, AFTER_DRAIN = false;
    bf16_t* O; int ldc; int scale_cols; float scale;
    __device__ __forceinline__ void operator()(const f32x4 (&acc)[2][2][4][2], const Unit& u, int wr, int wc, int fr, int fq) const {
        const int row0 = u.pm * BM + wr * 64 + fr, col0 = u.pn * BM + wc * 32 + 8 * fq;
        const float sc = (u.pn * BM < scale_cols) ? scale : 1.f;
#pragma unroll
        for (int ai = 0; ai < 2; ++ai)
#pragma unroll
            for (int m = 0; m < 4; ++m) { bf16_t* rowp = O + (size_t)(row0 + ai * HALF + m * 16) * ldc + col0;
#pragma unroll
                for (int bj = 0; bj < 2; ++bj) { f32x4 v0 = acc[ai][bj][m][0] * sc, v1 = acc[ai][bj][m][1] * sc;
                    u32x4 w; w.x = cvt_pk_bf16(v0[0], v0[1]); w.y = cvt_pk_bf16(v0[2], v0[3]); w.z = cvt_pk_bf16(v1[0], v1[1]); w.w = cvt_pk_bf16(v1[2], v1[3]);
                    *(u32x4*)(rowp + bj * HALF) = w; } }
    }
};
struct EpiMl {
    static constexpr bool PERM = true, AFTER_DRAIN = false;
    bf16_t* O; float* gates; const float* bias;
    __device__ __forceinline__ void operator()(const f32x4 (&acc)[2][2][4][2], const Unit& u, int wr, int wc, int fr, int fq) const {
        const int row0 = u.pm * BM + wr * 64 + fr;
        if (u.pn < 12) {
            const int col0 = u.pn * BM + wc * 32 + 8 * fq; const float sc = (u.pn < 2) ? 0.125f : 1.f;
#pragma unroll
            for (int ai = 0; ai < 2; ++ai)
#pragma unroll
                for (int m = 0; m < 4; ++m) { bf16_t* rowp = O + (size_t)(row0 + ai * HALF + m * 16) * 3072 + col0;
#pragma unroll
                    for (int bj = 0; bj < 2; ++bj) { f32x4 v0 = acc[ai][bj][m][0] * sc, v1 = acc[ai][bj][m][1] * sc;
                        u32x4 w; w.x = cvt_pk_bf16(v0[0], v0[1]); w.y = cvt_pk_bf16(v0[2], v0[3]); w.z = cvt_pk_bf16(v1[0], v1[1]); w.w = cvt_pk_bf16(v1[2], v1[3]);
                        *(u32x4*)(rowp + bj * HALF) = w; } }
        } else if (wc == 0) {
            const f32x4 b0 = *(const f32x4*)(bias + 8 * fq), b1 = *(const f32x4*)(bias + 8 * fq + 4);
#pragma unroll
            for (int ai = 0; ai < 2; ++ai)
#pragma unroll
                for (int m = 0; m < 4; ++m) { float* gp = gates + (size_t)(row0 + ai * HALF + m * 16) * 32 + 8 * fq;
                    *(f32x4*)gp = acc[ai][0][m][0] + b0; *(f32x4*)(gp + 4) = acc[ai][0][m][1] + b1; }
        }
    }
};
struct EpiFf1 {
    static constexpr bool PERM = true, AFTER_DRAIN = false;
    bf16_t* H; bf16_t* PP;
    __device__ __forceinline__ void operator()(const f32x4 (&acc)[2][2][4][2], const Unit& u, int wr, int wc, int fr, int fq) const {
        const int row0 = u.pm * BM + wr * 64 + fr;
        if (u.pn < 16) {
            const int col0 = u.pn * BM + wc * 32 + 8 * fq;
#pragma unroll
            for (int ai = 0; ai < 2; ++ai)
#pragma unroll
                for (int m = 0; m < 4; ++m) { bf16_t* rowp = H + (size_t)(row0 + ai * HALF + m * 16) * 4096 + col0;
#pragma unroll
                    for (int bj = 0; bj < 2; ++bj) { f32x4 v0 = acc[ai][bj][m][0], v1 = acc[ai][bj][m][1];
#pragma unroll
                        for (int e = 0; e < 4; ++e) { const float a = fmaxf(v0[e], 0.f), b = fmaxf(v1[e], 0.f); v0[e] = a * a; v1[e] = b * b; }
                        u32x4 w; w.x = cvt_pk_bf16(v0[0], v0[1]); w.y = cvt_pk_bf16(v0[2], v0[3]); w.z = cvt_pk_bf16(v1[0], v1[1]); w.w = cvt_pk_bf16(v1[2], v1[3]);
                        *(u32x4*)(rowp + bj * HALF) = w; } }
        } else {
            const int col0 = (u.pn - 16) * BM + wc * 32 + 8 * fq;
#pragma unroll
            for (int ai = 0; ai < 2; ++ai)
#pragma unroll
                for (int m = 0; m < 4; ++m) { bf16_t* rowp = PP + (size_t)(row0 + ai * HALF + m * 16) * 1024 + col0;
#pragma unroll
                    for (int bj = 0; bj < 2; ++bj) { f32x4 v0 = acc[ai][bj][m][0], v1 = acc[ai][bj][m][1];
                        const u32x4 pp = *(const u32x4*)(rowp + bj * HALF);
                        const unsigned pw[4] = {pp.x, pp.y, pp.z, pp.w};
#pragma unroll
                        for (int e = 0; e < 2; ++e) {
                            v0[2 * e]     = sigmoidf_(v0[2 * e])     * __uint_as_float(pw[e] << 16);
                            v0[2 * e + 1] = sigmoidf_(v0[2 * e + 1]) * __uint_as_float(pw[e] & 0xffff0000u);
                            v1[2 * e]     = sigmoidf_(v1[2 * e])     * __uint_as_float(pw[2 + e] << 16);
                            v1[2 * e + 1] = sigmoidf_(v1[2 * e + 1]) * __uint_as_float(pw[2 + e] & 0xffff0000u); }
                        u32x4 w; w.x = cvt_pk_bf16(v0[0], v0[1]); w.y = cvt_pk_bf16(v0[2], v0[3]); w.z = cvt_pk_bf16(v1[0], v1[1]); w.w = cvt_pk_bf16(v1[2], v1[3]);
                        *(u32x4*)(rowp + bj * HALF) = w; } }
        }
    }
};
struct EpiResidBf {
    static constexpr bool PERM = true, AFTER_DRAIN = false;
    bf16_t* X; const bf16_t* ple; float alpha;
    __device__ __forceinline__ void operator()(const f32x4 (&acc)[2][2][4][2], const Unit& u, int wr, int wc, int fr, int fq) const {
        const int row0 = u.pm * BM + wr * 64 + fr, col0 = u.pn * BM + wc * 32 + 8 * fq;
#pragma unroll
        for (int ai = 0; ai < 2; ++ai)
#pragma unroll
            for (int m = 0; m < 4; ++m) { const size_t off = (size_t)(row0 + ai * HALF + m * 16) * 1024 + col0;
#pragma unroll
                for (int bj = 0; bj < 2; ++bj) { f32x4 v0 = acc[ai][bj][m][0], v1 = acc[ai][bj][m][1];
                    const u32x4 r = *(const u32x4*)(X + off + bj * HALF);
                    v0[0] += alpha * __uint_as_float(r.x << 16); v0[1] += alpha * __uint_as_float(r.x & 0xffff0000u); v0[2] += alpha * __uint_as_float(r.y << 16); v0[3] += alpha * __uint_as_float(r.y & 0xffff0000u);
                    v1[0] += alpha * __uint_as_float(r.z << 16); v1[1] += alpha * __uint_as_float(r.z & 0xffff0000u); v1[2] += alpha * __uint_as_float(r.w << 16); v1[3] += alpha * __uint_as_float(r.w & 0xffff0000u);
                    if (ple) { const u32x4 p = *(const u32x4*)(ple + off + bj * HALF);
                        v0[0] += __uint_as_float(p.x << 16); v0[1] += __uint_as_float(p.x & 0xffff0000u); v0[2] += __uint_as_float(p.y << 16); v0[3] += __uint_as_float(p.y & 0xffff0000u);
                        v1[0] += __uint_as_float(p.z << 16); v1[1] += __uint_as_float(p.z & 0xffff0000u); v1[2] += __uint_as_float(p.w << 16); v1[3] += __uint_as_float(p.w & 0xffff0000u); }
                    u32x4 w; w.x = cvt_pk_bf16(v0[0], v0[1]); w.y = cvt_pk_bf16(v0[2], v0[3]); w.z = cvt_pk_bf16(v1[0], v1[1]); w.w = cvt_pk_bf16(v1[2], v1[3]);
                    *(u32x4*)(X + off + bj * HALF) = w; } }
    }
};
template <class Epi, class Sched, bool ALIGN_EPI = false, bool SP2 = false>
__device__ __forceinline__ void gemm_phase(PG8_LAS unsigned char* lds, const Gemm g, const Sched& S, const Epi& E) {
    const int tid = threadIdx.x, wid = __builtin_amdgcn_readfirstlane(tid >> 6), lane = tid & 63, wr = wid >> 2, wc = wid & 3, fr = lane & 15, fq = lane >> 4;
    const int K = g.K, nt = K / BK;
    unsigned voffA[2], voffB[2];
#pragma unroll
    for (int i = 0; i < 2; ++i) { int R, C; stage_rc(tid * 16 + i * 8192, R, C); const int Rb = Epi::PERM ? ((R & ~31) + perm32(R & 31)) : R;
        voffA[i] = (unsigned)(R * K + C) * 2u; voffB[i] = (unsigned)(Rb * K + C) * 2u; }
    const size_t kstep = (size_t)(BK * 2);
    const size_t hstep = (size_t)HALF * K * 2;
    const size_t tstep = 2 * hstep;
    const unsigned ldsw = (unsigned)wid * 1024u;
    const int aoff = lds_byte(wr * 64 + fr, fq * 8), boff = lds_byte(wc * 32 + fr, fq * 8);
#define PG8_SA(b, h) (((b) * 2 + (h)) * HTB)
#define PG8_SB(b, h) ((4 + (b) * 2 + (h)) * HTB)
#define PG8_STAGE(bufoff, gbase, voff) do { _Pragma("unroll") for (int _i = 0; _i < 2; ++_i) \
        __builtin_amdgcn_global_load_lds((const unsigned*)((const char*)(gbase) + (voff)[_i]), (PG8_LAS unsigned*)(lds + (bufoff) + ldsw + _i * 8192), 16, 0, 0); } while (0)
#define PG8_LDA(dst, b, h) do { _Pragma("unroll") for (int m = 0; m < 4; ++m) _Pragma("unroll") for (int k = 0; k < 2; ++k) dst[m][k] = *(const PG8_LAS bf16x8*)(lds + PG8_SA(b, h) + aoff + m * 2048 + k * 1024); } while (0)
#define PG8_LDB(dst, b, h) do { _Pragma("unroll") for (int n = 0; n < 2; ++n) _Pragma("unroll") for (int k = 0; k < 2; ++k) dst[n][k] = *(const PG8_LAS bf16x8*)(lds + PG8_SB(b, h) + boff + n * 2048 + k * 1024); } while (0)
#define PG8_MMA(ai, bj, At, Bt) do { __builtin_amdgcn_s_setprio(1); _Pragma("unroll") for (int m = 0; m < 4; ++m) _Pragma("unroll") for (int n = 0; n < 2; ++n) _Pragma("unroll") for (int k = 0; k < 2; ++k) \
        acc[ai][bj][m][n] = __builtin_amdgcn_mfma_f32_16x16x32_bf16(Bt[n][k], At[m][k], acc[ai][bj][m][n], 0, 0, 0); __builtin_amdgcn_s_setprio(0); } while (0)
#define PG8_WAIT_V(n) asm volatile("s_waitcnt vmcnt(" #n ")" ::: "memory")
#define PG8_WAIT_L(n) asm volatile("s_waitcnt lgkmcnt(" #n ")" ::: "memory")
#define PG8_BAR __builtin_amdgcn_s_barrier()
#define PG8_SCHED __builtin_amdgcn_sched_barrier(0)
    Unit cur, nxt; int ui = 0;
    if (!S.next(0, cur)) return;
    f32x4 acc[2][2][4][2];
#pragma unroll
    for (int a = 0; a < 2; ++a)
#pragma unroll
        for (int b = 0; b < 2; ++b)
#pragma unroll
            for (int m = 0; m < 4; ++m)
#pragma unroll
                for (int n = 0; n < 2; ++n) acc[a][b][m][n] = (f32x4){0.f, 0.f, 0.f, 0.f};
    bf16x8 At[4][2], B0[2][2], B1[2][2];
    const char* cA = (const char*)g.A + (size_t)cur.pm * tstep; const char* cB = (const char*)g.Bt + (size_t)cur.pn * tstep;
    S.a_ready(cur);
    if constexpr (SP2) {
        PG8_STAGE(PG8_SB(0, 0), cB, voffB); PG8_STAGE(PG8_SB(0, 1), cB + hstep, voffB); PG8_STAGE(PG8_SA(0, 0), cA, voffA); PG8_STAGE(PG8_SA(0, 1), cA + hstep, voffA);
        if (wr == 1) PG8_BAR;
        PG8_WAIT_V(2); PG8_BAR;
        PG8_STAGE(PG8_SB(1, 0), cB + kstep, voffB); PG8_STAGE(PG8_SA(1, 0), cA + kstep, voffA); PG8_STAGE(PG8_SB(1, 1), cB + hstep + kstep, voffB);
        PG8_WAIT_V(6); PG8_BAR;
    } else {
        PG8_STAGE(PG8_SB(0, 0), cB, voffB); PG8_STAGE(PG8_SA(0, 0), cA, voffA); PG8_STAGE(PG8_SB(0, 1), cB + hstep, voffB); PG8_STAGE(PG8_SA(0, 1), cA + hstep, voffA);
        if (wr == 1) PG8_BAR;
        PG8_WAIT_V(4); PG8_BAR;
        PG8_STAGE(PG8_SB(1, 0), cB + kstep, voffB); PG8_STAGE(PG8_SA(1, 0), cA + kstep, voffA); PG8_STAGE(PG8_SB(1, 1), cB + hstep + kstep, voffB);
        PG8_WAIT_V(6); PG8_BAR;
    }
    for (;;) {
        const bool has_next = S.next(ui + 1, nxt);
        const char* nA = has_next ? (const char*)g.A + (size_t)nxt.pm * tstep : cA; const char* nB = has_next ? (const char*)g.Bt + (size_t)nxt.pn * tstep : cB;
        for (int t = 0; t < nt; t += 2) {
            const bool last = (t == nt - 2);
            const char* a1 = cA + (size_t)(t + 1) * kstep;
            const char* a2 = last ? nA : cA + (size_t)(t + 2) * kstep; const char* b2 = last ? nB : cB + (size_t)(t + 2) * kstep;
            const char* a3 = a2 + kstep; const char* b3 = b2 + kstep;
            if (last && has_next) S.a_ready(nxt);
            if constexpr (SP2) {
            PG8_LDB(B0, 0, 0); PG8_LDB(B1, 0, 1); PG8_SCHED; PG8_LDA(At, 0, 0); PG8_STAGE(PG8_SA(1, 1), a1 + hstep, voffA);
            PG8_WAIT_V(8); PG8_WAIT_L(0); PG8_BAR; PG8_MMA(0, 0, At, B0); PG8_MMA(0, 1, At, B1); PG8_BAR; PG8_SCHED;
            PG8_LDA(At, 0, 1); PG8_STAGE(PG8_SB(0, 0), b2, voffB); PG8_STAGE(PG8_SB(0, 1), b2 + hstep, voffB); PG8_STAGE(PG8_SA(0, 0), a2, voffA);
            PG8_WAIT_V(8); PG8_WAIT_L(0); PG8_BAR; PG8_MMA(1, 0, At, B0); PG8_MMA(1, 1, At, B1); PG8_BAR; PG8_SCHED;
            PG8_LDB(B0, 1, 0); PG8_LDB(B1, 1, 1); PG8_SCHED; PG8_LDA(At, 1, 0); PG8_STAGE(PG8_SA(0, 1), a2 + hstep, voffA);
            PG8_WAIT_V(8); PG8_WAIT_L(0); PG8_BAR; PG8_MMA(0, 0, At, B0); PG8_MMA(0, 1, At, B1); PG8_BAR; PG8_SCHED;
            PG8_LDA(At, 1, 1); PG8_STAGE(PG8_SB(1, 0), b3, voffB); PG8_STAGE(PG8_SB(1, 1), b3 + hstep, voffB); PG8_STAGE(PG8_SA(1, 0), a3, voffA);
            PG8_WAIT_V(8); PG8_WAIT_L(0); PG8_BAR; PG8_MMA(1, 0, At, B0); PG8_MMA(1, 1, At, B1); PG8_BAR; PG8_SCHED;
            } else {
            PG8_LDB(B0, 0, 0); PG8_SCHED; PG8_LDA(At, 0, 0); PG8_STAGE(PG8_SA(1, 1), a1 + hstep, voffA);
            PG8_WAIT_L(8); PG8_BAR; PG8_WAIT_L(0); PG8_MMA(0, 0, At, B0); PG8_BAR; PG8_SCHED;
            PG8_LDB(B1, 0, 1); PG8_STAGE(PG8_SB(0, 0), b2, voffB);
            PG8_BAR; PG8_WAIT_L(0); PG8_MMA(0, 1, At, B1); PG8_BAR;
            PG8_LDA(At, 0, 1); PG8_STAGE(PG8_SA(0, 0), a2, voffA);
            PG8_BAR; PG8_WAIT_L(0); PG8_MMA(1, 0, At, B0); PG8_BAR; PG8_SCHED;
            PG8_STAGE(PG8_SB(0, 1), b2 + hstep, voffB);
            PG8_WAIT_V(6); PG8_BAR; PG8_MMA(1, 1, At, B1); PG8_BAR;
            PG8_LDB(B0, 1, 0); PG8_SCHED; PG8_LDA(At, 1, 0); PG8_STAGE(PG8_SA(0, 1), a2 + hstep, voffA);
            PG8_WAIT_L(8); PG8_BAR; PG8_WAIT_L(0); PG8_MMA(0, 0, At, B0); PG8_BAR; PG8_SCHED;
            PG8_LDB(B1, 1, 1); PG8_STAGE(PG8_SB(1, 0), b3, voffB);
            PG8_BAR; PG8_WAIT_L(0); PG8_MMA(0, 1, At, B1); PG8_BAR;
            PG8_LDA(At, 1, 1); PG8_STAGE(PG8_SA(1, 0), a3, voffA);
            PG8_BAR; PG8_WAIT_L(0); PG8_MMA(1, 0, At, B0); PG8_BAR; PG8_SCHED;
            PG8_STAGE(PG8_SB(1, 1), b3 + hstep, voffB);
            PG8_WAIT_V(6); PG8_BAR; PG8_MMA(1, 1, At, B1); PG8_BAR;
            }
        }
        if constexpr (ALIGN_EPI) { if (wr == 0) PG8_BAR; }
        if constexpr (!Epi::AFTER_DRAIN) { E(acc, cur, wr, wc, fr, fq); S.done(cur); }
        if (!has_next) break;
#pragma unroll
        for (int a = 0; a < 2; ++a)
#pragma unroll
            for (int b = 0; b < 2; ++b)
#pragma unroll
                for (int m = 0; m < 4; ++m)
#pragma unroll
                    for (int n = 0; n < 2; ++n) acc[a][b][m][n] = (f32x4){0.f, 0.f, 0.f, 0.f};
        cur = nxt; cA = nA; cB = nB; ++ui;
        if constexpr (ALIGN_EPI) { if (wr == 1) PG8_BAR; }
    }
    PG8_WAIT_V(0);
    if constexpr (!ALIGN_EPI) { if (wr == 0) PG8_BAR; }
    PG8_BAR;
    if constexpr (Epi::AFTER_DRAIN) { E.fused(acc, cur, wr, wc, fr, fq, lds, wid, lane); S.done(cur); }
#undef PG8_SA
#undef PG8_SB
#undef PG8_STAGE
#undef PG8_LDA
#undef PG8_LDB
#undef PG8_MMA
#undef PG8_WAIT_V
#undef PG8_WAIT_L
#undef PG8_BAR
#undef PG8_SCHED
}
}
#include <hip/hip_bf16.h>
#include <cmath>
namespace attn_body {
using bf16=__hip_bfloat16;
using bf16x8=__attribute__((ext_vector_type(8)))short;
using s16x4=__attribute__((ext_vector_type(4)))short;
using f32x16=__attribute__((ext_vector_type(16)))float;
using u32x4=__attribute__((ext_vector_type(4)))unsigned;
constexpr int BATCH=32,NHEAD=16,SEQ=2048,D=64,DM=1536,OP=1024;
constexpr int NW=8,QBLK=32,QB=QBLK*NW,KVBLK=64,NQB=SEQ/QB;
constexpr int ATTN_PITCH=DM, ATTN_UNIT_ROWS=QB;
__device__ __forceinline__ int crow(int r,int hi){return (r&3)+8*(r>>2)+4*hi;}
#define SBAR() __builtin_amdgcn_sched_barrier(0)
__device__ __forceinline__ void cmask(f32x16&p0,f32x16&p1,int jb,int qrel,int hi){
  const float NEG=-INFINITY; int kb=64*jb+4*hi;
  #pragma unroll
  for(int r=0;r<16;++r){int kv=kb+(r&3)+8*(r>>2); if(kv>qrel)p0[r]=NEG; if(kv+32>qrel)p1[r]=NEG;}
}

constexpr int NSLOT=3, SLOTB=8192;
constexpr int LDS_K=0, LDS_V=NSLOT*SLOTB, LDS_WS=2*NSLOT*SLOTB, LDS_OST=LDS_WS+NW*64*4, LDS_BYTES=LDS_OST+NW*4096;
constexpr float C2=0.125f*1.4426950408889634f;
__device__ __forceinline__ void glds16(const void*gsrc,unsigned lds_dst){unsigned keep;
  asm volatile("s_mov_b32 %0, m0\n\ts_mov_b32 m0, %2\n\ts_nop 0\n\tglobal_load_lds_dwordx4 %1, off\n\ts_mov_b32 m0, %0":"=&s"(keep):"v"(gsrc),"s"(lds_dst):"memory");}
__device__ __forceinline__ float max3f(float a,float b,float c){float r;asm("v_max3_f32 %0, %1, %2, %3":"=v"(r):"v"(a),"v"(b),"v"(c));return r;}
__device__ __forceinline__ float max2f(float a,float b){float r;asm("v_max_f32_e32 %0, %1, %2":"=v"(r):"v"(a),"v"(b));return r;}
__device__ __forceinline__ float fadd_s(float a,float b){float r;asm("v_add_f32_e32 %0, %1, %2":"=v"(r):"v"(a),"v"(b));return r;}
__device__ __forceinline__ float fsub_s(float a,float b){float r;asm("v_sub_f32_e32 %0, %1, %2":"=v"(r):"v"(a),"v"(b));return r;}
typedef float f32x2_t __attribute__((ext_vector_type(2))); typedef __bf16 bf16x2_t __attribute__((ext_vector_type(2)));
__device__ __forceinline__ unsigned cvtpk_s(float lo,float hi){f32x2_t v={lo,hi};bf16x2_t b=__builtin_convertvector(v,bf16x2_t);return __builtin_bit_cast(unsigned,b);}
#define WAIT_BAR(N) asm volatile("s_waitcnt vmcnt(" #N ") lgkmcnt(0)\n\ts_barrier":::"memory")

__device__ __forceinline__ void qkt(f32x16&p0,f32x16&p1,const char*Kslot,const bf16x8*qr,const f32x16&negm,int r32,int hi){
  const char*kb=Kslot+hi*1024+r32*16;
  #pragma unroll
  for(int d0=0;d0<4;++d0){
    const bf16x8 b0=*reinterpret_cast<const bf16x8*>(kb+d0*2048);
    const bf16x8 b1=*reinterpret_cast<const bf16x8*>(kb+d0*2048+512);
    if(d0==0){p0=__builtin_amdgcn_mfma_f32_32x32x16_bf16(b0,qr[0],negm,0,0,0);p1=__builtin_amdgcn_mfma_f32_32x32x16_bf16(b1,qr[0],negm,0,0,0);}
    else{p0=__builtin_amdgcn_mfma_f32_32x32x16_bf16(b0,qr[d0],p0,0,0,0);p1=__builtin_amdgcn_mfma_f32_32x32x16_bf16(b1,qr[d0],p1,0,0,0);}}
}
typedef __attribute__((address_space(3))) const char* lds_cptr;
typedef short v4i16_t __attribute__((ext_vector_type(4)));
__device__ __forceinline__ void kload8(bf16x8*kf,lds_cptr kp){
  kf[0]=*(const __attribute__((address_space(3))) bf16x8*)(kp);      kf[1]=*(const __attribute__((address_space(3))) bf16x8*)(kp+512);
  kf[2]=*(const __attribute__((address_space(3))) bf16x8*)(kp+2048); kf[3]=*(const __attribute__((address_space(3))) bf16x8*)(kp+2560);
  kf[4]=*(const __attribute__((address_space(3))) bf16x8*)(kp+4096); kf[5]=*(const __attribute__((address_space(3))) bf16x8*)(kp+4608);
  kf[6]=*(const __attribute__((address_space(3))) bf16x8*)(kp+6144); kf[7]=*(const __attribute__((address_space(3))) bf16x8*)(kp+6656);
}
__device__ __forceinline__ void kload2(bf16x8*kf,lds_cptr kp,int j){ kf[2*j]=*(const __attribute__((address_space(3))) bf16x8*)(kp+j*2048); kf[2*j+1]=*(const __attribute__((address_space(3))) bf16x8*)(kp+j*2048+512); }
__device__ __forceinline__ s16x4 vtr(lds_cptr p){ return __builtin_bit_cast(s16x4,__builtin_amdgcn_ds_read_tr16_b64_v4i16((__attribute__((address_space(3))) v4i16_t*)p)); }
__device__ __forceinline__ float rowmax(const f32x16&p0,const f32x16&p1){
  float a=max3f(p0[0],p0[1],p1[0]),b=max3f(p0[2],p0[3],p1[1]);a=max3f(a,p1[2],p1[3]);
  #pragma unroll
  for(int r=4;r<16;r+=4){a=max3f(a,p0[r],p0[r+1]);b=max3f(b,p0[r+2],p0[r+3]);a=max3f(a,p1[r],p1[r+1]);b=max3f(b,p1[r+2],p1[r+3]);}
  const float m=max2f(a,b);
  auto rr=__builtin_amdgcn_permlane32_swap(__float_as_uint(m),__float_as_uint(m),false,false);
  return max2f(__uint_as_float(rr[0]),__uint_as_float(rr[1]));
}
__device__ __forceinline__ void pv(f32x16*o,int vb,bf16x8 pa0,bf16x8 pa1,bf16x8 pa2,bf16x8 pa3){
  #pragma unroll
  for(int d0=0;d0<2;++d0){s16x4 lo[4],hi[4];
    #pragma unroll
    for(int ks=0;ks<4;++ks){
      asm volatile("ds_read_b64_tr_b16 %0,%1 offset:%c2":"=&v"(lo[ks]):"v"(vb),"i"(d0*4096+ks*1024):"memory");
      asm volatile("ds_read_b64_tr_b16 %0,%1 offset:%c2":"=&v"(hi[ks]):"v"(vb),"i"(d0*4096+ks*1024+512):"memory");}
    asm volatile("s_waitcnt lgkmcnt(0)":::"memory");SBAR();
    #define PK(k) (bf16x8){lo[k][0],lo[k][1],lo[k][2],lo[k][3],hi[k][0],hi[k][1],hi[k][2],hi[k][3]}
    o[d0]=__builtin_amdgcn_mfma_f32_32x32x16_bf16(pa0,PK(0),o[d0],0,0,0);
    o[d0]=__builtin_amdgcn_mfma_f32_32x32x16_bf16(pa1,PK(1),o[d0],0,0,0);
    o[d0]=__builtin_amdgcn_mfma_f32_32x32x16_bf16(pa2,PK(2),o[d0],0,0,0);
    o[d0]=__builtin_amdgcn_mfma_f32_32x32x16_bf16(pa3,PK(3),o[d0],0,0,0);
    #undef PK
  }
}

#ifndef ATTN_STORE16
#define ATTN_STORE16(p,v) (*(u32x4*)(p)=(v))
#endif
template<int THRL> __device__ __forceinline__ void attn_unit(int b,int h,int qb,const bf16*Q,const bf16*__restrict__ K,const bf16*__restrict__ V,bf16*O,char*shm){
  const int tid=threadIdx.x,lane=tid&63,r32=lane&31,hi=lane>>5; const int wid=__builtin_amdgcn_readfirstlane(tid>>6);
  const long rowbase=(long)b*SEQ; const int q0=qb*QB;
  const bf16*Qw=Q+(rowbase+q0+wid*QBLK)*DM+h*D;
  const bf16*Kh=K+rowbase*DM+(h>>2)*D,*Vh=V+rowbase*DM+(h>>2)*D;
  const unsigned lds0=(unsigned)(uintptr_t)shm;
  float*wsf=(float*)(shm+LDS_WS)+wid*64;
  const bf16*ksrc=Kh+(long)lane*DM+wid*8;
  const bf16*vsrc=Vh+(long)(16*(wid&3)+(lane>>2))*DM+(wid>>2)*32+(lane&3)*8;
  const unsigned kdst=lds0+LDS_K+wid*1024, vdst=lds0+LDS_V+wid*1024;
  #define DMA_K(t,slot) glds16(ksrc+(long)(t)*KVBLK*DM,(unsigned)__builtin_amdgcn_readfirstlane(kdst+(slot)))
  #define DMA_V(t,slot) glds16(vsrc+(long)(t)*KVBLK*DM,(unsigned)__builtin_amdgcn_readfirstlane(vdst+(slot)))
  const int vb0=(int)(lds0+LDS_V)+((lane>>4)&1)*32+(lane&3)*8+(4*hi+((lane&15)>>2))*64;
  const char*Kbase=shm+LDS_K; bf16x8 kf[8];
  const lds_cptr shm3=(lds_cptr)shm; const lds_cptr kp0=shm3+LDS_K+hi*1024+r32*16; const lds_cptr vp0=shm3+LDS_V+((lane>>4)&1)*32+(lane&3)*8+(4*hi+((lane&15)>>2))*64;
  const int NT=SEQ/KVBLK;
  DMA_K(0,0);DMA_V(0,0);DMA_K(1,SLOTB);
  bf16x8 qr[4];
  #pragma unroll
  for(int d0=0;d0<4;++d0)qr[d0]=*reinterpret_cast<const bf16x8*>(&Qw[(long)r32*DM+d0*16+hi*8]);
  float mhat=0.f,l_reg=0.f;f32x16 o[2];o[0]=f32x16{};o[1]=f32x16{};f32x16 negm=f32x16{};asm volatile("":"+v"(negm));

  #define CMASK(P0,P1,t) do{}while(0)
  bool resc=false;
  #define START(P0,P1) do{ const float rm=rowmax(P0,P1); resc=false; \
    { const float dl=rm; mhat=fadd_s(mhat,dl); \
      _Pragma("unroll") for(int r=0;r<16;++r){P0[r]=fsub_s(P0[r],dl);P1[r]=fsub_s(P1[r],dl);} \
      _Pragma("unroll") for(int r=0;r<16;++r)negm[r]=-mhat; asm volatile("":"+v"(negm)); } \
    _Pragma("unroll") for(int r=0;r<16;++r)P0[r]=__builtin_amdgcn_exp2f(P0[r]); }while(0)
  #define RESC() do{ if(resc){ asm volatile("s_waitcnt lgkmcnt(0)":::"memory"); \
      _Pragma("unroll") for(int d_=0;d_<2;++d_) _Pragma("unroll") for(int r=0;r<16;++r)o[d_][r]*=wsf[crow(r,hi)]; } }while(0)
  f32x16 pA0,pA1,pB0,pB1;
  int sl_prev=0,sl_cur=0,sl_next=SLOTB;
  #define ROT() do{sl_prev=sl_cur;sl_cur=sl_next;sl_next=(sl_next==(NSLOT-1)*SLOTB)?0:sl_next+SLOTB;}while(0)
  DMA_K(2,2*SLOTB);
  WAIT_BAR(3);
  qkt(pA0,pA1,Kbase,qr,negm,r32,hi);asm volatile("s_nop 15\n\ts_nop 7":"+v"(pA0),"+v"(pA1));CMASK(pA0,pA1,0);
  START(pA0,pA1);
  _Pragma("unroll") for(int r=0;r<16;++r)pA1[r]=__builtin_amdgcn_exp2f(pA1[r]);
  WAIT_BAR(0);
  DMA_K(3,0);DMA_V(1,SLOTB);
  ROT();
  kload8(kf,kp0+sl_cur);
  WAIT_BAR(2);
  s16x4 vlo[8],vhi[8]; u32x4 pw0,pw1,pw2,pw3;
  #define PKW(P,B) cvtpk_s(P[B],P[B+1])
  #define PAF(k) __builtin_bit_cast(bf16x8,pw##k)
  #define VFR(i) (bf16x8){vlo[i][0],vlo[i][1],vlo[i][2],vlo[i][3],vhi[i][0],vhi[i][1],vhi[i][2],vhi[i][3]}
  #define PIN(x) asm volatile("":"+v"(x))
  #define MX3(a,b,c) __builtin_fmaxf(__builtin_fmaxf((a),(b)),(c))
  #define GAPA(MF,A0,A1,A2,A3,W0,W1,PW) do{ MF; sacc+=A0; sacc+=A1; sacc+=A2; sacc+=A3; PIN(sacc); W0; W1; PIN(PW); SBAR(); }while(0)
  #define EX(v) __builtin_amdgcn_exp2f(v)
  #define GAPB(MF,X,B) do{ MF; X[B]=EX(X[B]); X[B+1]=EX(X[B+1]); X[B+2]=EX(X[B+2]); X[B+3]=EX(X[B+3]); PIN(X); SBAR(); }while(0)
  #define VRD(i) do{ vlo[i]=vtr(vp_+(((i)>>2)*4096+((i)&3)*1024)); vhi[i]=vtr(vp_+(((i)>>2)*4096+((i)&3)*1024+512)); }while(0)
  #define KRD(G,j) do{ if(G){ kload2(kf,kp0+sl_next,j); SBAR(); } }while(0)
  #define STEP(C0,C1,P0,P1,t,GK,GV,GL) do{ SBAR(); \
    const lds_cptr vp_=vp0+sl_prev; \
    VRD(0); SBAR(); float sacc=(P0[0]+P0[1]); \
    GAPA(C0=__builtin_amdgcn_mfma_f32_32x32x16_bf16(kf[0],qr[0],negm,0,0,0), P0[2],P0[3],P0[4],P0[5],     pw0[0]=PKW(P0,0), pw0[1]=PKW(P0,2), pw0); \
    VRD(4); SBAR(); GAPA(C1=__builtin_amdgcn_mfma_f32_32x32x16_bf16(kf[1],qr[0],negm,0,0,0), P0[6],P0[7],P0[8],P0[9],     pw0[2]=PKW(P0,4), pw0[3]=PKW(P0,6), pw0); \
    VRD(1); SBAR(); GAPA(C0=__builtin_amdgcn_mfma_f32_32x32x16_bf16(kf[2],qr[1],C0,0,0,0),   P0[10],P0[11],P0[12],P0[13], pw1[0]=PKW(P0,8), pw1[1]=PKW(P0,10), pw1); \
    VRD(5); SBAR(); GAPA(C1=__builtin_amdgcn_mfma_f32_32x32x16_bf16(kf[3],qr[1],C1,0,0,0),   P0[14],P0[15],P1[0],P1[1],   pw1[2]=PKW(P0,12),pw1[3]=PKW(P0,14), pw1); \
    VRD(2); SBAR(); GAPA(C0=__builtin_amdgcn_mfma_f32_32x32x16_bf16(kf[4],qr[2],C0,0,0,0),   P1[2],P1[3],P1[4],P1[5],     pw2[0]=PKW(P1,0), pw2[1]=PKW(P1,2), pw2); \
    VRD(6); SBAR(); GAPA(C1=__builtin_amdgcn_mfma_f32_32x32x16_bf16(kf[5],qr[2],C1,0,0,0),   P1[6],P1[7],P1[8],P1[9],     pw2[2]=PKW(P1,4), pw2[3]=PKW(P1,6), pw2); \
    VRD(3); SBAR(); GAPA(C0=__builtin_amdgcn_mfma_f32_32x32x16_bf16(kf[6],qr[3],C0,0,0,0),   P1[10],P1[11],P1[12],P1[13], pw3[0]=PKW(P1,8), pw3[1]=PKW(P1,10), pw3); \
    VRD(7); SBAR(); GAPA(C1=__builtin_amdgcn_mfma_f32_32x32x16_bf16(kf[7],qr[3],C1,0,0,0),   P1[14],P1[15],0.f,0.f,       pw3[2]=PKW(P1,12),pw3[3]=PKW(P1,14), pw3); \
    l_reg+=sacc; \
    if(GK){DMA_K((t)+3,sl_cur);} if(GV){DMA_V((t)+1,sl_next);} \
    CMASK(C0,C1,t); \
    { float a=MX3(C0[0],C0[1],C1[0]),b=MX3(C0[2],C0[3],C1[1]); a=MX3(a,C1[2],C1[3]); \
      _Pragma("unroll") for(int r=4;r<16;r+=4){a=MX3(a,C0[r],C0[r+1]);b=MX3(b,C0[r+2],C0[r+3]);a=MX3(a,C1[r],C1[r+1]);b=MX3(b,C1[r+2],C1[r+3]);} \
      float rm=__builtin_fmaxf(a,b); { auto rr=__builtin_amdgcn_permlane32_swap(__float_as_uint(rm),__float_as_uint(rm),false,false); rm=__builtin_fmaxf(__uint_as_float(rr[0]),__uint_as_float(rr[1])); } \
      resc=false; \
      if(__builtin_expect(__any(rm>(float)THRL),0)){ const float dl=__builtin_fmaxf(rm,0.f); mhat+=dl; \
        _Pragma("unroll") for(int r=0;r<16;++r){C0[r]-=dl;C1[r]-=dl;} \
        _Pragma("unroll") for(int r=0;r<16;++r)negm[r]=-mhat; asm volatile("":"+v"(negm)); \
        const float f=__builtin_amdgcn_exp2f(-dl); l_reg*=f; if(hi==0)wsf[r32]=f; resc=true; } } \
    SBAR(); \
    GAPB(o[0]=__builtin_amdgcn_mfma_f32_32x32x16_bf16(PAF(0),VFR(0),o[0],0,0,0), C0,0); \
    GAPB(o[1]=__builtin_amdgcn_mfma_f32_32x32x16_bf16(PAF(0),VFR(4),o[1],0,0,0), C0,4); \
    KRD(GL,0); GAPB(o[0]=__builtin_amdgcn_mfma_f32_32x32x16_bf16(PAF(1),VFR(1),o[0],0,0,0), C0,8); \
    KRD(GL,1); GAPB(o[1]=__builtin_amdgcn_mfma_f32_32x32x16_bf16(PAF(1),VFR(5),o[1],0,0,0), C0,12); \
    KRD(GL,2); GAPB(o[0]=__builtin_amdgcn_mfma_f32_32x32x16_bf16(PAF(2),VFR(2),o[0],0,0,0), C1,0); \
    KRD(GL,3); GAPB(o[1]=__builtin_amdgcn_mfma_f32_32x32x16_bf16(PAF(2),VFR(6),o[1],0,0,0), C1,4); \
    GAPB(o[0]=__builtin_amdgcn_mfma_f32_32x32x16_bf16(PAF(3),VFR(3),o[0],0,0,0), C1,8); \
    GAPB(o[1]=__builtin_amdgcn_mfma_f32_32x32x16_bf16(PAF(3),VFR(7),o[1],0,0,0), C1,12); \
    }while(0)
  int t=1;
  #undef CMASK
  #define CMASK(P0,P1,t) do{}while(0)
  for(;t+5<NT;t+=2){
    STEP(pB0,pB1,pA0,pA1,t,true,true,true);     WAIT_BAR(2); RESC(); ROT();
    STEP(pA0,pA1,pB0,pB1,t+1,true,true,true);   WAIT_BAR(2); RESC(); ROT();
  }
  #undef CMASK
  #define CMASK(P0,P1,t) do{}while(0)
  #define ENDW(tt) do{ if((tt)+3<NT){WAIT_BAR(2);} else if((tt)+2<NT){WAIT_BAR(1);} else {WAIT_BAR(0);} }while(0)
  for(;t+1<NT;t+=2){
    STEP(pB0,pB1,pA0,pA1,t,(t+3<NT),(t+1<NT),(t+1<NT));       ENDW(t);   RESC(); ROT();
    STEP(pA0,pA1,pB0,pB1,t+1,(t+4<NT),(t+2<NT),(t+2<NT));     ENDW(t+1); RESC(); ROT();
  }
  STEP(pB0,pB1,pA0,pA1,NT-1,false,false,false); RESC();
  { float sacc=pB0[0]+pB0[1]; _Pragma("unroll") for(int r=2;r<16;++r)sacc+=pB0[r]; _Pragma("unroll") for(int r=0;r<16;++r)sacc+=pB1[r]; l_reg+=sacc;
    pw0=(u32x4){PKW(pB0,0),PKW(pB0,2),PKW(pB0,4),PKW(pB0,6)};pw1=(u32x4){PKW(pB0,8),PKW(pB0,10),PKW(pB0,12),PKW(pB0,14)};pw2=(u32x4){PKW(pB1,0),PKW(pB1,2),PKW(pB1,4),PKW(pB1,6)};pw3=(u32x4){PKW(pB1,8),PKW(pB1,10),PKW(pB1,12),PKW(pB1,14)};
    SBAR(); pv(o,vb0+sl_cur,PAF(0),PAF(1),PAF(2),PAF(3)); }
  #undef PKW
  #undef PAF
  #undef VFR
  #undef PIN
  #undef MX3
  #undef GAPA
  #undef GAPB
  #undef EX
  #undef VRD
  #undef KRD
  #undef STEP
  #undef ENDW
  {auto rr=__builtin_amdgcn_permlane32_swap(__float_as_uint(l_reg),__float_as_uint(l_reg),false,false);l_reg=__uint_as_float(rr[0])+__uint_as_float(rr[1]);}
  if(hi==0)wsf[32+r32]=l_reg;asm volatile("s_waitcnt lgkmcnt(0)":::"memory");
  float rli[16];
  #pragma unroll
  for(int r=0;r<16;++r)rli[r]=__builtin_amdgcn_rcpf(wsf[32+crow(r,hi)]);
  bf16*Ow=O+(rowbase+q0+wid*QBLK)*OP+h*D;
  { bf16*stg=(bf16*)(shm+LDS_OST)+wid*2048;
    #pragma unroll
    for(int r=0;r<16;++r){const int orow=crow(r,hi);
      #pragma unroll
      for(int d0=0;d0<2;++d0)stg[orow*64+d0*32+r32]=__float2bfloat16(o[d0][r]*rli[r]);}
    asm volatile("s_waitcnt lgkmcnt(0)":::"memory");
    #pragma unroll
    for(int i=0;i<4;++i){const int row=i*8+(lane>>3),ch=lane&7; const u32x4 v=*(const u32x4*)(stg+row*64+ch*8); ATTN_STORE16(Ow+(long)row*OP+ch*8,v);} }
  asm volatile("s_waitcnt lgkmcnt(0)\n\ts_barrier":::"memory");
  #undef DMA_K
  #undef DMA_V
  #undef CMASK
  #undef START
  #undef RESC
  #undef ROT
}
constexpr int ATTN_LDS_BYTES=LDS_BYTES;
struct AttnTensors { const bf16* Q; const bf16* K; const bf16* V; bf16* O; };
struct AttnUnit { int bh; int qb; };
struct StaticOrder {
  int vcu,G;
  __device__ __forceinline__ explicit StaticOrder(int grid,int block):vcu((grid%8==0)?(block%8)*(grid/8)+block/8:block),G(grid){}
  __device__ __forceinline__ bool next(int i,AttnUnit&u)const{ const int x=i*G+vcu; if(x>=BATCH*NHEAD*NQB)return false; u.bh=x>>3; u.qb=x&7; return true; }
  __device__ __forceinline__ void a_ready(const AttnUnit&)const{}
  __device__ __forceinline__ void done(const AttnUnit&)const{}
};
template<class Sched,int THRL=8> __device__ __forceinline__ void attn_phase(char*lds,const AttnTensors&T,const Sched&S){
  AttnUnit u;
  for(int i=0;S.next(i,u);++i){ S.a_ready(u); attn_unit<THRL>(u.bh/NHEAD,u.bh%NHEAD,u.qb,T.Q,T.K,T.V,T.O,lds); S.done(u); }
}
#undef SBAR
#undef WAIT_BAR
}
constexpr int NWAVES = 8;
#ifndef DEPTH_
#define DEPTH_ 4
#endif
constexpr int M = 65536, D = 1024, SEQ = 2048, NBATCH = 32, FF = 4096, DPLE = 256, DEPTH = DEPTH_;
constexpr float DN_ALPHA = 1.6817928305074290f;
constexpr float LN_EPS = 1e-6f;
constexpr size_t MiB = 1u << 20;
constexpr size_t WS_W = 2 * MiB;
constexpr size_t WS_WIN = WS_W, WS_WO = WS_W + 28 * MiB, WS_W1G = WS_W + 36 * MiB, WS_W2 = WS_W + 76 * MiB, WS_WP = WS_W + 108 * MiB;
constexpr size_t WS_XN = 114 * MiB;
constexpr size_t WS_PB = 242 * MiB;
constexpr size_t WS_GATES = 274 * MiB;
constexpr size_t WS_QKV = 282 * MiB;
constexpr size_t WS_O = 698 * MiB;
constexpr size_t WS_PP = 826 * MiB;
constexpr size_t WS_H = 282 * MiB;
constexpr size_t WS_END = 954 * MiB;
constexpr int LDS_BYTES = 163840, LDS_CTL = LDS_BYTES - 512;

#define GAS __attribute__((address_space(1)))
#define LAS __attribute__((address_space(3)))
typedef unsigned short bf16;
typedef unsigned v4u __attribute__((ext_vector_type(4)));
typedef float f32x4 __attribute__((ext_vector_type(4)));
typedef short bf16x8 __attribute__((ext_vector_type(8)));
#define LDS_WAIT() asm volatile("s_waitcnt lgkmcnt(0)" ::: "memory")
typedef float f32x2_t_ __attribute__((ext_vector_type(2))); typedef __bf16 bf16x2_t_ __attribute__((ext_vector_type(2)));
__device__ __forceinline__ unsigned pk2(float lo, float hi) { const f32x2_t_ v = {lo, hi}; const bf16x2_t_ b = __builtin_convertvector(v, bf16x2_t_); return __builtin_bit_cast(unsigned, b); }
__device__ __forceinline__ unsigned f2bf(float f) { return pk2(f, f) & 0xffffu; }
__device__ __forceinline__ float bf2f(unsigned short h) { return __uint_as_float(((unsigned)h) << 16); }
__device__ __forceinline__ f32x4 mfma16(bf16x8 a, bf16x8 b, f32x4 c) { return __builtin_amdgcn_mfma_f32_16x16x32_bf16(a, b, c, 0, 0, 0); }
__device__ __forceinline__ float wave_sum(float v) {
#pragma unroll
    for (int o = 1; o < 64; o <<= 1) v += __shfl_xor(v, o);
    return v;
}

struct Args { const float* in[21]; float* out; unsigned char* ws; int skip, pad; };

__device__ __forceinline__ void p0_transpose_item(const float* W, int K, int N, bf16* WT, int row_off, LAS float* scr, int item, int lane) {
    const int nblk = N / 32, kb = item / nblk, nb = item % nblk, k0 = 64 * kb, n0 = 32 * nb;
#pragma unroll
    for (int i = 0; i < 32; ++i) { const int kk = 2 * i + (lane >> 5); scr[kk * 33 + (lane & 31)] = W[(size_t)(k0 + kk) * N + n0 + (lane & 31)]; }
    LDS_WAIT(); asm volatile("" ::: "memory");
    const int c = lane & 7;
#pragma unroll
    for (int j = 0; j < 4; ++j) { const int n = (lane >> 3) + 8 * j; const LAS float* s = scr + (8 * c) * 33 + n;
        v4u o; o.x = pk2(s[0 * 33], s[1 * 33]); o.y = pk2(s[2 * 33], s[3 * 33]); o.z = pk2(s[4 * 33], s[5 * 33]); o.w = pk2(s[6 * 33], s[7 * 33]);
        *(v4u*)(WT + (size_t)(row_off + n0 + n) * K + k0 + 8 * c) = o; }
    LDS_WAIT(); asm volatile("" ::: "memory");
}
struct WDesc { const float* src; int K, N; bf16* dst; int row_off; };
__device__ __forceinline__ WDesc wdesc(const Args& a, int idx) {
    const int l = idx / 6, kind = idx % 6; WDesc w; unsigned char* ws = a.ws;
    if (kind == 0) { w.K = 1024; w.row_off = 0; w.dst = (bf16*)(ws + WS_WIN + (size_t)l * 7 * MiB);
        if (l == 0) { w.src = a.in[2]; w.N = 3072; } else if (l == 1) { w.src = a.in[5]; w.N = 1536; } else if (l == 2) { w.src = a.in[9]; w.N = 3104; } else { w.src = a.in[2] + (size_t)1024 * 3072; w.N = 3072; } }
    else if (kind == 1) { w.K = 1024; w.N = 1024; w.row_off = 0; w.dst = (bf16*)(ws + WS_WO + (size_t)l * 2 * MiB);
        w.src = (l == 0) ? a.in[4] : (l == 1) ? a.in[8] : (l == 2) ? a.in[12] : a.in[4] + (size_t)1024 * 1024; }
    else if (kind == 2) { w.K = 1024; w.N = 4096; w.row_off = 0; w.dst = (bf16*)(ws + WS_W1G + (size_t)l * 10 * MiB); w.src = a.in[15] + (size_t)l * 1024 * 4096; }
    else if (kind == 3) { w.K = 1024; w.N = 1024; w.row_off = 4096; w.dst = (bf16*)(ws + WS_W1G + (size_t)l * 10 * MiB); w.src = a.in[19] + (size_t)l * 1024 * 1024; }
    else if (kind == 4) { w.K = 4096; w.N = 1024; w.row_off = 0; w.dst = (bf16*)(ws + WS_W2 + (size_t)l * 8 * MiB); w.src = a.in[16] + (size_t)l * 4096 * 1024; }
    else { w.K = 256; w.N = 1024; w.row_off = 0; w.dst = (bf16*)(ws + WS_WP + (size_t)l * (MiB / 2)); w.src = a.in[20] + (size_t)l * 256 * 1024; }
    return w;
}
__device__ __forceinline__ void cvt_rows(const float* src, bf16* dst, size_t n, int G) {
    const size_t nth = (size_t)G * 512, n8 = n / 8;
    for (size_t i0 = (size_t)blockIdx.x * 512 + threadIdx.x; i0 < n8; i0 += 4 * nth) {
        f32x4 a[4], b[4];
#pragma unroll
        for (int q = 0; q < 4; ++q) { const size_t i = i0 + q * nth; if (i < n8) { a[q] = *(const f32x4*)(src + i * 8); b[q] = *(const f32x4*)(src + i * 8 + 4); } }
#pragma unroll
        for (int q = 0; q < 4; ++q) { const size_t i = i0 + q * nth; if (i < n8) { v4u o; o.x = pk2(a[q][0], a[q][1]); o.y = pk2(a[q][2], a[q][3]); o.z = pk2(b[q][0], b[q][1]); o.w = pk2(b[q][2], b[q][3]);
            *(v4u*)(dst + i * 8) = o; } }
    }
}
__device__ __forceinline__ void prologue_phase(const Args& a, LAS unsigned char* lds, int G) {
    const int tid = threadIdx.x, lane = tid & 63, wave = tid >> 6;
    LAS float* scr = (LAS float*)(lds + wave * 16384);
    const int gw = blockIdx.x * NWAVES + wave, NGW = G * NWAVES;
    for (int idx = 0; idx < 24; ++idx) { const WDesc w = wdesc(a, idx); const int nitems = (w.K / 64) * (w.N / 32);
        for (int it = gw; it < nitems; it += NGW) p0_transpose_item(w.src, w.K, w.N, w.dst, w.row_off, scr, it, lane); }
    {
        v4u* z = (v4u*)((bf16*)(a.ws + WS_WIN + (size_t)2 * 7 * MiB) + (size_t)3104 * 1024); const size_t n16 = (size_t)224 * 1024 * 2 / 16;
        for (size_t i = (size_t)blockIdx.x * 512 + tid; i < n16; i += (size_t)G * 512) z[i] = (v4u){0u, 0u, 0u, 0u}; }
    cvt_rows(a.in[0], (bf16*)(a.ws + WS_XN), (size_t)M * D, G);
    cvt_rows(a.in[1], (bf16*)(a.ws + WS_PB), (size_t)M * DPLE, G);
}
__device__ __forceinline__ void ln_phase_bf(bf16* X, const float* g, const float* bta, float* outf, int G) {
    const int lane = threadIdx.x & 63, wave = threadIdx.x >> 6; const int gw = blockIdx.x * NWAVES + wave, NGW = G * NWAVES;
    f32x4 gv[4], bv[4];
#pragma unroll
    for (int j = 0; j < 4; ++j) { const int c = (j >> 1) * 512 + 8 * lane + (j & 1) * 4; gv[j] = *(const f32x4*)(g + c); bv[j] = *(const f32x4*)(bta + c); }
    for (int m = gw; m < M; m += NGW) {
        bf16* xr = X + (size_t)m * D + 8 * lane;
        const v4u r0 = *(const v4u*)xr, r1 = *(const v4u*)(xr + 512);
        f32x4 v[4];
        v[0] = (f32x4){__uint_as_float(r0.x << 16), __uint_as_float(r0.x & 0xffff0000u), __uint_as_float(r0.y << 16), __uint_as_float(r0.y & 0xffff0000u)};
        v[1] = (f32x4){__uint_as_float(r0.z << 16), __uint_as_float(r0.z & 0xffff0000u), __uint_as_float(r0.w << 16), __uint_as_float(r0.w & 0xffff0000u)};
        v[2] = (f32x4){__uint_as_float(r1.x << 16), __uint_as_float(r1.x & 0xffff0000u), __uint_as_float(r1.y << 16), __uint_as_float(r1.y & 0xffff0000u)};
        v[3] = (f32x4){__uint_as_float(r1.z << 16), __uint_as_float(r1.z & 0xffff0000u), __uint_as_float(r1.w << 16), __uint_as_float(r1.w & 0xffff0000u)};
        float s = 0.f;
#pragma unroll
        for (int j = 0; j < 4; ++j) s += (v[j][0] + v[j][1]) + (v[j][2] + v[j][3]);
        const float mean = wave_sum(s) * (1.f / D); float s2 = 0.f;
#pragma unroll
        for (int j = 0; j < 4; ++j) { v[j] = v[j] - mean; s2 += (v[j][0] * v[j][0] + v[j][1] * v[j][1]) + (v[j][2] * v[j][2] + v[j][3] * v[j][3]); }
        const float rstd = 1.f / sqrtf(wave_sum(s2) * (1.f / D) + LN_EPS);
#pragma unroll
        for (int j = 0; j < 4; ++j) v[j] = v[j] * rstd * gv[j] + bv[j];
        if (outf) { float* o = outf + (size_t)m * D + 8 * lane; *(f32x4*)o = v[0]; *(f32x4*)(o + 4) = v[1]; *(f32x4*)(o + 512) = v[2]; *(f32x4*)(o + 516) = v[3]; }
        else { *(v4u*)xr = (v4u){pk2(v[0][0], v[0][1]), pk2(v[0][2], v[0][3]), pk2(v[1][0], v[1][1]), pk2(v[1][2], v[1][3])};
               *(v4u*)(xr + 512) = (v4u){pk2(v[2][0], v[2][1]), pk2(v[2][2], v[2][3]), pk2(v[3][0], v[3][1]), pk2(v[3][2], v[3][3])}; }
    }
}

__device__ __forceinline__ void ln_rows32(bf16* X, int row0, const float* g, const float* bta, float* outf) {
    const int lane = threadIdx.x & 63;
    f32x4 gv[4], bv[4];
#pragma unroll
    for (int j = 0; j < 4; ++j) { const int c = (j >> 1) * 512 + 8 * lane + (j & 1) * 4; gv[j] = *(const f32x4*)(g + c); bv[j] = *(const f32x4*)(bta + c); }
    for (int it = 0; it < 8; ++it) {
        v4u r0[4], r1[4];
#pragma unroll
        for (int q = 0; q < 4; ++q) { const bf16* xr = X + (size_t)(row0 + it * 4 + q) * D + 8 * lane; r0[q] = *(const v4u*)xr; r1[q] = *(const v4u*)(xr + 512); }
#pragma unroll
        for (int q = 0; q < 4; ++q) {
            f32x4 v[4];
            v[0] = (f32x4){__uint_as_float(r0[q].x << 16), __uint_as_float(r0[q].x & 0xffff0000u), __uint_as_float(r0[q].y << 16), __uint_as_float(r0[q].y & 0xffff0000u)};
            v[1] = (f32x4){__uint_as_float(r0[q].z << 16), __uint_as_float(r0[q].z & 0xffff0000u), __uint_as_float(r0[q].w << 16), __uint_as_float(r0[q].w & 0xffff0000u)};
            v[2] = (f32x4){__uint_as_float(r1[q].x << 16), __uint_as_float(r1[q].x & 0xffff0000u), __uint_as_float(r1[q].y << 16), __uint_as_float(r1[q].y & 0xffff0000u)};
            v[3] = (f32x4){__uint_as_float(r1[q].z << 16), __uint_as_float(r1[q].z & 0xffff0000u), __uint_as_float(r1[q].w << 16), __uint_as_float(r1[q].w & 0xffff0000u)};
            float s = 0.f;
#pragma unroll
            for (int j = 0; j < 4; ++j) s += (v[j][0] + v[j][1]) + (v[j][2] + v[j][3]);
            const float mean = wave_sum(s) * (1.f / D); float s2 = 0.f;
#pragma unroll
            for (int j = 0; j < 4; ++j) { v[j] = v[j] - mean; s2 += (v[j][0] * v[j][0] + v[j][1] * v[j][1]) + (v[j][2] * v[j][2] + v[j][3] * v[j][3]); }
            const float rstd = 1.f / sqrtf(wave_sum(s2) * (1.f / D) + LN_EPS);
#pragma unroll
            for (int j = 0; j < 4; ++j) v[j] = v[j] * rstd * gv[j] + bv[j];
            const size_t ro = (size_t)(row0 + it * 4 + q) * D + 8 * lane;
            if (outf) { float* o = outf + ro; *(f32x4*)o = v[0]; *(f32x4*)(o + 4) = v[1]; *(f32x4*)(o + 512) = v[2]; *(f32x4*)(o + 516) = v[3]; }
            else { bf16* xr = X + ro; *(v4u*)xr = (v4u){pk2(v[0][0], v[0][1]), pk2(v[0][2], v[0][3]), pk2(v[1][0], v[1][1]), pk2(v[1][2], v[1][3])};
                   *(v4u*)(xr + 512) = (v4u){pk2(v[2][0], v[2][1]), pk2(v[2][2], v[2][3]), pk2(v[3][0], v[3][1]), pk2(v[3][2], v[3][3])}; }
        }
    }
}
struct LnOrder {
    pg8::StaticOrder base; bf16* X; const float* g; const float* bta; float* outf; unsigned* cnt; volatile LAS unsigned* flag;
    __device__ __forceinline__ bool next(int i, pg8::Unit& u) const { return base.next(i, u); }
    __device__ __forceinline__ void a_ready(const pg8::Unit&) const {}
    __device__ __forceinline__ void done(const pg8::Unit& u) const {
        asm volatile("s_waitcnt vmcnt(0)" ::: "memory");
        __builtin_amdgcn_s_barrier();
        if (threadIdx.x == 0) {
            __builtin_amdgcn_fence(__ATOMIC_RELEASE, "agent");
            const unsigned old = __hip_atomic_fetch_add(cnt + u.pm, 1u, __ATOMIC_RELAXED, __HIP_MEMORY_SCOPE_AGENT);
            if (old == 3u) __builtin_amdgcn_fence(__ATOMIC_ACQUIRE, "agent");
            flag[0] = old;
        }
        asm volatile("s_waitcnt vmcnt(0) lgkmcnt(0)" ::: "memory");
        __builtin_amdgcn_s_barrier();
        asm volatile("" ::: "memory");
        if (flag[0] == 3u) ln_rows32(X, u.pm * 256 + (int)(threadIdx.x >> 6) * 32, g, bta, outf);
    }
};

struct PanelLnOrder {
    int nM, G, c; bf16* X; const float* g; const float* bta; float* outf;
    __device__ __forceinline__ bool next(int i, pg8::Unit& u) const { const int p = (i >> 2) * G + c; if (p >= nM) return false; u.pm = p; u.pn = i & 3; return true; }
    __device__ __forceinline__ void a_ready(const pg8::Unit&) const {}
    __device__ __forceinline__ void done(const pg8::Unit& u) const {
        if (u.pn == 3) {
            asm volatile("s_waitcnt vmcnt(0)" ::: "memory");
            __builtin_amdgcn_s_barrier();
            asm volatile("" ::: "memory");
            ln_rows32(X, u.pm * 256 + (int)(threadIdx.x >> 6) * 32, g, bta, outf);
        }
    }
};
typedef unsigned long long u64_t;
#define NA_LBAR() asm volatile("s_waitcnt lgkmcnt(0)\n\ts_barrier" ::: "memory")
__device__ __forceinline__ void na_phase(const bf16* QKV, const float* rpb, bf16* O, LAS unsigned char* lds, int G) {
    const int tid = threadIdx.x, lane = tid & 63, wave = tid >> 6, l15 = lane & 15, quad = lane >> 4;
    const int jq = wave & 3, half = wave >> 2;
    LAS unsigned char* Kimg = lds;
    LAS unsigned char* Vimg = lds + 65536;
    LAS float* scr = (LAS float*)(lds + 131072);
    const int kc0 = (jq == 0) ? 0 : (jq == 1) ? 8 : (jq == 2) ? 24 : 32;
    const int c = jq * 16 + l15, c0 = min(max(c - 8, 0), 48);
    const int scol = tid >> 3, sch = tid & 7;
    for (int bh = blockIdx.x; bh < 512; bh += G) {
        const int b = bh >> 4, h = bh & 15; const size_t tokb = (size_t)b * 2048;
        const bf16* kbase = QKV + (tokb + scol) * 3072 + 1024 + h * 64 + sch * 8;
        const bf16* qbase = QKV + (tokb + c) * 3072 + h * 64 + quad * 8;
        const float* rp = rpb + h * (15 * 31);
        __syncthreads();
#define NA_STAGE_WRITE(kv, vv, slot) do { const int kidx_ = (slot) * 64 + scol; \
            *(LAS v4u*)(Kimg + kidx_ * 128 + ((sch ^ (kidx_ & 7)) * 16)) = (kv); \
            const unsigned vw_[4] = {(vv).x, (vv).y, (vv).z, (vv).w}; \
            _Pragma("unroll") for (int e_ = 0; e_ < 8; ++e_) { const int dh_ = sch * 8 + e_; \
                *(LAS bf16*)(Vimg + ((slot) * 64 + dh_) * 128 + (((scol >> 2) ^ (dh_ & 15)) * 8) + (scol & 3) * 2) = (bf16)((e_ & 1) ? (vw_[e_ >> 1] >> 16) : (vw_[e_ >> 1] & 0xffffu)); } } while (0)
#pragma unroll
        for (int g4 = 0; g4 < 2; ++g4) { v4u kk[4], vv[4];
#pragma unroll
            for (int i = 0; i < 4; ++i) { const bf16* p = kbase + (size_t)(g4 * 4 + i) * 64 * 3072; kk[i] = *(const v4u*)p; vv[i] = *(const v4u*)(p + 1024); }
#pragma unroll
            for (int i = 0; i < 4; ++i) NA_STAGE_WRITE(kk[i], vv[i], g4 * 4 + i); }
        bf16x8 qn0 = *(const bf16x8*)qbase, qn1 = *(const bf16x8*)(qbase + 32);
        __syncthreads();
        int prev_off = 1000; f32x4 bt[4][2];
#pragma unroll
        for (int ai = 0; ai < 4; ++ai) { bt[ai][0] = (f32x4){0.f, 0.f, 0.f, 0.f}; bt[ai][1] = (f32x4){0.f, 0.f, 0.f, 0.f}; }
        for (int r = 0; r < 32; ++r) {
            const int r0 = min(max(r - 4, 0), 24);
            const bf16x8 qf0 = qn0, qf1 = qn1;
            const bool slide = (r + 1 < 32) && (min(max(r - 3, 0), 24) != r0);
            v4u nk = {0u, 0u, 0u, 0u}, nv = {0u, 0u, 0u, 0u};
            if (slide) { const bf16* p = kbase + (size_t)(r0 + 8) * 64 * 3072; nk = *(const v4u*)p; nv = *(const v4u*)(p + 1024); }
            if (r + 1 < 32) { const bf16* p = qbase + (size_t)(r + 1) * 64 * 3072; qn0 = *(const bf16x8*)p; qn1 = *(const bf16x8*)(p + 32); }
            const int off = r0 - r;
            if (off != prev_off) { prev_off = off;
#pragma unroll
                for (int ai = 0; ai < 4; ++ai) { const int dr = off + half * 4 + ai + 7;
#pragma unroll
                    for (int cb = 0; cb < 2; ++cb)
#pragma unroll
                        for (int j = 0; j < 4; ++j) { const int kc = kc0 + cb * 16 + quad * 4 + j; const bool valid = (kc >= c0) && (kc < c0 + 16);
                            const int dc = min(max(kc - c + 15, 0), 30); const float bias = rp[dr * 31 + dc] * 1.4426950408889634f; bt[ai][cb][j] = valid ? bias : -INFINITY; } } }
            f32x4 sc[4][2]; float mx = -INFINITY;
#pragma unroll
            for (int ai = 0; ai < 4; ++ai) { const int slot = (r0 + half * 4 + ai) & 7;
#pragma unroll
                for (int cb = 0; cb < 2; ++cb) { const int kidx = slot * 64 + kc0 + cb * 16 + l15; const LAS unsigned char* ka = Kimg + kidx * 128;
                    const bf16x8 k0 = *(const LAS bf16x8*)(ka + ((quad ^ (kidx & 7)) * 16)), k1 = *(const LAS bf16x8*)(ka + (((quad + 4) ^ (kidx & 7)) * 16));
                    f32x4 acc = {0.f, 0.f, 0.f, 0.f}; acc = mfma16(k0, qf0, acc); acc = mfma16(k1, qf1, acc);
                    acc = acc + bt[ai][cb];
                    mx = fmaxf(fmaxf(fmaxf(mx, acc[0]), fmaxf(acc[1], acc[2])), acc[3]); sc[ai][cb] = acc; } }
            mx = fmaxf(mx, __shfl_xor(mx, 16)); mx = fmaxf(mx, __shfl_xor(mx, 32));
            float sum = 0.f;
#pragma unroll
            for (int ai = 0; ai < 4; ++ai)
#pragma unroll
                for (int cb = 0; cb < 2; ++cb)
#pragma unroll
                    for (int j = 0; j < 4; ++j) { const float p = __builtin_amdgcn_exp2f(sc[ai][cb][j] - mx); sc[ai][cb][j] = p; sum += p; }
            sum += __shfl_xor(sum, 16); sum += __shfl_xor(sum, 32);
            f32x4 o[4];
#pragma unroll
            for (int db = 0; db < 4; ++db) o[db] = (f32x4){0.f, 0.f, 0.f, 0.f};
#pragma unroll
            for (int ai = 0; ai < 4; ++ai) { const int slot = (r0 + half * 4 + ai) & 7;
                const v4u pw = {pk2(sc[ai][0][0], sc[ai][0][1]), pk2(sc[ai][0][2], sc[ai][0][3]), pk2(sc[ai][1][0], sc[ai][1][1]), pk2(sc[ai][1][2], sc[ai][1][3])};
                const bf16x8 pb = __builtin_bit_cast(bf16x8, pw);
                const int ch = (kc0 >> 2) + quad;
#pragma unroll
                for (int db = 0; db < 4; ++db) { const LAS unsigned char* va = Vimg + (slot * 64 + db * 16 + l15) * 128;
                    const u64_t lo = *(const LAS u64_t*)(va + ((ch ^ l15) * 8)), hi = *(const LAS u64_t*)(va + (((ch + 4) ^ l15) * 8));
                    const v4u vw = {(unsigned)lo, (unsigned)(lo >> 32), (unsigned)hi, (unsigned)(hi >> 32)};
                    o[db] = mfma16(__builtin_bit_cast(bf16x8, vw), pb, o[db]); } }
            if (half == 1) { LAS float* s = scr + jq * 18 * 64 + lane; s[0] = mx; s[64] = sum;
#pragma unroll
                for (int db = 0; db < 4; ++db)
#pragma unroll
                    for (int j = 0; j < 4; ++j) s[(2 + db * 4 + j) * 64] = o[db][j]; }
            NA_LBAR();
            if (half == 0) { const LAS float* s = scr + jq * 18 * 64 + lane; const float m1 = s[0], l1 = s[64];
                const float m = fmaxf(mx, m1), f0 = __builtin_amdgcn_exp2f(mx - m), f1 = __builtin_amdgcn_exp2f(m1 - m); const float inv = 1.0f / (sum * f0 + l1 * f1);
                const float g0 = f0 * inv, g1 = f1 * inv;
                bf16* op = O + (tokb + r * 64 + c) * 1024 + h * 64 + quad * 4;
#pragma unroll
                for (int db = 0; db < 4; ++db) { float v[4];
#pragma unroll
                    for (int j = 0; j < 4; ++j) v[j] = o[db][j] * g0 + s[(2 + db * 4 + j) * 64] * g1;
                    *(u64_t*)(op + db * 16) = (u64_t)pk2(v[0], v[1]) | ((u64_t)pk2(v[2], v[3]) << 32); } }
            if (slide) NA_STAGE_WRITE(nk, nv, r0 & 7);
            NA_LBAR();
        }
#undef NA_STAGE_WRITE
    }
}
__device__ __forceinline__ void gq_normrope_item(bf16* QKV, const float* qn, const float* kn, size_t g, const v4u raw) {
    const size_t item = g >> 3; const int l8 = (int)(g & 7); const size_t tok = item / 20; const int hv = (int)(item % 20);
    bf16* p = QKV + tok * 1536 + hv * 64 + l8 * 8;
    const unsigned rw[4] = {raw.x, raw.y, raw.z, raw.w};
    float x[8]; float ss = 0.f;
#pragma unroll
    for (int e = 0; e < 4; ++e) { x[2 * e] = __uint_as_float(rw[e] << 16); x[2 * e + 1] = __uint_as_float(rw[e] & 0xffff0000u); ss += x[2 * e] * x[2 * e] + x[2 * e + 1] * x[2 * e + 1]; }
    ss += __shfl_xor(ss, 1); ss += __shfl_xor(ss, 2); ss += __shfl_xor(ss, 4);
    const float rinv = 1.0f / sqrtf(ss * (1.f / 64.f) + 1e-6f);
    const float* gvec = ((hv < 16) ? qn : kn) + l8 * 8;
    const int s = (int)(tok & 2047), row = s >> 6, col = s & 63;
    const float scale = (hv < 16) ? (0.125f * 1.4426950408889634f) : 1.0f;
    unsigned ow[4];
#pragma unroll
    for (int pr = 0; pr < 4; ++pr) { const int i = l8 * 4 + pr; const float pos = (float)((i < 16) ? row : col); const int fi = i & 15;
        const float inv = exp2f(-(float)fi * (13.287712379549449f / 16.f)); const float ang = pos * inv;
        float rev = ang * 0.15915494309189535f; rev -= rintf(rev);
        const float sn = __builtin_amdgcn_sinf(rev), cs = __builtin_amdgcn_cosf(rev);
        const float x0 = x[2 * pr] * rinv * gvec[2 * pr], x1 = x[2 * pr + 1] * rinv * gvec[2 * pr + 1];
        ow[pr] = pk2((x0 * cs - x1 * sn) * scale, (x0 * sn + x1 * cs) * scale); }
    *(v4u*)p = (v4u){ow[0], ow[1], ow[2], ow[3]};
}
__device__ __forceinline__ void gq_normrope_phase(bf16* QKV, const float* qn, const float* kn, int G) {
    const size_t total = (size_t)M * 20 * 8, nth = (size_t)G * 512;
    size_t g = (size_t)blockIdx.x * 512 + threadIdx.x;
    for (; g + 3 * nth < total; g += 4 * nth) {
        v4u raw[4];
#pragma unroll
        for (int q = 0; q < 4; ++q) { const size_t gi = g + q * nth; const size_t item = gi >> 3; raw[q] = *(const v4u*)(QKV + (item / 20) * 1536 + (item % 20) * 64 + (gi & 7) * 8); }
#pragma unroll
        for (int q = 0; q < 4; ++q) gq_normrope_item(QKV, qn, kn, g + q * nth, raw[q]);
    }
    for (; g < total; g += nth) { const size_t item = g >> 3; const v4u raw = *(const v4u*)(QKV + (item / 20) * 1536 + (item % 20) * 64 + (g & 7) * 8); gq_normrope_item(QKV, qn, kn, g, raw); }
}
__device__ __forceinline__ f32x4 tile_mma64(const LAS bf16* A, int arow0, const LAS bf16* Bt, int brow0, f32x4 acc, int l15, int quad) {
    const LAS bf16* ap = A + (arow0 + l15) * 72 + quad * 8; const LAS bf16* bp = Bt + (brow0 + l15) * 72 + quad * 8;
    acc = mfma16(*(const LAS bf16x8*)ap, *(const LAS bf16x8*)bp, acc);
    acc = mfma16(*(const LAS bf16x8*)(ap + 32), *(const LAS bf16x8*)(bp + 32), acc);
    return acc;
}
__device__ __forceinline__ bf16x8 ml_fp(const LAS bf16* base, int row, int chunk) { return *(const LAS bf16x8*)(base + row * 72 + chunk * 8); }
__device__ __forceinline__ bf16x8 ml_fs(const LAS bf16* base, int row, int chunk) { return *(const LAS bf16x8*)((const LAS unsigned char*)base + row * 128 + ((chunk ^ (row & 7) ^ ((row >> 3) & 7)) * 16)); }
#define ML_TILE(acc_, FA, A_, ar_, FB, B_, br_) do { const int ra_ = (ar_) + l15, rb_ = (br_) + l15; \
    acc_ = mfma16(FA(A_, ra_, quad), FB(B_, rb_, quad), acc_); acc_ = mfma16(FA(A_, ra_, quad + 4), FB(B_, rb_, quad + 4), acc_); } while (0)
__device__ __forceinline__ void ml_phase(const bf16* Z, const float* gates, const float* norm_g, bf16* HFW, bf16* O, LAS unsigned char* lds, int G) {
    const int tid = threadIdx.x, lane = tid & 63, wave = tid >> 6, l15 = lane & 15, quad = lane >> 4;
    LAS bf16* Qs = (LAS bf16*)(lds);
    LAS bf16* Ks = (LAS bf16*)(lds + 9216);
    LAS bf16* Vt = (LAS bf16*)(lds + 18432);
    LAS bf16* Kt = (LAS bf16*)(lds + 39168);
    LAS bf16* Ct = (LAS bf16*)(lds + 48384);
    LAS bf16* As = (LAS bf16*)(lds + 69120);
    LAS float* Hs = (LAS float*)(lds + 78336);
    LAS float* vec = (LAS float*)(lds + 112128);
    for (int unit = blockIdx.x; unit < 256; unit += G) {
        const int b = unit >> 3, h = unit & 7; const size_t tokb = (size_t)b * 2048;
        for (int dir = 0; dir < 2; ++dir) {
            for (int i = tid; i < 144 * 72; i += 512) Ct[i] = 0;
            for (int i = tid; i < 16 * 64; i += 512) Vt[128 * 64 + i] = (i < 64) ? (bf16)0x3F80 : (bf16)0;
            f32x4 cst[4], cst8 = {0.f, 0.f, 0.f, 0.f};
#pragma unroll
            for (int i = 0; i < 4; ++i) cst[i] = (f32x4){0.f, 0.f, 0.f, 0.f};
            float m_run = 0.f;
            const int t8 = tid >> 3, ch = tid & 7;
#define ML_TOK(cs_, t_) (tokb + (size_t)(dir == 0 ? (cs_) * 64 + (t_) : 2047 - ((cs_) * 64 + (t_))))
            v4u pq, pk; bf16x8 pv[2]; float pli = 0.f, pf = 0.f;
#define ML_FETCH(cs_) do { const bf16* zr_ = Z + ML_TOK(cs_, t8) * 3072; pq = *(const v4u*)(zr_ + h * 64 + ch * 8); pk = *(const v4u*)(zr_ + 512 + h * 64 + ch * 8); \
                pv[0] = *(const bf16x8*)(zr_ + 1024 + h * 128 + ch * 8); pv[1] = *(const bf16x8*)(zr_ + 1024 + h * 128 + (ch + 8) * 8); \
                if (wave == 0) { const size_t tk_ = ML_TOK(cs_, lane); pli = gates[tk_ * 32 + dir * 16 + h]; pf = gates[tk_ * 32 + dir * 16 + 8 + h]; } } while (0)
            ML_FETCH(0);
            __syncthreads();
            for (int cs = 0; cs < 32; ++cs) {
                const size_t tok8 = ML_TOK(cs, t8);
                {
                    *(LAS v4u*)(Qs + t8 * 72 + ch * 8) = pq;
                    *(LAS v4u*)(Ks + t8 * 72 + ch * 8) = pk;
#pragma unroll
                    for (int i = 0; i < 2; ++i) { const int c16 = ch + 8 * i;
#pragma unroll
                        for (int e = 0; e < 8; ++e) Vt[(c16 * 8 + e) * 64 + ((((t8 >> 3) ^ e ^ ch) & 7) * 8) + (t8 & 7)] = (bf16)pv[i][e]; }
                }
                const float li = pli, f = pf;
                if (cs + 1 < 32) ML_FETCH(cs + 1);
                v4u hf0 = {0u, 0u, 0u, 0u}, hf1 = {0u, 0u, 0u, 0u}, og0 = {0u, 0u, 0u, 0u}, og1 = {0u, 0u, 0u, 0u};
                if (dir == 1) { const bf16* hp = HFW + tok8 * 1024 + h * 128 + ch * 16; hf0 = *(const v4u*)hp; hf1 = *(const v4u*)(hp + 8);
                    const bf16* og = Z + tok8 * 3072 + 2048 + h * 128 + ch * 16; og0 = *(const v4u*)og; og1 = *(const v4u*)(og + 8); }
                if (wave == 0) {
                    const float lf = fminf(f, 0.f) - log1pf(__expf(-fabsf(f)));
                    float bs = lf;
#pragma unroll
                    for (int o = 1; o < 64; o <<= 1) { const float y = __shfl_up(bs, o); if (lane >= o) bs += y; }
                    const float u = li - bs; float pm = u;
#pragma unroll
                    for (int o = 1; o < 64; o <<= 1) { const float y = __shfl_up(pm, o); if (lane >= o) pm = fmaxf(pm, y); }
                    const float Mt = fmaxf(pm, m_run), sint = __expf(m_run - Mt), mt = bs + Mt;
                    vec[lane] = u; vec[64 + lane] = Mt; vec[128 + lane] = sint; vec[192 + lane] = __expf(-mt);
                    m_run = __shfl(mt, 63);
                }
                NA_LBAR();
                {
                    const int tb = wave >> 1;
#pragma unroll
                    for (int i = 0; i < 2; ++i) { const int sb = 2 * (wave & 1) + i;
                        f32x4 acc = {0.f, 0.f, 0.f, 0.f}; if (sb <= tb) ML_TILE(acc, ml_fp, Qs, tb * 16, ml_fp, Ks, sb * 16);
                        const int s = sb * 16 + l15; const float us = vec[s];
#pragma unroll
                        for (int j = 0; j < 4; ++j) { const int t = tb * 16 + 4 * quad + j; const float w = (s <= t) ? __expf(us - vec[64 + t]) : 0.f; As[t * 72 + s] = (bf16)f2bf(acc[j] * w); } }
                    const float w63 = __expf(vec[t8] - vec[64 + 63]);
                    const bf16x8 kk = *(const LAS bf16x8*)(Ks + t8 * 72 + ch * 8);
#pragma unroll
                    for (int e = 0; e < 8; ++e) Kt[(ch * 8 + e) * 64 + ((((t8 >> 3) ^ e ^ ch) & 7) * 8) + (t8 & 7)] = (bf16)f2bf(bf2f((bf16)kk[e]) * w63);
                }
                NA_LBAR();
                {
#pragma unroll
                    for (int tb = 0; tb < 4; ++tb) { const f32x4 z4 = {0.f, 0.f, 0.f, 0.f};
                        f32x4 ah = z4, ag = z4; ML_TILE(ah, ml_fp, As, tb * 16, ml_fs, Vt, wave * 16); ML_TILE(ag, ml_fp, Qs, tb * 16, ml_fp, Ct, wave * 16);
#pragma unroll
                        for (int j = 0; j < 4; ++j) { const int t = tb * 16 + 4 * quad + j; Hs[t * 132 + wave * 16 + l15] = vec[128 + t] * ag[j] + ah[j]; } }
                    if (wave < 4) { const int tb = wave; const f32x4 z4 = {0.f, 0.f, 0.f, 0.f};
                        f32x4 ah = z4, ag = z4; ML_TILE(ah, ml_fp, As, tb * 16, ml_fs, Vt, 128); ML_TILE(ag, ml_fp, Qs, tb * 16, ml_fp, Ct, 128);
                        if (l15 == 0) {
#pragma unroll
                            for (int j = 0; j < 4; ++j) { const int t = tb * 16 + 4 * quad + j; vec[256 + t] = vec[128 + t] * ag[j] + ah[j]; } } }
                }
                NA_LBAR();
                {
                    const float decay = vec[128 + 63];
#pragma unroll
                    for (int db = 0; db < 4; ++db) { cst[db] = cst[db] * decay; ML_TILE(cst[db], ml_fs, Vt, wave * 16, ml_fs, Kt, db * 16);
#pragma unroll
                        for (int j = 0; j < 4; ++j) Ct[(wave * 16 + 4 * quad + j) * 72 + db * 16 + l15] = (bf16)f2bf(cst[db][j]); }
                    if (wave < 4) { cst8 = cst8 * decay; ML_TILE(cst8, ml_fs, Vt, 128, ml_fs, Kt, wave * 16);
#pragma unroll
                        for (int j = 0; j < 4; ++j) Ct[(128 + 4 * quad + j) * 72 + wave * 16 + l15] = (bf16)f2bf(cst8[j]); }
                    const float dn = fmaxf(fabsf(vec[256 + t8]), vec[192 + t8]); const float rd = 1.0f / dn;
                    float hv[16];
#pragma unroll
                    for (int e = 0; e < 16; ++e) hv[e] = Hs[t8 * 132 + ch * 16 + e] * rd;
                    const size_t ho = tok8 * 1024 + h * 128 + ch * 16;
                    if (dir == 0) {
                        v4u w0, w1; w0.x = pk2(hv[0], hv[1]); w0.y = pk2(hv[2], hv[3]); w0.z = pk2(hv[4], hv[5]); w0.w = pk2(hv[6], hv[7]);
                        w1.x = pk2(hv[8], hv[9]); w1.y = pk2(hv[10], hv[11]); w1.z = pk2(hv[12], hv[13]); w1.w = pk2(hv[14], hv[15]);
                        *(v4u*)(HFW + ho) = w0; *(v4u*)(HFW + ho + 8) = w1;
                    } else {
                        const unsigned fw[8] = {hf0.x, hf0.y, hf0.z, hf0.w, hf1.x, hf1.y, hf1.z, hf1.w};
                        float ss = 0.f;
#pragma unroll
                        for (int e = 0; e < 8; ++e) { hv[2 * e] += __uint_as_float(fw[e] << 16); hv[2 * e + 1] += __uint_as_float(fw[e] & 0xffff0000u); ss += hv[2 * e] * hv[2 * e] + hv[2 * e + 1] * hv[2 * e + 1]; }
                        ss += __shfl_xor(ss, 1); ss += __shfl_xor(ss, 2); ss += __shfl_xor(ss, 4);
                        const float rinv = 1.0f / sqrtf(ss * (1.f / 128.f) + 1e-6f);
                        const unsigned gw_[8] = {og0.x, og0.y, og0.z, og0.w, og1.x, og1.y, og1.z, og1.w};
                        const float* ng = norm_g + h * 128 + ch * 16;
                        unsigned ow[8];
#pragma unroll
                        for (int e = 0; e < 8; ++e) { const float o0 = 1.0f / (1.0f + __expf(-__uint_as_float(gw_[e] << 16))), o1 = 1.0f / (1.0f + __expf(-__uint_as_float(gw_[e] & 0xffff0000u)));
                            ow[e] = pk2(hv[2 * e] * rinv * ng[2 * e] * o0, hv[2 * e + 1] * rinv * ng[2 * e + 1] * o1); }
                        *(v4u*)(O + ho) = (v4u){ow[0], ow[1], ow[2], ow[3]}; *(v4u*)(O + ho + 8) = (v4u){ow[4], ow[5], ow[6], ow[7]};
                    }
                }
                NA_LBAR();
            }
#undef ML_FETCH
#undef ML_TOK
        }
    }
}
#define RLX_AGENT __ATOMIC_RELAXED, __HIP_MEMORY_SCOPE_AGENT
#define XB_TMO      128
#define XB_XCNT(j)  (256  + 64 * (j))
#define XB_XSUB(j)  (1280 + 64 * (j))
#define XB_XGEN(j)  (2304 + 64 * (j))
#define XB_TOP      3328
#define XB_TOPGEN   3392
#define XCD_BAR_WORDS 3456
#define XB_SPIN_CAP (1u << 18)

__device__ __forceinline__ unsigned xb_ld(unsigned* p)              { return __hip_atomic_load(p, __ATOMIC_RELAXED, __HIP_MEMORY_SCOPE_AGENT); }
__device__ __forceinline__ unsigned xb_add(unsigned* p, unsigned v) { return __hip_atomic_fetch_add(p, v, __ATOMIC_RELAXED, __HIP_MEMORY_SCOPE_AGENT); }
__device__ __forceinline__ unsigned xb_xcc_id() { return (unsigned)__builtin_amdgcn_s_getreg((3 << 11) | 20) & 0xFu; }
#define XB_SPIN(cond, bar) do { unsigned _sp = 0; while (cond) { __builtin_amdgcn_s_sleep(1); \
    if ((++_sp & 255u) == 0u) { if (xb_ld(&(bar)[XB_TMO])) break; if (_sp > XB_SPIN_CAP) { atomicAdd(&(bar)[XB_TMO], 1u); break; } } } } while (0)

struct XcdBarrier {
    unsigned* bar; unsigned x;
    volatile LAS unsigned* st;
};

__device__ __forceinline__ XcdBarrier xcd_barrier_post(unsigned* bar, volatile LAS unsigned* st) {
    XcdBarrier b; b.bar = bar; b.x = xb_xcc_id(); b.st = st;
    if (threadIdx.x == 0) (void)xb_add(&bar[XB_XCNT(b.x)], 1u);
    return b;
}
__device__ __forceinline__ void xcd_barrier_complete(unsigned* bar, unsigned x, unsigned& nloc, unsigned& nx) {
    const unsigned G = gridDim.x * gridDim.y * gridDim.z;
    unsigned sum, cnt, mine, sp = 0u;
    for (;;) {
        sum = 0u; cnt = 0u; mine = 0u;
#pragma unroll
        for (unsigned j = 0; j < 16; ++j) { const unsigned c = xb_ld(&bar[XB_XCNT(j)]); sum += c; cnt += (c > 0u) ? 1u : 0u; mine = (j == x) ? c : mine; }
        if (sum == G) break;
        __builtin_amdgcn_s_sleep(1);
        if ((++sp & 255u) == 0u) { if (xb_ld(&bar[XB_TMO])) break; if (sp > XB_SPIN_CAP) { atomicAdd(&bar[XB_TMO], 1u); break; } }
    }
    nloc = mine > 0u ? mine : 1u; nx = cnt > 0u ? cnt : 1u;
}

__device__ __forceinline__ void xcd_barrier(const XcdBarrier& b) {
    asm volatile("s_waitcnt vmcnt(0)" ::: "memory");
    __syncthreads();
    if (threadIdx.x == 0) {
        unsigned* bar = b.bar;
        __builtin_amdgcn_s_waitcnt(0);
        unsigned nloc = b.st[0], nx = b.st[1];
        if (nloc == 0u) { xcd_barrier_complete(bar, b.x, nloc, nx); b.st[0] = nloc; b.st[1] = nx; }
        const unsigned old = xb_add(&bar[XB_XSUB(b.x)], 1u);
        const unsigned gen = old / nloc;
        if (old + 1u == (gen + 1u) * nloc) {
            __builtin_amdgcn_fence(__ATOMIC_RELEASE, "agent");
            asm volatile("s_waitcnt vmcnt(0)" ::: "memory");
            const unsigned og = xb_add(&bar[XB_TOP], 1u);
            const unsigned tg = og / nx;
            if (og + 1u == (tg + 1u) * nx) xb_add(&bar[XB_TOPGEN], 1u);
            else XB_SPIN(xb_ld(&bar[XB_TOPGEN]) == tg, bar);
            __builtin_amdgcn_fence(__ATOMIC_ACQUIRE, "agent");
            xb_add(&bar[XB_XGEN(b.x)], 1u);
            asm volatile("s_waitcnt vmcnt(0)" ::: "memory");
        } else {
            XB_SPIN(xb_ld(&bar[XB_XGEN(b.x)]) == gen, bar);
            __builtin_amdgcn_fence(__ATOMIC_ACQUIRE, "agent");
            asm volatile("s_waitcnt vmcnt(0)" ::: "memory");
        }
    }
    __syncthreads();
}

#define GSYNC() xcd_barrier(bar)
#define SKIP(bit) ((skipmask >> (bit)) & 1)
template <int L> __device__ __forceinline__ void layer_program(const Args& a, LAS unsigned char* lds, unsigned char* lds_raw, const int G, const XcdBarrier& bar, const int skipmask) {
    constexpr int kind = L % 3;
    unsigned char* ws = a.ws;
    bf16* XN = (bf16*)(ws + WS_XN); bf16* QKV = (bf16*)(ws + WS_QKV); bf16* OB = (bf16*)(ws + WS_O); bf16* PP = (bf16*)(ws + WS_PP); bf16* HB = (bf16*)(ws + WS_H);
    if (!SKIP(1)) { const bf16* Win = (const bf16*)(ws + WS_WIN + (size_t)L * 7 * MiB);
        if constexpr (kind == 2) { pg8::Gemm g{XN, Win, M, 3328, D}; pg8::StaticOrder S; S.init(M, 3328, G, (int)blockIdx.x);
            pg8::EpiMl E{QKV, (float*)(ws + WS_GATES), a.in[10]};
            pg8::gemm_phase<pg8::EpiMl, pg8::StaticOrder, true, true>(lds, g, S, E); }
        else { constexpr int N = (kind == 0) ? 3072 : 1536; pg8::Gemm g{XN, Win, M, N, D}; pg8::StaticOrder S; S.init(M, N, G, (int)blockIdx.x);
            pg8::EpiPlain E{QKV, N, (kind == 0) ? 1024 : 0, 0.125f * 1.4426950408889634f};
            pg8::gemm_phase<pg8::EpiPlain, pg8::StaticOrder, true, true>(lds, g, S, E); } }
    if (!SKIP(2)) { pg8::Gemm g{(const bf16*)(ws + WS_PB), (const bf16*)(ws + WS_WP + (size_t)L * (MiB / 2)), M, D, DPLE}; pg8::StaticOrder S; S.init(M, D, G, (int)blockIdx.x);
        pg8::EpiPlain E{PP, D, 0, 1.f};
        pg8::gemm_phase<pg8::EpiPlain, pg8::StaticOrder, true, true>(lds, g, S, E); }
    GSYNC();
    if constexpr (kind == 1) { if (!SKIP(3)) gq_normrope_phase(QKV, a.in[6], a.in[7], G); GSYNC(); }
    if (!SKIP(4)) {
        if constexpr (kind == 0) na_phase(QKV, a.in[3] + (size_t)(L / 3) * 16 * 15 * 31, OB, lds, G);
        else if constexpr (kind == 1) { const attn_body::AttnTensors AT{(const attn_body::bf16*)QKV, (const attn_body::bf16*)(QKV + 1024), (const attn_body::bf16*)(QKV + 1280), (attn_body::bf16*)OB};
            const attn_body::StaticOrder S(G, (int)blockIdx.x); attn_body::attn_phase<attn_body::StaticOrder>((char*)lds_raw, AT, S); }
        else ml_phase(QKV, (const float*)(ws + WS_GATES), a.in[11], (bf16*)a.out, OB, lds, G);
    }
    GSYNC();
    if (!SKIP(5)) { pg8::Gemm g{OB, (const bf16*)(ws + WS_WO + (size_t)L * 2 * MiB), M, D, D};
        PanelLnOrder S; S.nM = M / 256; S.G = G; S.c = (int)blockIdx.x; S.X = XN; S.g = a.in[13] + (size_t)L * D; S.bta = a.in[14] + (size_t)L * D; S.outf = nullptr;
        pg8::EpiResidBf E{XN, nullptr, DN_ALPHA};
        pg8::gemm_phase<pg8::EpiResidBf, PanelLnOrder, true, true>(lds, g, S, E); }
    GSYNC();
    if (!SKIP(7)) { if constexpr (L + 1 < DEPTH) cvt_rows(a.in[1] + (size_t)(L + 1) * M * DPLE, (bf16*)(ws + WS_PB), (size_t)M * DPLE, G);
        pg8::Gemm g{XN, (const bf16*)(ws + WS_W1G + (size_t)L * 10 * MiB), M, FF + D, D}; pg8::StaticOrder S; S.init(M, FF + D, G, (int)blockIdx.x);
        pg8::EpiFf1 E{HB, PP};
        pg8::gemm_phase<pg8::EpiFf1, pg8::StaticOrder, true, true>(lds, g, S, E); }
    GSYNC();
    if (!SKIP(8)) { pg8::Gemm g{HB, (const bf16*)(ws + WS_W2 + (size_t)L * 8 * MiB), M, D, FF}; pg8::StaticOrder S; S.init(M, D, G, (int)blockIdx.x);
        pg8::EpiResidBf E{XN, PP, DN_ALPHA};
        pg8::gemm_phase<pg8::EpiResidBf, pg8::StaticOrder, true, true>(lds, g, S, E); }
    GSYNC();
    if (!SKIP(9)) { for (int r0 = ((int)blockIdx.x * NWAVES + (int)(threadIdx.x >> 6)) * 32; r0 < M; r0 += G * NWAVES * 32)
            ln_rows32(XN, r0, a.in[17] + (size_t)L * D, a.in[18] + (size_t)L * D, (L + 1 < DEPTH) ? nullptr : a.out); }
    if constexpr (L + 1 < DEPTH) GSYNC();
}
__global__ void __launch_bounds__(NWAVES * 64, 2) fwd_megakernel(Args a) {
    extern __shared__ __attribute__((aligned(16))) unsigned char lds_raw[];
    LAS unsigned char* lds = (LAS unsigned char*)lds_raw;
    cg::grid_group grid = cg::this_grid();
    const int G = gridDim.x;
    { volatile LAS unsigned* z = (volatile LAS unsigned*)(lds + LDS_CTL); if (threadIdx.x < 64) z[threadIdx.x] = 0u; }
    __syncthreads();
    const XcdBarrier bar = xcd_barrier_post((unsigned*)a.ws + 4096, (volatile LAS unsigned*)(lds + LDS_CTL + 64));
#ifdef PROBE_SKIP
#ifndef PROBE_LAYERS
#define PROBE_LAYERS 15
#endif
    {
        const int skipmask = a.skip;
        if (!SKIP(0)) prologue_phase(a, lds, G);
        GSYNC();
        if ((PROBE_LAYERS >> 0) & 1) layer_program<0>(a, lds, lds_raw, G, bar, skipmask); GSYNC();
        if ((PROBE_LAYERS >> 1) & 1) layer_program<1>(a, lds, lds_raw, G, bar, skipmask); GSYNC();
        if ((PROBE_LAYERS >> 2) & 1) layer_program<2>(a, lds, lds_raw, G, bar, skipmask); GSYNC();
        if ((PROBE_LAYERS >> 3) & 1) layer_program<3>(a, lds, lds_raw, G, bar, skipmask); GSYNC();
    }
#endif
    {
        const int skipmask = a.pad;
        if (!SKIP(0)) prologue_phase(a, lds, G);
        grid.sync();
        layer_program<0>(a, lds, lds_raw, G, bar, skipmask);
        layer_program<1>(a, lds, lds_raw, G, bar, skipmask);
        layer_program<2>(a, lds, lds_raw, G, bar, skipmask);
        layer_program<3>(a, lds, lds_raw, G, bar, skipmask);
    }
}
#undef SKIP

extern "C" void kernel_launch(void* const* d_in, const int* in_sizes, int n_in, void* d_out, int out_size, void* d_ws, size_t ws_size, hipStream_t stream) {
    static int grid = 0;
    if (grid == 0) {
        if (n_in != 21 || out_size != M * D || ws_size < WS_END) { fprintf(stderr, "kernel_launch: unexpected shapes (n_in %d, out %d, ws %zu)\n", n_in, out_size, ws_size); grid = -1; return; }
        int dev = 0, cus = 0, per_cu = 0;
        hipGetDevice(&dev); hipDeviceGetAttribute(&cus, hipDeviceAttributeMultiprocessorCount, dev);
        if (hipFuncSetAttribute((const void*)fwd_megakernel, hipFuncAttributeMaxDynamicSharedMemorySize, LDS_BYTES) != hipSuccess) { fprintf(stderr, "kernel_launch: hipFuncSetAttribute failed\n"); grid = -1; return; }
        if (hipOccupancyMaxActiveBlocksPerMultiprocessor(&per_cu, (const void*)fwd_megakernel, NWAVES * 64, LDS_BYTES) != hipSuccess || per_cu < 1) per_cu = 1;
        (void)hipGetLastError();
        grid = cus * per_cu;
        fprintf(stderr, "kernel_launch: grid %d (cus %d x %d)\n", grid, cus, per_cu);
    }
    if (grid < 0) return;
    Args a{};
    for (int i = 0; i < 21; ++i) a.in[i] = (const float*)d_in[i];
    a.out = (float*)d_out; a.ws = (unsigned char*)d_ws;
#ifdef PROBE_SKIP
    a.skip = PROBE_SKIP;
#else
    a.skip = 0;
#endif
    a.pad = 0;
    if (hipMemsetAsync(d_ws, 0, 65536, stream) != hipSuccess) { fprintf(stderr, "kernel_launch: hipMemsetAsync failed\n"); return; }
    void* args[] = {&a};
    const hipError_t e = hipLaunchCooperativeKernel((const void*)fwd_megakernel, dim3(grid), dim3(NWAVES * 64), args, LDS_BYTES, stream);
    if (e != hipSuccess) fprintf(stderr, "kernel_launch: cooperative launch failed: %s (grid %d)\n", hipGetErrorString(e), grid);
}
```

```cpp
#include <hip/hip_runtime.h>
#include <hip/hip_cooperative_groups.h>
#include <cstdio>
#include <cstdint>
namespace cg = cooperative_groups;
namespace pg8 {
#define PG8_LAS __attribute__((address_space(3)))
typedef unsigned short bf16_t;
typedef short bf16x8 __attribute__((ext_vector_type(8)));
typedef float f32x4 __attribute__((ext_vector_type(4)));
typedef unsigned u32x4 __attribute__((ext_vector_type(4)));
constexpr int BM = 256, BK = 64, HALF = 128, HTB = HALF * BK * 2  , STAGE_BYTES = 8 * HTB, NXCD = 8, WGM = 8;

__host__ __device__ __forceinline__ int lds_byte(int r, int c) { const int st = (r >> 4) * 2 + (c >> 5), rr = r & 15, cc = c & 31, ob = rr * 64 + cc * 2; return st * 1024 + (ob ^ (((ob >> 9) & 1) << 5)); }
__host__ __device__ __forceinline__ void stage_rc(int b, int& R, int& C) { const int st = b / 1024, sb = b % 1024, swz = sb ^ (((sb >> 9) & 1) << 5); R = (st >> 1) * 16 + swz / 64; C = (st & 1) * 32 + (swz % 64) / 2; }
__host__ __device__ __forceinline__ int perm32(int rho) { const int n = rho >> 4, i = rho & 15; return 8 * (i >> 2) + 4 * n + (i & 3); }

struct Unit { int pm, pn; };
struct Gemm { const bf16_t* A; const bf16_t* Bt; int M, N, K; };

struct StaticOrder {
    int nM, nN, nwg, G, c;
    __host__ __device__ void init(int M, int N, int G_, int c_) { nM = M / BM; nN = N / BM; nwg = nM * nN; G = G_; c = c_; }
    __host__ __device__ bool next(int i, Unit& u) const {
        const long L = (long)i * G + c; if (L >= nwg) return false;
        int wgid = (int)L; { const int q = nwg / NXCD, r = nwg % NXCD, xcd = wgid % NXCD, off = wgid / NXCD; wgid = (xcd < r ? xcd * (q + 1) : r * (q + 1) + (xcd - r) * q) + off; }
        const int nig = WGM * nN, gid = wgid / nig, fm = gid * WGM, gsz = (nM - fm) < WGM ? (nM - fm) : WGM;
        u.pm = fm + ((wgid % nig) % gsz); u.pn = (wgid % nig) / gsz; return true;
    }
    __device__ __forceinline__ void a_ready(const Unit&) const {}
    __device__ __forceinline__ void done(const Unit&) const {}
};

__device__ __forceinline__ unsigned cvt_pk_bf16(float lo, float hi) { unsigned r; asm volatile("v_cvt_pk_bf16_f32 %0, %1, %2" : "=v"(r) : "v"(lo), "v"(hi)); return r; }
typedef float f32x2 __attribute__((ext_vector_type(2)));
__device__ __forceinline__ float bf2f(unsigned short h) { return __uint_as_float(((unsigned)h) << 16); }
__device__ __forceinline__ float sigmoidf_(float x) { return __builtin_amdgcn_rcpf(1.0f + __expf(-x)); }
struct EpiPlain {
    static constexpr bool PERM = true, AFTER_DRAIN = false;
    bf16_t* O; int ldc; int scale_cols; float scale;
    __device__ __forceinline__ void operator()(const f32x4 (&acc)[2][2][4][2], const Unit& u, int wr, int wc, int fr, int fq) const {
        const int row0 = u.pm * BM + wr * 64 + fr, col0 = u.pn * BM + wc * 32 + 8 * fq;
        const float sc = (u.pn * BM < scale_cols) ? scale : 1.f;
#pragma unroll
        for (int ai = 0; ai < 2; ++ai)
#pragma unroll
            for (int m = 0; m < 4; ++m) { bf16_t* rowp = O + (size_t)(row0 + ai * HALF + m * 16) * ldc + col0;
#pragma unroll
                for (int bj = 0; bj < 2; ++bj) { f32x4 v0 = acc[ai][bj][m][0] * sc, v1 = acc[ai][bj][m][1] * sc;
                    u32x4 w; w.x = cvt_pk_bf16(v0[0], v0[1]); w.y = cvt_pk_bf16(v0[2], v0[3]); w.z = cvt_pk_bf16(v1[0], v1[1]); w.w = cvt_pk_bf16(v1[2], v1[3]);
                    *(u32x4*)(rowp + bj * HALF) = w; } }
    }
};
struct EpiMl {
    static constexpr bool PERM = true, AFTER_DRAIN = false;
    bf16_t* O; float* gates; const float* bias;
    __device__ __forceinline__ void operator()(const f32x4 (&acc)[2][2][4][2], const Unit& u, int wr, int wc, int fr, int fq) const {
        const int row0 = u.pm * BM + wr * 64 + fr;
        if (u.pn < 12) {
            const int col0 = u.pn * BM + wc * 32 + 8 * fq; const float sc = (u.pn < 2) ? 0.125f : 1.f;
#pragma unroll
            for (int ai = 0; ai < 2; ++ai)
#pragma unroll
                for (int m = 0; m < 4; ++m) { bf16_t* rowp = O + (size_t)(row0 + ai * HALF + m * 16) * 3072 + col0;
#pragma unroll
                    for (int bj = 0; bj < 2; ++bj) { f32x4 v0 = acc[ai][bj][m][0] * sc, v1 = acc[ai][bj][m][1] * sc;
                        u32x4 w; w.x = cvt_pk_bf16(v0[0], v0[1]); w.y = cvt_pk_bf16(v0[2], v0[3]); w.z = cvt_pk_bf16(v1[0], v1[1]); w.w = cvt_pk_bf16(v1[2], v1[3]);
                        *(u32x4*)(rowp + bj * HALF) = w; } }
        } else if (wc == 0) {
            const f32x4 b0 = *(const f32x4*)(bias + 8 * fq), b1 = *(const f32x4*)(bias + 8 * fq + 4);
#pragma unroll
            for (int ai = 0; ai < 2; ++ai)
#pragma unroll
                for (int m = 0; m < 4; ++m) { float* gp = gates + (size_t)(row0 + ai * HALF + m * 16) * 32 + 8 * fq;
                    *(f32x4*)gp = acc[ai][0][m][0] + b0; *(f32x4*)(gp + 4) = acc[ai][0][m][1] + b1; }
        }
    }
};
struct EpiFf1 {
    static constexpr bool PERM = true, AFTER_DRAIN = false;
    bf16_t* H; bf16_t* PP;
    __device__ __forceinline__ void operator()(const f32x4 (&acc)[2][2][4][2], const Unit& u, int wr, int wc, int fr, int fq) const {
        const int row0 = u.pm * BM + wr * 64 + fr;
        if (u.pn < 16) {
            const int col0 = u.pn * BM + wc * 32 + 8 * fq;
#pragma unroll
            for (int ai = 0; ai < 2; ++ai)
#pragma unroll
                for (int m = 0; m < 4; ++m) { bf16_t* rowp = H + (size_t)(row0 + ai * HALF + m * 16) * 4096 + col0;
#pragma unroll
                    for (int bj = 0; bj < 2; ++bj) { f32x4 v0 = acc[ai][bj][m][0], v1 = acc[ai][bj][m][1];
#pragma unroll
                        for (int e = 0; e < 4; ++e) { const float a = fmaxf(v0[e], 0.f), b = fmaxf(v1[e], 0.f); v0[e] = a * a; v1[e] = b * b; }
                        u32x4 w; w.x = cvt_pk_bf16(v0[0], v0[1]); w.y = cvt_pk_bf16(v0[2], v0[3]); w.z = cvt_pk_bf16(v1[0], v1[1]); w.w = cvt_pk_bf16(v1[2], v1[3]);
                        *(u32x4*)(rowp + bj * HALF) = w; } }
        } else {
            const int col0 = (u.pn - 16) * BM + wc * 32 + 8 * fq;
#pragma unroll
            for (int ai = 0; ai < 2; ++ai)
#pragma unroll
                for (int m = 0; m < 4; ++m) { bf16_t* rowp = PP + (size_t)(row0 + ai * HALF + m * 16) * 1024 + col0;
#pragma unroll
                    for (int bj = 0; bj < 2; ++bj) { f32x4 v0 = acc[ai][bj][m][0], v1 = acc[ai][bj][m][1];
                        const u32x4 pp = *(const u32x4*)(rowp + bj * HALF);
                        const unsigned pw[4] = {pp.x, pp.y, pp.z, pp.w};
#pragma unroll
                        for (int e = 0; e < 2; ++e) {
                            v0[2 * e]     = sigmoidf_(v0[2 * e])     * __uint_as_float(pw[e] << 16);
                            v0[2 * e + 1] = sigmoidf_(v0[2 * e + 1]) * __uint_as_float(pw[e] & 0xffff0000u);
                            v1[2 * e]     = sigmoidf_(v1[2 * e])     * __uint_as_float(pw[2 + e] << 16);
                            v1[2 * e + 1] = sigmoidf_(v1[2 * e + 1]) * __uint_as_float(pw[2 + e] & 0xffff0000u); }
                        u32x4 w; w.x = cvt_pk_bf16(v0[0], v0[1]); w.y = cvt_pk_bf16(v0[2], v0[3]); w.z = cvt_pk_bf16(v1[0], v1[1]); w.w = cvt_pk_bf16(v1[2], v1[3]);
                        *(u32x4*)(rowp + bj * HALF) = w; } }
        }
    }
};
struct EpiResidBf {
    static constexpr bool PERM = true, AFTER_DRAIN = false;
    bf16_t* X; const bf16_t* ple; float alpha;
    __device__ __forceinline__ void operator()(const f32x4 (&acc)[2][2][4][2], const Unit& u, int wr, int wc, int fr, int fq) const {
        const int row0 = u.pm * BM + wr * 64 + fr, col0 = u.pn * BM + wc * 32 + 8 * fq;
#pragma unroll
        for (int ai = 0; ai < 2; ++ai)
#pragma unroll
            for (int m = 0; m < 4; ++m) { const size_t off = (size_t)(row0 + ai * HALF + m * 16) * 1024 + col0;
#pragma unroll
                for (int bj = 0; bj < 2; ++bj) { f32x4 v0 = acc[ai][bj][m][0], v1 = acc[ai][bj][m][1];
                    const u32x4 r = *(const u32x4*)(X + off + bj * HALF);
                    v0[0] += alpha * __uint_as_float(r.x << 16); v0[1] += alpha * __uint_as_float(r.x & 0xffff0000u); v0[2] += alpha * __uint_as_float(r.y << 16); v0[3] += alpha * __uint_as_float(r.y & 0xffff0000u);
                    v1[0] += alpha * __uint_as_float(r.z << 16); v1[1] += alpha * __uint_as_float(r.z & 0xffff0000u); v1[2] += alpha * __uint_as_float(r.w << 16); v1[3] += alpha * __uint_as_float(r.w & 0xffff0000u);
                    if (ple) { const u32x4 p = *(const u32x4*)(ple + off + bj * HALF);
                        v0[0] += __uint_as_float(p.x << 16); v0[1] += __uint_as_float(p.x & 0xffff0000u); v0[2] += __uint_as_float(p.y << 16); v0[3] += __uint_as_float(p.y & 0xffff0000u);
                        v1[0] += __uint_as_float(p.z << 16); v1[1] += __uint_as_float(p.z & 0xffff0000u); v1[2] += __uint_as_float(p.w << 16); v1[3] += __uint_as_float(p.w & 0xffff0000u); }
                    u32x4 w; w.x = cvt_pk_bf16(v0[0], v0[1]); w.y = cvt_pk_bf16(v0[2], v0[3]); w.z = cvt_pk_bf16(v1[0], v1[1]); w.w = cvt_pk_bf16(v1[2], v1[3]);
                    *(u32x4*)(X + off + bj * HALF) = w; } }
    }
};
template <class Epi, class Sched, bool ALIGN_EPI = false, bool SP2 = false>
__device__ __forceinline__ void gemm_phase(PG8_LAS unsigned char* lds, const Gemm g, const Sched& S, const Epi& E) {
    const int tid = threadIdx.x, wid = __builtin_amdgcn_readfirstlane(tid >> 6), lane = tid & 63, wr = wid >> 2, wc = wid & 3, fr = lane & 15, fq = lane >> 4;
    const int K = g.K, nt = K / BK;
    unsigned voffA[2], voffB[2];
#pragma unroll
    for (int i = 0; i < 2; ++i) { int R, C; stage_rc(tid * 16 + i * 8192, R, C); const int Rb = Epi::PERM ? ((R & ~31) + perm32(R & 31)) : R;
        voffA[i] = (unsigned)(R * K + C) * 2u; voffB[i] = (unsigned)(Rb * K + C) * 2u; }
    const size_t kstep = (size_t)(BK * 2);
    const size_t hstep = (size_t)HALF * K * 2;
    const size_t tstep = 2 * hstep;
    const unsigned ldsw = (unsigned)wid * 1024u;
    const int aoff = lds_byte(wr * 64 + fr, fq * 8), boff = lds_byte(wc * 32 + fr, fq * 8);
#define PG8_SA(b, h) (((b) * 2 + (h)) * HTB)
#define PG8_SB(b, h) ((4 + (b) * 2 + (h)) * HTB)
#define PG8_STAGE(bufoff, gbase, voff) do { _Pragma("unroll") for (int _i = 0; _i < 2; ++_i) \
        __builtin_amdgcn_global_load_lds((const unsigned*)((const char*)(gbase) + (voff)[_i]), (PG8_LAS unsigned*)(lds + (bufoff) + ldsw + _i * 8192), 16, 0, 0); } while (0)
#define PG8_LDA(dst, b, h) do { _Pragma("unroll") for (int m = 0; m < 4; ++m) _Pragma("unroll") for (int k = 0; k < 2; ++k) dst[m][k] = *(const PG8_LAS bf16x8*)(lds + PG8_SA(b, h) + aoff + m * 2048 + k * 1024); } while (0)
#define PG8_LDB(dst, b, h) do { _Pragma("unroll") for (int n = 0; n < 2; ++n) _Pragma("unroll") for (int k = 0; k < 2; ++k) dst[n][k] = *(const PG8_LAS bf16x8*)(lds + PG8_SB(b, h) + boff + n * 2048 + k * 1024); } while (0)
#define PG8_MMA(ai, bj, At, Bt) do { __builtin_amdgcn_s_setprio(1); _Pragma("unroll") for (int m = 0; m < 4; ++m) _Pragma("unroll") for (int n = 0; n < 2; ++n) _Pragma("unroll") for (int k = 0; k < 2; ++k) \
        acc[ai][bj][m][n] = __builtin_amdgcn_mfma_f32_16x16x32_bf16(Bt[n][k], At[m][k], acc[ai][bj][m][n], 0, 0, 0); __builtin_amdgcn_s_setprio(0); } while (0)
#define PG8_WAIT_V(n) asm volatile("s_waitcnt vmcnt(" #n ")" ::: "memory")
#define PG8_WAIT_L(n) asm volatile("s_waitcnt lgkmcnt(" #n ")" ::: "memory")
#define PG8_BAR __builtin_amdgcn_s_barrier()
#define PG8_SCHED __builtin_amdgcn_sched_barrier(0)
    Unit cur, nxt; int ui = 0;
    if (!S.next(0, cur)) return;
    f32x4 acc[2][2][4][2];
#pragma unroll
    for (int a = 0; a < 2; ++a)
#pragma unroll
        for (int b = 0; b < 2; ++b)
#pragma unroll
            for (int m = 0; m < 4; ++m)
#pragma unroll
                for (int n = 0; n < 2; ++n) acc[a][b][m][n] = (f32x4){0.f, 0.f, 0.f, 0.f};
    bf16x8 At[4][2], B0[2][2], B1[2][2];
    const char* cA = (const char*)g.A + (size_t)cur.pm * tstep; const char* cB = (const char*)g.Bt + (size_t)cur.pn * tstep;
    S.a_ready(cur);
    if constexpr (SP2) {
        PG8_STAGE(PG8_SB(0, 0), cB, voffB); PG8_STAGE(PG8_SB(0, 1), cB + hstep, voffB); PG8_STAGE(PG8_SA(0, 0), cA, voffA); PG8_STAGE(PG8_SA(0, 1), cA + hstep, voffA);
        if (wr == 1) PG8_BAR;
        PG8_WAIT_V(2); PG8_BAR;
        PG8_STAGE(PG8_SB(1, 0), cB + kstep, voffB); PG8_STAGE(PG8_SA(1, 0), cA + kstep, voffA); PG8_STAGE(PG8_SB(1, 1), cB + hstep + kstep, voffB);
        PG8_WAIT_V(6); PG8_BAR;
    } else {
        PG8_STAGE(PG8_SB(0, 0), cB, voffB); PG8_STAGE(PG8_SA(0, 0), cA, voffA); PG8_STAGE(PG8_SB(0, 1), cB + hstep, voffB); PG8_STAGE(PG8_SA(0, 1), cA + hstep, voffA);
        if (wr == 1) PG8_BAR;
        PG8_WAIT_V(4); PG8_BAR;
        PG8_STAGE(PG8_SB(1, 0), cB + kstep, voffB); PG8_STAGE(PG8_SA(1, 0), cA + kstep, voffA); PG8_STAGE(PG8_SB(1, 1), cB + hstep + kstep, voffB);
        PG8_WAIT_V(6); PG8_BAR;
    }
    for (;;) {
        const bool has_next = S.next(ui + 1, nxt);
        const char* nA = has_next ? (const char*)g.A + (size_t)nxt.pm * tstep : cA; const char* nB = has_next ? (const char*)g.Bt + (size_t)nxt.pn * tstep : cB;
        for (int t = 0; t < nt; t += 2) {
            const bool last = (t == nt - 2);
            const char* a1 = cA + (size_t)(t + 1) * kstep;
            const char* a2 = last ? nA : cA + (size_t)(t + 2) * kstep; const char* b2 = last ? nB : cB + (size_t)(t + 2) * kstep;
            const char* a3 = a2 + kstep; const char* b3 = b2 + kstep;
            if (last && has_next) S.a_ready(nxt);
            if constexpr (SP2) {
            PG8_LDB(B0, 0, 0); PG8_LDB(B1, 0, 1); PG8_SCHED; PG8_LDA(At, 0, 0); PG8_STAGE(PG8_SA(1, 1), a1 + hstep, voffA);
            PG8_WAIT_V(8); PG8_WAIT_L(0); PG8_BAR; PG8_MMA(0, 0, At, B0); PG8_MMA(0, 1, At, B1); PG8_BAR; PG8_SCHED;
            PG8_LDA(At, 0, 1); PG8_STAGE(PG8_SB(0, 0), b2, voffB); PG8_STAGE(PG8_SB(0, 1), b2 + hstep, voffB); PG8_STAGE(PG8_SA(0, 0), a2, voffA);
            PG8_WAIT_V(8); PG8_WAIT_L(0); PG8_BAR; PG8_MMA(1, 0, At, B0); PG8_MMA(1, 1, At, B1); PG8_BAR; PG8_SCHED;
            PG8_LDB(B0, 1, 0); PG8_LDB(B1, 1, 1); PG8_SCHED; PG8_LDA(At, 1, 0); PG8_STAGE(PG8_SA(0, 1), a2 + hstep, voffA);
            PG8_WAIT_V(8); PG8_WAIT_L(0); PG8_BAR; PG8_MMA(0, 0, At, B0); PG8_MMA(0, 1, At, B1); PG8_BAR; PG8_SCHED;
            PG8_LDA(At, 1, 1); PG8_STAGE(PG8_SB(1, 0), b3, voffB); PG8_STAGE(PG8_SB(1, 1), b3 + hstep, voffB); PG8_STAGE(PG8_SA(1, 0), a3, voffA);
            PG8_WAIT_V(8); PG8_WAIT_L(0); PG8_BAR; PG8_MMA(1, 0, At, B0); PG8_MMA(1, 1, At, B1); PG8_BAR; PG8_SCHED;
            } else {
            PG8_LDB(B0, 0, 0); PG8_SCHED; PG8_LDA(At, 0, 0); PG8_STAGE(PG8_SA(1, 1), a1 + hstep, voffA);
            PG8_WAIT_L(8); PG8_BAR; PG8_WAIT_L(0); PG8_MMA(0, 0, At, B0); PG8_BAR; PG8_SCHED;
            PG8_LDB(B1, 0, 1); PG8_STAGE(PG8_SB(0, 0), b2, voffB);
            PG8_BAR; PG8_WAIT_L(0); PG8_MMA(0, 1, At, B1); PG8_BAR;
            PG8_LDA(At, 0, 1); PG8_STAGE(PG8_SA(0, 0), a2, voffA);
            PG8_BAR; PG8_WAIT_L(0); PG8_MMA(1, 0, At, B0); PG8_BAR; PG8_SCHED;
            PG8_STAGE(PG8_SB(0, 1), b2 + hstep, voffB);
            PG8_WAIT_V(6); PG8_BAR; PG8_MMA(1, 1, At, B1); PG8_BAR;
            PG8_LDB(B0, 1, 0); PG8_SCHED; PG8_LDA(At, 1, 0); PG8_STAGE(PG8_SA(0, 1), a2 + hstep, voffA);
            PG8_WAIT_L(8); PG8_BAR; PG8_WAIT_L(0); PG8_MMA(0, 0, At, B0); PG8_BAR; PG8_SCHED;
            PG8_LDB(B1, 1, 1); PG8_STAGE(PG8_SB(1, 0), b3, voffB);
            PG8_BAR; PG8_WAIT_L(0); PG8_MMA(0, 1, At, B1); PG8_BAR;
            PG8_LDA(At, 1, 1); PG8_STAGE(PG8_SA(1, 0), a3, voffA);
            PG8_BAR; PG8_WAIT_L(0); PG8_MMA(1, 0, At, B0); PG8_BAR; PG8_SCHED;
            PG8_STAGE(PG8_SB(1, 1), b3 + hstep, voffB);
            PG8_WAIT_V(6); PG8_BAR; PG8_MMA(1, 1, At, B1); PG8_BAR;
            }
        }
        if constexpr (ALIGN_EPI) { if (wr == 0) PG8_BAR; }
        if constexpr (!Epi::AFTER_DRAIN) { E(acc, cur, wr, wc, fr, fq); S.done(cur); }
        if (!has_next) break;
#pragma unroll
        for (int a = 0; a < 2; ++a)
#pragma unroll
            for (int b = 0; b < 2; ++b)
#pragma unroll
                for (int m = 0; m < 4; ++m)
#pragma unroll
                    for (int n = 0; n < 2; ++n) acc[a][b][m][n] = (f32x4){0.f, 0.f, 0.f, 0.f};
        cur = nxt; cA = nA; cB = nB; ++ui;
        if constexpr (ALIGN_EPI) { if (wr == 1) PG8_BAR; }
    }
    PG8_WAIT_V(0);
    if constexpr (!ALIGN_EPI) { if (wr == 0) PG8_BAR; }
    PG8_BAR;
    if constexpr (Epi::AFTER_DRAIN) { E.fused(acc, cur, wr, wc, fr, fq, lds, wid, lane); S.done(cur); }
#undef PG8_SA
#undef PG8_SB
#undef PG8_STAGE
#undef PG8_LDA
#undef PG8_LDB
#undef PG8_MMA
#undef PG8_WAIT_V
#undef PG8_WAIT_L
#undef PG8_BAR
#undef PG8_SCHED
}
}
#include <hip/hip_bf16.h>
#include <cmath>
namespace attn_body {
using bf16=__hip_bfloat16;
using bf16x8=__attribute__((ext_vector_type(8)))short;
using s16x4=__attribute__((ext_vector_type(4)))short;
using f32x16=__attribute__((ext_vector_type(16)))float;
using u32x4=__attribute__((ext_vector_type(4)))unsigned;
constexpr int BATCH=32,NHEAD=16,SEQ=2048,D=64,DM=1536,OP=1024;
constexpr int NW=8,QBLK=32,QB=QBLK*NW,KVBLK=64,NQB=SEQ/QB;
constexpr int ATTN_PITCH=DM, ATTN_UNIT_ROWS=QB;
__device__ __forceinline__ int crow(int r,int hi){return (r&3)+8*(r>>2)+4*hi;}
#define SBAR() __builtin_amdgcn_sched_barrier(0)
__device__ __forceinline__ void cmask(f32x16&p0,f32x16&p1,int jb,int qrel,int hi){
  const float NEG=-INFINITY; int kb=64*jb+4*hi;
  #pragma unroll
  for(int r=0;r<16;++r){int kv=kb+(r&3)+8*(r>>2); if(kv>qrel)p0[r]=NEG; if(kv+32>qrel)p1[r]=NEG;}
}

constexpr int NSLOT=3, SLOTB=8192;
constexpr int LDS_K=0, LDS_V=NSLOT*SLOTB, LDS_WS=2*NSLOT*SLOTB, LDS_OST=LDS_WS+NW*64*4, LDS_BYTES=LDS_OST+NW*4096;
constexpr float C2=0.125f*1.4426950408889634f;
__device__ __forceinline__ void glds16(const void*gsrc,unsigned lds_dst){unsigned keep;
  asm volatile("s_mov_b32 %0, m0\n\ts_mov_b32 m0, %2\n\ts_nop 0\n\tglobal_load_lds_dwordx4 %1, off\n\ts_mov_b32 m0, %0":"=&s"(keep):"v"(gsrc),"s"(lds_dst):"memory");}
__device__ __forceinline__ float max3f(float a,float b,float c){float r;asm("v_max3_f32 %0, %1, %2, %3":"=v"(r):"v"(a),"v"(b),"v"(c));return r;}
__device__ __forceinline__ float max2f(float a,float b){float r;asm("v_max_f32_e32 %0, %1, %2":"=v"(r):"v"(a),"v"(b));return r;}
__device__ __forceinline__ float fadd_s(float a,float b){float r;asm("v_add_f32_e32 %0, %1, %2":"=v"(r):"v"(a),"v"(b));return r;}
__device__ __forceinline__ float fsub_s(float a,float b){float r;asm("v_sub_f32_e32 %0, %1, %2":"=v"(r):"v"(a),"v"(b));return r;}
typedef float f32x2_t __attribute__((ext_vector_type(2))); typedef __bf16 bf16x2_t __attribute__((ext_vector_type(2)));
__device__ __forceinline__ unsigned cvtpk_s(float lo,float hi){f32x2_t v={lo,hi};bf16x2_t b=__builtin_convertvector(v,bf16x2_t);return __builtin_bit_cast(unsigned,b);}
#define WAIT_BAR(N) asm volatile("s_waitcnt vmcnt(" #N ") lgkmcnt(0)\n\ts_barrier":::"memory")

__device__ __forceinline__ void qkt(f32x16&p0,f32x16&p1,const char*Kslot,const bf16x8*qr,const f32x16&negm,int r32,int hi){
  const char*kb=Kslot+hi*1024+r32*16;
  #pragma unroll
  for(int d0=0;d0<4;++d0){
    const bf16x8 b0=*reinterpret_cast<const bf16x8*>(kb+d0*2048);
    const bf16x8 b1=*reinterpret_cast<const bf16x8*>(kb+d0*2048+512);
    if(d0==0){p0=__builtin_amdgcn_mfma_f32_32x32x16_bf16(b0,qr[0],negm,0,0,0);p1=__builtin_amdgcn_mfma_f32_32x32x16_bf16(b1,qr[0],negm,0,0,0);}
    else{p0=__builtin_amdgcn_mfma_f32_32x32x16_bf16(b0,qr[d0],p0,0,0,0);p1=__builtin_amdgcn_mfma_f32_32x32x16_bf16(b1,qr[d0],p1,0,0,0);}}
}
typedef __attribute__((address_space(3))) const char* lds_cptr;
typedef short v4i16_t __attribute__((ext_vector_type(4)));
__device__ __forceinline__ void kload8(bf16x8*kf,lds_cptr kp){
  kf[0]=*(const __attribute__((address_space(3))) bf16x8*)(kp);      kf[1]=*(const __attribute__((address_space(3))) bf16x8*)(kp+512);
  kf[2]=*(const __attribute__((address_space(3))) bf16x8*)(kp+2048); kf[3]=*(const __attribute__((address_space(3))) bf16x8*)(kp+2560);
  kf[4]=*(const __attribute__((address_space(3))) bf16x8*)(kp+4096); kf[5]=*(const __attribute__((address_space(3))) bf16x8*)(kp+4608);
  kf[6]=*(const __attribute__((address_space(3))) bf16x8*)(kp+6144); kf[7]=*(const __attribute__((address_space(3))) bf16x8*)(kp+6656);
}
__device__ __forceinline__ void kload2(bf16x8*kf,lds_cptr kp,int j){ kf[2*j]=*(const __attribute__((address_space(3))) bf16x8*)(kp+j*2048); kf[2*j+1]=*(const __attribute__((address_space(3))) bf16x8*)(kp+j*2048+512); }
__device__ __forceinline__ s16x4 vtr(lds_cptr p){ return __builtin_bit_cast(s16x4,__builtin_amdgcn_ds_read_tr16_b64_v4i16((__attribute__((address_space(3))) v4i16_t*)p)); }
__device__ __forceinline__ float rowmax(const f32x16&p0,const f32x16&p1){
  float a=max3f(p0[0],p0[1],p1[0]),b=max3f(p0[2],p0[3],p1[1]);a=max3f(a,p1[2],p1[3]);
  #pragma unroll
  for(int r=4;r<16;r+=4){a=max3f(a,p0[r],p0[r+1]);b=max3f(b,p0[r+2],p0[r+3]);a=max3f(a,p1[r],p1[r+1]);b=max3f(b,p1[r+2],p1[r+3]);}
  const float m=max2f(a,b);
  auto rr=__builtin_amdgcn_permlane32_swap(__float_as_uint(m),__float_as_uint(m),false,false);
  return max2f(__uint_as_float(rr[0]),__uint_as_float(rr[1]));
}
__device__ __forceinline__ void pv(f32x16*o,int vb,bf16x8 pa0,bf16x8 pa1,bf16x8 pa2,bf16x8 pa3){
  #pragma unroll
  for(int d0=0;d0<2;++d0){s16x4 lo[4],hi[4];
    #pragma unroll
    for(int ks=0;ks<4;++ks){
      asm volatile("ds_read_b64_tr_b16 %0,%1 offset:%c2":"=&v"(lo[ks]):"v"(vb),"i"(d0*4096+ks*1024):"memory");
      asm volatile("ds_read_b64_tr_b16 %0,%1 offset:%c2":"=&v"(hi[ks]):"v"(vb),"i"(d0*4096+ks*1024+512):"memory");}
    asm volatile("s_waitcnt lgkmcnt(0)":::"memory");SBAR();
    #define PK(k) (bf16x8){lo[k][0],lo[k][1],lo[k][2],lo[k][3],hi[k][0],hi[k][1],hi[k][2],hi[k][3]}
    o[d0]=__builtin_amdgcn_mfma_f32_32x32x16_bf16(pa0,PK(0),o[d0],0,0,0);
    o[d0]=__builtin_amdgcn_mfma_f32_32x32x16_bf16(pa1,PK(1),o[d0],0,0,0);
    o[d0]=__builtin_amdgcn_mfma_f32_32x32x16_bf16(pa2,PK(2),o[d0],0,0,0);
    o[d0]=__builtin_amdgcn_mfma_f32_32x32x16_bf16(pa3,PK(3),o[d0],0,0,0);
    #undef PK
  }
}

#ifndef ATTN_STORE16
#define ATTN_STORE16(p,v) (*(u32x4*)(p)=(v))
#endif
template<int THRL> __device__ __forceinline__ void attn_unit(int b,int h,int qb,const bf16*Q,const bf16*__restrict__ K,const bf16*__restrict__ V,bf16*O,char*shm){
  const int tid=threadIdx.x,lane=tid&63,r32=lane&31,hi=lane>>5; const int wid=__builtin_amdgcn_readfirstlane(tid>>6);
  const long rowbase=(long)b*SEQ; const int q0=qb*QB;
  const bf16*Qw=Q+(rowbase+q0+wid*QBLK)*DM+h*D;
  const bf16*Kh=K+rowbase*DM+(h>>2)*D,*Vh=V+rowbase*DM+(h>>2)*D;
  const unsigned lds0=(unsigned)(uintptr_t)shm;
  float*wsf=(float*)(shm+LDS_WS)+wid*64;
  const bf16*ksrc=Kh+(long)lane*DM+wid*8;
  const bf16*vsrc=Vh+(long)(16*(wid&3)+(lane>>2))*DM+(wid>>2)*32+(lane&3)*8;
  const unsigned kdst=lds0+LDS_K+wid*1024, vdst=lds0+LDS_V+wid*1024;
  #define DMA_K(t,slot) glds16(ksrc+(long)(t)*KVBLK*DM,(unsigned)__builtin_amdgcn_readfirstlane(kdst+(slot)))
  #define DMA_V(t,slot) glds16(vsrc+(long)(t)*KVBLK*DM,(unsigned)__builtin_amdgcn_readfirstlane(vdst+(slot)))
  const int vb0=(int)(lds0+LDS_V)+((lane>>4)&1)*32+(lane&3)*8+(4*hi+((lane&15)>>2))*64;
  const char*Kbase=shm+LDS_K; bf16x8 kf[8];
  const lds_cptr shm3=(lds_cptr)shm; const lds_cptr kp0=shm3+LDS_K+hi*1024+r32*16; const lds_cptr vp0=shm3+LDS_V+((lane>>4)&1)*32+(lane&3)*8+(4*hi+((lane&15)>>2))*64;
  const int NT=SEQ/KVBLK;
  DMA_K(0,0);DMA_V(0,0);DMA_K(1,SLOTB);
  bf16x8 qr[4];
  #pragma unroll
  for(int d0=0;d0<4;++d0)qr[d0]=*reinterpret_cast<const bf16x8*>(&Qw[(long)r32*DM+d0*16+hi*8]);
  float mhat=0.f,l_reg=0.f;f32x16 o[2];o[0]=f32x16{};o[1]=f32x16{};f32x16 negm=f32x16{};asm volatile("":"+v"(negm));

  #define CMASK(P0,P1,t) do{}while(0)
  bool resc=false;
  #define START(P0,P1) do{ const float rm=rowmax(P0,P1); resc=false; \
    { const float dl=rm; mhat=fadd_s(mhat,dl); \
      _Pragma("unroll") for(int r=0;r<16;++r){P0[r]=fsub_s(P0[r],dl);P1[r]=fsub_s(P1[r],dl);} \
      _Pragma("unroll") for(int r=0;r<16;++r)negm[r]=-mhat; asm volatile("":"+v"(negm)); } \
    _Pragma("unroll") for(int r=0;r<16;++r)P0[r]=__builtin_amdgcn_exp2f(P0[r]); }while(0)
  #define RESC() do{ if(resc){ asm volatile("s_waitcnt lgkmcnt(0)":::"memory"); \
      _Pragma("unroll") for(int d_=0;d_<2;++d_) _Pragma("unroll") for(int r=0;r<16;++r)o[d_][r]*=wsf[crow(r,hi)]; } }while(0)
  f32x16 pA0,pA1,pB0,pB1;
  int sl_prev=0,sl_cur=0,sl_next=SLOTB;
  #define ROT() do{sl_prev=sl_cur;sl_cur=sl_next;sl_next=(sl_next==(NSLOT-1)*SLOTB)?0:sl_next+SLOTB;}while(0)
  DMA_K(2,2*SLOTB);
  WAIT_BAR(3);
  qkt(pA0,pA1,Kbase,qr,negm,r32,hi);asm volatile("s_nop 15\n\ts_nop 7":"+v"(pA0),"+v"(pA1));CMASK(pA0,pA1,0);
  START(pA0,pA1);
  _Pragma("unroll") for(int r=0;r<16;++r)pA1[r]=__builtin_amdgcn_exp2f(pA1[r]);
  WAIT_BAR(0);
  DMA_K(3,0);DMA_V(1,SLOTB);
  ROT();
  kload8(kf,kp0+sl_cur);
  WAIT_BAR(2);
  s16x4 vlo[8],vhi[8]; u32x4 pw0,pw1,pw2,pw3;
  #define PKW(P,B) cvtpk_s(P[B],P[B+1])
  #define PAF(k) __builtin_bit_cast(bf16x8,pw##k)
  #define VFR(i) (bf16x8){vlo[i][0],vlo[i][1],vlo[i][2],vlo[i][3],vhi[i][0],vhi[i][1],vhi[i][2],vhi[i][3]}
  #define PIN(x) asm volatile("":"+v"(x))
  #define MX3(a,b,c) __builtin_fmaxf(__builtin_fmaxf((a),(b)),(c))
  #define GAPA(MF,A0,A1,A2,A3,W0,W1,PW) do{ MF; sacc+=A0; sacc+=A1; sacc+=A2; sacc+=A3; PIN(sacc); W0; W1; PIN(PW); SBAR(); }while(0)
  #define EX(v) __builtin_amdgcn_exp2f(v)
  #define GAPB(MF,X,B) do{ MF; X[B]=EX(X[B]); X[B+1]=EX(X[B+1]); X[B+2]=EX(X[B+2]); X[B+3]=EX(X[B+3]); PIN(X); SBAR(); }while(0)
  #define VRD(i) do{ vlo[i]=vtr(vp_+(((i)>>2)*4096+((i)&3)*1024)); vhi[i]=vtr(vp_+(((i)>>2)*4096+((i)&3)*1024+512)); }while(0)
  #define KRD(G,j) do{ if(G){ kload2(kf,kp0+sl_next,j); SBAR(); } }while(0)
  #define STEP(C0,C1,P0,P1,t,GK,GV,GL) do{ SBAR(); \
    const lds_cptr vp_=vp0+sl_prev; \
    VRD(0); SBAR(); float sacc=(P0[0]+P0[1]); \
    GAPA(C0=__builtin_amdgcn_mfma_f32_32x32x16_bf16(kf[0],qr[0],negm,0,0,0), P0[2],P0[3],P0[4],P0[5],     pw0[0]=PKW(P0,0), pw0[1]=PKW(P0,2), pw0); \
    VRD(4); SBAR(); GAPA(C1=__builtin_amdgcn_mfma_f32_32x32x16_bf16(kf[1],qr[0],negm,0,0,0), P0[6],P0[7],P0[8],P0[9],     pw0[2]=PKW(P0,4), pw0[3]=PKW(P0,6), pw0); \
    VRD(1); SBAR(); GAPA(C0=__builtin_amdgcn_mfma_f32_32x32x16_bf16(kf[2],qr[1],C0,0,0,0),   P0[10],P0[11],P0[12],P0[13], pw1[0]=PKW(P0,8), pw1[1]=PKW(P0,10), pw1); \
    VRD(5); SBAR(); GAPA(C1=__builtin_amdgcn_mfma_f32_32x32x16_bf16(kf[3],qr[1],C1,0,0,0),   P0[14],P0[15],P1[0],P1[1],   pw1[2]=PKW(P0,12),pw1[3]=PKW(P0,14), pw1); \
    VRD(2); SBAR(); GAPA(C0=__builtin_amdgcn_mfma_f32_32x32x16_bf16(kf[4],qr[2],C0,0,0,0),   P1[2],P1[3],P1[4],P1[5],     pw2[0]=PKW(P1,0), pw2[1]=PKW(P1,2), pw2); \
    VRD(6); SBAR(); GAPA(C1=__builtin_amdgcn_mfma_f32_32x32x16_bf16(kf[5],qr[2],C1,0,0,0),   P1[6],P1[7],P1[8],P1[9],     pw2[2]=PKW(P1,4), pw2[3]=PKW(P1,6), pw2); \
    VRD(3); SBAR(); GAPA(C0=__builtin_amdgcn_mfma_f32_32x32x16_bf16(kf[6],qr[3],C0,0,0,0),   P1[10],P1[11],P1[12],P1[13], pw3[0]=PKW(P1,8), pw3[1]=PKW(P1,10), pw3); \
    VRD(7); SBAR(); GAPA(C1=__builtin_amdgcn_mfma_f32_32x32x16_bf16(kf[7],qr[3],C1,0,0,0),   P1[14],P1[15],0.f,0.f,       pw3[2]=PKW(P1,12),pw3[3]=PKW(P1,14), pw3); \
    l_reg+=sacc; \
    if(GK){DMA_K((t)+3,sl_cur);} if(GV){DMA_V((t)+1,sl_next);} \
    CMASK(C0,C1,t); \
    { float a=MX3(C0[0],C0[1],C1[0]),b=MX3(C0[2],C0[3],C1[1]); a=MX3(a,C1[2],C1[3]); \
      _Pragma("unroll") for(int r=4;r<16;r+=4){a=MX3(a,C0[r],C0[r+1]);b=MX3(b,C0[r+2],C0[r+3]);a=MX3(a,C1[r],C1[r+1]);b=MX3(b,C1[r+2],C1[r+3]);} \
      float rm=__builtin_fmaxf(a,b); { auto rr=__builtin_amdgcn_permlane32_swap(__float_as_uint(rm),__float_as_uint(rm),false,false); rm=__builtin_fmaxf(__uint_as_float(rr[0]),__uint_as_float(rr[1])); } \
      resc=false; \
      if(__builtin_expect(__any(rm>(float)THRL),0)){ const float dl=__builtin_fmaxf(rm,0.f); mhat+=dl; \
        _Pragma("unroll") for(int r=0;r<16;++r){C0[r]-=dl;C1[r]-=dl;} \
        _Pragma("unroll") for(int r=0;r<16;++r)negm[r]=-mhat; asm volatile("":"+v"(negm)); \
        const float f=__builtin_amdgcn_exp2f(-dl); l_reg*=f; if(hi==0)wsf[r32]=f; resc=true; } } \
    SBAR(); \
    GAPB(o[0]=__builtin_amdgcn_mfma_f32_32x32x16_bf16(PAF(0),VFR(0),o[0],0,0,0), C0,0); \
    GAPB(o[1]=__builtin_amdgcn_mfma_f32_32x32x16_bf16(PAF(0),VFR(4),o[1],0,0,0), C0,4); \
    KRD(GL,0); GAPB(o[0]=__builtin_amdgcn_mfma_f32_32x32x16_bf16(PAF(1),VFR(1),o[0],0,0,0), C0,8); \
    KRD(GL,1); GAPB(o[1]=__builtin_amdgcn_mfma_f32_32x32x16_bf16(PAF(1),VFR(5),o[1],0,0,0), C0,12); \
    KRD(GL,2); GAPB(o[0]=__builtin_amdgcn_mfma_f32_32x32x16_bf16(PAF(2),VFR(2),o[0],0,0,0), C1,0); \
    KRD(GL,3); GAPB(o[1]=__builtin_amdgcn_mfma_f32_32x32x16_bf16(PAF(2),VFR(6),o[1],0,0,0), C1,4); \
    GAPB(o[0]=__builtin_amdgcn_mfma_f32_32x32x16_bf16(PAF(3),VFR(3),o[0],0,0,0), C1,8); \
    GAPB(o[1]=__builtin_amdgcn_mfma_f32_32x32x16_bf16(PAF(3),VFR(7),o[1],0,0,0), C1,12); \
    }while(0)
  int t=1;
  #undef CMASK
  #define CMASK(P0,P1,t) do{}while(0)
  for(;t+5<NT;t+=2){
    STEP(pB0,pB1,pA0,pA1,t,true,true,true);     WAIT_BAR(2); RESC(); ROT();
    STEP(pA0,pA1,pB0,pB1,t+1,true,true,true);   WAIT_BAR(2); RESC(); ROT();
  }
  #undef CMASK
  #define CMASK(P0,P1,t) do{}while(0)
  #define ENDW(tt) do{ if((tt)+3<NT){WAIT_BAR(2);} else if((tt)+2<NT){WAIT_BAR(1);} else {WAIT_BAR(0);} }while(0)
  for(;t+1<NT;t+=2){
    STEP(pB0,pB1,pA0,pA1,t,(t+3<NT),(t+1<NT),(t+1<NT));       ENDW(t);   RESC(); ROT();
    STEP(pA0,pA1,pB0,pB1,t+1,(t+4<NT),(t+2<NT),(t+2<NT));     ENDW(t+1); RESC(); ROT();
  }
  STEP(pB0,pB1,pA0,pA1,NT-1,false,false,false); RESC();
  { float sacc=pB0[0]+pB0[1]; _Pragma("unroll") for(int r=2;r<16;++r)sacc+=pB0[r]; _Pragma("unroll") for(int r=0;r<16;++r)sacc+=pB1[r]; l_reg+=sacc;
    pw0=(u32x4){PKW(pB0,0),PKW(pB0,2),PKW(pB0,4),PKW(pB0,6)};pw1=(u32x4){PKW(pB0,8),PKW(pB0,10),PKW(pB0,12),PKW(pB0,14)};pw2=(u32x4){PKW(pB1,0),PKW(pB1,2),PKW(pB1,4),PKW(pB1,6)};pw3=(u32x4){PKW(pB1,8),PKW(pB1,10),PKW(pB1,12),PKW(pB1,14)};
    SBAR(); pv(o,vb0+sl_cur,PAF(0),PAF(1),PAF(2),PAF(3)); }
  #undef PKW
  #undef PAF
  #undef VFR
  #undef PIN
  #undef MX3
  #undef GAPA
  #undef GAPB
  #undef EX
  #undef VRD
  #undef KRD
  #undef STEP
  #undef ENDW
  {auto rr=__builtin_amdgcn_permlane32_swap(__float_as_uint(l_reg),__float_as_uint(l_reg),false,false);l_reg=__uint_as_float(rr[0])+__uint_as_float(rr[1]);}
  if(hi==0)wsf[32+r32]=l_reg;asm volatile("s_waitcnt lgkmcnt(0)":::"memory");
  float rli[16];
  #pragma unroll
  for(int r=0;r<16;++r)rli[r]=__builtin_amdgcn_rcpf(wsf[32+crow(r,hi)]);
  bf16*Ow=O+(rowbase+q0+wid*QBLK)*OP+h*D;
  { bf16*stg=(bf16*)(shm+LDS_OST)+wid*2048;
    #pragma unroll
    for(int r=0;r<16;++r){const int orow=crow(r,hi);
      #pragma unroll
      for(int d0=0;d0<2;++d0)stg[orow*64+d0*32+r32]=__float2bfloat16(o[d0][r]*rli[r]);}
    asm volatile("s_waitcnt lgkmcnt(0)":::"memory");
    #pragma unroll
    for(int i=0;i<4;++i){const int row=i*8+(lane>>3),ch=lane&7; const u32x4 v=*(const u32x4*)(stg+row*64+ch*8); ATTN_STORE16(Ow+(long)row*OP+ch*8,v);} }
  asm volatile("s_waitcnt lgkmcnt(0)\n\ts_barrier":::"memory");
  #undef DMA_K
  #undef DMA_V
  #undef CMASK
  #undef START
  #undef RESC
  #undef ROT
}
constexpr int ATTN_LDS_BYTES=LDS_BYTES;
struct AttnTensors { const bf16* Q; const bf16* K; const bf16* V; bf16* O; };
struct AttnUnit { int bh; int qb; };
struct StaticOrder {
  int vcu,G;
  __device__ __forceinline__ explicit StaticOrder(int grid,int block):vcu((grid%8==0)?(block%8)*(grid/8)+block/8:block),G(grid){}
  __device__ __forceinline__ bool next(int i,AttnUnit&u)const{ const int x=i*G+vcu; if(x>=BATCH*NHEAD*NQB)return false; u.bh=x>>3; u.qb=x&7; return true; }
  __device__ __forceinline__ void a_ready(const AttnUnit&)const{}
  __device__ __forceinline__ void done(const AttnUnit&)const{}
};
template<class Sched,int THRL=8> __device__ __forceinline__ void attn_phase(char*lds,const AttnTensors&T,const Sched&S){
  AttnUnit u;
  for(int i=0;S.next(i,u);++i){ S.a_ready(u); attn_unit<THRL>(u.bh/NHEAD,u.bh%NHEAD,u.qb,T.Q,T.K,T.V,T.O,lds); S.done(u); }
}
#undef SBAR
#undef WAIT_BAR
}
constexpr int NWAVES = 8;
#ifndef DEPTH_
#define DEPTH_ 4
#endif
constexpr int M = 65536, D = 1024, SEQ = 2048, NBATCH = 32, FF = 4096, DPLE = 256, DEPTH = DEPTH_;
constexpr float DN_ALPHA = 1.6817928305074290f;
constexpr float LN_EPS = 1e-6f;
constexpr size_t MiB = 1u << 20;
constexpr size_t WS_W = 2 * MiB;
constexpr size_t WS_WIN = WS_W, WS_WO = WS_W + 28 * MiB, WS_W1G = WS_W + 36 * MiB, WS_W2 = WS_W + 76 * MiB, WS_WP = WS_W + 108 * MiB;
constexpr size_t WS_XN = 114 * MiB;
constexpr size_t WS_PB = 242 * MiB;
constexpr size_t WS_GATES = 274 * MiB;
constexpr size_t WS_QKV = 282 * MiB;
constexpr size_t WS_O = 698 * MiB;
constexpr size_t WS_PP = 826 * MiB;
constexpr size_t WS_H = 282 * MiB;
constexpr size_t WS_END = 954 * MiB;
constexpr int LDS_BYTES = 163840, LDS_CTL = LDS_BYTES - 512;

#define GAS __attribute__((address_space(1)))
#define LAS __attribute__((address_space(3)))
typedef unsigned short bf16;
typedef unsigned v4u __attribute__((ext_vector_type(4)));
typedef float f32x4 __attribute__((ext_vector_type(4)));
typedef short bf16x8 __attribute__((ext_vector_type(8)));
#define LDS_WAIT() asm volatile("s_waitcnt lgkmcnt(0)" ::: "memory")
typedef float f32x2_t_ __attribute__((ext_vector_type(2))); typedef __bf16 bf16x2_t_ __attribute__((ext_vector_type(2)));
__device__ __forceinline__ unsigned pk2(float lo, float hi) { const f32x2_t_ v = {lo, hi}; const bf16x2_t_ b = __builtin_convertvector(v, bf16x2_t_); return __builtin_bit_cast(unsigned, b); }
__device__ __forceinline__ unsigned f2bf(float f) { return pk2(f, f) & 0xffffu; }
__device__ __forceinline__ float bf2f(unsigned short h) { return __uint_as_float(((unsigned)h) << 16); }
__device__ __forceinline__ f32x4 mfma16(bf16x8 a, bf16x8 b, f32x4 c) { return __builtin_amdgcn_mfma_f32_16x16x32_bf16(a, b, c, 0, 0, 0); }
__device__ __forceinline__ float wave_sum(float v) {
#pragma unroll
    for (int o = 1; o < 64; o <<= 1) v += __shfl_xor(v, o);
    return v;
}

struct Args { const float* in[21]; float* out; unsigned char* ws; int skip, pad; };

__device__ __forceinline__ void p0_transpose_item(const float* W, int K, int N, bf16* WT, int row_off, LAS float* scr, int item, int lane) {
    const int nblk = N / 32, kb = item / nblk, nb = item % nblk, k0 = 64 * kb, n0 = 32 * nb;
#pragma unroll
    for (int i = 0; i < 32; ++i) { const int kk = 2 * i + (lane >> 5); scr[kk * 33 + (lane & 31)] = W[(size_t)(k0 + kk) * N + n0 + (lane & 31)]; }
    LDS_WAIT(); asm volatile("" ::: "memory");
    const int c = lane & 7;
#pragma unroll
    for (int j = 0; j < 4; ++j) { const int n = (lane >> 3) + 8 * j; const LAS float* s = scr + (8 * c) * 33 + n;
        v4u o; o.x = pk2(s[0 * 33], s[1 * 33]); o.y = pk2(s[2 * 33], s[3 * 33]); o.z = pk2(s[4 * 33], s[5 * 33]); o.w = pk2(s[6 * 33], s[7 * 33]);
        *(v4u*)(WT + (size_t)(row_off + n0 + n) * K + k0 + 8 * c) = o; }
    LDS_WAIT(); asm volatile("" ::: "memory");
}
struct WDesc { const float* src; int K, N; bf16* dst; int row_off; };
__device__ __forceinline__ WDesc wdesc(const Args& a, int idx) {
    const int l = idx / 6, kind = idx % 6; WDesc w; unsigned char* ws = a.ws;
    if (kind == 0) { w.K = 1024; w.row_off = 0; w.dst = (bf16*)(ws + WS_WIN + (size_t)l * 7 * MiB);
        if (l == 0) { w.src = a.in[2]; w.N = 3072; } else if (l == 1) { w.src = a.in[5]; w.N = 1536; } else if (l == 2) { w.src = a.in[9]; w.N = 3104; } else { w.src = a.in[2] + (size_t)1024 * 3072; w.N = 3072; } }
    else if (kind == 1) { w.K = 1024; w.N = 1024; w.row_off = 0; w.dst = (bf16*)(ws + WS_WO + (size_t)l * 2 * MiB);
        w.src = (l == 0) ? a.in[4] : (l == 1) ? a.in[8] : (l == 2) ? a.in[12] : a.in[4] + (size_t)1024 * 1024; }
    else if (kind == 2) { w.K = 1024; w.N = 4096; w.row_off = 0; w.dst = (bf16*)(ws + WS_W1G + (size_t)l * 10 * MiB); w.src = a.in[15] + (size_t)l * 1024 * 4096; }
    else if (kind == 3) { w.K = 1024; w.N = 1024; w.row_off = 4096; w.dst = (bf16*)(ws + WS_W1G + (size_t)l * 10 * MiB); w.src = a.in[19] + (size_t)l * 1024 * 1024; }
    else if (kind == 4) { w.K = 4096; w.N = 1024; w.row_off = 0; w.dst = (bf16*)(ws + WS_W2 + (size_t)l * 8 * MiB); w.src = a.in[16] + (size_t)l * 4096 * 1024; }
    else { w.K = 256; w.N = 1024; w.row_off = 0; w.dst = (bf16*)(ws + WS_WP + (size_t)l * (MiB / 2)); w.src = a.in[20] + (size_t)l * 256 * 1024; }
    return w;
}
__device__ __forceinline__ void cvt_rows(const float* src, bf16* dst, size_t n, int G) {
    const size_t nth = (size_t)G * 512, n8 = n / 8;
    for (size_t i0 = (size_t)blockIdx.x * 512 + threadIdx.x; i0 < n8; i0 += 4 * nth) {
        f32x4 a[4], b[4];
#pragma unroll
        for (int q = 0; q < 4; ++q) { const size_t i = i0 + q * nth; if (i < n8) { a[q] = *(const f32x4*)(src + i * 8); b[q] = *(const f32x4*)(src + i * 8 + 4); } }
#pragma unroll
        for (int q = 0; q < 4; ++q) { const size_t i = i0 + q * nth; if (i < n8) { v4u o; o.x = pk2(a[q][0], a[q][1]); o.y = pk2(a[q][2], a[q][3]); o.z = pk2(b[q][0], b[q][1]); o.w = pk2(b[q][2], b[q][3]);
            *(v4u*)(dst + i * 8) = o; } }
    }
}
__device__ __forceinline__ void prologue_phase(const Args& a, LAS unsigned char* lds, int G) {
    const int tid = threadIdx.x, lane = tid & 63, wave = tid >> 6;
    LAS float* scr = (LAS float*)(lds + wave * 16384);
    const int gw = blockIdx.x * NWAVES + wave, NGW = G * NWAVES;
    for (int idx = 0; idx < 24; ++idx) { const WDesc w = wdesc(a, idx); const int nitems = (w.K / 64) * (w.N / 32);
        for (int it = gw; it < nitems; it += NGW) p0_transpose_item(w.src, w.K, w.N, w.dst, w.row_off, scr, it, lane); }
    {
        v4u* z = (v4u*)((bf16*)(a.ws + WS_WIN + (size_t)2 * 7 * MiB) + (size_t)3104 * 1024); const size_t n16 = (size_t)224 * 1024 * 2 / 16;
        for (size_t i = (size_t)blockIdx.x * 512 + tid; i < n16; i += (size_t)G * 512) z[i] = (v4u){0u, 0u, 0u, 0u}; }
    cvt_rows(a.in[0], (bf16*)(a.ws + WS_XN), (size_t)M * D, G);
    cvt_rows(a.in[1], (bf16*)(a.ws + WS_PB), (size_t)M * DPLE, G);
}
__device__ __forceinline__ void ln_phase_bf(bf16* X, const float* g, const float* bta, float* outf, int G) {
    const int lane = threadIdx.x & 63, wave = threadIdx.x >> 6; const int gw = blockIdx.x * NWAVES + wave, NGW = G * NWAVES;
    f32x4 gv[4], bv[4];
#pragma unroll
    for (int j = 0; j < 4; ++j) { const int c = (j >> 1) * 512 + 8 * lane + (j & 1) * 4; gv[j] = *(const f32x4*)(g + c); bv[j] = *(const f32x4*)(bta + c); }
    for (int m = gw; m < M; m += NGW) {
        bf16* xr = X + (size_t)m * D + 8 * lane;
        const v4u r0 = *(const v4u*)xr, r1 = *(const v4u*)(xr + 512);
        f32x4 v[4];
        v[0] = (f32x4){__uint_as_float(r0.x << 16), __uint_as_float(r0.x & 0xffff0000u), __uint_as_float(r0.y << 16), __uint_as_float(r0.y & 0xffff0000u)};
        v[1] = (f32x4){__uint_as_float(r0.z << 16), __uint_as_float(r0.z & 0xffff0000u), __uint_as_float(r0.w << 16), __uint_as_float(r0.w & 0xffff0000u)};
        v[2] = (f32x4){__uint_as_float(r1.x << 16), __uint_as_float(r1.x & 0xffff0000u), __uint_as_float(r1.y << 16), __uint_as_float(r1.y & 0xffff0000u)};
        v[3] = (f32x4){__uint_as_float(r1.z << 16), __uint_as_float(r1.z & 0xffff0000u), __uint_as_float(r1.w << 16), __uint_as_float(r1.w & 0xffff0000u)};
        float s = 0.f;
#pragma unroll
        for (int j = 0; j < 4; ++j) s += (v[j][0] + v[j][1]) + (v[j][2] + v[j][3]);
        const float mean = wave_sum(s) * (1.f / D); float s2 = 0.f;
#pragma unroll
        for (int j = 0; j < 4; ++j) { v[j] = v[j] - mean; s2 += (v[j][0] * v[j][0] + v[j][1] * v[j][1]) + (v[j][2] * v[j][2] + v[j][3] * v[j][3]); }
        const float rstd = 1.f / sqrtf(wave_sum(s2) * (1.f / D) + LN_EPS);
#pragma unroll
        for (int j = 0; j < 4; ++j) v[j] = v[j] * rstd * gv[j] + bv[j];
        if (outf) { float* o = outf + (size_t)m * D + 8 * lane; *(f32x4*)o = v[0]; *(f32x4*)(o + 4) = v[1]; *(f32x4*)(o + 512) = v[2]; *(f32x4*)(o + 516) = v[3]; }
        else { *(v4u*)xr = (v4u){pk2(v[0][0], v[0][1]), pk2(v[0][2], v[0][3]), pk2(v[1][0], v[1][1]), pk2(v[1][2], v[1][3])};
               *(v4u*)(xr + 512) = (v4u){pk2(v[2][0], v[2][1]), pk2(v[2][2], v[2][3]), pk2(v[3][0], v[3][1]), pk2(v[3][2], v[3][3])}; }
    }
}

__device__ __forceinline__ void ln_rows32(bf16* X, int row0, const float* g, const float* bta, float* outf) {
    const int lane = threadIdx.x & 63;
    f32x4 gv[4], bv[4];
#pragma unroll
    for (int j = 0; j < 4; ++j) { const int c = (j >> 1) * 512 + 8 * lane + (j & 1) * 4; gv[j] = *(const f32x4*)(g + c); bv[j] = *(const f32x4*)(bta + c); }
    for (int it = 0; it < 8; ++it) {
        v4u r0[4], r1[4];
#pragma unroll
        for (int q = 0; q < 4; ++q) { const bf16* xr = X + (size_t)(row0 + it * 4 + q) * D + 8 * lane; r0[q] = *(const v4u*)xr; r1[q] = *(const v4u*)(xr + 512); }
#pragma unroll
        for (int q = 0; q < 4; ++q) {
            f32x4 v[4];
            v[0] = (f32x4){__uint_as_float(r0[q].x << 16), __uint_as_float(r0[q].x & 0xffff0000u), __uint_as_float(r0[q].y << 16), __uint_as_float(r0[q].y & 0xffff0000u)};
            v[1] = (f32x4){__uint_as_float(r0[q].z << 16), __uint_as_float(r0[q].z & 0xffff0000u), __uint_as_float(r0[q].w << 16), __uint_as_float(r0[q].w & 0xffff0000u)};
            v[2] = (f32x4){__uint_as_float(r1[q].x << 16), __uint_as_float(r1[q].x & 0xffff0000u), __uint_as_float(r1[q].y << 16), __uint_as_float(r1[q].y & 0xffff0000u)};
            v[3] = (f32x4){__uint_as_float(r1[q].z << 16), __uint_as_float(r1[q].z & 0xffff0000u), __uint_as_float(r1[q].w << 16), __uint_as_float(r1[q].w & 0xffff0000u)};
            float s = 0.f;
#pragma unroll
            for (int j = 0; j < 4; ++j) s += (v[j][0] + v[j][1]) + (v[j][2] + v[j][3]);
            const float mean = wave_sum(s) * (1.f / D); float s2 = 0.f;
#pragma unroll
            for (int j = 0; j < 4; ++j) { v[j] = v[j] - mean; s2 += (v[j][0] * v[j][0] + v[j][1] * v[j][1]) + (v[j][2] * v[j][2] + v[j][3] * v[j][3]); }
            const float rstd = 1.f / sqrtf(wave_sum(s2) * (1.f / D) + LN_EPS);
#pragma unroll
            for (int j = 0; j < 4; ++j) v[j] = v[j] * rstd * gv[j] + bv[j];
            const size_t ro = (size_t)(row0 + it * 4 + q) * D + 8 * lane;
            if (outf) { float* o = outf + ro; *(f32x4*)o = v[0]; *(f32x4*)(o + 4) = v[1]; *(f32x4*)(o + 512) = v[2]; *(f32x4*)(o + 516) = v[3]; }
            else { bf16* xr = X + ro; *(v4u*)xr = (v4u){pk2(v[0][0], v[0][1]), pk2(v[0][2], v[0][3]), pk2(v[1][0], v[1][1]), pk2(v[1][2], v[1][3])};
                   *(v4u*)(xr + 512) = (v4u){pk2(v[2][0], v[2][1]), pk2(v[2][2], v[2][3]), pk2(v[3][0], v[3][1]), pk2(v[3][2], v[3][3])}; }
        }
    }
}
struct LnOrder {
    pg8::StaticOrder base; bf16* X; const float* g; const float* bta; float* outf; unsigned* cnt; volatile LAS unsigned* flag;
    __device__ __forceinline__ bool next(int i, pg8::Unit& u) const { return base.next(i, u); }
    __device__ __forceinline__ void a_ready(const pg8::Unit&) const {}
    __device__ __forceinline__ void done(const pg8::Unit& u) const {
        asm volatile("s_waitcnt vmcnt(0)" ::: "memory");
        __builtin_amdgcn_s_barrier();
        if (threadIdx.x == 0) {
            __builtin_amdgcn_fence(__ATOMIC_RELEASE, "agent");
            const unsigned old = __hip_atomic_fetch_add(cnt + u.pm, 1u, __ATOMIC_RELAXED, __HIP_MEMORY_SCOPE_AGENT);
            if (old == 3u) __builtin_amdgcn_fence(__ATOMIC_ACQUIRE, "agent");
            flag[0] = old;
        }
        asm volatile("s_waitcnt vmcnt(0) lgkmcnt(0)" ::: "memory");
        __builtin_amdgcn_s_barrier();
        asm volatile("" ::: "memory");
        if (flag[0] == 3u) ln_rows32(X, u.pm * 256 + (int)(threadIdx.x >> 6) * 32, g, bta, outf);
    }
};

struct PanelLnOrder {
    int nM, G, c; bf16* X; const float* g; const float* bta; float* outf;
    __device__ __forceinline__ bool next(int i, pg8::Unit& u) const { const int p = (i >> 2) * G + c; if (p >= nM) return false; u.pm = p; u.pn = i & 3; return true; }
    __device__ __forceinline__ void a_ready(const pg8::Unit&) const {}
    __device__ __forceinline__ void done(const pg8::Unit& u) const {
        if (u.pn == 3) {
            asm volatile("s_waitcnt vmcnt(0)" ::: "memory");
            __builtin_amdgcn_s_barrier();
            asm volatile("" ::: "memory");
            ln_rows32(X, u.pm * 256 + (int)(threadIdx.x >> 6) * 32, g, bta, outf);
        }
    }
};
typedef unsigned long long u64_t;
#define NA_LBAR() asm volatile("s_waitcnt lgkmcnt(0)\n\ts_barrier" ::: "memory")
__device__ __forceinline__ void na_phase(const bf16* QKV, const float* rpb, bf16* O, LAS unsigned char* lds, int G) {
    const int tid = threadIdx.x, lane = tid & 63, wave = tid >> 6, l15 = lane & 15, quad = lane >> 4;
    const int jq = wave & 3, half = wave >> 2;
    LAS unsigned char* Kimg = lds;
    LAS unsigned char* Vimg = lds + 65536;
    LAS float* scr = (LAS float*)(lds + 131072);
    const int kc0 = (jq == 0) ? 0 : (jq == 1) ? 8 : (jq == 2) ? 24 : 32;
    const int c = jq * 16 + l15, c0 = min(max(c - 8, 0), 48);
    const int scol = tid >> 3, sch = tid & 7;
    for (int bh = blockIdx.x; bh < 512; bh += G) {
        const int b = bh >> 4, h = bh & 15; const size_t tokb = (size_t)b * 2048;
        const bf16* kbase = QKV + (tokb + scol) * 3072 + 1024 + h * 64 + sch * 8;
        const bf16* qbase = QKV + (tokb + c) * 3072 + h * 64 + quad * 8;
        const float* rp = rpb + h * (15 * 31);
        __syncthreads();
#define NA_STAGE_WRITE(kv, vv, slot) do { const int kidx_ = (slot) * 64 + scol; \
            *(LAS v4u*)(Kimg + kidx_ * 128 + ((sch ^ (kidx_ & 7)) * 16)) = (kv); \
            const unsigned vw_[4] = {(vv).x, (vv).y, (vv).z, (vv).w}; \
            _Pragma("unroll") for (int e_ = 0; e_ < 8; ++e_) { const int dh_ = sch * 8 + e_; \
                *(LAS bf16*)(Vimg + ((slot) * 64 + dh_) * 128 + (((scol >> 2) ^ (dh_ & 15)) * 8) + (scol & 3) * 2) = (bf16)((e_ & 1) ? (vw_[e_ >> 1] >> 16) : (vw_[e_ >> 1] & 0xffffu)); } } while (0)
#pragma unroll
        for (int g4 = 0; g4 < 2; ++g4) { v4u kk[4], vv[4];
#pragma unroll
            for (int i = 0; i < 4; ++i) { const bf16* p = kbase + (size_t)(g4 * 4 + i) * 64 * 3072; kk[i] = *(const v4u*)p; vv[i] = *(const v4u*)(p + 1024); }
#pragma unroll
            for (int i = 0; i < 4; ++i) NA_STAGE_WRITE(kk[i], vv[i], g4 * 4 + i); }
        bf16x8 qn0 = *(const bf16x8*)qbase, qn1 = *(const bf16x8*)(qbase + 32);
        __syncthreads();
        int prev_off = 1000; f32x4 bt[4][2];
#pragma unroll
        for (int ai = 0; ai < 4; ++ai) { bt[ai][0] = (f32x4){0.f, 0.f, 0.f, 0.f}; bt[ai][1] = (f32x4){0.f, 0.f, 0.f, 0.f}; }
        for (int r = 0; r < 32; ++r) {
            const int r0 = min(max(r - 4, 0), 24);
            const bf16x8 qf0 = qn0, qf1 = qn1;
            const bool slide = (r + 1 < 32) && (min(max(r - 3, 0), 24) != r0);
            v4u nk = {0u, 0u, 0u, 0u}, nv = {0u, 0u, 0u, 0u};
            if (slide) { const bf16* p = kbase + (size_t)(r0 + 8) * 64 * 3072; nk = *(const v4u*)p; nv = *(const v4u*)(p + 1024); }
            if (r + 1 < 32) { const bf16* p = qbase + (size_t)(r + 1) * 64 * 3072; qn0 = *(const bf16x8*)p; qn1 = *(const bf16x8*)(p + 32); }
            const int off = r0 - r;
            if (off != prev_off) { prev_off = off;
#pragma unroll
                for (int ai = 0; ai < 4; ++ai) { const int dr = off + half * 4 + ai + 7;
#pragma unroll
                    for (int cb = 0; cb < 2; ++cb)
#pragma unroll
                        for (int j = 0; j < 4; ++j) { const int kc = kc0 + cb * 16 + quad * 4 + j; const bool valid = (kc >= c0) && (kc < c0 + 16);
                            const int dc = min(max(kc - c + 15, 0), 30); const float bias = rp[dr * 31 + dc] * 1.4426950408889634f; bt[ai][cb][j] = valid ? bias : -INFINITY; } } }
            f32x4 sc[4][2]; float mx = -INFINITY;
#pragma unroll
            for (int ai = 0; ai < 4; ++ai) { const int slot = (r0 + half * 4 + ai) & 7;
#pragma unroll
                for (int cb = 0; cb < 2; ++cb) { const int kidx = slot * 64 + kc0 + cb * 16 + l15; const LAS unsigned char* ka = Kimg + kidx * 128;
                    const bf16x8 k0 = *(const LAS bf16x8*)(ka + ((quad ^ (kidx & 7)) * 16)), k1 = *(const LAS bf16x8*)(ka + (((quad + 4) ^ (kidx & 7)) * 16));
                    f32x4 acc = {0.f, 0.f, 0.f, 0.f}; acc = mfma16(k0, qf0, acc); acc = mfma16(k1, qf1, acc);
                    acc = acc + bt[ai][cb];
                    mx = fmaxf(fmaxf(fmaxf(mx, acc[0]), fmaxf(acc[1], acc[2])), acc[3]); sc[ai][cb] = acc; } }
            mx = fmaxf(mx, __shfl_xor(mx, 16)); mx = fmaxf(mx, __shfl_xor(mx, 32));
            float sum = 0.f;
#pragma unroll
            for (int ai = 0; ai < 4; ++ai)
#pragma unroll
                for (int cb = 0; cb < 2; ++cb)
#pragma unroll
                    for (int j = 0; j < 4; ++j) { const float p = __builtin_amdgcn_exp2f(sc[ai][cb][j] - mx); sc[ai][cb][j] = p; sum += p; }
            sum += __shfl_xor(sum, 16); sum += __shfl_xor(sum, 32);
            f32x4 o[4];
#pragma unroll
            for (int db = 0; db < 4; ++db) o[db] = (f32x4){0.f, 0.f, 0.f, 0.f};
#pragma unroll
            for (int ai = 0; ai < 4; ++ai) { const int slot = (r0 + half * 4 + ai) & 7;
                const v4u pw = {pk2(sc[ai][0][0], sc[ai][0][1]), pk2(sc[ai][0][2], sc[ai][0][3]), pk2(sc[ai][1][0], sc[ai][1][1]), pk2(sc[ai][1][2], sc[ai][1][3])};
                const bf16x8 pb = __builtin_bit_cast(bf16x8, pw);
                const int ch = (kc0 >> 2) + quad;
#pragma unroll
                for (int db = 0; db < 4; ++db) { const LAS unsigned char* va = Vimg + (slot * 64 + db * 16 + l15) * 128;
                    const u64_t lo = *(const LAS u64_t*)(va + ((ch ^ l15) * 8)), hi = *(const LAS u64_t*)(va + (((ch + 4) ^ l15) * 8));
                    const v4u vw = {(unsigned)lo, (unsigned)(lo >> 32), (unsigned)hi, (unsigned)(hi >> 32)};
                    o[db] = mfma16(__builtin_bit_cast(bf16x8, vw), pb, o[db]); } }
            if (half == 1) { LAS float* s = scr + jq * 18 * 64 + lane; s[0] = mx; s[64] = sum;
#pragma unroll
                for (int db = 0; db < 4; ++db)
#pragma unroll
                    for (int j = 0; j < 4; ++j) s[(2 + db * 4 + j) * 64] = o[db][j]; }
            NA_LBAR();
            if (half == 0) { const LAS float* s = scr + jq * 18 * 64 + lane; const float m1 = s[0], l1 = s[64];
                const float m = fmaxf(mx, m1), f0 = __builtin_amdgcn_exp2f(mx - m), f1 = __builtin_amdgcn_exp2f(m1 - m); const float inv = __builtin_amdgcn_rcpf(sum * f0 + l1 * f1);
                const float g0 = f0 * inv, g1 = f1 * inv;
                bf16* op = O + (tokb + r * 64 + c) * 1024 + h * 64 + quad * 4;
#pragma unroll
                for (int db = 0; db < 4; ++db) { float v[4];
#pragma unroll
                    for (int j = 0; j < 4; ++j) v[j] = o[db][j] * g0 + s[(2 + db * 4 + j) * 64] * g1;
                    *(u64_t*)(op + db * 16) = (u64_t)pk2(v[0], v[1]) | ((u64_t)pk2(v[2], v[3]) << 32); } }
            if (slide) NA_STAGE_WRITE(nk, nv, r0 & 7);
            NA_LBAR();
        }
#undef NA_STAGE_WRITE
    }
}
__device__ __forceinline__ void gq_normrope_item(bf16* QKV, const float* qn, const float* kn, size_t g, const v4u raw) {
    const size_t item = g >> 3; const int l8 = (int)(g & 7); const size_t tok = item / 20; const int hv = (int)(item % 20);
    bf16* p = QKV + tok * 1536 + hv * 64 + l8 * 8;
    const unsigned rw[4] = {raw.x, raw.y, raw.z, raw.w};
    float x[8]; float ss = 0.f;
#pragma unroll
    for (int e = 0; e < 4; ++e) { x[2 * e] = __uint_as_float(rw[e] << 16); x[2 * e + 1] = __uint_as_float(rw[e] & 0xffff0000u); ss += x[2 * e] * x[2 * e] + x[2 * e + 1] * x[2 * e + 1]; }
    ss += __shfl_xor(ss, 1); ss += __shfl_xor(ss, 2); ss += __shfl_xor(ss, 4);
    const float rinv = __builtin_amdgcn_rsqf(ss * (1.f / 64.f) + 1e-6f);
    const float* gvec = ((hv < 16) ? qn : kn) + l8 * 8;
    const int s = (int)(tok & 2047), row = s >> 6, col = s & 63;
    const float scale = (hv < 16) ? (0.125f * 1.4426950408889634f) : 1.0f;
    unsigned ow[4];
#pragma unroll
    for (int pr = 0; pr < 4; ++pr) { const int i = l8 * 4 + pr; const float pos = (float)((i < 16) ? row : col); const int fi = i & 15;
        const float inv = __builtin_amdgcn_exp2f(-(float)fi * (13.287712379549449f / 16.f)); const float ang = pos * inv;
        float rev = ang * 0.15915494309189535f; rev -= rintf(rev);
        const float sn = __builtin_amdgcn_sinf(rev), cs = __builtin_amdgcn_cosf(rev);
        const float x0 = x[2 * pr] * rinv * gvec[2 * pr], x1 = x[2 * pr + 1] * rinv * gvec[2 * pr + 1];
        ow[pr] = pk2((x0 * cs - x1 * sn) * scale, (x0 * sn + x1 * cs) * scale); }
    *(v4u*)p = (v4u){ow[0], ow[1], ow[2], ow[3]};
}
__device__ __forceinline__ void gq_normrope_phase(bf16* QKV, const float* qn, const float* kn, int G) {
    const size_t total = (size_t)M * 20 * 8, nth = (size_t)G * 512;
    size_t g = (size_t)blockIdx.x * 512 + threadIdx.x;
    for (; g + 3 * nth < total; g += 4 * nth) {
        v4u raw[4];
#pragma unroll
        for (int q = 0; q < 4; ++q) { const size_t gi = g + q * nth; const size_t item = gi >> 3; raw[q] = *(const v4u*)(QKV + (item / 20) * 1536 + (item % 20) * 64 + (gi & 7) * 8); }
#pragma unroll
        for (int q = 0; q < 4; ++q) gq_normrope_item(QKV, qn, kn, g + q * nth, raw[q]);
    }
    for (; g < total; g += nth) { const size_t item = g >> 3; const v4u raw = *(const v4u*)(QKV + (item / 20) * 1536 + (item % 20) * 64 + (g & 7) * 8); gq_normrope_item(QKV, qn, kn, g, raw); }
}
__device__ __forceinline__ f32x4 tile_mma64(const LAS bf16* A, int arow0, const LAS bf16* Bt, int brow0, f32x4 acc, int l15, int quad) {
    const LAS bf16* ap = A + (arow0 + l15) * 72 + quad * 8; const LAS bf16* bp = Bt + (brow0 + l15) * 72 + quad * 8;
    acc = mfma16(*(const LAS bf16x8*)ap, *(const LAS bf16x8*)bp, acc);
    acc = mfma16(*(const LAS bf16x8*)(ap + 32), *(const LAS bf16x8*)(bp + 32), acc);
    return acc;
}
__device__ __forceinline__ bf16x8 ml_fp(const LAS bf16* base, int row, int chunk) { return *(const LAS bf16x8*)(base + row * 72 + chunk * 8); }
__device__ __forceinline__ bf16x8 ml_fs(const LAS bf16* base, int row, int chunk) { return *(const LAS bf16x8*)((const LAS unsigned char*)base + row * 128 + ((chunk ^ (row & 7) ^ ((row >> 3) & 7)) * 16)); }
#define ML_TILE(acc_, FA, A_, ar_, FB, B_, br_) do { const int ra_ = (ar_) + l15, rb_ = (br_) + l15; \
    acc_ = mfma16(FA(A_, ra_, quad), FB(B_, rb_, quad), acc_); acc_ = mfma16(FA(A_, ra_, quad + 4), FB(B_, rb_, quad + 4), acc_); } while (0)
__device__ __forceinline__ void ml_phase(const bf16* Z, const float* gates, const float* norm_g, bf16* HFW, bf16* O, LAS unsigned char* lds, int G) {
    const int tid = threadIdx.x, lane = tid & 63, wave = tid >> 6, l15 = lane & 15, quad = lane >> 4;
    LAS bf16* Qs = (LAS bf16*)(lds);
    LAS bf16* Ks = (LAS bf16*)(lds + 9216);
    LAS bf16* Vt = (LAS bf16*)(lds + 18432);
    LAS bf16* Kt = (LAS bf16*)(lds + 39168);
    LAS bf16* Ct = (LAS bf16*)(lds + 48384);
    LAS bf16* As = (LAS bf16*)(lds + 69120);
    LAS float* Hs = (LAS float*)(lds + 78336);
    LAS float* vec = (LAS float*)(lds + 112128);
    for (int unit = blockIdx.x; unit < 256; unit += G) {
        const int b = unit >> 3, h = unit & 7; const size_t tokb = (size_t)b * 2048;
        for (int dir = 0; dir < 2; ++dir) {
            for (int i = tid; i < 144 * 72; i += 512) Ct[i] = 0;
            for (int i = tid; i < 16 * 64; i += 512) Vt[128 * 64 + i] = (i < 64) ? (bf16)0x3F80 : (bf16)0;
            f32x4 cst[4], cst8 = {0.f, 0.f, 0.f, 0.f};
#pragma unroll
            for (int i = 0; i < 4; ++i) cst[i] = (f32x4){0.f, 0.f, 0.f, 0.f};
            float m_run = 0.f;
            const int t8 = tid >> 3, ch = tid & 7;
#define ML_TOK(cs_, t_) (tokb + (size_t)(dir == 0 ? (cs_) * 64 + (t_) : 2047 - ((cs_) * 64 + (t_))))
            v4u pq, pk; bf16x8 pv[2]; float pli = 0.f, pf = 0.f;
#define ML_FETCH(cs_) do { const bf16* zr_ = Z + ML_TOK(cs_, t8) * 3072; pq = *(const v4u*)(zr_ + h * 64 + ch * 8); pk = *(const v4u*)(zr_ + 512 + h * 64 + ch * 8); \
                pv[0] = *(const bf16x8*)(zr_ + 1024 + h * 128 + ch * 8); pv[1] = *(const bf16x8*)(zr_ + 1024 + h * 128 + (ch + 8) * 8); \
                if (wave == 0) { const size_t tk_ = ML_TOK(cs_, lane); pli = gates[tk_ * 32 + dir * 16 + h]; pf = gates[tk_ * 32 + dir * 16 + 8 + h]; } } while (0)
            ML_FETCH(0);
            __syncthreads();
            for (int cs = 0; cs < 32; ++cs) {
                const size_t tok8 = ML_TOK(cs, t8);
                {
                    *(LAS v4u*)(Qs + t8 * 72 + ch * 8) = pq;
                    *(LAS v4u*)(Ks + t8 * 72 + ch * 8) = pk;
#pragma unroll
                    for (int i = 0; i < 2; ++i) { const int c16 = ch + 8 * i;
#pragma unroll
                        for (int e = 0; e < 8; ++e) Vt[(c16 * 8 + e) * 64 + ((((t8 >> 3) ^ e ^ ch) & 7) * 8) + (t8 & 7)] = (bf16)pv[i][e]; }
                }
                const float li = pli, f = pf;
                if (cs + 1 < 32) ML_FETCH(cs + 1);
                v4u hf0 = {0u, 0u, 0u, 0u}, hf1 = {0u, 0u, 0u, 0u}, og0 = {0u, 0u, 0u, 0u}, og1 = {0u, 0u, 0u, 0u};
                if (dir == 1) { const bf16* hp = HFW + tok8 * 1024 + h * 128 + ch * 16; hf0 = *(const v4u*)hp; hf1 = *(const v4u*)(hp + 8);
                    const bf16* og = Z + tok8 * 3072 + 2048 + h * 128 + ch * 16; og0 = *(const v4u*)og; og1 = *(const v4u*)(og + 8); }
                if (wave == 0) {
                    const float lf = fminf(f, 0.f) - log1pf(__expf(-fabsf(f)));
                    float bs = lf;
#pragma unroll
                    for (int o = 1; o < 64; o <<= 1) { const float y = __shfl_up(bs, o); if (lane >= o) bs += y; }
                    const float u = li - bs; float pm = u;
#pragma unroll
                    for (int o = 1; o < 64; o <<= 1) { const float y = __shfl_up(pm, o); if (lane >= o) pm = fmaxf(pm, y); }
                    const float Mt = fmaxf(pm, m_run), sint = __expf(m_run - Mt), mt = bs + Mt;
                    vec[lane] = u; vec[64 + lane] = Mt; vec[128 + lane] = sint; vec[192 + lane] = __expf(-mt);
                    m_run = __shfl(mt, 63);
                }
                NA_LBAR();
                {
                    const int tb = wave >> 1;
#pragma unroll
                    for (int i = 0; i < 2; ++i) { const int sb = 2 * (wave & 1) + i;
                        f32x4 acc = {0.f, 0.f, 0.f, 0.f}; if (sb <= tb) ML_TILE(acc, ml_fp, Qs, tb * 16, ml_fp, Ks, sb * 16);
                        const int s = sb * 16 + l15; const float us = vec[s];
#pragma unroll
                        for (int j = 0; j < 4; ++j) { const int t = tb * 16 + 4 * quad + j; const float w = (s <= t) ? __expf(us - vec[64 + t]) : 0.f; As[t * 72 + s] = (bf16)f2bf(acc[j] * w); } }
                    const float w63 = __expf(vec[t8] - vec[64 + 63]);
                    const bf16x8 kk = *(const LAS bf16x8*)(Ks + t8 * 72 + ch * 8);
#pragma unroll
                    for (int e = 0; e < 8; ++e) Kt[(ch * 8 + e) * 64 + ((((t8 >> 3) ^ e ^ ch) & 7) * 8) + (t8 & 7)] = (bf16)f2bf(bf2f((bf16)kk[e]) * w63);
                }
                NA_LBAR();
                {
#pragma unroll
                    for (int tb = 0; tb < 4; ++tb) { const f32x4 z4 = {0.f, 0.f, 0.f, 0.f};
                        f32x4 ah = z4, ag = z4; ML_TILE(ah, ml_fp, As, tb * 16, ml_fs, Vt, wave * 16); ML_TILE(ag, ml_fp, Qs, tb * 16, ml_fp, Ct, wave * 16);
#pragma unroll
                        for (int j = 0; j < 4; ++j) { const int t = tb * 16 + 4 * quad + j; Hs[t * 132 + wave * 16 + l15] = vec[128 + t] * ag[j] + ah[j]; } }
                    if (wave < 4) { const int tb = wave; const f32x4 z4 = {0.f, 0.f, 0.f, 0.f};
                        f32x4 ah = z4, ag = z4; ML_TILE(ah, ml_fp, As, tb * 16, ml_fs, Vt, 128); ML_TILE(ag, ml_fp, Qs, tb * 16, ml_fp, Ct, 128);
                        if (l15 == 0) {
#pragma unroll
                            for (int j = 0; j < 4; ++j) { const int t = tb * 16 + 4 * quad + j; vec[256 + t] = vec[128 + t] * ag[j] + ah[j]; } } }
                }
                NA_LBAR();
                {
                    const float decay = vec[128 + 63];
#pragma unroll
                    for (int db = 0; db < 4; ++db) { cst[db] = cst[db] * decay; ML_TILE(cst[db], ml_fs, Vt, wave * 16, ml_fs, Kt, db * 16);
#pragma unroll
                        for (int j = 0; j < 4; ++j) Ct[(wave * 16 + 4 * quad + j) * 72 + db * 16 + l15] = (bf16)f2bf(cst[db][j]); }
                    if (wave < 4) { cst8 = cst8 * decay; ML_TILE(cst8, ml_fs, Vt, 128, ml_fs, Kt, wave * 16);
#pragma unroll
                        for (int j = 0; j < 4; ++j) Ct[(128 + 4 * quad + j) * 72 + wave * 16 + l15] = (bf16)f2bf(cst8[j]); }
                    const float dn = fmaxf(fabsf(vec[256 + t8]), vec[192 + t8]); const float rd = __builtin_amdgcn_rcpf(dn);
                    float hv[16];
#pragma unroll
                    for (int e = 0; e < 16; ++e) hv[e] = Hs[t8 * 132 + ch * 16 + e] * rd;
                    const size_t ho = tok8 * 1024 + h * 128 + ch * 16;
                    if (dir == 0) {
                        v4u w0, w1; w0.x = pk2(hv[0], hv[1]); w0.y = pk2(hv[2], hv[3]); w0.z = pk2(hv[4], hv[5]); w0.w = pk2(hv[6], hv[7]);
                        w1.x = pk2(hv[8], hv[9]); w1.y = pk2(hv[10], hv[11]); w1.z = pk2(hv[12], hv[13]); w1.w = pk2(hv[14], hv[15]);
                        *(v4u*)(HFW + ho) = w0; *(v4u*)(HFW + ho + 8) = w1;
                    } else {
                        const unsigned fw[8] = {hf0.x, hf0.y, hf0.z, hf0.w, hf1.x, hf1.y, hf1.z, hf1.w};
                        float ss = 0.f;
#pragma unroll
                        for (int e = 0; e < 8; ++e) { hv[2 * e] += __uint_as_float(fw[e] << 16); hv[2 * e + 1] += __uint_as_float(fw[e] & 0xffff0000u); ss += hv[2 * e] * hv[2 * e] + hv[2 * e + 1] * hv[2 * e + 1]; }
                        ss += __shfl_xor(ss, 1); ss += __shfl_xor(ss, 2); ss += __shfl_xor(ss, 4);
                        const float rinv = __builtin_amdgcn_rsqf(ss * (1.f / 128.f) + 1e-6f);
                        const unsigned gw_[8] = {og0.x, og0.y, og0.z, og0.w, og1.x, og1.y, og1.z, og1.w};
                        const float* ng = norm_g + h * 128 + ch * 16;
                        unsigned ow[8];
#pragma unroll
                        for (int e = 0; e < 8; ++e) { const float o0 = __builtin_amdgcn_rcpf(1.0f + __expf(-__uint_as_float(gw_[e] << 16))), o1 = __builtin_amdgcn_rcpf(1.0f + __expf(-__uint_as_float(gw_[e] & 0xffff0000u)));
                            ow[e] = pk2(hv[2 * e] * rinv * ng[2 * e] * o0, hv[2 * e + 1] * rinv * ng[2 * e + 1] * o1); }
                        *(v4u*)(O + ho) = (v4u){ow[0], ow[1], ow[2], ow[3]}; *(v4u*)(O + ho + 8) = (v4u){ow[4], ow[5], ow[6], ow[7]};
                    }
                }
                NA_LBAR();
            }
#undef ML_FETCH
#undef ML_TOK
        }
    }
}
#define RLX_AGENT __ATOMIC_RELAXED, __HIP_MEMORY_SCOPE_AGENT
#define XB_TMO      128
#define XB_XCNT(j)  (256  + 64 * (j))
#define XB_XSUB(j)  (1280 + 64 * (j))
#define XB_XGEN(j)  (2304 + 64 * (j))
#define XB_TOP      3328
#define XB_TOPGEN   3392
#define XCD_BAR_WORDS 3456
#define XB_SPIN_CAP (1u << 18)

__device__ __forceinline__ unsigned xb_ld(unsigned* p)              { return __hip_atomic_load(p, __ATOMIC_RELAXED, __HIP_MEMORY_SCOPE_AGENT); }
__device__ __forceinline__ unsigned xb_add(unsigned* p, unsigned v) { return __hip_atomic_fetch_add(p, v, __ATOMIC_RELAXED, __HIP_MEMORY_SCOPE_AGENT); }
__device__ __forceinline__ unsigned xb_xcc_id() { return (unsigned)__builtin_amdgcn_s_getreg((3 << 11) | 20) & 0xFu; }
#define XB_SPIN(cond, bar) do { unsigned _sp = 0; while (cond) { __builtin_amdgcn_s_sleep(1); \
    if ((++_sp & 255u) == 0u) { if (xb_ld(&(bar)[XB_TMO])) break; if (_sp > XB_SPIN_CAP) { atomicAdd(&(bar)[XB_TMO], 1u); break; } } } } while (0)

struct XcdBarrier {
    unsigned* bar; unsigned x;
    volatile LAS unsigned* st;
};

__device__ __forceinline__ XcdBarrier xcd_barrier_post(unsigned* bar, volatile LAS unsigned* st) {
    XcdBarrier b; b.bar = bar; b.x = xb_xcc_id(); b.st = st;
    if (threadIdx.x == 0) (void)xb_add(&bar[XB_XCNT(b.x)], 1u);
    return b;
}
__device__ __forceinline__ void xcd_barrier_complete(unsigned* bar, unsigned x, unsigned& nloc, unsigned& nx) {
    const unsigned G = gridDim.x * gridDim.y * gridDim.z;
    unsigned sum, cnt, mine, sp = 0u;
    for (;;) {
        sum = 0u; cnt = 0u; mine = 0u;
#pragma unroll
        for (unsigned j = 0; j < 16; ++j) { const unsigned c = xb_ld(&bar[XB_XCNT(j)]); sum += c; cnt += (c > 0u) ? 1u : 0u; mine = (j == x) ? c : mine; }
        if (sum == G) break;
        __builtin_amdgcn_s_sleep(1);
        if ((++sp & 255u) == 0u) { if (xb_ld(&bar[XB_TMO])) break; if (sp > XB_SPIN_CAP) { atomicAdd(&bar[XB_TMO], 1u); break; } }
    }
    nloc = mine > 0u ? mine : 1u; nx = cnt > 0u ? cnt : 1u;
}

__device__ __forceinline__ void xcd_barrier(const XcdBarrier& b) {
    asm volatile("s_waitcnt vmcnt(0)" ::: "memory");
    __syncthreads();
    if (threadIdx.x == 0) {
        unsigned* bar = b.bar;
        __builtin_amdgcn_s_waitcnt(0);
        unsigned nloc = b.st[0], nx = b.st[1];
        if (nloc == 0u) { xcd_barrier_complete(bar, b.x, nloc, nx); b.st[0] = nloc; b.st[1] = nx; }
        const unsigned old = xb_add(&bar[XB_XSUB(b.x)], 1u);
        const unsigned gen = old / nloc;
        if (old + 1u == (gen + 1u) * nloc) {
            __builtin_amdgcn_fence(__ATOMIC_RELEASE, "agent");
            asm volatile("s_waitcnt vmcnt(0)" ::: "memory");
            const unsigned og = xb_add(&bar[XB_TOP], 1u);
            const unsigned tg = og / nx;
            if (og + 1u == (tg + 1u) * nx) xb_add(&bar[XB_TOPGEN], 1u);
            else XB_SPIN(xb_ld(&bar[XB_TOPGEN]) == tg, bar);
            __builtin_amdgcn_fence(__ATOMIC_ACQUIRE, "agent");
            xb_add(&bar[XB_XGEN(b.x)], 1u);
            asm volatile("s_waitcnt vmcnt(0)" ::: "memory");
        } else {
            XB_SPIN(xb_ld(&bar[XB_XGEN(b.x)]) == gen, bar);
            __builtin_amdgcn_fence(__ATOMIC_ACQUIRE, "agent");
            asm volatile("s_waitcnt vmcnt(0)" ::: "memory");
        }
    }
    __syncthreads();
}

#define GSYNC() xcd_barrier(bar)
#define SKIP(bit) ((skipmask >> (bit)) & 1)
template <int L> __device__ __forceinline__ void layer_program(const Args& a, LAS unsigned char* lds, unsigned char* lds_raw, const int G, const XcdBarrier& bar, const int skipmask) {
    constexpr int kind = L % 3;
    unsigned char* ws = a.ws;
    bf16* XN = (bf16*)(ws + WS_XN); bf16* QKV = (bf16*)(ws + WS_QKV); bf16* OB = (bf16*)(ws + WS_O); bf16* PP = (bf16*)(ws + WS_PP); bf16* HB = (bf16*)(ws + WS_H);
    if (!SKIP(1)) { const bf16* Win = (const bf16*)(ws + WS_WIN + (size_t)L * 7 * MiB);
        if constexpr (kind == 2) { pg8::Gemm g{XN, Win, M, 3328, D}; pg8::StaticOrder S; S.init(M, 3328, G, (int)blockIdx.x);
            pg8::EpiMl E{QKV, (float*)(ws + WS_GATES), a.in[10]};
            pg8::gemm_phase<pg8::EpiMl, pg8::StaticOrder, true, true>(lds, g, S, E); }
        else { constexpr int N = (kind == 0) ? 3072 : 1536; pg8::Gemm g{XN, Win, M, N, D}; pg8::StaticOrder S; S.init(M, N, G, (int)blockIdx.x);
            pg8::EpiPlain E{QKV, N, (kind == 0) ? 1024 : 0, 0.125f * 1.4426950408889634f};
            pg8::gemm_phase<pg8::EpiPlain, pg8::StaticOrder, true, true>(lds, g, S, E); } }
    if (!SKIP(2)) { pg8::Gemm g{(const bf16*)(ws + WS_PB), (const bf16*)(ws + WS_WP + (size_t)L * (MiB / 2)), M, D, DPLE}; pg8::StaticOrder S; S.init(M, D, G, (int)blockIdx.x);
        pg8::EpiPlain E{PP, D, 0, 1.f};
        pg8::gemm_phase<pg8::EpiPlain, pg8::StaticOrder, true, true>(lds, g, S, E); }
    GSYNC();
    if constexpr (kind == 1) { if (!SKIP(3)) gq_normrope_phase(QKV, a.in[6], a.in[7], G); GSYNC(); }
    if (!SKIP(4)) {
        if constexpr (kind == 0) na_phase(QKV, a.in[3] + (size_t)(L / 3) * 16 * 15 * 31, OB, lds, G);
        else if constexpr (kind == 1) { const attn_body::AttnTensors AT{(const attn_body::bf16*)QKV, (const attn_body::bf16*)(QKV + 1024), (const attn_body::bf16*)(QKV + 1280), (attn_body::bf16*)OB};
            const attn_body::StaticOrder S(G, (int)blockIdx.x); attn_body::attn_phase<attn_body::StaticOrder>((char*)lds_raw, AT, S); }
        else ml_phase(QKV, (const float*)(ws + WS_GATES), a.in[11], (bf16*)a.out, OB, lds, G);
    }
    GSYNC();
    if (!SKIP(5)) { pg8::Gemm g{OB, (const bf16*)(ws + WS_WO + (size_t)L * 2 * MiB), M, D, D};
        PanelLnOrder S; S.nM = M / 256; S.G = G; S.c = (int)blockIdx.x; S.X = XN; S.g = a.in[13] + (size_t)L * D; S.bta = a.in[14] + (size_t)L * D; S.outf = nullptr;
        pg8::EpiResidBf E{XN, nullptr, DN_ALPHA};
        pg8::gemm_phase<pg8::EpiResidBf, PanelLnOrder, true, true>(lds, g, S, E); }
    GSYNC();
    if (!SKIP(7)) { if constexpr (L + 1 < DEPTH) cvt_rows(a.in[1] + (size_t)(L + 1) * M * DPLE, (bf16*)(ws + WS_PB), (size_t)M * DPLE, G);
        pg8::Gemm g{XN, (const bf16*)(ws + WS_W1G + (size_t)L * 10 * MiB), M, FF + D, D}; pg8::StaticOrder S; S.init(M, FF + D, G, (int)blockIdx.x);
        pg8::EpiFf1 E{HB, PP};
        pg8::gemm_phase<pg8::EpiFf1, pg8::StaticOrder, true, true>(lds, g, S, E); }
    GSYNC();
    if (!SKIP(8)) { pg8::Gemm g{HB, (const bf16*)(ws + WS_W2 + (size_t)L * 8 * MiB), M, D, FF}; pg8::StaticOrder S; S.init(M, D, G, (int)blockIdx.x);
        pg8::EpiResidBf E{XN, PP, DN_ALPHA};
        pg8::gemm_phase<pg8::EpiResidBf, pg8::StaticOrder, true, true>(lds, g, S, E); }
    GSYNC();
    if (!SKIP(9)) { for (int r0 = ((int)blockIdx.x * NWAVES + (int)(threadIdx.x >> 6)) * 32; r0 < M; r0 += G * NWAVES * 32)
            ln_rows32(XN, r0, a.in[17] + (size_t)L * D, a.in[18] + (size_t)L * D, (L + 1 < DEPTH) ? nullptr : a.out); }
    if constexpr (L + 1 < DEPTH) GSYNC();
}
__global__ void __launch_bounds__(NWAVES * 64, 2) fwd_megakernel(Args a) {
    extern __shared__ __attribute__((aligned(16))) unsigned char lds_raw[];
    LAS unsigned char* lds = (LAS unsigned char*)lds_raw;
    cg::grid_group grid = cg::this_grid();
    const int G = gridDim.x;
    { volatile LAS unsigned* z = (volatile LAS unsigned*)(lds + LDS_CTL); if (threadIdx.x < 64) z[threadIdx.x] = 0u; }
    __syncthreads();
    const XcdBarrier bar = xcd_barrier_post((unsigned*)a.ws + 4096, (volatile LAS unsigned*)(lds + LDS_CTL + 64));
#ifdef PROBE_SKIP
#ifndef PROBE_LAYERS
#define PROBE_LAYERS 15
#endif
    {
        const int skipmask = a.skip;
        if (!SKIP(0)) prologue_phase(a, lds, G);
        GSYNC();
        if ((PROBE_LAYERS >> 0) & 1) layer_program<0>(a, lds, lds_raw, G, bar, skipmask); GSYNC();
        if ((PROBE_LAYERS >> 1) & 1) layer_program<1>(a, lds, lds_raw, G, bar, skipmask); GSYNC();
        if ((PROBE_LAYERS >> 2) & 1) layer_program<2>(a, lds, lds_raw, G, bar, skipmask); GSYNC();
        if ((PROBE_LAYERS >> 3) & 1) layer_program<3>(a, lds, lds_raw, G, bar, skipmask); GSYNC();
    }
#endif
    {
        const int skipmask = a.pad;
        if (!SKIP(0)) prologue_phase(a, lds, G);
        grid.sync();
        layer_program<0>(a, lds, lds_raw, G, bar, skipmask);
        layer_program<1>(a, lds, lds_raw, G, bar, skipmask);
        layer_program<2>(a, lds, lds_raw, G, bar, skipmask);
        layer_program<3>(a, lds, lds_raw, G, bar, skipmask);
    }
}
#undef SKIP

extern "C" void kernel_launch(void* const* d_in, const int* in_sizes, int n_in, void* d_out, int out_size, void* d_ws, size_t ws_size, hipStream_t stream) {
    static int grid = 0;
    if (grid == 0) {
        if (n_in != 21 || out_size != M * D || ws_size < WS_END) { fprintf(stderr, "kernel_launch: unexpected shapes (n_in %d, out %d, ws %zu)\n", n_in, out_size, ws_size); grid = -1; return; }
        int dev = 0, cus = 0, per_cu = 0;
        hipGetDevice(&dev); hipDeviceGetAttribute(&cus, hipDeviceAttributeMultiprocessorCount, dev);
        if (hipFuncSetAttribute((const void*)fwd_megakernel, hipFuncAttributeMaxDynamicSharedMemorySize, LDS_BYTES) != hipSuccess) { fprintf(stderr, "kernel_launch: hipFuncSetAttribute failed\n"); grid = -1; return; }
        if (hipOccupancyMaxActiveBlocksPerMultiprocessor(&per_cu, (const void*)fwd_megakernel, NWAVES * 64, LDS_BYTES) != hipSuccess || per_cu < 1) per_cu = 1;
        (void)hipGetLastError();
        grid = cus * per_cu;
        fprintf(stderr, "kernel_launch: grid %d (cus %d x %d)\n", grid, cus, per_cu);
    }
    if (grid < 0) return;
    Args a{};
    for (int i = 0; i < 21; ++i) a.in[i] = (const float*)d_in[i];
    a.out = (float*)d_out; a.ws = (unsigned char*)d_ws;
#ifdef PROBE_SKIP
    a.skip = PROBE_SKIP;
#else
    a.skip = 0;
#endif
    a.pad = 0;
    if (hipMemsetAsync(d_ws, 0, 65536, stream) != hipSuccess) { fprintf(stderr, "kernel_launch: hipMemsetAsync failed\n"); return; }
    void* args[] = {&a};
    const hipError_t e = hipLaunchCooperativeKernel((const void*)fwd_megakernel, dim3(grid), dim3(NWAVES * 64), args, LDS_BYTES, stream);
    if (e != hipSuccess) fprintf(stderr, "kernel_launch: cooperative launch failed: %s (grid %d)\n", hipGetErrorString(e), grid);
}
```
